# Optimizing an MI355X kernel written in HIP

```python
import numpy as np
import jax, jax.numpy as jnp
from jax import lax

D_MODEL = 4096
BATCH = 4
SEQ = 2048
DEPTH = 2

HEAD_DIM = 128
H_GDN = 16
GDN_CONV = 4
GDN_CHUNK = 64
H_NSA = 16
G_NSA = 4
HPG_NSA = H_NSA // G_NSA
L_CMP = 32
S_CMP = 16
L_SLC = 64
N_SEL = 8
WINDOW = 512
SLC_QBLOCK = 64
FORCE_SCORE = 1e4
H_HGRN = 16
HGRN_CHUNK = 64
H_FOX = 16
ATT_QBLOCK = 128
D_FF = 11008
FFN_CONV = 3
D_PLE = 256
EPS = 1e-6

N_AB = (DEPTH + 1) // 2
N_CD = DEPTH // 2
AB_SPLITS = [3 * H_GDN * HEAD_DIM, H_GDN, H_GDN, H_GDN * HEAD_DIM,
             H_NSA * HEAD_DIM, 6 * G_NSA * HEAD_DIM, 3 * H_NSA]
CD_SPLITS = [H_HGRN * HEAD_DIM] * 4 + [3 * H_FOX * HEAD_DIM, H_FOX]
AB_IN = sum(AB_SPLITS)
CD_IN = sum(CD_SPLITS)
AB_OUT = (H_GDN + H_NSA) * HEAD_DIM
CD_OUT = (H_HGRN + H_FOX) * HEAD_DIM

kernel_name = 'hybrid_gdn_nsa_hgrn2_fox_block'

F32 = jnp.float32


def rmsnorm(z, w):
    zf = z.astype(F32)
    y = zf * lax.rsqrt(jnp.mean(zf * zf, -1, keepdims=True) + EPS)
    return (y * w.astype(F32)).astype(z.dtype)


def l2norm(z):
    return z * lax.rsqrt(jnp.sum(z * z, -1, keepdims=True) + EPS)


def masked_softmax(s, mask):
    s = jnp.where(mask, s, -jnp.inf)
    m = jnp.max(s, -1, keepdims=True)
    e = jnp.exp(s - jnp.where(jnp.isfinite(m), m, 0.0))
    d = jnp.sum(e, -1, keepdims=True)
    return e / jnp.where(d > 0, d, 1.0)


def causal_dwconv(z, w):
    k, t = w.shape[0], z.shape[1]
    zp = jnp.pad(z, ((0, 0), (k - 1, 0), (0, 0)))
    y = zp[:, :t] * w[0]
    for j in range(1, k):
        y = y + zp[:, j:j + t] * w[j]
    return y


def split_cols(z, sizes):
    return jnp.split(z, np.cumsum(sizes)[:-1].tolist(), axis=-1)


def split_blocks(z, axis, size):
    shp = z.shape
    z = z.reshape(shp[:axis] + (shp[axis] // size, size) + shp[axis + 1:])
    return jnp.moveaxis(z, axis, 0)


def merge_blocks(z, axis):
    z = jnp.moveaxis(z, 0, axis)
    shp = z.shape
    return z.reshape(shp[:axis] + (shp[axis] * shp[axis + 1],) + shp[axis + 2:])


def gated_deltanet(qkv, a, b, gate, conv_w, a_log, dt_bias, norm_w):
    bsz, t, _ = qkv.shape
    c = GDN_CHUNK
    z = jax.nn.silu(causal_dwconv(qkv, conv_w)).astype(F32)
    z = z.reshape(bsz, t, 3, H_GDN, HEAD_DIM).transpose(2, 0, 3, 1, 4)
    q = l2norm(z[0]) * HEAD_DIM ** -0.5
    k = l2norm(z[1])
    v = z[2]
    beta = jax.nn.sigmoid(b.astype(F32)).transpose(0, 2, 1)
    g = (-jnp.exp(a_log.astype(F32)) * jax.nn.softplus(a.astype(F32) + dt_bias.astype(F32))).transpose(0, 2, 1)
    qc, kc, vc = (split_blocks(u, 2, c) for u in (q, k, v))
    bc = split_blocks(beta, 2, c)
    gam = jnp.cumsum(split_blocks(g, 2, c), -1)
    incl = jnp.tril(jnp.ones((c, c), bool))
    strict = jnp.tril(jnp.ones((c, c), bool), -1)
    dec = jnp.exp(jnp.where(incl, gam[..., :, None] - gam[..., None, :], -jnp.inf))
    a_mat = jnp.where(strict, bc[..., :, None] * dec * jnp.einsum('nbhrd,nbhjd->nbhrj', kc, kc), 0.0)
    rhs = jnp.concatenate([vc * bc[..., None], kc * (bc * jnp.exp(gam))[..., None]], -1)
    sol = lax.linalg.triangular_solve(a_mat + jnp.eye(c, dtype=F32), rhs, left_side=True,
                                      lower=True, unit_diagonal=True)
    u0, w = sol[..., :HEAD_DIM], sol[..., HEAD_DIM:]
    qk = dec * jnp.einsum('nbhrd,nbhjd->nbhrj', qc, kc)
    q_dec = qc * jnp.exp(gam)[..., None]
    k_dec = kc * jnp.exp(gam[..., -1:] - gam)[..., None]
    g_last = jnp.exp(gam[..., -1])

    def step(s, xs):
        u0_n, w_n, qk_n, qd_n, kd_n, gl_n = xs
        u = u0_n - jnp.einsum('bhcd,bhde->bhce', w_n, s)
        o = jnp.einsum('bhcd,bhde->bhce', qd_n, s) + jnp.einsum('bhcj,bhje->bhce', qk_n, u)
        s = s * gl_n[..., None, None] + jnp.einsum('bhcd,bhce->bhde', kd_n, u)
        return s, o

    s0 = jnp.zeros((bsz, H_GDN, HEAD_DIM, HEAD_DIM), F32)
    _, o = lax.scan(step, s0, (u0, w, qk, q_dec, k_dec, g_last))
    o = merge_blocks(o, 2).transpose(0, 2, 1, 3)
    o = rmsnorm(o, norm_w) * jax.nn.silu(gate.astype(F32).reshape(bsz, t, H_GDN, HEAD_DIM))
    return o.reshape(bsz, t, H_GDN * HEAD_DIM)


def nsa_attention(q, kv, gates, pe_k, pe_v, wk1, wk2, wv1, wv2):
    bsz, t, _ = q.shape
    q = q.astype(F32).reshape(bsz, t, G_NSA, HPG_NSA, HEAD_DIM).transpose(0, 2, 3, 1, 4) * HEAD_DIM ** -0.5
    k_c, v_c, k_s, v_s, k_w, v_w = kv.astype(F32).reshape(bsz, t, 6, G_NSA, HEAD_DIM).transpose(2, 0, 3, 1, 4)
    pos = jnp.arange(t, dtype=jnp.int32)

    n_cmp = (t - L_CMP) // S_CMP + 1
    cmp_idx = np.arange(n_cmp)[:, None] * S_CMP + np.arange(L_CMP)[None, :]

    def compress(z, pe, w1, w2):
        zb = (z[:, :, cmp_idx] + pe.astype(F32)).reshape(bsz, G_NSA, n_cmp, L_CMP * HEAD_DIM)
        return jax.nn.silu(zb @ w1.astype(F32)) @ w2.astype(F32)

    kc = compress(k_c, pe_k, wk1, wk2)
    vc = compress(v_c, pe_v, wv1, wv2)
    cmp_mask = jnp.asarray(cmp_idx[:, -1], jnp.int32)[None, :] <= pos[:, None]
    p_cmp = masked_softmax(jnp.einsum('bgptd,bgnd->bgptn', q, kc), cmp_mask)
    o_cmp = jnp.einsum('bgptn,bgnd->bgptd', p_cmp, vc)

    n_slc = t // L_SLC
    cs = np.arange(n_cmp) * S_CMP
    ss = np.arange(n_slc) * L_SLC
    overlap = ((cs[:, None] < ss[None, :] + L_SLC) & (cs[:, None] + L_CMP > ss[None, :])).astype(np.float32)
    imp = jnp.einsum('bgptn,nm->bgtm', p_cmp, jnp.asarray(overlap))
    blk = jnp.arange(n_slc, dtype=jnp.int32)[None, :]
    cur = (pos // L_SLC)[:, None]
    valid = blk <= cur
    forced = (blk == 0) | (blk == cur) | (blk == cur - 1)
    score = jnp.where(valid, jnp.where(forced, FORCE_SCORE, imp), -jnp.inf)
    n_top = min(N_SEL, n_slc)
    top_val, top_idx = lax.top_k(score, n_top)
    top_ok = jnp.isfinite(top_val)
    kb = k_s.reshape(bsz, G_NSA, n_slc, L_SLC, HEAD_DIM)
    vb = v_s.reshape(bsz, G_NSA, n_slc, L_SLC, HEAD_DIM)
    gather = jax.vmap(jax.vmap(lambda z, i: z[i]))
    offs = jnp.arange(L_SLC, dtype=jnp.int32)
    n_keys = n_top * L_SLC

    def slc_block(xs):
        qb, ib, okb, tb = xs
        ks = gather(kb, ib).reshape(bsz, G_NSA, SLC_QBLOCK, n_keys, HEAD_DIM)
        vs = gather(vb, ib).reshape(bsz, G_NSA, SLC_QBLOCK, n_keys, HEAD_DIM)
        tok = (ib[..., None] * L_SLC + offs).reshape(bsz, G_NSA, SLC_QBLOCK, n_keys)
        ok = jnp.repeat(okb, L_SLC, axis=-1) & (tok <= tb[:, None])
        pr = masked_softmax(jnp.einsum('bgpqd,bgqmd->bgpqm', qb, ks), ok[:, :, None])
        return jnp.einsum('bgpqm,bgqmd->bgpqd', pr, vs)

    o_slc = merge_blocks(lax.map(slc_block, (split_blocks(q, 3, SLC_QBLOCK),
                                             split_blocks(top_idx, 2, SLC_QBLOCK),
                                             split_blocks(top_ok, 2, SLC_QBLOCK),
                                             pos.reshape(-1, SLC_QBLOCK))), 3)

    kwp = jnp.pad(k_w, ((0, 0), (0, 0), (WINDOW, 0), (0, 0)))
    vwp = jnp.pad(v_w, ((0, 0), (0, 0), (WINDOW, 0), (0, 0)))
    span = WINDOW + ATT_QBLOCK

    def win_block(xs):
        qb, q0 = xs
        kk = lax.dynamic_slice_in_dim(kwp, q0, span, axis=2)
        vv = lax.dynamic_slice_in_dim(vwp, q0, span, axis=2)
        tq = q0 + jnp.arange(ATT_QBLOCK, dtype=jnp.int32)
        ts = q0 - WINDOW + jnp.arange(span, dtype=jnp.int32)
        d = tq[:, None] - ts[None, :]
        m = (d >= 0) & (d < WINDOW) & (ts[None, :] >= 0)
        pr = masked_softmax(jnp.einsum('bgpqd,bgkd->bgpqk', qb, kk), m)
        return jnp.einsum('bgpqk,bgkd->bgpqd', pr, vv)

    q0s = jnp.arange(t // ATT_QBLOCK, dtype=jnp.int32) * ATT_QBLOCK
    o_win = merge_blocks(lax.map(win_block, (split_blocks(q, 3, ATT_QBLOCK), q0s)), 3)

    gt = jax.nn.sigmoid(gates.astype(F32)).reshape(bsz, t, 3, G_NSA, HPG_NSA).transpose(2, 0, 3, 4, 1)[..., None]
    o = gt[0] * o_cmp + gt[1] * o_slc + gt[2] * o_win
    return o.transpose(0, 3, 1, 2, 4).reshape(bsz, t, H_NSA * HEAD_DIM)


def hgrn2(q, f, i, g, lb, norm_w):
    bsz, t, _ = q.shape
    c = HGRN_CHUNK
    shp = (bsz, t, H_HGRN, HEAD_DIM)
    lb = lb.astype(F32).reshape(H_HGRN, HEAD_DIM)
    fx = f.astype(F32).reshape(shp)
    log_f = jnp.logaddexp(jnp.log(lb), jnp.log1p(-lb) + jax.nn.log_sigmoid(fx))
    k = (1.0 - lb) * jax.nn.sigmoid(-fx)
    q = jax.nn.silu(q.astype(F32)).reshape(shp)
    v = i.astype(F32).reshape(shp)
    qc, kc, vc, lfc = (split_blocks(u.transpose(0, 2, 1, 3), 2, c) for u in (q, k, v, log_f))
    bcum = jnp.cumsum(lfc, axis=3)
    incl = jnp.tril(jnp.ones((c, c), bool))[:, :, None]

    def step(s, xs):
        q_n, k_n, v_n, b_n = xs
        dec = jnp.exp(jnp.where(incl, b_n[:, :, :, None, :] - b_n[:, :, None, :, :], -jnp.inf))
        att = jnp.einsum('bhrd,bhjd,bhrjd->bhrj', q_n, k_n, dec)
        b_last = b_n[:, :, -1]
        o = jnp.einsum('bhrd,bhde->bhre', q_n * jnp.exp(b_n), s) + jnp.einsum('bhrj,bhje->bhre', att, v_n)
        s = s * jnp.exp(b_last)[..., None] + jnp.einsum('bhjd,bhje->bhde', k_n * jnp.exp(b_last[:, :, None] - b_n), v_n)
        return s, o

    s0 = jnp.zeros((bsz, H_HGRN, HEAD_DIM, HEAD_DIM), F32)
    _, o = lax.scan(step, s0, (qc, kc, vc, bcum))
    o = merge_blocks(o, 2).transpose(0, 2, 1, 3)
    o = rmsnorm(o, norm_w) * jax.nn.silu(g.astype(F32).reshape(shp))
    return o.reshape(bsz, t, H_HGRN * HEAD_DIM)


def forgetting_attention(qkv, fgate, f_bias):
    bsz, t, _ = qkv.shape
    z = qkv.astype(F32).reshape(bsz, t, 3, H_FOX, HEAD_DIM).transpose(2, 0, 3, 1, 4)
    q, k, v = z[0] * HEAD_DIM ** -0.5, z[1], z[2]
    cum = jnp.cumsum(jax.nn.log_sigmoid(fgate.astype(F32) + f_bias.astype(F32)), axis=1).transpose(0, 2, 1)
    pos = jnp.arange(t, dtype=jnp.int32)

    def blk(xs):
        qb, cb, tq = xs
        s = jnp.einsum('bhqd,bhkd->bhqk', qb, k) + cb[..., None] - cum[:, :, None, :]
        pr = masked_softmax(s, pos[None, :] <= tq[:, None])
        return jnp.einsum('bhqk,bhkd->bhqd', pr, v)

    o = merge_blocks(lax.map(blk, (split_blocks(q, 2, ATT_QBLOCK), split_blocks(cum, 2, ATT_QBLOCK),
                                   pos.reshape(-1, ATT_QBLOCK))), 2)
    return o.transpose(0, 2, 1, 3).reshape(bsz, t, H_FOX * HEAD_DIM)


def conv_ffn(h, w_up, conv_w, conv_b, w_down):
    u = causal_dwconv(h @ w_up, conv_w) + conv_b
    gt, up = jnp.split(u, 2, axis=-1)
    return (jax.nn.silu(gt) * up) @ w_down


def setup_inputs(seed: int = 0) -> dict:
    key = jax.random.key(seed)
    ks = iter(jax.random.split(key, 40))

    def nrm(shape, scale):
        return jax.random.normal(next(ks), shape, F32) * scale

    def gain(shape):
        return 1.0 + 0.05 * jax.random.normal(next(ks), shape, F32)

    dt = jnp.exp(jax.random.uniform(next(ks), (N_AB, H_GDN), F32, np.log(1e-3), np.log(1e-1)))
    return {
        'x': nrm((BATCH, SEQ, D_MODEL), 1.0),
        'p': nrm((DEPTH, BATCH, SEQ, D_PLE), 1.0),
        'ab_norm_pre': gain((N_AB, D_MODEL)),
        'ab_norm_post': gain((N_AB, D_MODEL)),
        'ab_w_in': nrm((N_AB, D_MODEL, AB_IN), D_MODEL ** -0.5),
        'gdn_conv_w': nrm((N_AB, GDN_CONV, 3 * H_GDN * HEAD_DIM), GDN_CONV ** -0.5),
        'gdn_a_log': jnp.log(jax.random.uniform(next(ks), (N_AB, H_GDN), F32, 1.0, 16.0)),
        'gdn_dt_bias': dt + jnp.log(-jnp.expm1(-dt)),
        'gdn_norm': gain((N_AB, HEAD_DIM)),
        'nsa_pe_k': nrm((N_AB, L_CMP, HEAD_DIM), 0.1),
        'nsa_pe_v': nrm((N_AB, L_CMP, HEAD_DIM), 0.1),
        'nsa_cmp_k1': nrm((N_AB, L_CMP * HEAD_DIM, HEAD_DIM), (L_CMP * HEAD_DIM) ** -0.5),
        'nsa_cmp_k2': nrm((N_AB, HEAD_DIM, HEAD_DIM), HEAD_DIM ** -0.5),
        'nsa_cmp_v1': nrm((N_AB, L_CMP * HEAD_DIM, HEAD_DIM), (L_CMP * HEAD_DIM) ** -0.5),
        'nsa_cmp_v2': nrm((N_AB, HEAD_DIM, HEAD_DIM), HEAD_DIM ** -0.5),
        'ab_w_out': nrm((N_AB, AB_OUT, D_MODEL), AB_OUT ** -0.5),
        'cd_norm_pre': gain((N_CD, D_MODEL)),
        'cd_norm_post': gain((N_CD, D_MODEL)),
        'cd_w_in': nrm((N_CD, D_MODEL, CD_IN), D_MODEL ** -0.5),
        'hgrn_lb_logits': nrm((DEPTH, H_HGRN * HEAD_DIM), 1.0),
        'hgrn_norm': gain((N_CD, HEAD_DIM)),
        'fox_f_bias': 2.0 + nrm((N_CD, H_FOX), 0.5),
        'cd_w_out': nrm((N_CD, CD_OUT, D_MODEL), CD_OUT ** -0.5),
        'ffn_norm_pre': gain((DEPTH, D_MODEL)),
        'ffn_norm_post': gain((DEPTH, D_MODEL)),
        'ffn_w_up': nrm((DEPTH, D_MODEL, 2 * D_FF), D_MODEL ** -0.5),
        'ffn_conv_w': nrm((DEPTH, FFN_CONV, 2 * D_FF), FFN_CONV ** -0.5),
        'ffn_conv_b': nrm((DEPTH, 2 * D_FF), 0.02),
        'ffn_w_down': nrm((DEPTH, D_FF, D_MODEL), D_FF ** -0.5),
        'ple_w_proj': nrm((DEPTH, D_PLE, D_MODEL), D_PLE ** -0.5),
        'ple_gate_norm': gain((DEPTH, D_MODEL)),
        'ple_w_gate': nrm((DEPTH, D_MODEL, D_MODEL), D_MODEL ** -0.5),
        'ple_norm_post': gain((DEPTH, D_MODEL)),
    }


def reference(x, p, ab_norm_pre, ab_norm_post, ab_w_in, gdn_conv_w, gdn_a_log, gdn_dt_bias,
              gdn_norm, nsa_pe_k, nsa_pe_v, nsa_cmp_k1, nsa_cmp_k2, nsa_cmp_v1, nsa_cmp_v2,
              ab_w_out, cd_norm_pre, cd_norm_post, cd_w_in, hgrn_lb_logits, hgrn_norm,
              fox_f_bias, cd_w_out, ffn_norm_pre, ffn_norm_post, ffn_w_up, ffn_conv_w,
              ffn_conv_b, ffn_w_down, ple_w_proj, ple_gate_norm, ple_w_gate, ple_norm_post):
    sm = jax.nn.softmax(hgrn_lb_logits.astype(F32), axis=0)
    lb_table = jnp.cumsum(sm, axis=0) - sm[0]
    for li in range(DEPTH):
        j = li // 2
        if li % 2 == 0:
            h = rmsnorm(x, ab_norm_pre[j])
            g_qkv, g_a, g_b, g_gate, n_q, n_kv, n_gate = split_cols(h @ ab_w_in[j], AB_SPLITS)
            o_a = gated_deltanet(g_qkv, g_a, g_b, g_gate, gdn_conv_w[j], gdn_a_log[j],
                                 gdn_dt_bias[j], gdn_norm[j])
            o_b = nsa_attention(n_q, n_kv, n_gate, nsa_pe_k[j], nsa_pe_v[j], nsa_cmp_k1[j],
                                nsa_cmp_k2[j], nsa_cmp_v1[j], nsa_cmp_v2[j])
            y = jnp.concatenate([o_a, o_b], -1).astype(x.dtype) @ ab_w_out[j]
            x = x + rmsnorm(y, ab_norm_post[j])
        else:
            h = rmsnorm(x, cd_norm_pre[j])
            h_q, h_f, h_i, h_g, f_qkv, f_f = split_cols(h @ cd_w_in[j], CD_SPLITS)
            o_c = hgrn2(h_q, h_f, h_i, h_g, lb_table[li], hgrn_norm[j])
            o_d = forgetting_attention(f_qkv, f_f, fox_f_bias[j])
            y = jnp.concatenate([o_c, o_d], -1).astype(x.dtype) @ cd_w_out[j]
            x = x + rmsnorm(y, cd_norm_post[j])
        h = rmsnorm(x, ffn_norm_pre[li])
        x = x + rmsnorm(conv_ffn(h, ffn_w_up[li], ffn_conv_w[li], ffn_conv_b[li], ffn_w_down[li]),
                        ffn_norm_post[li])
        gate = jax.nn.sigmoid(rmsnorm(x, ple_gate_norm[li]) @ ple_w_gate[li])
        x = x + rmsnorm(gate * (p[li].astype(x.dtype) @ ple_w_proj[li]), ple_norm_post[li])
    return x
```

```cpp
#include <hip/hip_runtime.h>
#include <cstdio>
#include <cstdint>
namespace pg8 {
#define PG8_LAS __attribute__((address_space(3)))
typedef unsigned short bf16_t;
typedef short bf16x8 __attribute__((ext_vector_type(8)));
typedef float f32x4 __attribute__((ext_vector_type(4)));
typedef unsigned u32x4 __attribute__((ext_vector_type(4)));
constexpr int BM = 256, BK = 64, HALF = 128, HTB = HALF * BK * 2  , STAGE_BYTES = 8 * HTB, NXCD = 8, WGM = 8;

__host__ __device__ __forceinline__ int lds_byte(int r, int c) { const int st = (r >> 4) * 2 + (c >> 5), rr = r & 15, cc = c & 31, ob = rr * 64 + cc * 2; return st * 1024 + (ob ^ (((ob >> 9) & 1) << 5)); }
__host__ __device__ __forceinline__ void stage_rc(int b, int& R, int& C) { const int st = b / 1024, sb = b % 1024, swz = sb ^ (((sb >> 9) & 1) << 5); R = (st >> 1) * 16 + swz / 64; C = (st & 1) * 32 + (swz % 64) / 2; }
__host__ __device__ __forceinline__ int perm32(int rho) { const int n = rho >> 4, i = rho & 15; return 8 * (i >> 2) + 4 * n + (i & 3); }

struct Unit { int pm, pn; };
struct Gemm { const bf16_t* A; const bf16_t* Bt; int M, N, K, lda; };

struct StaticOrder {
    int nM, nN, nwg, G, c;
    __host__ __device__ void init(int M, int N, int G_, int c_) { nM = M / BM; nN = N / BM; nwg = nM * nN; G = G_; c = c_; }
    __host__ __device__ bool next(int i, Unit& u) const {
        const long L = (long)i * G + c; if (L >= nwg) return false;
        int wgid = (int)L; { const int q = nwg / NXCD, r = nwg % NXCD, xcd = wgid % NXCD, off = wgid / NXCD; wgid = (xcd < r ? xcd * (q + 1) : r * (q + 1) + (xcd - r) * q) + off; }
        const int nig = WGM * nN, gid = wgid / nig, fm = gid * WGM, gsz = (nM - fm) < WGM ? (nM - fm) : WGM;
        u.pm = fm + ((wgid % nig) % gsz); u.pn = (wgid % nig) / gsz; return true;
    }
    __device__ __forceinline__ void a_ready(const Unit&) const {}
    __device__ __forceinline__ void done(const Unit&) const {}
};

__device__ __forceinline__ unsigned cvt_pk_bf16(float lo, float hi) { unsigned r; asm volatile("v_cvt_pk_bf16_f32 %0, %1, %2" : "=v"(r) : "v"(lo), "v"(hi)); return r; }
typedef float f32x2 __attribute__((ext_vector_type(2)));
struct EpiB16 {
    static constexpr bool PERM = true, AFTER_DRAIN = false;
    bf16_t* O; int ldc; const float* rs;
    __device__ __forceinline__ void operator()(const f32x4 (&acc)[2][2][4][2], const Unit& u, int wr, int wc, int fr, int fq) const {
        const int row0 = u.pm * BM + wr * 64 + fr, col0 = u.pn * BM + wc * 32 + 8 * fq;
#pragma unroll
        for (int ai = 0; ai < 2; ++ai)
#pragma unroll
            for (int m = 0; m < 4; ++m) { const int row = row0 + ai * HALF + m * 16; const float sc = rs ? rs[row] : 1.f; bf16_t* rowp = O + (size_t)row * ldc + col0;
#pragma unroll
                for (int bj = 0; bj < 2; ++bj) { const f32x4 v0 = acc[ai][bj][m][0] * sc, v1 = acc[ai][bj][m][1] * sc;
                    u32x4 w; w.x = cvt_pk_bf16(v0[0], v0[1]); w.y = cvt_pk_bf16(v0[2], v0[3]); w.z = cvt_pk_bf16(v1[0], v1[1]); w.w = cvt_pk_bf16(v1[2], v1[3]);
                    *(u32x4*)(rowp + bj * HALF) = w; } }
    }
};
struct EpiProj {
    static constexpr bool PERM = true, AFTER_DRAIN = false;
    bf16_t* O; int ldc; float* S; int nb16; const float* rs;
    __device__ __forceinline__ void operator()(const f32x4 (&acc)[2][2][4][2], const Unit& u, int wr, int wc, int fr, int fq) const {
        const int row0 = u.pm * BM + wr * 64 + fr;
        if (u.pn < nb16) {
            const int col0 = u.pn * BM + wc * 32 + 8 * fq;
#pragma unroll
            for (int ai = 0; ai < 2; ++ai)
#pragma unroll
                for (int m = 0; m < 4; ++m) { const int row = row0 + ai * HALF + m * 16; const float sc = rs[row]; bf16_t* rowp = O + (size_t)row * ldc + col0;
#pragma unroll
                    for (int bj = 0; bj < 2; ++bj) { const f32x4 v0 = acc[ai][bj][m][0] * sc, v1 = acc[ai][bj][m][1] * sc;
                        u32x4 w; w.x = cvt_pk_bf16(v0[0], v0[1]); w.y = cvt_pk_bf16(v0[2], v0[3]); w.z = cvt_pk_bf16(v1[0], v1[1]); w.w = cvt_pk_bf16(v1[2], v1[3]);
                        *(u32x4*)(rowp + bj * HALF) = w; } }
        } else {
            const int col0 = wc * 32 + 8 * fq;
#pragma unroll
            for (int ai = 0; ai < 2; ++ai)
#pragma unroll
                for (int m = 0; m < 4; ++m) { const int row = row0 + ai * HALF + m * 16; const float sc = rs[row]; float* rowp = S + (size_t)row * 256 + col0;
#pragma unroll
                    for (int bj = 0; bj < 2; ++bj) { *(f32x4*)(rowp + bj * HALF) = acc[ai][bj][m][0] * sc; *(f32x4*)(rowp + bj * HALF + 4) = acc[ai][bj][m][1] * sc; } }
        }
    }
};
struct EpiGate {
    static constexpr bool PERM = true, AFTER_DRAIN = false;
    bf16_t* C; const bf16_t* PP; int ldc; const float* rs;
    __device__ __forceinline__ void operator()(const f32x4 (&acc)[2][2][4][2], const Unit& u, int wr, int wc, int fr, int fq) const {
        const int row0 = u.pm * BM + wr * 64 + fr, col0 = u.pn * BM + wc * 32 + 8 * fq;
#pragma unroll
        for (int ai = 0; ai < 2; ++ai)
#pragma unroll
            for (int m = 0; m < 4; ++m) { const int row = row0 + ai * HALF + m * 16; const float sc = rs[row]; const size_t off = (size_t)row * ldc + col0;
#pragma unroll
                for (int bj = 0; bj < 2; ++bj) { const u32x4 pw = *(const u32x4*)(PP + off + bj * HALF); const f32x4 a = acc[ai][bj][m][0] * sc, b = acc[ai][bj][m][1] * sc; u32x4 w;
                    w.x = cvt_pk_bf16(__uint_as_float(pw.x << 16) / (1.f + __expf(-a[0])), __uint_as_float(pw.x & 0xffff0000u) / (1.f + __expf(-a[1])));
                    w.y = cvt_pk_bf16(__uint_as_float(pw.y << 16) / (1.f + __expf(-a[2])), __uint_as_float(pw.y & 0xffff0000u) / (1.f + __expf(-a[3])));
                    w.z = cvt_pk_bf16(__uint_as_float(pw.z << 16) / (1.f + __expf(-b[0])), __uint_as_float(pw.z & 0xffff0000u) / (1.f + __expf(-b[1])));
                    w.w = cvt_pk_bf16(__uint_as_float(pw.w << 16) / (1.f + __expf(-b[2])), __uint_as_float(pw.w & 0xffff0000u) / (1.f + __expf(-b[3])));
                    *(u32x4*)(C + off + bj * HALF) = w; } }
    }
};
template <class Epi, class Sched, bool ALIGN_EPI = false, bool SP2 = false>
__device__ __forceinline__ void gemm_phase(PG8_LAS unsigned char* lds, const Gemm g, const Sched& S, const Epi& E) {
    const int tid = threadIdx.x, wid = __builtin_amdgcn_readfirstlane(tid >> 6), lane = tid & 63, wr = wid >> 2, wc = wid & 3, fr = lane & 15, fq = lane >> 4;
    const int K = g.K, nt = K / BK;
    unsigned voffA[2], voffB[2];
#pragma unroll
    for (int i = 0; i < 2; ++i) { int R, C; stage_rc(tid * 16 + i * 8192, R, C); const int Rb = Epi::PERM ? ((R & ~31) + perm32(R & 31)) : R;
        voffA[i] = (unsigned)(R * g.lda + C) * 2u; voffB[i] = (unsigned)(Rb * K + C) * 2u; }
    const size_t kstep = (size_t)(BK * 2);
    const size_t hstepA = (size_t)HALF * g.lda * 2, hstepB = (size_t)HALF * K * 2;
    const size_t tstepA = 2 * hstepA, tstepB = 2 * hstepB;
    const unsigned ldsw = (unsigned)wid * 1024u;
    const int aoff = lds_byte(wr * 64 + fr, fq * 8), boff = lds_byte(wc * 32 + fr, fq * 8);
#define PG8_SA(b, h) (((b) * 2 + (h)) * HTB)
#define PG8_SB(b, h) ((4 + (b) * 2 + (h)) * HTB)
#define PG8_STAGE(bufoff, gbase, voff) do { _Pragma("unroll") for (int _i = 0; _i < 2; ++_i) \
        __builtin_amdgcn_global_load_lds((const unsigned*)((const char*)(gbase) + (voff)[_i]), (PG8_LAS unsigned*)(lds + (bufoff) + ldsw + _i * 8192), 16, 0, 0); } while (0)
#define PG8_LDA(dst, b, h) do { _Pragma("unroll") for (int m = 0; m < 4; ++m) _Pragma("unroll") for (int k = 0; k < 2; ++k) dst[m][k] = *(const PG8_LAS bf16x8*)(lds + PG8_SA(b, h) + aoff + m * 2048 + k * 1024); } while (0)
#define PG8_LDB(dst, b, h) do { _Pragma("unroll") for (int n = 0; n < 2; ++n) _Pragma("unroll") for (int k = 0; k < 2; ++k) dst[n][k] = *(const PG8_LAS bf16x8*)(lds + PG8_SB(b, h) + boff + n * 2048 + k * 1024); } while (0)
#define PG8_MMA(ai, bj, At, Bt) do { __builtin_amdgcn_s_setprio(1); _Pragma("unroll") for (int m = 0; m < 4; ++m) _Pragma("unroll") for (int n = 0; n < 2; ++n) _Pragma("unroll") for (int k = 0; k < 2; ++k) \
        acc[ai][bj][m][n] = __builtin_amdgcn_mfma_f32_16x16x32_bf16(Bt[n][k], At[m][k], acc[ai][bj][m][n], 0, 0, 0); __builtin_amdgcn_s_setprio(0); } while (0)
#define PG8_WAIT_V(n) asm volatile("s_waitcnt vmcnt(" #n ")" ::: "memory")
#define PG8_WAIT_L(n) asm volatile("s_waitcnt lgkmcnt(" #n ")" ::: "memory")
#define PG8_BAR __builtin_amdgcn_s_barrier()
#define PG8_SCHED __builtin_amdgcn_sched_barrier(0)
    Unit cur, nxt; int ui = 0;
    if (!S.next(0, cur)) return;
    f32x4 acc[2][2][4][2];
#pragma unroll
    for (int a = 0; a < 2; ++a)
#pragma unroll
        for (int b = 0; b < 2; ++b)
#pragma unroll
            for (int m = 0; m < 4; ++m)
#pragma unroll
                for (int n = 0; n < 2; ++n) acc[a][b][m][n] = (f32x4){0.f, 0.f, 0.f, 0.f};
    bf16x8 At[4][2], B0[2][2], B1[2][2];
    const char* cA = (const char*)g.A + (size_t)cur.pm * tstepA; const char* cB = (const char*)g.Bt + (size_t)cur.pn * tstepB;
    S.a_ready(cur);
    if constexpr (SP2) {
        PG8_STAGE(PG8_SB(0, 0), cB, voffB); PG8_STAGE(PG8_SB(0, 1), cB + hstepB, voffB); PG8_STAGE(PG8_SA(0, 0), cA, voffA); PG8_STAGE(PG8_SA(0, 1), cA + hstepA, voffA);
        if (wr == 1) PG8_BAR;
        PG8_WAIT_V(2); PG8_BAR;
        PG8_STAGE(PG8_SB(1, 0), cB + kstep, voffB); PG8_STAGE(PG8_SA(1, 0), cA + kstep, voffA); PG8_STAGE(PG8_SB(1, 1), cB + hstepB + kstep, voffB);
        PG8_WAIT_V(6); PG8_BAR;
    } else {
        PG8_STAGE(PG8_SB(0, 0), cB, voffB); PG8_STAGE(PG8_SA(0, 0), cA, voffA); PG8_STAGE(PG8_SB(0, 1), cB + hstepB, voffB); PG8_STAGE(PG8_SA(0, 1), cA + hstepA, voffA);
        if (wr == 1) PG8_BAR;
        PG8_WAIT_V(4); PG8_BAR;
        PG8_STAGE(PG8_SB(1, 0), cB + kstep, voffB); PG8_STAGE(PG8_SA(1, 0), cA + kstep, voffA); PG8_STAGE(PG8_SB(1, 1), cB + hstepB + kstep, voffB);
        PG8_WAIT_V(6); PG8_BAR;
    }
    for (;;) {
        const bool has_next = S.next(ui + 1, nxt);
        const char* nA = has_next ? (const char*)g.A + (size_t)nxt.pm * tstepA : cA; const char* nB = has_next ? (const char*)g.Bt + (size_t)nxt.pn * tstepB : cB;
        for (int t = 0; t < nt; t += 2) {
            const bool last = (t == nt - 2);
            const char* a1 = cA + (size_t)(t + 1) * kstep;
            const char* a2 = last ? nA : cA + (size_t)(t + 2) * kstep; const char* b2 = last ? nB : cB + (size_t)(t + 2) * kstep;
            const char* a3 = a2 + kstep; const char* b3 = b2 + kstep;
            if (last && has_next) S.a_ready(nxt);
            if constexpr (SP2) {
            PG8_LDB(B0, 0, 0); PG8_LDB(B1, 0, 1); PG8_SCHED; PG8_LDA(At, 0, 0); PG8_STAGE(PG8_SA(1, 1), a1 + hstepA, voffA);
            PG8_WAIT_V(8); PG8_WAIT_L(0); PG8_BAR; PG8_MMA(0, 0, At, B0); PG8_MMA(0, 1, At, B1); PG8_BAR; PG8_SCHED;
            PG8_LDA(At, 0, 1); PG8_STAGE(PG8_SB(0, 0), b2, voffB); PG8_STAGE(PG8_SB(0, 1), b2 + hstepB, voffB); PG8_STAGE(PG8_SA(0, 0), a2, voffA);
            PG8_WAIT_V(8); PG8_WAIT_L(0); PG8_BAR; PG8_MMA(1, 0, At, B0); PG8_MMA(1, 1, At, B1); PG8_BAR; PG8_SCHED;
            PG8_LDB(B0, 1, 0); PG8_LDB(B1, 1, 1); PG8_SCHED; PG8_LDA(At, 1, 0); PG8_STAGE(PG8_SA(0, 1), a2 + hstepA, voffA);
            PG8_WAIT_V(8); PG8_WAIT_L(0); PG8_BAR; PG8_MMA(0, 0, At, B0); PG8_MMA(0, 1, At, B1); PG8_BAR; PG8_SCHED;
            PG8_LDA(At, 1, 1); PG8_STAGE(PG8_SB(1, 0), b3, voffB); PG8_STAGE(PG8_SB(1, 1), b3 + hstepB, voffB); PG8_STAGE(PG8_SA(1, 0), a3, voffA);
            PG8_WAIT_V(8); PG8_WAIT_L(0); PG8_BAR; PG8_MMA(1, 0, At, B0); PG8_MMA(1, 1, At, B1); PG8_BAR; PG8_SCHED;
            } else {
            PG8_LDB(B0, 0, 0); PG8_SCHED; PG8_LDA(At, 0, 0); PG8_STAGE(PG8_SA(1, 1), a1 + hstepA, voffA);
            PG8_WAIT_L(8); PG8_BAR; PG8_WAIT_L(0); PG8_MMA(0, 0, At, B0); PG8_BAR; PG8_SCHED;
            PG8_LDB(B1, 0, 1); PG8_STAGE(PG8_SB(0, 0), b2, voffB);
            PG8_BAR; PG8_WAIT_L(0); PG8_MMA(0, 1, At, B1); PG8_BAR;
            PG8_LDA(At, 0, 1); PG8_STAGE(PG8_SA(0, 0), a2, voffA);
            PG8_BAR; PG8_WAIT_L(0); PG8_MMA(1, 0, At, B0); PG8_BAR; PG8_SCHED;
            PG8_STAGE(PG8_SB(0, 1), b2 + hstepB, voffB);
            PG8_WAIT_V(6); PG8_BAR; PG8_MMA(1, 1, At, B1); PG8_BAR;
            PG8_LDB(B0, 1, 0); PG8_SCHED; PG8_LDA(At, 1, 0); PG8_STAGE(PG8_SA(0, 1), a2 + hstepA, voffA);
            PG8_WAIT_L(8); PG8_BAR; PG8_WAIT_L(0); PG8_MMA(0, 0, At, B0); PG8_BAR; PG8_SCHED;
            PG8_LDB(B1, 1, 1); PG8_STAGE(PG8_SB(1, 0), b3, voffB);
            PG8_BAR; PG8_WAIT_L(0); PG8_MMA(0, 1, At, B1); PG8_BAR;
            PG8_LDA(At, 1, 1); PG8_STAGE(PG8_SA(1, 0), a3, voffA);
            PG8_BAR; PG8_WAIT_L(0); PG8_MMA(1, 0, At, B0); PG8_BAR; PG8_SCHED;
            PG8_STAGE(PG8_SB(1, 1), b3 + hstepB, voffB);
            PG8_WAIT_V(6); PG8_BAR; PG8_MMA(1, 1, At, B1); PG8_BAR;
            }
        }
        if constexpr (ALIGN_EPI) { if (wr == 0) PG8_BAR; }
        if constexpr (!Epi::AFTER_DRAIN) { E(acc, cur, wr, wc, fr, fq); S.done(cur); }
        if (!has_next) break;
#pragma unroll
        for (int a = 0; a < 2; ++a)
#pragma unroll
            for (int b = 0; b < 2; ++b)
#pragma unroll
                for (int m = 0; m < 4; ++m)
#pragma unroll
                    for (int n = 0; n < 2; ++n) acc[a][b][m][n] = (f32x4){0.f, 0.f, 0.f, 0.f};
        cur = nxt; cA = nA; cB = nB; ++ui;
        if constexpr (ALIGN_EPI) { if (wr == 1) PG8_BAR; }
    }
    PG8_WAIT_V(0);
    if constexpr (!ALIGN_EPI) { if (wr == 0) PG8_BAR; }
    PG8_BAR;
    if constexpr (Epi::AFTER_DRAIN) { E.fused(acc, cur, wr, wc, fr, fq, lds, wid, lane); S.done(cur); }
#undef PG8_SA
#undef PG8_SB
#undef PG8_STAGE
#undef PG8_LDA
#undef PG8_LDB
#undef PG8_MMA
#undef PG8_WAIT_V
#undef PG8_WAIT_L
#undef PG8_BAR
#undef PG8_SCHED
}
}
constexpr int NB = 4, T = 2048, DM = 4096, M = NB * T, HD = 128, NH = 16, DFF = 11008, DPLE = 256;
constexpr int AB_IN = 13392, CD_IN = 14352;
constexpr int AB_LDP = 13312, AB_NPAD = 13568;
constexpr int CD_LDP = 14336, CD_NPAD = 14592;
constexpr int A_QKV = 0, A_GATE = 6144, A_NQ = 8192, A_NKV = 10240;
constexpr int C_HQ = 0, C_HF = 2048, C_HI = 4096, C_HG = 6144, C_FQ = 8192, C_FK = 10240, C_FV = 12288;
constexpr int NCMP = 127;
constexpr float EPS = 1e-6f, QSCALE = 0.08838834764831845f;
constexpr size_t MiB = 1u << 20;
constexpr size_t WS_CTL = 0, CTL_BYTES = 65536;
constexpr size_t WS_WABIN = 1 * MiB;
constexpr size_t WS_WABOUT = WS_WABIN + 106 * MiB;
constexpr size_t WS_WCDIN = WS_WABOUT + 32 * MiB;
constexpr size_t WS_WCDOUT = WS_WCDIN + 114 * MiB;
constexpr size_t WS_WUP = WS_WCDOUT + 32 * MiB;
constexpr size_t WS_WDOWN = WS_WUP + 2 * 172 * MiB;
constexpr size_t WS_WGATE = WS_WDOWN + 2 * 86 * MiB;
constexpr size_t WS_WPROJ = WS_WGATE + 2 * 32 * MiB;
constexpr size_t WS_XRES = WS_WPROJ + 2 * 2 * MiB;
constexpr size_t WS_H = WS_XRES + 128 * MiB;
constexpr size_t WS_PROJ = WS_H + 64 * MiB;
constexpr size_t WS_SMALL = WS_PROJ + 224 * MiB;
constexpr size_t WS_Y = WS_SMALL + 8 * MiB;
constexpr size_t WS_OBUF = WS_Y + 128 * MiB;
constexpr size_t WS_Z = WS_OBUF + 64 * MiB;
constexpr size_t WS_ACT = WS_Z + 344 * MiB;
constexpr size_t WS_PP = WS_ACT + 172 * MiB;
constexpr size_t WS_PBF = WS_PP + 64 * MiB;
constexpr size_t WS_MISC = WS_PBF + 8 * MiB;
constexpr size_t WS_END = WS_MISC + 8 * MiB;
constexpr size_t WS_QN = WS_Z, WS_KN = WS_Z + 64 * MiB, WS_VV = WS_Z + 128 * MiB, WS_ORAW = WS_Z + 192 * MiB, WS_OCMP = WS_Z + 256 * MiB;
constexpr size_t MS_KC = 0, MS_VC = 1 * MiB  , MS_GG = 2 * MiB, MS_BB = 2 * MiB + 512 * 1024, MS_SEL = 3 * MiB, MS_CUM = 4 * MiB, MS_PEB = 5 * MiB;
constexpr int CW_BAR = 4096;

constexpr int NWAVES = 8, NTHR = 512;
constexpr int RING_BYTES = 131072, LDSCTL_OFF = RING_BYTES, MISC_OFF = LDSCTL_OFF + 320, LDS_BYTES = 147456;

#define GAS __attribute__((address_space(1)))
#define LAS __attribute__((address_space(3)))
typedef unsigned short bf16;
typedef unsigned v4u __attribute__((ext_vector_type(4)));
typedef unsigned v2u __attribute__((ext_vector_type(2)));
typedef float f32x4 __attribute__((ext_vector_type(4)));
#define LDS_WAIT() asm volatile("s_waitcnt lgkmcnt(0)" ::: "memory")
__device__ __forceinline__ unsigned f2bf(float f) { unsigned u = __float_as_uint(f); return (u + 0x7fffu + ((u >> 16) & 1u)) >> 16; }
__device__ __forceinline__ unsigned pk2(float lo, float hi) { return f2bf(lo) | (f2bf(hi) << 16); }
__device__ __forceinline__ float bflo(unsigned w) { return __uint_as_float(w << 16); }
__device__ __forceinline__ float bfhi(unsigned w) { return __uint_as_float(w & 0xffff0000u); }
__device__ __forceinline__ float bf2f(bf16 b) { return __uint_as_float(((unsigned)b) << 16); }
__device__ __forceinline__ float wave_sum(float v) {
#pragma unroll
    for (int o = 1; o < 64; o <<= 1) v += __shfl_xor(v, o);
    return v; }
__device__ __forceinline__ float wave_max(float v) {
#pragma unroll
    for (int o = 1; o < 64; o <<= 1) v = fmaxf(v, __shfl_xor(v, o));
    return v; }
__device__ __forceinline__ float sigm(float x) { return 1.f / (1.f + __expf(-x)); }
__device__ __forceinline__ float silu(float x) { return x / (1.f + __expf(-x)); }
__device__ __forceinline__ float softplus(float x) { return x > 20.f ? x : log1pf(__expf(x)); }
__device__ __forceinline__ float logsigm(float x) { return fminf(x, 0.f) - log1pf(__expf(-fabsf(x))); }

#define XB_TMO      128
#define XB_XCNT(j)  (256  + 64 * (j))
#define XB_XSUB(j)  (1280 + 64 * (j))
#define XB_XGEN(j)  (2304 + 64 * (j))
#define XB_TOP      3328
#define XB_TOPGEN   3392
#define XCD_BAR_WORDS 3456
#define XB_SPIN_CAP (1u << 18)
__device__ __forceinline__ unsigned xb_ld(unsigned* p)              { return __hip_atomic_load(p, __ATOMIC_RELAXED, __HIP_MEMORY_SCOPE_AGENT); }
__device__ __forceinline__ unsigned xb_add(unsigned* p, unsigned v) { return __hip_atomic_fetch_add(p, v, __ATOMIC_RELAXED, __HIP_MEMORY_SCOPE_AGENT); }
__device__ __forceinline__ unsigned xb_xcc_id() { return (unsigned)__builtin_amdgcn_s_getreg((3 << 11) | 20) & 0xFu; }
#define XB_SPIN(cond, bar) do { unsigned _sp = 0; while (cond) { __builtin_amdgcn_s_sleep(1); \
    if ((++_sp & 255u) == 0u) { if (xb_ld(&(bar)[XB_TMO])) break; if (_sp > XB_SPIN_CAP) { atomicAdd(&(bar)[XB_TMO], 1u); break; } } } } while (0)
struct XcdBarrier { unsigned* bar; unsigned x; volatile LAS unsigned* st; };
__device__ __forceinline__ XcdBarrier xcd_barrier_post(unsigned* bar, volatile LAS unsigned* st) {
    XcdBarrier b; b.bar = bar; b.x = xb_xcc_id(); b.st = st;
    if (threadIdx.x == 0) (void)xb_add(&bar[XB_XCNT(b.x)], 1u);
    return b;
}
__device__ __forceinline__ void xcd_barrier_complete(unsigned* bar, unsigned x, unsigned& nloc, unsigned& nx) {
    const unsigned G = gridDim.x * gridDim.y * gridDim.z;
    unsigned sum, cnt, mine, sp = 0u;
    for (;;) {
        sum = 0u; cnt = 0u; mine = 0u;
#pragma unroll
        for (unsigned j = 0; j < 16; ++j) { const unsigned c = xb_ld(&bar[XB_XCNT(j)]); sum += c; cnt += (c > 0u) ? 1u : 0u; mine = (j == x) ? c : mine; }
        if (sum == G) break;
        __builtin_amdgcn_s_sleep(1);
        if ((++sp & 255u) == 0u) { if (xb_ld(&bar[XB_TMO])) break; if (sp > XB_SPIN_CAP) { atomicAdd(&bar[XB_TMO], 1u); break; } }
    }
    nloc = mine > 0u ? mine : 1u; nx = cnt > 0u ? cnt : 1u;
}
__device__ __forceinline__ void xcd_barrier(const XcdBarrier& b) {
    asm volatile("s_waitcnt vmcnt(0)" ::: "memory");
    __syncthreads();
    if (threadIdx.x == 0) {
        unsigned* bar = b.bar;
        __builtin_amdgcn_s_waitcnt(0);
        unsigned nloc = b.st[0], nx = b.st[1];
        if (nloc == 0u) { xcd_barrier_complete(bar, b.x, nloc, nx); b.st[0] = nloc; b.st[1] = nx; }
        const unsigned old = xb_add(&bar[XB_XSUB(b.x)], 1u);
        const unsigned gen = old / nloc;
        if (old + 1u == (gen + 1u) * nloc) {
            __builtin_amdgcn_fence(__ATOMIC_RELEASE, "agent");
            asm volatile("s_waitcnt vmcnt(0)" ::: "memory");
            const unsigned og = xb_add(&bar[XB_TOP], 1u);
            const unsigned tg = og / nx;
            if (og + 1u == (tg + 1u) * nx) xb_add(&bar[XB_TOPGEN], 1u);
            else XB_SPIN(xb_ld(&bar[XB_TOPGEN]) == tg, bar);
            __builtin_amdgcn_fence(__ATOMIC_ACQUIRE, "agent");
            xb_add(&bar[XB_XGEN(b.x)], 1u);
            asm volatile("s_waitcnt vmcnt(0)" ::: "memory");
        } else {
            XB_SPIN(xb_ld(&bar[XB_XGEN(b.x)]) == gen, bar);
            __builtin_amdgcn_fence(__ATOMIC_ACQUIRE, "agent");
            asm volatile("s_waitcnt vmcnt(0)" ::: "memory");
        }
    }
    __syncthreads();
}

__device__ __forceinline__ void transpose_seg(const float* W, int K, int ldw, int c0, int nvalid, int npad, bf16* Wt, int r0, LAS float* scr, int gw, int ngw, int lane, const float* kscale = nullptr) {
    const int nblk = npad / 32, nitems = (K / 64) * nblk;
    const int nkb = K / 64, GK = (nkb % 8 == 0) ? 8 : ((nkb % 4 == 0) ? 4 : 1), GN = 64 / GK; const bool blocked = (GK > 1) && (nblk % GN == 0);
    for (int item = gw; item < nitems; item += ngw) {
        int kb, nb;
        if (blocked) { const int grp = item >> 6, w = item & 63, gpr = nblk / GN; kb = GK * (grp / gpr) + w / GN; nb = GN * (grp % gpr) + w % GN; }
        else { kb = item / nblk; nb = item % nblk; }
        const int k0 = 64 * kb, n0 = 32 * nb;
        const int nn = n0 + (lane & 31); const bool ok = nn < nvalid;
        const float* src = W + (size_t)k0 * ldw + c0 + (ok ? nn : 0);
#pragma unroll 8
        for (int i = 0; i < 32; ++i) { const int kk = 2 * i + (lane >> 5); const float v = src[(size_t)kk * ldw]; scr[kk * 33 + (lane & 31)] = ok ? v : 0.f; }
        LDS_WAIT(); asm volatile("" ::: "memory");
        const int c = lane & 7;
        f32x4 ka = (f32x4){1.f, 1.f, 1.f, 1.f}, kb2 = ka;
        if (kscale) { ka = *(const f32x4*)(kscale + k0 + 8 * c); kb2 = *(const f32x4*)(kscale + k0 + 8 * c + 4); }
#pragma unroll
        for (int j = 0; j < 4; ++j) { const int n = (lane >> 3) + 8 * j; const LAS float* s = scr + (8 * c) * 33 + n;
            v4u o; o.x = pk2(s[0 * 33] * ka.x, s[1 * 33] * ka.y); o.y = pk2(s[2 * 33] * ka.z, s[3 * 33] * ka.w); o.z = pk2(s[4 * 33] * kb2.x, s[5 * 33] * kb2.y); o.w = pk2(s[6 * 33] * kb2.z, s[7 * 33] * kb2.w);
            *(v4u*)(Wt + (size_t)(r0 + n0 + n) * K + k0 + 8 * c) = o; }
        LDS_WAIT(); asm volatile("" ::: "memory");
    }
}
__device__ __forceinline__ void prep_row(const float* xrow, bf16* orow, float* rs, int lane) {
    asm volatile("" : "+v"(lane));
    const f32x4* xr = (const f32x4*)xrow; v4u* o = (v4u*)orow; float s = 0.f;
#pragma unroll
    for (int j = 0; j < 8; ++j) { const int c = lane + 64 * j; const f32x4 a = xr[2 * c], b = xr[2 * c + 1];
        s += (a.x * a.x + a.y * a.y) + (a.z * a.z + a.w * a.w) + (b.x * b.x + b.y * b.y) + (b.z * b.z + b.w * b.w);
        v4u w; w.x = pk2(a.x, a.y); w.y = pk2(a.z, a.w); w.z = pk2(b.x, b.y); w.w = pk2(b.z, b.w); o[c] = w; }
    s = wave_sum(s); if (lane == 0) *rs = rsqrtf(s * (1.f / DM) + EPS);
}
template <bool FINAL>
__device__ __forceinline__ void post_row(const bf16* yrow, bf16* xrow, float* fout, const float* wpost, float* rs, int lane) {
    asm volatile("" : "+v"(lane));
    const v4u* yr = (const v4u*)yrow; v4u* xr = (v4u*)xrow; const f32x4* wp = (const f32x4*)wpost; v4u yv[8]; float s = 0.f;
#pragma unroll
    for (int j = 0; j < 8; ++j) { yv[j] = yr[lane + 64 * j]; const v4u w = yv[j];
        s += (bflo(w.x) * bflo(w.x) + bfhi(w.x) * bfhi(w.x)) + (bflo(w.y) * bflo(w.y) + bfhi(w.y) * bfhi(w.y)) + (bflo(w.z) * bflo(w.z) + bfhi(w.z) * bfhi(w.z)) + (bflo(w.w) * bflo(w.w) + bfhi(w.w) * bfhi(w.w)); }
    const float rstd = rsqrtf(wave_sum(s) * (1.f / DM) + EPS); float s2 = 0.f;
#pragma unroll
    for (int j = 0; j < 8; ++j) { const int c = lane + 64 * j; const v4u xw = xr[c], yw = yv[j]; const f32x4 wa = wp[2 * c], wb = wp[2 * c + 1];
        f32x4 a, b;
        a.x = bflo(xw.x) + bflo(yw.x) * rstd * wa.x; a.y = bfhi(xw.x) + bfhi(yw.x) * rstd * wa.y; a.z = bflo(xw.y) + bflo(yw.y) * rstd * wa.z; a.w = bfhi(xw.y) + bfhi(yw.y) * rstd * wa.w;
        b.x = bflo(xw.z) + bflo(yw.z) * rstd * wb.x; b.y = bfhi(xw.z) + bfhi(yw.z) * rstd * wb.y; b.z = bflo(xw.w) + bflo(yw.w) * rstd * wb.z; b.w = bfhi(xw.w) + bfhi(yw.w) * rstd * wb.w;
        if (FINAL) { ((f32x4*)fout)[2 * c] = a; ((f32x4*)fout)[2 * c + 1] = b; }
        else { s2 += (a.x * a.x + a.y * a.y) + (a.z * a.z + a.w * a.w) + (b.x * b.x + b.y * b.y) + (b.z * b.z + b.w * b.w);
            v4u w; w.x = pk2(a.x, a.y); w.y = pk2(a.z, a.w); w.z = pk2(b.x, b.y); w.w = pk2(b.z, b.w); xr[c] = w; } }
    if (!FINAL) { s2 = wave_sum(s2); if (lane == 0) *rs = rsqrtf(s2 * (1.f / DM) + EPS); }
}
__device__ __forceinline__ void ff_rows_mfma(const bf16* X, const bf16* WT, const float* RS, float* SMALLp, LAS unsigned char* lds, int tid, int lane, int wave) {
    typedef short bf16x8_ __attribute__((ext_vector_type(8))); typedef float f32x16_ __attribute__((ext_vector_type(16)));
    const int r = lane & 31, hh = lane >> 5; const int m = 8 * (int)blockIdx.x + (r & 7) + 2048 * (r >> 3);
    const bf16* xa = X + (size_t)m * DM + 512 * wave + 8 * hh; const bf16* wb = WT + (size_t)(r & 15) * DM + 512 * wave + 8 * hh;
    f32x16_ acc;
#pragma unroll
    for (int i = 0; i < 16; ++i) acc[i] = 0.f;
#pragma unroll 8
    for (int ks = 0; ks < 32; ++ks) { const bf16x8_ a = *(const bf16x8_*)(xa + 16 * ks); bf16x8_ b = *(const bf16x8_*)(wb + 16 * ks); if (r >= 16) b = (bf16x8_){0, 0, 0, 0, 0, 0, 0, 0};
        acc = __builtin_amdgcn_mfma_f32_32x32x16_bf16(a, b, acc, 0, 0, 0); }
    LAS float* P = (LAS float*)lds;
    if (r < 16) {
#pragma unroll
        for (int i = 0; i < 16; ++i) { const int rr = (i & 3) + 8 * (i >> 2) + 4 * hh; P[(wave * 32 + rr) * 16 + r] = acc[i]; } }
    __syncthreads();
    { const int rr = tid >> 4, c = tid & 15; float sacc = 0.f;
#pragma unroll
      for (int w = 0; w < 8; ++w) sacc += P[(w * 32 + rr) * 16 + c];
      const int mm = 8 * (int)blockIdx.x + (rr & 7) + 2048 * (rr >> 3);
      SMALLp[(size_t)mm * 256 + c] = sacc * RS[mm]; }
    __syncthreads();
}
__device__ __forceinline__ void convact_phase(const bf16* Z, const float* cw, const float* cb, bf16* ACT, int gtid, int ngt) {
    constexpr int CG = DFF / 8, RROWS = 16, RG = M / RROWS;
    for (int item = gtid; item < CG * RG; item += ngt) {
        const int cg = item % CG, rg = item / CG, c = cg * 8, r0 = rg * RROWS, t0 = r0 & (T - 1);
        float w[2][3][8], bb[2][8];
#pragma unroll
        for (int s = 0; s < 2; ++s) {
#pragma unroll
            for (int j = 0; j < 3; ++j) { const f32x4 a = *(const f32x4*)(cw + (size_t)j * 2 * DFF + s * DFF + c), b = *(const f32x4*)(cw + (size_t)j * 2 * DFF + s * DFF + c + 4);
                w[s][j][0] = a.x; w[s][j][1] = a.y; w[s][j][2] = a.z; w[s][j][3] = a.w; w[s][j][4] = b.x; w[s][j][5] = b.y; w[s][j][6] = b.z; w[s][j][7] = b.w; }
            const f32x4 a = *(const f32x4*)(cb + s * DFF + c), b = *(const f32x4*)(cb + s * DFF + c + 4);
            bb[s][0] = a.x; bb[s][1] = a.y; bb[s][2] = a.z; bb[s][3] = a.w; bb[s][4] = b.x; bb[s][5] = b.y; bb[s][6] = b.z; bb[s][7] = b.w; }
        float zm2[2][8], zm1[2][8];
#pragma unroll
        for (int s = 0; s < 2; ++s) {
            v4u a = (v4u){0u, 0u, 0u, 0u}, b = (v4u){0u, 0u, 0u, 0u};
            if (t0 >= 2) a = *(const v4u*)(Z + (size_t)(r0 - 2) * (2 * DFF) + s * DFF + c);
            if (t0 >= 1) b = *(const v4u*)(Z + (size_t)(r0 - 1) * (2 * DFF) + s * DFF + c);
            zm2[s][0] = bflo(a.x); zm2[s][1] = bfhi(a.x); zm2[s][2] = bflo(a.y); zm2[s][3] = bfhi(a.y); zm2[s][4] = bflo(a.z); zm2[s][5] = bfhi(a.z); zm2[s][6] = bflo(a.w); zm2[s][7] = bfhi(a.w);
            zm1[s][0] = bflo(b.x); zm1[s][1] = bfhi(b.x); zm1[s][2] = bflo(b.y); zm1[s][3] = bfhi(b.y); zm1[s][4] = bflo(b.z); zm1[s][5] = bfhi(b.z); zm1[s][6] = bflo(b.w); zm1[s][7] = bfhi(b.w); }
#pragma unroll
        for (int i = 0; i < RROWS; ++i) {
            float z0[2][8], u[2][8];
#pragma unroll
            for (int s = 0; s < 2; ++s) { const v4u a = *(const v4u*)(Z + (size_t)(r0 + i) * (2 * DFF) + s * DFF + c);
                z0[s][0] = bflo(a.x); z0[s][1] = bfhi(a.x); z0[s][2] = bflo(a.y); z0[s][3] = bfhi(a.y); z0[s][4] = bflo(a.z); z0[s][5] = bfhi(a.z); z0[s][6] = bflo(a.w); z0[s][7] = bfhi(a.w);
#pragma unroll
                for (int e = 0; e < 8; ++e) { u[s][e] = bb[s][e] + w[s][0][e] * zm2[s][e] + w[s][1][e] * zm1[s][e] + w[s][2][e] * z0[s][e]; zm2[s][e] = zm1[s][e]; zm1[s][e] = z0[s][e]; } }
            v4u o; o.x = pk2(silu(u[0][0]) * u[1][0], silu(u[0][1]) * u[1][1]); o.y = pk2(silu(u[0][2]) * u[1][2], silu(u[0][3]) * u[1][3]);
            o.z = pk2(silu(u[0][4]) * u[1][4], silu(u[0][5]) * u[1][5]); o.w = pk2(silu(u[0][6]) * u[1][6], silu(u[0][7]) * u[1][7]);
            *(v4u*)(ACT + (size_t)(r0 + i) * DFF + c) = o;
        }
    }
}
__device__ __forceinline__ void gdn_prep_naive(const bf16* proj, const float* small, const float* cw, const float* a_log, const float* dt_bias,
                                               float* QN, float* KN, float* VV, float* GG, float* BB, int gw, int ngw, int lane) {
    for (int item = gw; item < M * NH; item += ngw) {
        const int row = item >> 4, h = item & 15, t = row & (T - 1), b = row >> 11;
        float val[3][2];
#pragma unroll
        for (int s = 0; s < 3; ++s)
#pragma unroll
            for (int dd = 0; dd < 2; ++dd) { const int ch = s * 2048 + h * HD + lane + 64 * dd; float acc = 0.f;
#pragma unroll
                for (int j = 0; j < 4; ++j) { const int tt = t - 3 + j; if (tt >= 0) acc += cw[j * 6144 + ch] * bf2f(proj[(size_t)(row - 3 + j) * AB_LDP + A_QKV + ch]); }
                val[s][dd] = silu(acc); }
        const float qi = rsqrtf(wave_sum(val[0][0] * val[0][0] + val[0][1] * val[0][1]) + EPS) * QSCALE;
        const float ki = rsqrtf(wave_sum(val[1][0] * val[1][0] + val[1][1] * val[1][1]) + EPS);
        const size_t o = ((size_t)(b * NH + h) * T + t) * HD + lane;
        QN[o] = val[0][0] * qi; QN[o + 64] = val[0][1] * qi; KN[o] = val[1][0] * ki; KN[o + 64] = val[1][1] * ki; VV[o] = val[2][0]; VV[o + 64] = val[2][1];
        if (lane == 0) { const float a = small[(size_t)row * 256 + h]; GG[(b * NH + h) * T + t] = -__expf(a_log[h]) * softplus(a + dt_bias[h]); BB[(b * NH + h) * T + t] = sigm(small[(size_t)row * 256 + 16 + h]); }
    }
}
__device__ __forceinline__ void gdn_scan_naive(const float* QN, const float* KN, const float* VV, const float* GG, const float* BB, float* ORAW, int item, int lane) {
    const int bh = item >> 2, e = (item & 3) * 32 + (lane & 31), dh = (lane >> 5) * 64, b = bh >> 4, h = bh & 15;
    float S[64];
#pragma unroll
    for (int d = 0; d < 64; ++d) S[d] = 0.f;
    const float* qp = QN + (size_t)bh * T * HD + dh; const float* kp = KN + (size_t)bh * T * HD + dh; const float* vp = VV + (size_t)bh * T * HD;
    for (int t = 0; t < T; ++t) {
        const float eg = __expf(GG[bh * T + t]), beta = BB[bh * T + t], ve = vp[(size_t)t * HD + e];
        float k[64]; float dot = 0.f;
#pragma unroll
        for (int d4 = 0; d4 < 16; ++d4) { const f32x4 k4 = *(const f32x4*)(kp + (size_t)t * HD + 4 * d4);
#pragma unroll
            for (int i = 0; i < 4; ++i) { k[4 * d4 + i] = k4[i]; S[4 * d4 + i] *= eg; dot += S[4 * d4 + i] * k4[i]; } }
        dot += __shfl_xor(dot, 32);
        const float u = beta * (ve - dot); float o = 0.f;
#pragma unroll
        for (int d4 = 0; d4 < 16; ++d4) { const f32x4 q4 = *(const f32x4*)(qp + (size_t)t * HD + 4 * d4);
#pragma unroll
            for (int i = 0; i < 4; ++i) { S[4 * d4 + i] += k[4 * d4 + i] * u; o += S[4 * d4 + i] * q4[i]; } }
        o += __shfl_xor(o, 32);
        if (lane < 32) ORAW[(size_t)(b * T + t) * 2048 + h * HD + e] = o;
    }
}
__device__ __forceinline__ void headnorm_gate(const float* ORAW, const float* nw, const bf16* gate, int ldg, bf16* OBUF, int gw, int ngw, int lane) {
    for (int item = gw; item < M * NH; item += ngw) {
        const int row = item >> 4, h = item & 15;
        const float o0 = ORAW[(size_t)row * 2048 + h * HD + 2 * lane], o1 = ORAW[(size_t)row * 2048 + h * HD + 2 * lane + 1];
        const float rstd = rsqrtf(wave_sum(o0 * o0 + o1 * o1) * (1.f / HD) + EPS);
        const unsigned gwd = *(const unsigned*)(gate + (size_t)row * ldg + h * HD + 2 * lane);
        *(unsigned*)(OBUF + (size_t)row * DM + h * HD + 2 * lane) = pk2(o0 * rstd * nw[2 * lane] * silu(bflo(gwd)), o1 * rstd * nw[2 * lane + 1] * silu(bfhi(gwd)));
    }
}
__device__ __forceinline__ void hgrn_prep_naive(const bf16* proj, const float* lbl, float* FB, float* QB, int gw, int ngw, int lane) {
    for (int item = gw; item < M * NH; item += ngw) {
        const int row = item >> 4, h = item & 15, t = row & (T - 1), b = row >> 11;
#pragma unroll
        for (int dd = 0; dd < 2; ++dd) { const int c = h * HD + lane + 64 * dd; const float lb = sigm(lbl[2048 + c] - lbl[c]);
            const float fx = bf2f(proj[(size_t)row * CD_LDP + C_HF + c]), qx = bf2f(proj[(size_t)row * CD_LDP + C_HQ + c]);
            const size_t o = ((size_t)(b * NH + h) * T + t) * HD + lane + 64 * dd; FB[o] = lb + (1.f - lb) * sigm(fx); QB[o] = silu(qx); }
    }
}
__device__ __forceinline__ void hgrn_scan_naive(const float* FB, const float* QB, const bf16* proj, float* ORAW, int item, int lane) {
    const int bh = item >> 1, e = (item & 1) * 64 + lane, b = bh >> 4, h = bh & 15;
    float S[HD];
#pragma unroll
    for (int d = 0; d < HD; ++d) S[d] = 0.f;
    const float* fp = FB + (size_t)bh * T * HD; const float* qp = QB + (size_t)bh * T * HD;
    for (int t = 0; t < T; ++t) {
        const float ve = bf2f(proj[(size_t)(b * T + t) * CD_LDP + C_HI + h * HD + e]); float o = 0.f;
#pragma unroll
        for (int d4 = 0; d4 < HD / 4; ++d4) { const f32x4 f4 = *(const f32x4*)(fp + (size_t)t * HD + 4 * d4), q4 = *(const f32x4*)(qp + (size_t)t * HD + 4 * d4);
#pragma unroll
            for (int i = 0; i < 4; ++i) { S[4 * d4 + i] = f4[i] * S[4 * d4 + i] + (1.f - f4[i]) * ve; o += S[4 * d4 + i] * q4[i]; } }
        ORAW[(size_t)(b * T + t) * 2048 + h * HD + e] = o;
    }
}
__device__ __forceinline__ void fox_cum(const float* small, const float* fbias, float* CUM, int item, int lane) {
    const int b = item >> 4, h = item & 15; float loc[32]; float run = 0.f;
#pragma unroll
    for (int i = 0; i < 32; ++i) { run += logsigm(small[(size_t)(b * T + 32 * lane + i) * 256 + h] + fbias[h]); loc[i] = run; }
    float incl = run;
#pragma unroll
    for (int o = 1; o < 64; o <<= 1) { const float v = __shfl_up(incl, o); if (lane >= o) incl += v; }
    const float excl = incl - run;
#pragma unroll
    for (int i = 0; i < 32; ++i) CUM[(size_t)item * T + 32 * lane + i] = excl + loc[i];
}
struct RowAcc { float m, l, a0, a1; };
__device__ __forceinline__ float dot128(const LAS float* qs, const bf16* krow) {
    const v4u* kr = (const v4u*)krow; float dot = 0.f;
#pragma unroll
    for (int c = 0; c < 16; ++c) { const v4u w = kr[c]; const f32x4 qa = *(const LAS f32x4*)(qs + 8 * c), qb = *(const LAS f32x4*)(qs + 8 * c + 4);
        dot += bflo(w.x) * qa[0] + bfhi(w.x) * qa[1] + bflo(w.y) * qa[2] + bfhi(w.y) * qa[3] + bflo(w.z) * qb[0] + bfhi(w.z) * qb[1] + bflo(w.w) * qb[2] + bfhi(w.w) * qb[3]; }
    return dot;
}
__device__ __forceinline__ void attend_chunk(RowAcc& st, const LAS float* qs, const bf16* Kb, const bf16* Vb, size_t ld, int kb, int kmax, bool valid, float bias, LAS float* pbuf, int lane) {
    int key = kb + lane; key = key < 0 ? 0 : (key > kmax ? kmax : key);
    const float dot = dot128(qs, Kb + (size_t)key * ld);
    const float s = valid ? dot + bias : -INFINITY;
    const float cm = wave_max(s);
    if (cm == -INFINITY) return;
    const float mn = fmaxf(st.m, cm), corr = __expf(st.m - mn), p = valid ? __expf(s - mn) : 0.f;
    st.l = st.l * corr + wave_sum(p); st.m = mn; st.a0 *= corr; st.a1 *= corr;
    asm volatile("s_waitcnt lgkmcnt(0)" ::: "memory"); pbuf[lane] = p; asm volatile("s_waitcnt lgkmcnt(0)" ::: "memory");
    for (int j = 0; j < 64; ++j) { const float pj = pbuf[j]; int kj = kb + j; kj = kj < 0 ? 0 : (kj > kmax ? kmax : kj);
        const unsigned w = *(const unsigned*)(Vb + (size_t)kj * ld + 2 * lane); st.a0 += pj * bflo(w); st.a1 += pj * bfhi(w); }
    asm volatile("s_waitcnt lgkmcnt(0)" ::: "memory");
}
__device__ __forceinline__ void fox_attn_naive(const bf16* proj, const float* CUM, bf16* OBUF, LAS float* wl, int gw, int ngw, int lane) {
    LAS float* qs = wl; LAS float* pbuf = wl + 128;
    for (int item = gw; item < M * NH; item += ngw) {
        const int row = item >> 4, h = item & 15, t = row & (T - 1), b = row >> 11;
        const unsigned qw = *(const unsigned*)(proj + (size_t)row * CD_LDP + C_FQ + h * HD + 2 * lane);
        asm volatile("s_waitcnt lgkmcnt(0)" ::: "memory"); qs[2 * lane] = bflo(qw) * QSCALE; qs[2 * lane + 1] = bfhi(qw) * QSCALE; asm volatile("s_waitcnt lgkmcnt(0)" ::: "memory");
        const bf16* Kb = proj + (size_t)b * T * CD_LDP + C_FK + h * HD; const bf16* Vb = proj + (size_t)b * T * CD_LDP + C_FV + h * HD;
        const float* cum = CUM + (size_t)(b * NH + h) * T; const float cq = cum[t];
        RowAcc st{-INFINITY, 0.f, 0.f, 0.f};
        for (int kb = 0; kb <= t; kb += 64) { const int key = kb + lane; const bool valid = key <= t; attend_chunk(st, qs, Kb, Vb, CD_LDP, kb, T - 1, valid, cq - cum[key > T - 1 ? T - 1 : key], pbuf, lane); }
        const float il = 1.f / st.l;
        *(unsigned*)(OBUF + (size_t)row * DM + 2048 + h * HD + 2 * lane) = pk2(st.a0 * il, st.a1 * il);
    }
}
__device__ __forceinline__ void nsa_compress_naive(const bf16* proj, const float* pe_k, const float* pe_v, const float* wk1, const float* wk2, const float* wv1, const float* wv2,
                                                   bf16* KC, bf16* VC, LAS float* lf, int tid) {
    for (int item = blockIdx.x; item < 16 * NCMP * 2; item += gridDim.x) {
        const int kv = item & 1, r = item >> 1, n = r % NCMP, bg = r / NCMP, b = bg >> 2, g = bg & 3;
        const float* pe = kv ? pe_v : pe_k; const float* w1 = kv ? wv1 : wk1; const float* w2 = kv ? wv2 : wk2;
        const int j = tid & 127, part = tid >> 7; float acc = 0.f;
        for (int i = part * 1024; i < part * 1024 + 1024; ++i) { const int l = i >> 7, d = i & 127;
            const float z = bf2f(proj[(size_t)(b * T + 16 * n + l) * AB_LDP + A_NKV + kv * 512 + g * HD + d]) + pe[i];
            acc += z * w1[(size_t)i * HD + j]; }
        lf[part * 128 + j] = acc;
        __syncthreads();
        if (tid < 128) { const float hsum = lf[j] + lf[128 + j] + lf[256 + j] + lf[384 + j]; lf[512 + j] = silu(hsum); }
        __syncthreads();
        if (tid < 128) { float o = 0.f; for (int i = 0; i < 128; ++i) o += lf[512 + i] * w2[i * HD + j]; if (kv) VC[((size_t)bg * 128 + j) * 128 + (n & ~15) + ((n >> 2) & 1) * 8 + ((n & 15) >> 3) * 4 + (n & 3)] = (bf16)f2bf(o); else KC[((size_t)bg * 128 + n) * HD + j] = (bf16)f2bf(o); }
        __syncthreads();
    }
}
__device__ __forceinline__ void nsa_cmp_naive(const bf16* proj, const bf16* KC, const bf16* VC, float* OCMP, unsigned* SEL, LAS float* wl, int gw, int ngw, int lane) {
    LAS float* qs = wl; LAS float* pbuf = wl + 128;
    for (int item = gw; item < M * 4; item += ngw) {
        const int row = item >> 2, g = item & 3, t = row & (T - 1), b = row >> 11, bg = b * 4 + g;
        const bf16* Kb = KC + (size_t)bg * 128 * HD; const bf16* Vb = VC + (size_t)bg * 128 * HD;
        const int n0 = lane, n1 = lane + 64; const bool v0 = 16 * n0 + 31 <= t, v1 = (n1 < NCMP) && (16 * n1 + 31 <= t);
        float ps0 = 0.f, ps1 = 0.f;
        for (int p = 0; p < 4; ++p) {
            const int head = g * 4 + p;
            const unsigned qw = *(const unsigned*)(proj + (size_t)row * AB_LDP + A_NQ + head * HD + 2 * lane);
            asm volatile("s_waitcnt lgkmcnt(0)" ::: "memory"); qs[2 * lane] = bflo(qw) * QSCALE; qs[2 * lane + 1] = bfhi(qw) * QSCALE; asm volatile("s_waitcnt lgkmcnt(0)" ::: "memory");
            const float s0 = v0 ? dot128(qs, Kb + (size_t)n0 * HD) : -INFINITY, s1 = v1 ? dot128(qs, Kb + (size_t)(n1 < 128 ? n1 : 127) * HD) : -INFINITY;
            const float mx = wave_max(fmaxf(s0, s1)); float p0 = 0.f, p1 = 0.f;
            if (mx != -INFINITY) { const float e0 = v0 ? __expf(s0 - mx) : 0.f, e1 = v1 ? __expf(s1 - mx) : 0.f; const float il = 1.f / wave_sum(e0 + e1); p0 = e0 * il; p1 = e1 * il; }
            ps0 += p0; ps1 += p1;
            pbuf[lane] = p0; pbuf[64 + lane] = p1; asm volatile("s_waitcnt lgkmcnt(0)" ::: "memory");
            float a0 = 0.f, a1 = 0.f;
            for (int n = 0; n < NCMP; ++n) { const float pj = pbuf[n]; const unsigned w = *(const unsigned*)(Vb + (size_t)n * HD + 2 * lane); a0 += pj * bflo(w); a1 += pj * bfhi(w); }
            *(float2*)(OCMP + (size_t)row * 2048 + head * HD + 2 * lane) = make_float2(a0, a1);
            asm volatile("s_waitcnt lgkmcnt(0)" ::: "memory");
        }
        pbuf[lane] = ps0; pbuf[64 + lane] = ps1; asm volatile("s_waitcnt lgkmcnt(0)" ::: "memory");
        const int cur = t >> 6, m = lane; float sc = -INFINITY;
        if (m < 32 && m <= cur) {
            if (m == 0 || m == cur || m == cur - 1) sc = 1e4f;
            else { float im = 0.f; for (int n = 4 * m - 1; n <= 4 * m + 3; ++n) if (n >= 0 && n < NCMP) im += pbuf[n]; sc = im; }
        }
        unsigned mask = 0u;
        for (int r = 0; r < 8; ++r) { const float mx = wave_max(sc); if (mx == -INFINITY) break;
            const unsigned long long ball = __ballot(sc == mx); const int idx = __ffsll((long long)ball) - 1; mask |= 1u << idx; if (lane == idx) sc = -INFINITY; }
        if (lane == 0) SEL[(size_t)bg * T + t] = mask;
        asm volatile("s_waitcnt lgkmcnt(0)" ::: "memory");
    }
}
__device__ __forceinline__ void nsa_slcwin_naive(const bf16* proj, const float* small, const float* OCMP, const unsigned* SEL, bf16* OBUF, LAS float* wl, int gw, int ngw, int lane) {
    LAS float* qs = wl; LAS float* pbuf = wl + 128;
    for (int item = gw; item < M * NH; item += ngw) {
        const int row = item >> 4, head = item & 15, g = head >> 2, t = row & (T - 1), b = row >> 11;
        const unsigned qw = *(const unsigned*)(proj + (size_t)row * AB_LDP + A_NQ + head * HD + 2 * lane);
        asm volatile("s_waitcnt lgkmcnt(0)" ::: "memory"); qs[2 * lane] = bflo(qw) * QSCALE; qs[2 * lane + 1] = bfhi(qw) * QSCALE; asm volatile("s_waitcnt lgkmcnt(0)" ::: "memory");
        const bf16* base = proj + (size_t)b * T * AB_LDP + A_NKV + g * HD;
        const unsigned sel = SEL[(size_t)(b * 4 + g) * T + t]; const int cur = t >> 6;
        RowAcc ss{-INFINITY, 0.f, 0.f, 0.f};
        for (int m = 0; m <= cur; ++m) if ((sel >> m) & 1u) { const int key = 64 * m + lane; attend_chunk(ss, qs, base + 2 * 512, base + 3 * 512, AB_LDP, 64 * m, T - 1, key <= t, 0.f, pbuf, lane); }
        RowAcc sw{-INFINITY, 0.f, 0.f, 0.f};
        const int first = t - 511 > 0 ? t - 511 : 0;
        for (int kb = first & ~63; kb <= t; kb += 64) { const int key = kb + lane; attend_chunk(sw, qs, base + 4 * 512, base + 5 * 512, AB_LDP, kb, T - 1, key >= first && key <= t, 0.f, pbuf, lane); }
        const float gc = sigm(small[(size_t)row * 256 + 32 + head]), gs = sigm(small[(size_t)row * 256 + 48 + head]), gwn = sigm(small[(size_t)row * 256 + 64 + head]);
        const float2 oc = *(const float2*)(OCMP + (size_t)row * 2048 + head * HD + 2 * lane);
        const float is = gs / ss.l, iw = gwn / sw.l;
        *(unsigned*)(OBUF + (size_t)row * DM + 2048 + head * HD + 2 * lane) = pk2(gc * oc.x + is * ss.a0 + iw * sw.a0, gc * oc.y + is * ss.a1 + iw * sw.a1);
    }
}
typedef short bf16x8 __attribute__((ext_vector_type(8)));
typedef float f32x16 __attribute__((ext_vector_type(16)));
typedef __bf16 bf16x2_t __attribute__((ext_vector_type(2)));
typedef float f32x2_t __attribute__((ext_vector_type(2)));
__device__ __forceinline__ unsigned cvtpk(float lo, float hi) { f32x2_t v = {lo, hi}; return __builtin_bit_cast(unsigned, __builtin_convertvector(v, bf16x2_t)); }
#define MFMA32(a, b, c) __builtin_amdgcn_mfma_f32_32x32x16_bf16((a), (b), (c), 0, 0, 0)
constexpr float LOG2E = 1.4426950408889634f, C1 = QSCALE * LOG2E;
constexpr int AT_K = 0, AT_V = 16384, AT_CK = 32768;
__device__ __forceinline__ void vt_transpose(const bf16* src, int ld, int col0, int nh, bf16* VT, int gtid, int ngt) {
    const int total = NB * nh * 128 * (T / 8);
    for (int idx = gtid; idx < total; idx += ngt) {
        const int d = idx & 127, tc = (idx >> 7) & 255, bh = idx >> 15, b = bh / nh, hh = bh % nh;
        unsigned short e[8];
#pragma unroll
        for (int j = 0; j < 8; ++j) { const int p = 8 * tc + j, pp = p & 15, h2 = pp >> 3, jj = pp & 7, t = (p & ~15) + 8 * (jj >> 2) + 4 * h2 + (jj & 3);
            e[j] = src[(size_t)(b * T + t) * ld + col0 + hh * 128 + d]; }
        v4u o; o.x = e[0] | ((unsigned)e[1] << 16); o.y = e[2] | ((unsigned)e[3] << 16); o.z = e[4] | ((unsigned)e[5] << 16); o.w = e[6] | ((unsigned)e[7] << 16);
        *(v4u*)(VT + ((size_t)bh * 128 + d) * T + 8 * tc) = o;
    }
}
__device__ __forceinline__ void qk_tile(const LAS unsigned char* ldk, const bf16x8 (&qf)[8], f32x16 (&s)[2], int lane) {
    const int r = lane & 31; int y = (lane >> 5) ^ (r & 15); asm volatile("" : "+v"(y));
    const LAS unsigned char* base = ldk + r * 256;
#pragma unroll
    for (int i = 0; i < 16; ++i) { s[0][i] = 0.f; s[1][i] = 0.f; }
#pragma unroll
    for (int ks = 0; ks < 8; ++ks)
#pragma unroll
        for (int rb = 0; rb < 2; ++rb) {
            const bf16x8 a = *(const LAS bf16x8*)(base + rb * 8192 + (((2 * ks) ^ y) << 4));
            s[rb] = MFMA32(a, qf[ks], s[rb]); }
}
__device__ __forceinline__ void qk_tile_lq(const LAS unsigned char* ldk, const LAS unsigned char* ldq, f32x16 (&s)[2], int lane) {
    const int r = lane & 31; int y = (lane >> 5) ^ (r & 15); asm volatile("" : "+v"(y));
    const LAS unsigned char* base = ldk + r * 256; const LAS unsigned char* qb = ldq + r * 256;
#pragma unroll
    for (int i = 0; i < 16; ++i) { s[0][i] = 0.f; s[1][i] = 0.f; }
#pragma unroll
    for (int ks = 0; ks < 8; ++ks) { const bf16x8 q = *(const LAS bf16x8*)(qb + (((2 * ks) ^ y) << 4));
#pragma unroll
        for (int rb = 0; rb < 2; ++rb) {
            const bf16x8 a = *(const LAS bf16x8*)(base + rb * 8192 + (((2 * ks) ^ y) << 4));
            s[rb] = MFMA32(a, q, s[rb]); }
        if ((ks & 3) == 3) __builtin_amdgcn_sched_barrier(0); }
}
__device__ __forceinline__ void pv_tile(const LAS unsigned char* ldv, const f32x16 (&p)[2], f32x16 (&O)[4], int lane) {
    const int r = lane & 31; int y = (lane >> 5) ^ ((r >> 1) & 7); asm volatile("" : "+v"(y));
    const LAS unsigned char* base = ldv + r * 128;
    bf16x8 pf[2][2];
#pragma unroll
    for (int rb = 0; rb < 2; ++rb)
#pragma unroll
        for (int st = 0; st < 2; ++st) { v4u w; w.x = cvtpk(p[rb][8 * st + 0], p[rb][8 * st + 1]); w.y = cvtpk(p[rb][8 * st + 2], p[rb][8 * st + 3]); w.z = cvtpk(p[rb][8 * st + 4], p[rb][8 * st + 5]); w.w = cvtpk(p[rb][8 * st + 6], p[rb][8 * st + 7]);
            pf[rb][st] = __builtin_bit_cast(bf16x8, w); }
#pragma unroll
    for (int db = 0; db < 4; ++db) {
#pragma unroll
        for (int kk = 0; kk < 4; ++kk) { const bf16x8 a = *(const LAS bf16x8*)(base + db * 4096 + (((2 * kk) ^ y) << 4));
            O[db] = MFMA32(a, pf[kk >> 1][kk & 1], O[db]); } }
}
struct TileRegs { v4u k[2], v[2]; float ck; };
__device__ __forceinline__ void tile_fetch(TileRegs& R, const bf16* Kg  , size_t ldk, const bf16* Vg  , size_t ldv, const float* ckg, int tid) {
#pragma unroll
    for (int i = 0; i < 2; ++i) { const int id = tid + 512 * i; R.k[i] = *(const v4u*)(Kg + (size_t)(id >> 4) * ldk + (id & 15) * 8); R.v[i] = *(const v4u*)(Vg + (size_t)(id >> 3) * ldv + (id & 7) * 8); }
    R.ck = (ckg && tid < 64) ? ckg[tid] * LOG2E : 0.f;
}
__device__ __forceinline__ void tile_commit(const TileRegs& R, LAS unsigned char* ldk, LAS unsigned char* ldv, LAS unsigned char* ldc, int tid) {
#pragma unroll
    for (int i = 0; i < 2; ++i) { const int id = tid + 512 * i; const int key = id >> 4, c = id & 15, d = id >> 3, c2 = id & 7;
        *(LAS v4u*)(ldk + key * 256 + ((c ^ (key & 15)) * 16)) = R.k[i];
        *(LAS v4u*)(ldv + d * 128 + ((c2 ^ ((d >> 1) & 7)) * 16)) = R.v[i]; }
    if (ldc && tid < 64) *(LAS float*)(ldc + tid * 4) = R.ck;
}
__device__ __forceinline__ void tile_dma(const bf16* Kg, size_t ldk, const bf16* Vg, size_t ldv, LAS unsigned char* dk, LAS unsigned char* dv, int wave, int lane) {
#pragma unroll
    for (int i = 0; i < 2; ++i) { const int piece = wave * 2 + i;
        const int krow = 4 * piece + (lane >> 4), kc = (lane & 15) ^ (krow & 15);
        __builtin_amdgcn_global_load_lds((const unsigned*)(Kg + (size_t)krow * ldk + kc * 8), (LAS unsigned*)(dk + piece * 1024), 16, 0, 0);
        const int d = 8 * piece + (lane >> 3), vc = (lane & 7) ^ ((d >> 1) & 7);
        __builtin_amdgcn_global_load_lds((const unsigned*)(Vg + (size_t)d * ldv + vc * 8), (LAS unsigned*)(dv + piece * 1024), 16, 0, 0); }
}
constexpr int AT_B1 = 32768, AT_CK0 = 65536, AT_CK1 = 65536 + 256;
__device__ __forceinline__ void fox_attn_mfma(const bf16* proj, const bf16* VTG, const float* CUM, bf16* OBUF, LAS unsigned char* lds, int tid, int lane, int wave) {
    const int r = lane & 31, hh = lane >> 5;
    for (int idx = blockIdx.x; idx < 512; idx += gridDim.x) {
        const int bh = idx & 63, qq = idx >> 6, qt = qq < 4 ? qq : 11 - qq, b = bh >> 4, h = bh & 15, q0 = qt * 256, wq0 = q0 + 32 * wave, qi = wq0 + r;
        bf16x8 qf[8];
#pragma unroll
        for (int ks = 0; ks < 8; ++ks) qf[ks] = *(const bf16x8*)(proj + (size_t)(b * T + qi) * CD_LDP + C_FQ + h * HD + 16 * ks + 8 * hh);
        const float cq2 = CUM[(size_t)bh * T + qi] * LOG2E;
        float m = -INFINITY, l = 0.f; f32x16 O[4];
#pragma unroll
        for (int db = 0; db < 4; ++db)
#pragma unroll
            for (int i = 0; i < 16; ++i) O[db][i] = 0.f;
        const bf16* Kg = proj + (size_t)b * T * CD_LDP + C_FK + h * HD; const bf16* Vg = VTG + (size_t)bh * 128 * T; const float* ckg = CUM + (size_t)bh * T;
        const int ntiles = 4 * qt + 4;
        __syncthreads();
        tile_dma(Kg, CD_LDP, Vg, T, lds + AT_K, lds + AT_V, wave, lane);
        if (wave == 0) __builtin_amdgcn_global_load_lds((const unsigned*)(ckg + lane), (LAS unsigned*)(lds + AT_CK0), 4, 0, 0);
        for (int kt = 0; kt < ntiles; ++kt) {
            const int bo = (kt & 1) * AT_B1;
            asm volatile("s_waitcnt vmcnt(0)" ::: "memory"); __syncthreads();
            if (kt + 1 < ntiles) { tile_dma(Kg + (size_t)(kt + 1) * 64 * CD_LDP, CD_LDP, Vg + (kt + 1) * 64, T, lds + AT_K + (AT_B1 - bo), lds + AT_V + (AT_B1 - bo), wave, lane);
                if (wave == 0) __builtin_amdgcn_global_load_lds((const unsigned*)(ckg + (kt + 1) * 64 + lane), (LAS unsigned*)(lds + ((kt & 1) ? AT_CK0 : AT_CK1)), 4, 0, 0); }
            if (kt * 64 <= wq0 + 31) {
                f32x16 s[2]; qk_tile(lds + AT_K + bo, qf, s, lane);
                const bool full = kt * 64 + 63 <= wq0; float mx = -INFINITY;
#pragma unroll
                for (int rb = 0; rb < 2; ++rb)
#pragma unroll
                    for (int g4 = 0; g4 < 4; ++g4) { const f32x4 ck4 = *(const LAS f32x4*)(lds + ((kt & 1) ? AT_CK1 : AT_CK0) + (32 * rb + 8 * g4 + 4 * hh) * 4);
#pragma unroll
                        for (int e = 0; e < 4; ++e) { const int i = 4 * g4 + e, key = kt * 64 + 32 * rb + 8 * g4 + 4 * hh + e;
                            float v = s[rb][i] * C1 + (cq2 - ck4[e] * LOG2E); if (!full && key > qi) v = -INFINITY; s[rb][i] = v; mx = fmaxf(mx, v); } }
                mx = fmaxf(mx, __shfl_xor(mx, 32));
                if (!__all(mx - m <= 8.f)) {
                    const float mn = fmaxf(m, mx), corr = __builtin_amdgcn_exp2f(m - mn); m = mn; l *= corr;
#pragma unroll
                    for (int db = 0; db < 4; ++db)
#pragma unroll
                        for (int i = 0; i < 16; ++i) O[db][i] *= corr;
                }
                float ls = 0.f;
#pragma unroll
                for (int rb = 0; rb < 2; ++rb)
#pragma unroll
                    for (int i = 0; i < 16; ++i) { const float p = __builtin_amdgcn_exp2f(s[rb][i] - m); s[rb][i] = p; ls += p; }
                l += ls;
                pv_tile(lds + AT_V + bo, s, O, lane);
            }
        }
        l += __shfl_xor(l, 32); const float il = 1.f / l;
        bf16* orow = OBUF + (size_t)(b * T + qi) * DM + 2048 + h * HD;
#pragma unroll
        for (int db = 0; db < 4; ++db)
#pragma unroll
            for (int g4 = 0; g4 < 4; ++g4) { v2u w; w.x = cvtpk(O[db][4 * g4] * il, O[db][4 * g4 + 1] * il); w.y = cvtpk(O[db][4 * g4 + 2] * il, O[db][4 * g4 + 3] * il);
                *(v2u*)(orow + 32 * db + 8 * g4 + 4 * hh) = w; }
    }
}

__device__ __forceinline__ void softmax_update(f32x16 (&s)[2], float& m, float& l, f32x16 (&O)[4]) {
    float mx = -INFINITY;
#pragma unroll
    for (int rb = 0; rb < 2; ++rb)
#pragma unroll
        for (int i = 0; i < 16; ++i) mx = fmaxf(mx, s[rb][i]);
    mx = fmaxf(mx, __shfl_xor(mx, 32));
    if (!__all(mx - m <= 8.f)) {
        const float mn = fmaxf(m, mx), ms = (mn == -INFINITY) ? 0.f : mn, corr = __builtin_amdgcn_exp2f(m - ms); m = mn; l *= corr;
#pragma unroll
        for (int db = 0; db < 4; ++db)
#pragma unroll
            for (int i = 0; i < 16; ++i) O[db][i] *= corr;
    }
    const float ms = (m == -INFINITY) ? 0.f : m; float ls = 0.f;
#pragma unroll
    for (int rb = 0; rb < 2; ++rb)
#pragma unroll
        for (int i = 0; i < 16; ++i) { const float p = __builtin_amdgcn_exp2f(s[rb][i] - ms); s[rb][i] = p; ls += p; }
    l += ls;
}
#define NS_ROWPTRS() int rr_ = lane & 31; asm volatile("" : "+v"(rr_)); const size_t row_ = (size_t)(b * T + 64 * c + 32 * th + rr_); bf16* oacc = OACC + row_ * 2048 + head * HD; const float* smr = small + row_ * 256 + head
constexpr int NS_K0 = 0, NS_V0 = 16384, NS_K1 = 32768, NS_V1 = 49152, NS_Q = 65536, NS_IMP = 131072 + 512, NS_SEL = NS_IMP + 64 * 33 * 4, NS_UNI = NS_SEL + 256;
static_assert(NS_UNI + 4 <= LDS_BYTES, "NSA LDS map");
__device__ __forceinline__ void nsa_attn_mfma(const bf16* proj, const float* small, const bf16* KC, const bf16* VCT, const bf16* VTS, const bf16* VTW, bf16* OACC, bf16* OBUF, LAS unsigned char* lds, int tid, int lane, int wave) {
    const int p = wave >> 1, th = wave & 1;
    LAS float* IMP = (LAS float*)(lds + NS_IMP); LAS unsigned* SELM = (LAS unsigned*)(lds + NS_SEL); LAS unsigned* UNI = (LAS unsigned*)(lds + NS_UNI);
    for (int idx = blockIdx.x; idx < 512; idx += gridDim.x) {
        asm volatile("" : "+v"(lane), "+v"(tid));
        const int r = lane & 31, hh = lane >> 5;
        const int bg = idx & 15, cc = idx >> 4, c = cc < 16 ? cc : 47 - cc, b = bg >> 2, g = bg & 3, head = 4 * g + p, tok = 32 * th + r, t = 64 * c + tok;
        __syncthreads();
        bf16x8 qf[8];
#pragma unroll
        for (int ks = 0; ks < 8; ++ks) qf[ks] = *(const bf16x8*)(proj + (size_t)(b * T + t) * AB_LDP + A_NQ + head * HD + 16 * ks + 8 * hh);
        for (int i = tid; i < 64 * 33; i += NTHR) IMP[i] = 0.f;
        if (tid == 0) UNI[0] = 0u;
        const int ncmp_t = c >= 16 ? 2 : 1;
        { TileRegs R;
          tile_fetch(R, KC + (size_t)bg * 128 * HD, HD, VCT + (size_t)bg * 128 * 128, 128, nullptr, tid); tile_commit(R, lds + NS_K0, lds + NS_V0, nullptr, tid);
          if (ncmp_t == 2) { tile_fetch(R, KC + (size_t)bg * 128 * HD + 64 * HD, HD, VCT + (size_t)bg * 128 * 128 + 64, 128, nullptr, tid); tile_commit(R, lds + NS_K1, lds + NS_V1, nullptr, tid); } }
        __syncthreads();
        float mC = -INFINITY, lC = 0.f;
        for (int tl = 0; tl < ncmp_t; ++tl) {
            f32x16 s[2]; qk_tile(lds + (tl ? NS_K1 : NS_K0), qf, s, lane); float mx = -INFINITY;
#pragma unroll
            for (int rb = 0; rb < 2; ++rb)
#pragma unroll
                for (int i = 0; i < 16; ++i) { const int n = 64 * tl + 32 * rb + (i & 3) + 8 * (i >> 2) + 4 * hh; float v = s[rb][i] * C1; if (16 * n + 31 > t) v = -INFINITY; s[rb][i] = v; mx = fmaxf(mx, v); }
            mx = fmaxf(mx, __shfl_xor(mx, 32));
            const float mn = fmaxf(mC, mx), ms = (mn == -INFINITY) ? 0.f : mn; float ls = 0.f;
#pragma unroll
            for (int rb = 0; rb < 2; ++rb)
#pragma unroll
                for (int i = 0; i < 16; ++i) ls += __builtin_amdgcn_exp2f(s[rb][i] - ms);
            ls += __shfl_xor(ls, 32);
            lC = lC * __builtin_amdgcn_exp2f(mC - ms) + ls; mC = mn;
        }
        { const float ms = (mC == -INFINITY) ? 0.f : mC, il = lC > 0.f ? 1.f / lC : 0.f; float gc; { NS_ROWPTRS(); gc = sigm(smr[32]); }
          f32x16 OC[4];
#pragma unroll
          for (int db = 0; db < 4; ++db)
#pragma unroll
              for (int i = 0; i < 16; ++i) OC[db][i] = 0.f;
          for (int tl = 0; tl < ncmp_t; ++tl) {
            f32x16 s[2]; qk_tile(lds + (tl ? NS_K1 : NS_K0), qf, s, lane);
#pragma unroll
            for (int rb = 0; rb < 2; ++rb)
#pragma unroll
                for (int g4 = 0; g4 < 4; ++g4) { float grp = 0.f, last = 0.f;
#pragma unroll
                    for (int e = 0; e < 4; ++e) { const int i = 4 * g4 + e, n = 64 * tl + 32 * rb + 8 * g4 + 4 * hh + e; float v = s[rb][i] * C1; if (16 * n + 31 > t) v = -INFINITY;
                        const float pr = __builtin_amdgcn_exp2f(v - ms) * il; s[rb][i] = pr * gc; grp += pr; last = pr; }
                    const int mb = 16 * tl + 8 * rb + 2 * g4 + hh;
                    __hip_atomic_fetch_add(&IMP[tok * 33 + mb], grp, __ATOMIC_RELAXED, __HIP_MEMORY_SCOPE_WORKGROUP); if (mb + 1 < 32) __hip_atomic_fetch_add(&IMP[tok * 33 + mb + 1], last, __ATOMIC_RELAXED, __HIP_MEMORY_SCOPE_WORKGROUP); }
            pv_tile(lds + (tl ? NS_V1 : NS_V0), s, OC, lane);
          }
          NS_ROWPTRS();
#pragma unroll
          for (int db = 0; db < 4; ++db)
#pragma unroll
              for (int g4 = 0; g4 < 4; ++g4) { v2u w; w.x = cvtpk(OC[db][4 * g4], OC[db][4 * g4 + 1]); w.y = cvtpk(OC[db][4 * g4 + 2], OC[db][4 * g4 + 3]); *(v2u*)(oacc + 32 * db + 8 * g4 + 4 * hh) = w; }
        }
        __syncthreads();
        if (tid < 64) {
            unsigned sel = 1u | (1u << c) | (c >= 1 ? (1u << (c - 1)) : 0u); const int need = 8 - __popc(sel);
            for (int rr = 0; rr < need; ++rr) { int best = -1; float bv = -1.f;
                for (int mm = 1; mm <= c - 2; ++mm) if (!((sel >> mm) & 1u)) { const float v = IMP[tid * 33 + mm]; if (v > bv) { bv = v; best = mm; } }
                if (best < 0) break; sel |= 1u << best; }
            SELM[tid] = sel; __hip_atomic_fetch_or(UNI, sel, __ATOMIC_RELAXED, __HIP_MEMORY_SCOPE_WORKGROUP);
        }
        __syncthreads();
        const unsigned uni = UNI[0], mysel = SELM[tok];
        const bf16* kvb = proj + (size_t)b * T * AB_LDP + A_NKV + g * HD;
        {
            float m = -INFINITY, l = 0.f; f32x16 O[4];
#pragma unroll
            for (int db = 0; db < 4; ++db)
#pragma unroll
                for (int i = 0; i < 16; ++i) O[db][i] = 0.f;
            const bf16* Vg = VTS + (size_t)bg * 128 * T;
            tile_dma(kvb + 2 * 512, AB_LDP, Vg, T, lds + NS_K0, lds + NS_V0, wave, lane);
            for (int mt = 0, bo = 0; mt >= 0; bo ^= AT_B1) {
                const unsigned rest = (mt >= 31) ? 0u : ((uni >> (mt + 1)) << (mt + 1)); const int nx = rest ? (int)__builtin_ctz(rest) : -1;
                asm volatile("s_waitcnt vmcnt(0)" ::: "memory"); __syncthreads();
                if (nx >= 0) tile_dma(kvb + 2 * 512 + (size_t)nx * 64 * AB_LDP, AB_LDP, Vg + nx * 64, T, lds + NS_K0 + (bo ^ AT_B1), lds + NS_V0 + (bo ^ AT_B1), wave, lane);
                const bool mine = (mysel >> mt) & 1u;
                if (__ballot(mine) != 0ull) {
                    f32x16 s[2]; qk_tile(lds + NS_K0 + bo, qf, s, lane);
                    const float mbias = mine ? 0.f : -INFINITY;
                    if (mt == c) {
#pragma unroll
                        for (int rb = 0; rb < 2; ++rb)
#pragma unroll
                            for (int i = 0; i < 16; ++i) { const int key = 64 * mt + 32 * rb + (i & 3) + 8 * (i >> 2) + 4 * hh; float v = fmaf(s[rb][i], C1, mbias); if (key > t) v = -INFINITY; s[rb][i] = v; }
                    } else {
#pragma unroll
                        for (int rb = 0; rb < 2; ++rb)
#pragma unroll
                            for (int i = 0; i < 16; ++i) s[rb][i] = fmaf(s[rb][i], C1, mbias);
                    }
                    softmax_update(s, m, l, O);
                    pv_tile(lds + NS_V0 + bo, s, O, lane);
                }
                mt = nx;
            }
            l += __shfl_xor(l, 32); NS_ROWPTRS(); const float sc = sigm(smr[48]) / l;
#pragma unroll
            for (int db = 0; db < 4; ++db)
#pragma unroll
                for (int g4 = 0; g4 < 4; ++g4) { v2u* pa = (v2u*)(oacc + 32 * db + 8 * g4 + 4 * hh); const v2u a = *pa; v2u w;
                    w.x = cvtpk(bflo(a.x) + O[db][4 * g4] * sc, bfhi(a.x) + O[db][4 * g4 + 1] * sc); w.y = cvtpk(bflo(a.y) + O[db][4 * g4 + 2] * sc, bfhi(a.y) + O[db][4 * g4 + 3] * sc); *pa = w; }
        }
        {
            float m = -INFINITY, l = 0.f; f32x16 O[4];
#pragma unroll
            for (int db = 0; db < 4; ++db)
#pragma unroll
                for (int i = 0; i < 16; ++i) O[db][i] = 0.f;
            const bf16* Vg = VTW + (size_t)bg * 128 * T;
            const int kt0 = c >= 8 ? c - 8 : 0;
            __syncthreads();
            tile_dma(kvb + 4 * 512 + (size_t)kt0 * 64 * AB_LDP, AB_LDP, Vg + kt0 * 64, T, lds + NS_K0, lds + NS_V0, wave, lane);
            for (int kt = kt0, bo = 0; kt <= c; ++kt, bo ^= AT_B1) {
                asm volatile("s_waitcnt vmcnt(0)" ::: "memory"); __syncthreads();
                if (kt < c) tile_dma(kvb + 4 * 512 + (size_t)(kt + 1) * 64 * AB_LDP, AB_LDP, Vg + (kt + 1) * 64, T, lds + NS_K0 + (bo ^ AT_B1), lds + NS_V0 + (bo ^ AT_B1), wave, lane);
                f32x16 s[2]; qk_tile(lds + NS_K0 + bo, qf, s, lane);
                const bool edge = (kt == c) || (kt == c - 8);
                if (edge) {
#pragma unroll
                    for (int rb = 0; rb < 2; ++rb)
#pragma unroll
                        for (int i = 0; i < 16; ++i) { const int key = 64 * kt + 32 * rb + (i & 3) + 8 * (i >> 2) + 4 * hh; float v = s[rb][i] * C1; if (key > t || key < t - 511) v = -INFINITY; s[rb][i] = v; }
                } else {
#pragma unroll
                    for (int rb = 0; rb < 2; ++rb)
#pragma unroll
                        for (int i = 0; i < 16; ++i) s[rb][i] *= C1;
                }
                softmax_update(s, m, l, O);
                pv_tile(lds + NS_V0 + bo, s, O, lane);
            }
            l += __shfl_xor(l, 32); NS_ROWPTRS(); const float sc = sigm(smr[64]) / l;
            bf16* orow = OBUF + row_ * DM + 2048 + head * HD;
#pragma unroll
            for (int db = 0; db < 4; ++db)
#pragma unroll
                for (int g4 = 0; g4 < 4; ++g4) { const v2u a = *(const v2u*)(oacc + 32 * db + 8 * g4 + 4 * hh);
                    v2u w; w.x = cvtpk(bflo(a.x) + O[db][4 * g4] * sc, bfhi(a.x) + O[db][4 * g4 + 1] * sc); w.y = cvtpk(bflo(a.y) + O[db][4 * g4 + 2] * sc, bfhi(a.y) + O[db][4 * g4 + 3] * sc);
                    *(v2u*)(orow + 32 * db + 8 * g4 + 4 * hh) = w; }
        }
    }
}
__device__ __forceinline__ int perm16(int k) { return ((k >> 2) & 1) * 8 + (k >> 3) * 4 + (k & 3); }
__device__ __forceinline__ int crow(int i, int hh) { return (i & 3) + 8 * (i >> 2) + 4 * hh; }
__device__ __forceinline__ bf16x8 pack8(const f32x16& x, int s) { v4u w; w.x = cvtpk(x[8 * s + 0], x[8 * s + 1]); w.y = cvtpk(x[8 * s + 2], x[8 * s + 3]); w.z = cvtpk(x[8 * s + 4], x[8 * s + 5]); w.w = cvtpk(x[8 * s + 6], x[8 * s + 7]); return __builtin_bit_cast(bf16x8, w); }
constexpr int CH_QT = 0, CH_KT = 16384, CH_VT = 32768, CH_KD = 49152, CH_PS = 65536, CH_OT = 0;
constexpr size_t SZ_QH = (size_t)64 * 128, SZ_DS = (size_t)128 * 128, SZ_SN = (size_t)128 * 128;
__device__ __forceinline__ void hgrn_chunk_prep(const bf16* proj, const float* lbl, bf16* QH, bf16* OI, bf16* DS, float* DEC, LAS unsigned char* lds, int tid, int lane, int wave) {
    const int d = tid & 127, pt = tid >> 7, r = lane & 31, hh = lane >> 5;
    unsigned short rf[16], rq[16], rv[16];
#define HG_LOAD_RAW(IDX) do { const int bh_ = (IDX) >> 5, n_ = (IDX) & 31; const bf16* pr_ = proj + ((size_t)(bh_ >> 4) * T + n_ * 64 + 16 * pt) * CD_LDP + (bh_ & 15) * HD + d; \
        _Pragma("unroll") for (int i_ = 0; i_ < 16; ++i_) { rf[i_] = pr_[(size_t)i_ * CD_LDP + C_HF]; rq[i_] = pr_[(size_t)i_ * CD_LDP + C_HQ]; rv[i_] = pr_[(size_t)i_ * CD_LDP + C_HI]; } } while (0)
    if ((int)blockIdx.x < 2048) HG_LOAD_RAW((int)blockIdx.x);
    for (int idx = blockIdx.x; idx < 2048; idx += gridDim.x) {
        const int bh = idx >> 5, n = idx & 31, b = bh >> 4, h = bh & 15; const size_t row0 = (size_t)b * T + n * 64;
        __syncthreads();
        const float lb = sigm(lbl[2048 + h * HD + d] - lbl[h * HD + d]);
        float cs[16], kk[16], qv[16]; unsigned short vb[16]; float run = 0.f;
#pragma unroll
        for (int i = 0; i < 16; ++i) {
            const float sg = sigm(bf2f(rf[i])), f = lb + (1.f - lb) * sg; run += __logf(f); cs[i] = run; kk[i] = (1.f - lb) * (1.f - sg); qv[i] = silu(bf2f(rq[i])); vb[i] = rv[i]; }
        LAS float* PS = (LAS float*)(lds + CH_PS);
        PS[pt * 128 + d] = run;
        __syncthreads();
        const float p0 = PS[d], p1 = PS[128 + d], p2 = PS[256 + d], p3 = PS[384 + d];
        const float pre = pt == 0 ? 0.f : (pt == 1 ? p0 : (pt == 2 ? p0 + p1 : p0 + p1 + p2)), bmid = p0 + p1, tot = (p0 + p1) + (p2 + p3);
        if (pt == 0) DEC[(size_t)idx * 128 + d] = __expf(tot);
        unsigned short kdb[16];
#pragma unroll
        for (int i = 0; i < 16; ++i) { const int rr = 16 * pt + i; const float bb = pre + cs[i];
            const float dmid = fminf(fmaxf(bb - bmid, -80.f), 80.f);
            const unsigned qt = f2bf(qv[i] * __expf(dmid)), kt = f2bf(kk[i] * __expf(-dmid)), qh = f2bf(qv[i] * __expf(bb));
            kdb[i] = (unsigned short)f2bf(kk[i] * __expf(tot - bb));
            const int sw = rr * 256 + (((d >> 3) ^ (rr & 15)) << 4) + (d & 7) * 2;
            *(LAS unsigned short*)(lds + CH_QT + sw) = (unsigned short)qt; *(LAS unsigned short*)(lds + CH_KT + sw) = (unsigned short)kt;
            QH[(size_t)idx * SZ_QH + rr * 128 + (d & ~15) + perm16(d & 15)] = (bf16)qh; }
#pragma unroll
        for (int h2 = 0; h2 < 2; ++h2) { v4u wk, wv; unsigned ek[8], ev[8];
#pragma unroll
            for (int j = 0; j < 8; ++j) { const int i = 8 * (j >> 2) + 4 * h2 + (j & 3); ek[j] = kdb[i]; ev[j] = vb[i]; }
            wk.x = ek[0] | (ek[1] << 16); wk.y = ek[2] | (ek[3] << 16); wk.z = ek[4] | (ek[5] << 16); wk.w = ek[6] | (ek[7] << 16);
            wv.x = ev[0] | (ev[1] << 16); wv.y = ev[2] | (ev[3] << 16); wv.z = ev[4] | (ev[5] << 16); wv.w = ev[6] | (ev[7] << 16);
            const int sw = d * 128 + (((2 * pt + h2) ^ ((d >> 1) & 7)) << 4);
            *(LAS v4u*)(lds + CH_KD + sw) = wk; *(LAS v4u*)(lds + CH_VT + sw) = wv; }
        __syncthreads();
        if (idx + (int)gridDim.x < 2048) HG_LOAD_RAW(idx + (int)gridDim.x);
        const int rbk = wave & 1, eb = wave >> 1;
        int yk = hh ^ (r & 15); asm volatile("" : "+v"(yk)); int yv = hh ^ ((r >> 1) & 7); asm volatile("" : "+v"(yv));
        f32x16 oi;
#pragma unroll
        for (int i = 0; i < 16; ++i) oi[i] = 0.f;
#pragma unroll
        for (int jb = 0; jb < 2; ++jb) {
            if (jb > rbk) continue;
            f32x16 s;
#pragma unroll
            for (int i = 0; i < 16; ++i) s[i] = 0.f;
#pragma unroll
            for (int ks = 0; ks < 8; ++ks) { const bf16x8 a = *(const LAS bf16x8*)(lds + CH_KT + (32 * jb + r) * 256 + (((2 * ks) ^ yk) << 4)), q = *(const LAS bf16x8*)(lds + CH_QT + (32 * rbk + r) * 256 + (((2 * ks) ^ yk) << 4));
                s = MFMA32(a, q, s); }
            if (jb == rbk) {
#pragma unroll
                for (int i = 0; i < 16; ++i) if (crow(i, hh) > r) s[i] = 0.f; }
#pragma unroll
            for (int st = 0; st < 2; ++st) { const bf16x8 a = *(const LAS bf16x8*)(lds + CH_VT + (32 * eb + r) * 128 + (((2 * (2 * jb + st)) ^ yv) << 4));
                oi = MFMA32(a, pack8(s, st), oi); }
        }
        { bf16* op = OI + ((size_t)idx * 64 + 32 * rbk + r) * 128 + 32 * eb + 4 * hh;
#pragma unroll
          for (int g4 = 0; g4 < 4; ++g4) { v2u w; w.x = cvtpk(oi[4 * g4], oi[4 * g4 + 1]); w.y = cvtpk(oi[4 * g4 + 2], oi[4 * g4 + 3]); *(v2u*)(op + 8 * g4) = w; } }
#pragma unroll
        for (int tt = 0; tt < 2; ++tt) { const int tile = 2 * wave + tt, db = tile >> 2, eb2 = tile & 3; f32x16 acc;
#pragma unroll
            for (int i = 0; i < 16; ++i) acc[i] = 0.f;
#pragma unroll
            for (int kq = 0; kq < 4; ++kq) { const bf16x8 a = *(const LAS bf16x8*)(lds + CH_KD + (32 * db + r) * 128 + (((2 * kq) ^ yv) << 4)), bq = *(const LAS bf16x8*)(lds + CH_VT + (32 * eb2 + r) * 128 + (((2 * kq) ^ yv) << 4));
                acc = MFMA32(a, bq, acc); }
            bf16* dp = DS + (size_t)idx * SZ_DS + ((size_t)tile * 4 * 64 + lane) * 4;
#pragma unroll
            for (int g4 = 0; g4 < 4; ++g4) { v2u w; w.x = cvtpk(acc[4 * g4], acc[4 * g4 + 1]); w.y = cvtpk(acc[4 * g4 + 2], acc[4 * g4 + 3]); *(v2u*)(dp + g4 * 256) = w; } }
    }
}
__device__ __forceinline__ void hgrn_state_scan(const bf16* DS, const float* DEC, bf16* SN, int item, int lane) {
    const int bh = item >> 2, eb = item & 3, hh = lane >> 5;
    f32x16 S[4];
#pragma unroll
    for (int rb = 0; rb < 4; ++rb)
#pragma unroll
        for (int i = 0; i < 16; ++i) S[rb][i] = 0.f;
    for (int n = 0; n < 32; ++n) {
        const size_t idx = (size_t)bh * 32 + n;
        f32x4 ds[4][4], dc[4][4];
#pragma unroll
        for (int rb = 0; rb < 4; ++rb)
#pragma unroll
            for (int g4 = 0; g4 < 4; ++g4) { const v2u w = *(const v2u*)(DS + idx * SZ_DS + ((size_t)((rb * 4 + eb) * 4 + g4) * 64 + lane) * 4); ds[rb][g4] = (f32x4){bflo(w.x), bfhi(w.x), bflo(w.y), bfhi(w.y)}; dc[rb][g4] = *(const f32x4*)(DEC + idx * 128 + 32 * rb + 8 * g4 + 4 * hh); }
        bf16* sp = SN + idx * SZ_SN + (size_t)eb * 8 * 512 + lane * 8;
#pragma unroll
        for (int rb = 0; rb < 4; ++rb)
#pragma unroll
            for (int st = 0; st < 2; ++st) *(bf16x8*)(sp + (rb * 2 + st) * 512) = pack8(S[rb], st);
#pragma unroll
        for (int rb = 0; rb < 4; ++rb)
#pragma unroll
            for (int i = 0; i < 16; ++i) S[rb][i] = S[rb][i] * dc[rb][i >> 2][i & 3] + ds[rb][i >> 2][i & 3];
    }
}
__device__ __forceinline__ void chunk_output(const bf16* QH, const bf16* SN, const bf16* OI, const float* nw, const bf16* gate, int ldg, bf16* OBUF, LAS unsigned char* lds, int tid, int lane, int wave) {
    const int r = lane & 31, hh = lane >> 5, rbk = wave & 1, eb = wave >> 1;
    LAS float* OT = (LAS float*)(lds + CH_OT);
    bf16x8 qf[8], sf[8]; unsigned short oi[16]; unsigned gw8[8];
#define CO_LOAD(IDX) do { const int bh_ = (IDX) >> 5, n_ = (IDX) & 31; const size_t row0_ = (size_t)(bh_ >> 4) * T + n_ * 64; \
        const bf16* qa_ = QH + (size_t)(IDX) * SZ_QH + (32 * rbk + r) * 128 + 8 * hh; const bf16* sb_ = SN + (size_t)(IDX) * SZ_SN + (size_t)eb * 8 * 512 + lane * 8; \
        _Pragma("unroll") for (int k8 = 0; k8 < 8; ++k8) { qf[k8] = *(const bf16x8*)(qa_ + 16 * k8); sf[k8] = *(const bf16x8*)(sb_ + k8 * 512); } \
        const bf16* op_ = OI + ((size_t)(IDX) * 64 + 32 * rbk) * 128 + 32 * eb + r; \
        _Pragma("unroll") for (int i = 0; i < 16; ++i) oi[i] = op_[crow(i, hh) * 128]; \
        _Pragma("unroll") for (int j = 0; j < 8; ++j) gw8[j] = *(const unsigned*)(gate + (row0_ + 8 * wave + j) * ldg + (bh_ & 15) * HD + 2 * lane); } while (0)
    if ((int)blockIdx.x < 2048) CO_LOAD((int)blockIdx.x);
    for (int idx = blockIdx.x; idx < 2048; idx += gridDim.x) {
        const int bh = idx >> 5, n = idx & 31, b = bh >> 4, h = bh & 15; const size_t row0 = (size_t)b * T + n * 64;
        f32x16 acc;
#pragma unroll
        for (int i = 0; i < 16; ++i) acc[i] = 0.f;
#pragma unroll
        for (int k8 = 0; k8 < 8; ++k8) acc = MFMA32(qf[k8], sf[k8], acc);
        float ov[16]; unsigned gcur[8];
#pragma unroll
        for (int i = 0; i < 16; ++i) ov[i] = acc[i] + bf2f(oi[i]);
#pragma unroll
        for (int j = 0; j < 8; ++j) gcur[j] = gw8[j];
        __syncthreads();
#pragma unroll
        for (int i = 0; i < 16; ++i) OT[(32 * rbk + crow(i, hh)) * 128 + 32 * eb + r] = ov[i];
        if (idx + (int)gridDim.x < 2048) CO_LOAD(idx + (int)gridDim.x);
        __syncthreads();
#pragma unroll
        for (int j = 0; j < 8; ++j) { const int rr = 8 * wave + j; const float o0 = OT[rr * 128 + 2 * lane], o1 = OT[rr * 128 + 2 * lane + 1];
            const float rstd = rsqrtf(wave_sum(o0 * o0 + o1 * o1) * (1.f / HD) + EPS);
            *(unsigned*)(OBUF + (row0 + rr) * DM + h * HD + 2 * lane) = pk2(o0 * rstd * nw[2 * lane] * silu(bflo(gcur[j])), o1 * rstd * nw[2 * lane + 1] * silu(bfhi(gcur[j]))); }
    }
#undef CO_LOAD
}
__device__ __forceinline__ int img256(int row, int c) { return row * 256 + ((c ^ (row & 15)) << 4); }
__device__ __forceinline__ int img128(int row, int c) { return row * 128 + ((c ^ ((row >> 1) & 7)) << 4); }
constexpr int G1_KT = 0, G1_SS = 16384, G1_GAM = 16384 + 1024, G1_BET = G1_GAM + 256;
constexpr int G3_KT = 0, G3_QT = 16384, G3_TT = 32768, G3_KBG = 40960, G3_VB = 57344, G3_KD = 73728, G3_QK = 90112, G3_GAM = 98304, G3_BET = G3_GAM + 256;
__device__ __forceinline__ void gdn_pass1(int idx, const bf16* proj, const float* small, const float* cw, const float* a_log, const float* dt_bias,
                                          bf16* QS, bf16* KS, bf16* VS, float* GB, float* AM, LAS unsigned char* lds, int tid, int lane, int wave) {
    asm volatile("" : "+v"(tid), "+v"(lane));
    const int d = tid & 127, pt = tid >> 7, r = lane & 31, hh = lane >> 5;
    const int bh = idx >> 5, n = idx & 31, b = bh >> 4, h = bh & 15; const size_t row0 = (size_t)b * T + n * 64;
    LAS float* SS = (LAS float*)(lds + G1_SS); LAS float* GAM = (LAS float*)(lds + G1_GAM); LAS float* BET = (LAS float*)(lds + G1_BET);
    __syncthreads();
    if (tid < 64) { float g = -__expf(a_log[h]) * softplus(small[(row0 + tid) * 256 + h] + dt_bias[h]);
#pragma unroll
        for (int o = 1; o < 64; o <<= 1) { const float v = __shfl_up(g, o); if (lane >= o) g += v; }
        const float be = sigm(small[(row0 + tid) * 256 + 16 + h]); GAM[tid] = g; BET[tid] = be; GB[(size_t)idx * 128 + tid] = g; GB[(size_t)idx * 128 + 64 + tid] = be; }
    { const int o = tid & 15;
#pragma unroll
      for (int s = 0; s < 3; ++s) { const int ch0 = s * 2048 + h * HD + 8 * o; float w[4][8];
#pragma unroll
          for (int j = 0; j < 4; ++j) { const f32x4 wa = *(const f32x4*)(cw + j * 6144 + ch0), wb = *(const f32x4*)(cw + j * 6144 + ch0 + 4);
              w[j][0] = wa.x; w[j][1] = wa.y; w[j][2] = wa.z; w[j][3] = wa.w; w[j][4] = wb.x; w[j][5] = wb.y; w[j][6] = wb.z; w[j][7] = wb.w; }
#pragma unroll
          for (int it = 0; it < 2; ++it) { const int rr = (tid >> 4) + 32 * it; float val[8];
#pragma unroll
              for (int e = 0; e < 8; ++e) val[e] = 0.f;
#pragma unroll
              for (int j = 0; j < 4; ++j) { const int rj = rr - 3 + j; v4u x = (v4u){0u, 0u, 0u, 0u};
                  if (n * 64 + rj >= 0) x = *(const v4u*)(proj + (row0 + rj) * AB_LDP + A_QKV + ch0);
                  val[0] += w[j][0] * bflo(x.x); val[1] += w[j][1] * bfhi(x.x); val[2] += w[j][2] * bflo(x.y); val[3] += w[j][3] * bfhi(x.y);
                  val[4] += w[j][4] * bflo(x.z); val[5] += w[j][5] * bfhi(x.z); val[6] += w[j][6] * bflo(x.w); val[7] += w[j][7] * bfhi(x.w); }
              float ssq = 0.f;
#pragma unroll
              for (int e = 0; e < 8; ++e) { val[e] = silu(val[e]); ssq += val[e] * val[e]; }
              if (s < 2) { ssq += __shfl_xor(ssq, 1); ssq += __shfl_xor(ssq, 2); ssq += __shfl_xor(ssq, 4); ssq += __shfl_xor(ssq, 8);
                  const float inv = rsqrtf(ssq + EPS) * (s == 0 ? QSCALE : 1.f);
#pragma unroll
                  for (int e = 0; e < 8; ++e) val[e] *= inv; }
              v4u pk; pk.x = pk2(val[0], val[1]); pk.y = pk2(val[2], val[3]); pk.z = pk2(val[4], val[5]); pk.w = pk2(val[6], val[7]);
              if (s == 1) *(LAS v4u*)(lds + G1_KT + img256(rr, o)) = pk;
              *(v4u*)((s == 0 ? QS : (s == 1 ? KS : VS)) + (size_t)idx * SZ_QH + rr * 128 + 8 * o) = pk; } } }
    __syncthreads();
    if (wave < 3) {
        const int jb = wave >> 1, rbk = (wave + 1) >> 1; int yk = hh ^ (r & 15); asm volatile("" : "+v"(yk));
        f32x16 acc;
#pragma unroll
        for (int i = 0; i < 16; ++i) acc[i] = 0.f;
#pragma unroll
        for (int ks = 0; ks < 8; ++ks) acc = MFMA32(*(const LAS bf16x8*)(lds + G1_KT + (32 * jb + r) * 256 + (((2 * ks) ^ yk) << 4)), *(const LAS bf16x8*)(lds + G1_KT + (32 * rbk + r) * 256 + (((2 * ks) ^ yk) << 4)), acc);
        const int rr = 32 * rbk + r; const float gr = GAM[rr], br = BET[rr];
#pragma unroll
        for (int g4 = 0; g4 < 4; ++g4) { const int j0 = 32 * jb + 8 * g4 + 4 * hh; const f32x4 gj = *(const LAS f32x4*)(GAM + j0); f32x4 o;
#pragma unroll
            for (int e = 0; e < 4; ++e) o[e] = (j0 + e < rr) ? br * __expf(gr - gj[e]) * acc[4 * g4 + e] : 0.f;
            *(f32x4*)(AM + (size_t)idx * 4096 + rr * 64 + j0) = o; }
    } else if (wave == 3) {
#pragma unroll
        for (int g4 = 0; g4 < 4; ++g4) *(f32x4*)(AM + (size_t)idx * 4096 + r * 64 + 32 + 8 * g4 + 4 * hh) = (f32x4){0.f, 0.f, 0.f, 0.f};
    }
}
__device__ __forceinline__ void gdn_pass2(int idx, const float* AM, bf16* TM, LAS unsigned char* wlds, int lane) {
    float Ar[64], Tr[64];
    { const f32x4* src = (const f32x4*)(AM + (size_t)idx * 4096 + lane * 64);
#pragma unroll
      for (int i = 0; i < 16; ++i) { const f32x4 v = src[i]; Ar[4 * i] = v[0]; Ar[4 * i + 1] = v[1]; Ar[4 * i + 2] = v[2]; Ar[4 * i + 3] = v[3]; } }
#pragma unroll
    for (int c = 0; c < 64; ++c) Tr[c] = (lane == c) ? 1.f : 0.f;
#pragma unroll
    for (int j = 0; j < 63; ++j) {
        const float na = -Ar[j];
#pragma unroll
        for (int c = 0; c <= j; ++c) { const float tj = __builtin_bit_cast(float, __builtin_amdgcn_readlane(__builtin_bit_cast(int, Tr[c]), j)); Tr[c] = fmaf(na, tj, Tr[c]); }
    }
    v4u* out = (v4u*)(TM + (size_t)idx * 4096 + lane * 64);
#pragma unroll
    for (int i = 0; i < 8; ++i) { v4u w; w.x = cvtpk(Tr[8 * i], Tr[8 * i + 1]); w.y = cvtpk(Tr[8 * i + 2], Tr[8 * i + 3]); w.z = cvtpk(Tr[8 * i + 4], Tr[8 * i + 5]); w.w = cvtpk(Tr[8 * i + 6], Tr[8 * i + 7]); out[i] = w; }
}
struct G3Pre { float g; v4u t[5]; unsigned short kc[16], vc[16]; };
__device__ __forceinline__ void g3_load(G3Pre& P, int idx, const bf16* QS, const bf16* KS, const bf16* VS, const float* GB, const bf16* TM, int tid) {
    const int d = tid & 127, pt = tid >> 7;
    P.g = tid < 128 ? GB[(size_t)idx * 128 + tid] : 0.f;
#pragma unroll
    for (int i = 0; i < 2; ++i) { const int id = tid + 512 * i, rw = id >> 4, c = id & 15; P.t[2 * i] = *(const v4u*)(KS + (size_t)idx * SZ_QH + rw * 128 + c * 8); P.t[2 * i + 1] = *(const v4u*)(QS + (size_t)idx * SZ_QH + rw * 128 + c * 8); }
    { const int rw = tid >> 3, c = tid & 7; P.t[4] = *(const v4u*)(TM + (size_t)idx * 4096 + rw * 64 + c * 8); }
#pragma unroll
    for (int i = 0; i < 16; ++i) { const size_t o = (size_t)idx * SZ_QH + (16 * pt + i) * 128 + d; P.kc[i] = KS[o]; P.vc[i] = VS[o]; }
}
__device__ __forceinline__ void gdn_pass3(int idx, int idx_next, G3Pre& P, const bf16* QS, const bf16* KS, const bf16* VS, const float* GB, const bf16* TM, bf16* QH, bf16* OI, bf16* AN, bf16* DS,
                                          LAS unsigned char* lds, int tid, int lane, int wave) {
    asm volatile("" : "+v"(tid), "+v"(lane));
    const int d = tid & 127, pt = tid >> 7, r = lane & 31, hh = lane >> 5;
    LAS float* GAM = (LAS float*)(lds + G3_GAM); LAS float* BET = (LAS float*)(lds + G3_BET);
    __syncthreads();
    if (tid < 128) GAM[tid] = P.g;
#pragma unroll
    for (int i = 0; i < 2; ++i) { const int id = tid + 512 * i, rw = id >> 4, c = id & 15;
        *(LAS v4u*)(lds + G3_KT + img256(rw, c)) = P.t[2 * i];
        *(LAS v4u*)(lds + G3_QT + img256(rw, c)) = P.t[2 * i + 1]; }
    { const int rw = tid >> 3, c = tid & 7; *(LAS v4u*)(lds + G3_TT + img128(rw, c)) = P.t[4]; }
    float kv[16], vv[16];
#pragma unroll
    for (int i = 0; i < 16; ++i) { kv[i] = bf2f(P.kc[i]); vv[i] = bf2f(P.vc[i]); }
    if (idx_next < 2048) g3_load(P, idx_next, QS, KS, VS, GB, TM, tid);
    __syncthreads();
    { const float glast = GAM[63]; unsigned kbg[16], vb[16], kd[16];
#pragma unroll
      for (int i = 0; i < 16; ++i) { const float gm = GAM[16 * pt + i], bm = BET[16 * pt + i]; kbg[i] = f2bf(kv[i] * bm * __expf(gm)); vb[i] = f2bf(vv[i] * bm); kd[i] = f2bf(kv[i] * __expf(glast - gm)); }
#pragma unroll
      for (int h2 = 0; h2 < 2; ++h2) { v4u a, bq, c;
          a.x = kbg[8 * h2] | (kbg[8 * h2 + 1] << 16); a.y = kbg[8 * h2 + 2] | (kbg[8 * h2 + 3] << 16); a.z = kbg[8 * h2 + 4] | (kbg[8 * h2 + 5] << 16); a.w = kbg[8 * h2 + 6] | (kbg[8 * h2 + 7] << 16);
          bq.x = vb[8 * h2] | (vb[8 * h2 + 1] << 16); bq.y = vb[8 * h2 + 2] | (vb[8 * h2 + 3] << 16); bq.z = vb[8 * h2 + 4] | (vb[8 * h2 + 5] << 16); bq.w = vb[8 * h2 + 6] | (vb[8 * h2 + 7] << 16);
          unsigned e[8];
#pragma unroll
          for (int j = 0; j < 8; ++j) e[j] = kd[8 * (j >> 2) + 4 * h2 + (j & 3)];
          c.x = e[0] | (e[1] << 16); c.y = e[2] | (e[3] << 16); c.z = e[4] | (e[5] << 16); c.w = e[6] | (e[7] << 16);
          const int sw = img128(d, 2 * pt + h2);
          *(LAS v4u*)(lds + G3_KBG + sw) = a; *(LAS v4u*)(lds + G3_VB + sw) = bq; *(LAS v4u*)(lds + G3_KD + sw) = c; } }
    int yk = hh ^ (r & 15); asm volatile("" : "+v"(yk)); int yv = hh ^ ((r >> 1) & 7); asm volatile("" : "+v"(yv));
    if (wave < 3) {
        const int jb = wave >> 1, rbk = (wave + 1) >> 1; f32x16 acc;
#pragma unroll
        for (int i = 0; i < 16; ++i) acc[i] = 0.f;
#pragma unroll
        for (int ks = 0; ks < 8; ++ks) acc = MFMA32(*(const LAS bf16x8*)(lds + G3_KT + (32 * jb + r) * 256 + (((2 * ks) ^ yk) << 4)), *(const LAS bf16x8*)(lds + G3_QT + (32 * rbk + r) * 256 + (((2 * ks) ^ yk) << 4)), acc);
        const int rr = 32 * rbk + r; const float gr = GAM[rr];
#pragma unroll
        for (int g4 = 0; g4 < 4; ++g4) { const int j0 = 32 * jb + 8 * g4 + 4 * hh; const f32x4 gj = *(const LAS f32x4*)(GAM + j0); float o[4];
#pragma unroll
            for (int e = 0; e < 4; ++e) o[e] = (j0 + e <= rr) ? __expf(gr - gj[e]) * acc[4 * g4 + e] : 0.f;
            v2u w; w.x = cvtpk(o[0], o[1]); w.y = cvtpk(o[2], o[3]);
            *(LAS v2u*)(lds + G3_QK + img128(rr, 2 * (j0 >> 4) + hh) + 8 * (g4 & 1)) = w; }
    } else if (wave == 3) {
        const v2u z = (v2u){0u, 0u};
#pragma unroll
        for (int g4 = 0; g4 < 4; ++g4) { const int j0 = 32 + 8 * g4 + 4 * hh; *(LAS v2u*)(lds + G3_QK + img128(r, 2 * (j0 >> 4) + hh) + 8 * (g4 & 1)) = z; }
    }
    __syncthreads();
    const int cb = wave & 3; const bool isw = wave < 4; const int boff = isw ? G3_KBG : G3_VB;
    f32x16 X[2];
#pragma unroll
    for (int jb = 0; jb < 2; ++jb) {
#pragma unroll
        for (int i = 0; i < 16; ++i) X[jb][i] = 0.f;
#pragma unroll
        for (int ms = 0; ms < 4; ++ms) X[jb] = MFMA32(*(const LAS bf16x8*)(lds + G3_TT + (32 * jb + r) * 128 + (((2 * ms) ^ yv) << 4)), *(const LAS bf16x8*)(lds + boff + (32 * cb + r) * 128 + (((2 * ms) ^ yv) << 4)), X[jb]); }
    bf16x8 xf[4];
#pragma unroll
    for (int kq = 0; kq < 4; ++kq) xf[kq] = pack8(X[kq >> 1], kq & 1);
    __syncthreads();
#pragma unroll 1
    for (int rbk = 0; rbk < 2; ++rbk) { f32x16 acc;
#pragma unroll
        for (int i = 0; i < 16; ++i) acc[i] = 0.f;
#pragma unroll
        for (int kq = 0; kq < 4; ++kq) acc = MFMA32(*(const LAS bf16x8*)(lds + G3_QK + (32 * rbk + r) * 128 + (((2 * kq) ^ yv) << 4)), xf[kq], acc);
        const int col = 32 * cb + r;
        if (isw) {
#pragma unroll
            for (int i = 0; i < 16; ++i) { const int rr = 32 * rbk + crow(i, hh); const float qv = bf2f(*(const LAS unsigned short*)(lds + G3_QT + img256(rr, col >> 3) + (col & 7) * 2));
                *(LAS unsigned short*)(lds + G3_KT + rr * 256 + ((col & ~15) + perm16(col & 15)) * 2) = (unsigned short)f2bf(qv * __expf(GAM[rr]) - acc[i]); }
        } else {
#pragma unroll
            for (int i = 0; i < 16; ++i) { const int rr = 32 * rbk + crow(i, hh); OI[((size_t)idx * 64 + rr) * 128 + col] = (bf16)f2bf(acc[i]); }
        } }
    const float gl = __expf(GAM[63]);
#pragma unroll 1
    for (int rb = 0; rb < 4; ++rb) { f32x16 acc;
#pragma unroll
        for (int i = 0; i < 16; ++i) acc[i] = 0.f;
#pragma unroll
        for (int kq = 0; kq < 4; ++kq) acc = MFMA32(*(const LAS bf16x8*)(lds + G3_KD + (32 * rb + r) * 128 + (((2 * kq) ^ yv) << 4)), xf[kq], acc);
        const int col = 32 * cb + r;
        if (isw) {
#pragma unroll
            for (int i = 0; i < 16; ++i) { const int dr = 32 * rb + crow(i, hh); *(LAS unsigned short*)(lds + G3_TT + dr * 256 + ((col & ~15) + perm16(col & 15)) * 2) = (unsigned short)f2bf((dr == col ? gl : 0.f) - acc[i]); }
        } else {
            bf16* dp = DS + (size_t)idx * SZ_DS + ((size_t)(rb * 4 + cb) * 4 * 64 + lane) * 4;
#pragma unroll
            for (int g4 = 0; g4 < 4; ++g4) { v2u w; w.x = cvtpk(acc[4 * g4], acc[4 * g4 + 1]); w.y = cvtpk(acc[4 * g4 + 2], acc[4 * g4 + 3]); *(v2u*)(dp + g4 * 256) = w; }
        } }
    __syncthreads();
#pragma unroll
    for (int i = 0; i < 2; ++i) { const int id = tid + 512 * i; *(v4u*)(QH + (size_t)idx * SZ_QH + id * 8) = *(const LAS v4u*)(lds + G3_KT + id * 16); }
#pragma unroll
    for (int i = 0; i < 4; ++i) { const int id = tid + 512 * i; *(v4u*)(AN + (size_t)idx * SZ_DS + id * 8) = *(const LAS v4u*)(lds + G3_TT + id * 16); }
}
__device__ __forceinline__ void gdn_prep_a(const bf16* proj, const float* small, const float* cw, const float* a_log, const float* dt_bias, bf16* QS, bf16* KS, bf16* VS, float* GB, float* AM, LAS unsigned char* lds, int tid, int lane, int wave) {
#pragma unroll 1
    for (int k = 0; k < 8; ++k) { const int idx = blockIdx.x + k * gridDim.x; if (idx < 2048) gdn_pass1(idx, proj, small, cw, a_log, dt_bias, QS, KS, VS, GB, AM, lds, tid, lane, wave); }
    asm volatile("s_waitcnt vmcnt(0)" ::: "memory"); __syncthreads();
}
__device__ __forceinline__ void gdn_prep_b(const float* AM, bf16* TM, LAS unsigned char* lds, int lane, int wave) {
    { const int idx = blockIdx.x + wave * gridDim.x; if (idx < 2048) gdn_pass2(idx, AM, TM, lds + wave * 16384, lane); }
    asm volatile("s_waitcnt vmcnt(0)" ::: "memory"); __syncthreads();
}
__device__ __forceinline__ void gdn_prep_c(const bf16* QS, const bf16* KS, const bf16* VS, const float* GB, const bf16* TM, bf16* QH, bf16* OI, bf16* AN, bf16* DS, LAS unsigned char* lds, int tid, int lane, int wave) {
    G3Pre P; if ((int)blockIdx.x < 2048) g3_load(P, (int)blockIdx.x, QS, KS, VS, GB, TM, tid);
#pragma unroll 1
    for (int k = 0; k < 8; ++k) { const int idx = blockIdx.x + k * gridDim.x; if (idx < 2048) gdn_pass3(idx, k < 7 ? idx + (int)gridDim.x : 2048, P, QS, KS, VS, GB, TM, QH, OI, AN, DS, lds, tid, lane, wave); }
}
__device__ __forceinline__ void gdn_state_scan(const bf16* AN, const bf16* DS, bf16* SN, int item, int lane) {
    const int bh = item >> 2, eb = item & 3, r = lane & 31, hh = lane >> 5;
    f32x16 S[4];
#pragma unroll
    for (int rb = 0; rb < 4; ++rb)
#pragma unroll
        for (int i = 0; i < 16; ++i) S[rb][i] = 0.f;
    for (int n = 0; n < 32; ++n) {
        const size_t idx = (size_t)bh * 32 + n;
        bf16x8 sf[8];
#pragma unroll
        for (int k8 = 0; k8 < 8; ++k8) sf[k8] = pack8(S[k8 >> 1], k8 & 1);
        bf16* sp = SN + idx * SZ_SN + (size_t)eb * 8 * 512 + lane * 8;
#pragma unroll
        for (int k8 = 0; k8 < 8; ++k8) *(bf16x8*)(sp + k8 * 512) = sf[k8];
#pragma unroll
        for (int rb = 0; rb < 4; ++rb) {
#pragma unroll
            for (int g4 = 0; g4 < 4; ++g4) { const v2u w = *(const v2u*)(DS + idx * SZ_DS + ((size_t)((rb * 4 + eb) * 4 + g4) * 64 + lane) * 4); S[rb][4 * g4] = bflo(w.x); S[rb][4 * g4 + 1] = bfhi(w.x); S[rb][4 * g4 + 2] = bflo(w.y); S[rb][4 * g4 + 3] = bfhi(w.y); }
            const bf16* ap = AN + idx * SZ_DS + (32 * rb + r) * 128 + 8 * hh;
#pragma unroll
            for (int k8 = 0; k8 < 8; ++k8) S[rb] = MFMA32(*(const bf16x8*)(ap + 16 * k8), sf[k8], S[rb]);
        }
    }
}

constexpr size_t MS_BIAS = 5 * MiB, MS_W2T = 5 * MiB + 65536, MS_WFF = 5 * MiB + 131072, MS_W1T = 6 * MiB;
constexpr int CP_PART = 0, CP_HID = 16384;
__device__ __forceinline__ void nsa_compress_mfma(const bf16* proj, const bf16* W1T, const bf16* W2T, const float* BIAS, bf16* KC, bf16* VCT, LAS unsigned char* lds, int tid, int lane, int wave) {
    const int r = lane & 31, hh = lane >> 5, jb = wave & 3, kh = wave >> 2;
    for (int item = (int)blockIdx.x - ((int)gridDim.x - 128); item < 128; item += gridDim.x) {
        if (item < 0) break;
        const int nb = item & 3, kv = (item >> 2) & 1, bg = item >> 3, b = bg >> 2, g = bg & 3;
        const int n = 32 * nb + r, ne = n < NCMP ? n : NCMP - 1;
        const bf16* ap = proj + (size_t)(b * T + 16 * ne) * AB_LDP + A_NKV + kv * 512 + g * HD + 8 * hh;
        const bf16* bp = W1T + ((size_t)kv * 128 + 32 * jb + r) * 4096 + 8 * hh;
        f32x16 acc;
#pragma unroll
        for (int i = 0; i < 16; ++i) acc[i] = 0.f;
#pragma unroll 4
        for (int l = 16 * kh; l < 16 * kh + 16; ++l) {
#pragma unroll
            for (int q = 0; q < 8; ++q) acc = MFMA32(*(const bf16x8*)(ap + (size_t)l * AB_LDP + 16 * q), *(const bf16x8*)(bp + l * 128 + 16 * q), acc); }
        __syncthreads();
        LAS float* PART = (LAS float*)(lds + CP_PART);
        if (kh == 1) {
#pragma unroll
            for (int i = 0; i < 16; ++i) PART[crow(i, hh) * 128 + 32 * jb + r] = acc[i]; }
        __syncthreads();
        if (kh == 0) { const float bs = BIAS[kv * 128 + 32 * jb + r]; const int col = 32 * jb + r;
#pragma unroll
            for (int i = 0; i < 16; ++i) { const int rr = crow(i, hh); const float hv = silu(acc[i] + PART[rr * 128 + col] + bs);
                *(LAS unsigned short*)(lds + CP_HID + img256(rr, col >> 3) + (col & 7) * 2) = (unsigned short)f2bf(hv); } }
        __syncthreads();
        if (wave < 4) { int yk = hh ^ (r & 15); asm volatile("" : "+v"(yk));
            const bf16* wp = W2T + ((size_t)kv * 128 + 32 * wave + r) * 128 + 8 * hh; f32x16 o;
#pragma unroll
            for (int i = 0; i < 16; ++i) o[i] = 0.f;
#pragma unroll
            for (int ks = 0; ks < 8; ++ks) o = MFMA32(*(const LAS bf16x8*)(lds + CP_HID + r * 256 + (((2 * ks) ^ yk) << 4)), *(const bf16x8*)(wp + 16 * ks), o);
            const int j = 32 * wave + r;
#pragma unroll
            for (int i = 0; i < 16; ++i) { const int nn = 32 * nb + crow(i, hh); const bf16 v = nn < NCMP ? (bf16)f2bf(o[i]) : (bf16)0;
                if (kv) VCT[((size_t)bg * 128 + j) * 128 + (nn & ~15) + perm16(nn & 15)] = v; else KC[((size_t)bg * 128 + nn) * HD + j] = v; } }
    }
}
#ifndef MK_SINGLE
#define MK_SINGLE 1
#endif
constexpr int NPHASE = 28;
struct Args { const float* in[33]; float* out; unsigned char* ws; int ph_lo, ph_hi; };
enum { I_X = 0, I_P, I_AB_NPRE, I_AB_NPOST, I_AB_WIN, I_GDN_CW, I_GDN_ALOG, I_GDN_DTB, I_GDN_NORM, I_PE_K, I_PE_V, I_K1, I_K2, I_V1, I_V2, I_AB_WOUT, I_CD_NPRE, I_CD_NPOST, I_CD_WIN,
       I_LB, I_HGRN_NORM, I_FOX_B, I_CD_WOUT, I_FFN_NPRE, I_FFN_NPOST, I_FFN_WUP, I_FFN_CW, I_FFN_CB, I_FFN_WDOWN, I_PLE_WPROJ, I_PLE_GNORM, I_PLE_WGATE, I_PLE_NPOST };

__global__ void __launch_bounds__(NTHR, 2) fwd(Args args) {
    extern __shared__ __attribute__((aligned(16))) unsigned char lds_raw[];
    LAS unsigned char* lds = (LAS unsigned char*)lds_raw;
    volatile LAS unsigned* MISC = (volatile LAS unsigned*)(lds + MISC_OFF);
    const int tid = threadIdx.x, lane = tid & 63, wave = __builtin_amdgcn_readfirstlane(tid >> 6);
    const int G = gridDim.x, gw = blockIdx.x * NWAVES + wave, ngw = G * NWAVES, gw2 = wave * G + blockIdx.x;
    unsigned char* ws = args.ws;
    unsigned* ctl = (unsigned*)(ws + WS_CTL);
    for (int u = tid; u < (LDS_BYTES - LDSCTL_OFF) / 4; u += NTHR) ((LAS unsigned*)(lds + LDSCTL_OFF))[u] = 0u;
    __syncthreads();
    const int lo = args.ph_lo, hi = args.ph_hi;
    XcdBarrier bar; bar.bar = ctl + CW_BAR; bar.x = 0; bar.st = nullptr;
    if (hi - lo > 1) bar = xcd_barrier_post(ctl + CW_BAR, MISC + 8);
#ifndef PH_MASK
#define PH_MASK 0xFFFFFFFFu
#endif
#define IN(k) (((PH_MASK >> (k)) & 1u) && lo <= (k) && (k) < hi)
#define SEAM(k) do { if (IN(k) && IN((k) + 1)) xcd_barrier(bar); } while (0)
    bf16* WABIN = (bf16*)(ws + WS_WABIN); bf16* WABOUT = (bf16*)(ws + WS_WABOUT); bf16* WCDIN = (bf16*)(ws + WS_WCDIN); bf16* WCDOUT = (bf16*)(ws + WS_WCDOUT);
    bf16* WUP = (bf16*)(ws + WS_WUP); bf16* WDOWN = (bf16*)(ws + WS_WDOWN); bf16* WGATE = (bf16*)(ws + WS_WGATE); bf16* WPROJ = (bf16*)(ws + WS_WPROJ);
    float* XRES = (float*)(ws + WS_XRES); bf16* H = (bf16*)(ws + WS_H); bf16* PROJ = (bf16*)(ws + WS_PROJ); float* SMALL = (float*)(ws + WS_SMALL); float* Y = (float*)(ws + WS_Y);
    bf16* OBUF = (bf16*)(ws + WS_OBUF); bf16* Z = (bf16*)(ws + WS_Z); bf16* ACT = (bf16*)(ws + WS_ACT); bf16* PP = (bf16*)(ws + WS_PP); bf16* PBF = (bf16*)(ws + WS_PBF);
    float* QN = (float*)(ws + WS_QN); float* KN = (float*)(ws + WS_KN); float* VV = (float*)(ws + WS_VV); float* ORAW = (float*)(ws + WS_ORAW); float* OCMP = (float*)(ws + WS_OCMP);
    unsigned char* ms = ws + WS_MISC;
    bf16* KC = (bf16*)(ms + MS_KC); bf16* VC = (bf16*)(ms + MS_VC); float* GG = (float*)(ms + MS_GG); float* BB = (float*)(ms + MS_BB); unsigned* SEL = (unsigned*)(ms + MS_SEL); float* CUM = (float*)(ms + MS_CUM);
    bf16* QH = (bf16*)(ws + WS_Z); bf16* OI = (bf16*)(ws + WS_Z + 32 * MiB); bf16* SN = (bf16*)(ws + WS_Z + 96 * MiB); bf16* AN = (bf16*)(ws + WS_Z + 160 * MiB); float* DEC = (float*)(ws + WS_Z + 224 * MiB); bf16* DS = (bf16*)(ws + WS_ACT + 32 * MiB);
    bf16* QS = (bf16*)(ws + WS_Z + 225 * MiB); bf16* KS = (bf16*)(ws + WS_Z + 257 * MiB); bf16* VS = (bf16*)(ws + WS_Z + 289 * MiB); float* AMX = (float*)(ws + WS_PP); float* GB = (float*)(ws + WS_PP + 32 * MiB); bf16* TM = (bf16*)(ws + WS_ACT + 16 * MiB);
    float* RS = (float*)(ws + WS_MISC + 4 * MiB + 768 * 1024); bf16* YB = (bf16*)(ws + WS_Y);
    LAS float* wl = (LAS float*)(lds + wave * 1024);
    constexpr size_t SZ_UP = (size_t)2 * DFF * DM, SZ_DOWN = (size_t)DFF * DM, SZ_SQ = (size_t)DM * DM, SZ_PJ = (size_t)DPLE * DM;

    if (IN(0)) {
        LAS float* scr = (LAS float*)(lds + wave * 16384);
        transpose_seg(args.in[I_AB_WIN], DM, AB_IN, 0, 6144, 6144, WABIN, 0, scr, gw, ngw, lane, args.in[I_AB_NPRE]);
        transpose_seg(args.in[I_AB_WIN], DM, AB_IN, 6176, 7168, 7168, WABIN, 6144, scr, gw, ngw, lane, args.in[I_AB_NPRE]);
        transpose_seg(args.in[I_AB_WIN], DM, AB_IN, 6144, 32, 32, WABIN, 13312, scr, gw, ngw, lane, args.in[I_AB_NPRE]);
        transpose_seg(args.in[I_AB_WIN], DM, AB_IN, 13344, 48, 64, WABIN, 13344, scr, gw, ngw, lane, args.in[I_AB_NPRE]);
        transpose_seg(args.in[I_AB_WIN], DM, AB_IN, 0, 0, 160, WABIN, 13408, scr, gw, ngw, lane);
        transpose_seg(args.in[I_AB_WOUT], DM, DM, 0, DM, DM, WABOUT, 0, scr, gw, ngw, lane);
        transpose_seg(args.in[I_CD_WIN], DM, CD_IN, 0, 14336, 14336, WCDIN, 0, scr, gw, ngw, lane, args.in[I_CD_NPRE]);
        for (int i = blockIdx.x * NTHR + tid; i < DM * 16; i += G * NTHR) { const int cc = i & 15, k = i >> 4;
            ((bf16*)(ms + MS_WFF))[(size_t)cc * DM + k] = (bf16)f2bf(args.in[I_CD_WIN][(size_t)k * CD_IN + 14336 + cc] * args.in[I_CD_NPRE][k]); }
        for (int l = 0; l < 2; ++l) {
            transpose_seg(args.in[I_FFN_WUP] + l * SZ_UP, DM, 2 * DFF, 0, 2 * DFF, 2 * DFF, WUP + l * SZ_UP, 0, scr, gw, ngw, lane, args.in[I_FFN_NPRE] + l * DM);
            if (l == 0) transpose_seg(args.in[I_FFN_WDOWN] + l * SZ_DOWN, DFF, DM, 0, DM, DM, WDOWN + l * SZ_DOWN, 0, scr, gw, ngw, lane);
            if (l == 0) transpose_seg(args.in[I_PLE_WGATE] + l * SZ_SQ, DM, DM, 0, DM, DM, WGATE + l * SZ_SQ, 0, scr, gw, ngw, lane, args.in[I_PLE_GNORM] + l * DM);
            transpose_seg(args.in[I_PLE_WPROJ] + l * SZ_PJ, DPLE, DM, 0, DM, DM, WPROJ + l * SZ_PJ, 0, scr, gw, ngw, lane);
        }
        for (int m = gw; m < M; m += ngw) prep_row(args.in[I_X] + (size_t)m * DM, H + (size_t)m * DM, RS + m, lane);
        transpose_seg(args.in[I_K1], 4096, 128, 0, 128, 128, (bf16*)(ms + MS_W1T), 0, scr, gw, ngw, lane);
        transpose_seg(args.in[I_V1], 4096, 128, 0, 128, 128, (bf16*)(ms + MS_W1T) + (size_t)128 * 4096, 0, scr, gw, ngw, lane);
        transpose_seg(args.in[I_K2], 128, 128, 0, 128, 128, (bf16*)(ms + MS_W2T), 0, scr, gw, ngw, lane);
        transpose_seg(args.in[I_V2], 128, 128, 0, 128, 128, (bf16*)(ms + MS_W2T) + 128 * 128, 0, scr, gw, ngw, lane);
        if (gw < 256) { const int kv = gw >> 7, j = gw & 127; const float* pe = args.in[kv ? I_PE_V : I_PE_K]; const float* w1 = args.in[kv ? I_V1 : I_K1]; float sacc = 0.f;
            for (int i = lane; i < 4096; i += 64) sacc += pe[i] * w1[(size_t)i * 128 + j];
            sacc = wave_sum(sacc); if (lane == 0) ((float*)(ms + MS_BIAS))[gw] = sacc; }
        { const float* p = args.in[I_P]; for (size_t i = (size_t)blockIdx.x * NTHR + tid; i < (size_t)2 * M * DPLE / 4; i += (size_t)G * NTHR) { const f32x4 v = ((const f32x4*)p)[i]; v2u o; o.x = pk2(v.x, v.y); o.y = pk2(v.z, v.w); ((v2u*)PBF)[i] = o; } }
        for (int i = blockIdx.x * NTHR + tid; i < 16 * HD; i += G * NTHR) { const int bg = i >> 7, d = i & 127; KC[((size_t)bg * 128 + 127) * HD + d] = 0; VC[((size_t)bg * 128 + d) * 128 + 127] = 0; }
    }
    SEAM(0);
    if (IN(1)) { pg8::Gemm g{H, WABIN, M, AB_NPAD, DM, DM}; pg8::StaticOrder S; S.init(M, AB_NPAD, G, (int)blockIdx.x); pg8::EpiProj E{PROJ, AB_LDP, SMALL, AB_LDP / 256, RS};
        pg8::gemm_phase<pg8::EpiProj, pg8::StaticOrder, true, true>(lds, g, S, E); }
    SEAM(1);
    if (IN(2)) gdn_prep_a(PROJ, SMALL, args.in[I_GDN_CW], args.in[I_GDN_ALOG], args.in[I_GDN_DTB], QS, KS, VS, GB, AMX, lds, tid, lane, wave);
    if (IN(2)) gdn_prep_b(AMX, TM, lds, lane, wave);
    if (IN(2)) { gdn_prep_c(QS, KS, VS, GB, TM, QH, OI, AN, DS, lds, tid, lane, wave); __syncthreads(); }
    if (IN(2)) {
        nsa_compress_mfma(PROJ, (const bf16*)(ms + MS_W1T), (const bf16*)(ms + MS_W2T), (const float*)(ms + MS_BIAS), KC, VC, lds, tid, lane, wave);
        if (G == 256) { if (blockIdx.x < 128) { vt_transpose(PROJ, AB_LDP, A_NKV + 3 * 512, 4, (bf16*)(ws + WS_ACT), blockIdx.x * NTHR + tid, 128 * NTHR);
                vt_transpose(PROJ, AB_LDP, A_NKV + 5 * 512, 4, (bf16*)(ws + WS_ACT + 8 * MiB), blockIdx.x * NTHR + tid, 128 * NTHR); } }
        else { vt_transpose(PROJ, AB_LDP, A_NKV + 3 * 512, 4, (bf16*)(ws + WS_ACT), blockIdx.x * NTHR + tid, G * NTHR);
            vt_transpose(PROJ, AB_LDP, A_NKV + 5 * 512, 4, (bf16*)(ws + WS_ACT + 8 * MiB), blockIdx.x * NTHR + tid, G * NTHR); }
    }
    SEAM(2);
    if (IN(3)) { if (wave == 0) { if (gw2 < 256) gdn_state_scan(AN, DS, SN, gw2, lane); }
        else transpose_seg(args.in[I_FFN_WDOWN] + SZ_DOWN, DFF, DM, 0, DM, DM, WDOWN + SZ_DOWN, 0, (LAS float*)(lds + wave * 16384), (int)blockIdx.x * 7 + wave - 1, G * 7, lane); }
    SEAM(3);
    if (IN(4)) { nsa_attn_mfma(PROJ, SMALL, KC, VC, (const bf16*)(ws + WS_ACT), (const bf16*)(ws + WS_ACT + 8 * MiB), (bf16*)Y, OBUF, lds, tid, lane, wave); __syncthreads(); }
    if (IN(5)) {
        chunk_output(QH, SN, OI, args.in[I_GDN_NORM], PROJ + A_GATE, AB_LDP, OBUF, lds, tid, lane, wave);
    }
    SEAM(5);
    if (IN(6)) { pg8::Gemm g{OBUF, WABOUT, M, DM, DM, DM}; pg8::StaticOrder S; S.init(M, DM, G, (int)blockIdx.x); pg8::EpiB16 E{YB, DM, nullptr};
        pg8::gemm_phase<pg8::EpiB16, pg8::StaticOrder, true, true>(lds, g, S, E); }
    SEAM(6);
    if (IN(7)) for (int m = gw; m < M; m += ngw) post_row<false>(YB + (size_t)m * DM, H + (size_t)m * DM, nullptr, args.in[I_AB_NPOST], RS + m, lane);
    SEAM(7);
#define FFN_PLE(P0, L, FINALP) \
    if (IN(P0)) { pg8::Gemm g{H, WUP + (L) * SZ_UP, M, 2 * DFF, DM, DM}; pg8::StaticOrder S; S.init(M, 2 * DFF, G, (int)blockIdx.x); pg8::EpiB16 E{Z, 2 * DFF, RS}; \
        pg8::gemm_phase<pg8::EpiB16, pg8::StaticOrder, true, true>(lds, g, S, E); } \
    SEAM(P0); \
    if (IN(P0 + 1)) convact_phase(Z, args.in[I_FFN_CW] + (size_t)(L) * 3 * 2 * DFF, args.in[I_FFN_CB] + (size_t)(L) * 2 * DFF, ACT, blockIdx.x * NTHR + tid, G * NTHR); \
    SEAM(P0 + 1); \
    if (IN(P0 + 2)) { pg8::Gemm g{ACT, WDOWN + (L) * SZ_DOWN, M, DM, DFF, DFF}; pg8::StaticOrder S; S.init(M, DM, G, (int)blockIdx.x); pg8::EpiB16 E{YB, DM, nullptr}; \
        pg8::gemm_phase<pg8::EpiB16, pg8::StaticOrder, true, true>(lds, g, S, E); } \
    SEAM(P0 + 2); \
    if (IN(P0 + 3)) for (int m = gw; m < M; m += ngw) post_row<false>(YB + (size_t)m * DM, H + (size_t)m * DM, nullptr, args.in[I_FFN_NPOST] + (L) * DM, RS + m, lane); \
    SEAM(P0 + 3); \
    if (IN(P0 + 4)) { pg8::Gemm g{PBF + (size_t)(L) * M * DPLE, WPROJ + (L) * SZ_PJ, M, DM, DPLE, DPLE}; pg8::StaticOrder S; S.init(M, DM, G, (int)blockIdx.x); pg8::EpiB16 E{PP, DM, nullptr}; \
        pg8::gemm_phase<pg8::EpiB16, pg8::StaticOrder, true, true>(lds, g, S, E); } \
    SEAM(P0 + 4); \
    if (IN(P0 + 5)) { pg8::Gemm g{H, WGATE + (L) * SZ_SQ, M, DM, DM, DM}; pg8::StaticOrder S; S.init(M, DM, G, (int)blockIdx.x); pg8::EpiGate E{YB, PP, DM, RS}; \
        pg8::gemm_phase<pg8::EpiGate, pg8::StaticOrder, true, true>(lds, g, S, E); } \
    SEAM(P0 + 5); \
    if (IN(P0 + 6)) { \
        for (int m = gw; m < M; m += ngw) post_row<FINALP>(YB + (size_t)m * DM, H + (size_t)m * DM, FINALP ? args.out + (size_t)m * DM : (float*)nullptr, args.in[I_PLE_NPOST] + (L) * DM, RS + m, lane); \
        if (!(FINALP) && G == 256) { asm volatile("s_waitcnt vmcnt(0)" ::: "memory"); __syncthreads(); ff_rows_mfma(H, (const bf16*)(ms + MS_WFF), RS, SMALL, lds, tid, lane, wave); } }

    FFN_PLE(8, 0, false)
    SEAM(14);
    if (IN(15)) { pg8::Gemm g{H, WCDIN, M, CD_LDP, DM, DM}; pg8::StaticOrder S; S.init(M, CD_LDP, G, (int)blockIdx.x); pg8::EpiProj E{PROJ, CD_LDP, SMALL, CD_LDP / 256, RS};
        pg8::gemm_phase<pg8::EpiProj, pg8::StaticOrder, true, true>(lds, g, S, E); }
    SEAM(15);
    if (IN(16)) {
        hgrn_chunk_prep(PROJ, args.in[I_LB], QH, OI, DS, DEC, lds, tid, lane, wave);
        if (gw2 < 64) fox_cum(SMALL, args.in[I_FOX_B], CUM, gw2, lane);
        vt_transpose(PROJ, CD_LDP, C_FV, NH, (bf16*)(ws + WS_ACT), blockIdx.x * NTHR + tid, G * NTHR);
    }
    SEAM(16);
    if (IN(17)) { if (wave == 0) { if (gw2 < 256) hgrn_state_scan(DS, DEC, SN, gw2, lane); }
        else { LAS float* scr7 = (LAS float*)(lds + wave * 16384);
            transpose_seg(args.in[I_CD_WOUT], DM, DM, 0, DM, DM, WCDOUT, 0, scr7, (int)blockIdx.x * 7 + wave - 1, G * 7, lane);
            transpose_seg(args.in[I_PLE_WGATE] + SZ_SQ, DM, DM, 0, DM, DM, WGATE + SZ_SQ, 0, scr7, (int)blockIdx.x * 7 + wave - 1, G * 7, lane, args.in[I_PLE_GNORM] + DM); } }
    SEAM(17);
    if (IN(18)) {
        fox_attn_mfma(PROJ, (const bf16*)(ws + WS_ACT), CUM, OBUF, lds, tid, lane, wave);
        __syncthreads();
        chunk_output(QH, SN, OI, args.in[I_HGRN_NORM], PROJ + C_HG, CD_LDP, OBUF, lds, tid, lane, wave);
    }
    SEAM(18);
    if (IN(19)) { pg8::Gemm g{OBUF, WCDOUT, M, DM, DM, DM}; pg8::StaticOrder S; S.init(M, DM, G, (int)blockIdx.x); pg8::EpiB16 E{YB, DM, nullptr};
        pg8::gemm_phase<pg8::EpiB16, pg8::StaticOrder, true, true>(lds, g, S, E); }
    SEAM(19);
    if (IN(20)) for (int m = gw; m < M; m += ngw) post_row<false>(YB + (size_t)m * DM, H + (size_t)m * DM, nullptr, args.in[I_CD_NPOST], RS + m, lane);
    SEAM(20);
    FFN_PLE(21, 1, true)
#undef IN
#undef SEAM
}

extern "C" void kernel_launch(void* const* d_in, const int* in_sizes, int n_in, void* d_out, int out_size, void* d_ws, size_t ws_size, hipStream_t stream) {
    static int grid = 0;
    if (grid == 0) {
        if (n_in != 33 || out_size != M * DM || ws_size < WS_END) { fprintf(stderr, "kernel_launch: unexpected problem (n_in %d, out %d, ws %zu < %zu)\n", n_in, out_size, ws_size, (size_t)WS_END); grid = -1; return; }
        int dev = 0, cus = 0, per_cu = 0;
        if (hipGetDevice(&dev) != hipSuccess || hipDeviceGetAttribute(&cus, hipDeviceAttributeMultiprocessorCount, dev) != hipSuccess) { grid = -1; return; }
        if (hipFuncSetAttribute((const void*)fwd, hipFuncAttributeMaxDynamicSharedMemorySize, LDS_BYTES) != hipSuccess) { fprintf(stderr, "kernel_launch: hipFuncSetAttribute failed\n"); grid = -1; return; }
        if (hipOccupancyMaxActiveBlocksPerMultiprocessor(&per_cu, (const void*)fwd, NTHR, LDS_BYTES) != hipSuccess || per_cu < 1) fprintf(stderr, "kernel_launch: occupancy query says %d\n", per_cu);
        (void)hipGetLastError();
        if (cus * 8 < 2048) { fprintf(stderr, "kernel_launch: needs >= 256 CUs (GDN chunk prep owns 8 chunks per workgroup)\n"); grid = -1; return; }
        grid = 256;
    }
    if (grid < 0) return;
    (void)hipMemsetAsync((char*)d_ws + WS_CTL, 0, CTL_BYTES, stream);
    Args a{};
    for (int i = 0; i < 33; ++i) a.in[i] = (const float*)d_in[i];
    a.out = (float*)d_out; a.ws = (unsigned char*)d_ws;
#if MK_SINGLE
    a.ph_lo = 0; a.ph_hi = NPHASE;
    hipLaunchKernelGGL(fwd, dim3(grid), dim3(NTHR), LDS_BYTES, stream, a);
#else
    for (int ph = 0; ph < NPHASE; ++ph) { a.ph_lo = ph; a.ph_hi = ph + 1; hipLaunchKernelGGL(fwd, dim3(grid), dim3(NTHR), LDS_BYTES, stream, a); }
#endif
}
```

```cpp
#include <hip/hip_runtime.h>
#include <cstdio>
#include <cstdint>
namespace pg8 {
#define PG8_LAS __attribute__((address_space(3)))
typedef unsigned short bf16_t;
typedef short bf16x8 __attribute__((ext_vector_type(8)));
typedef float f32x4 __attribute__((ext_vector_type(4)));
typedef unsigned u32x4 __attribute__((ext_vector_type(4)));
constexpr int BM = 256, BK = 64, HALF = 128, HTB = HALF * BK * 2  , STAGE_BYTES = 8 * HTB, NXCD = 8, WGM = 8;

__host__ __device__ __forceinline__ int lds_byte(int r, int c) { const int st = (r >> 4) * 2 + (c >> 5), rr = r & 15, cc = c & 31, ob = rr * 64 + cc * 2; return st * 1024 + (ob ^ (((ob >> 9) & 1) << 5)); }
__host__ __device__ __forceinline__ void stage_rc(int b, int& R, int& C) { const int st = b / 1024, sb = b % 1024, swz = sb ^ (((sb >> 9) & 1) << 5); R = (st >> 1) * 16 + swz / 64; C = (st & 1) * 32 + (swz % 64) / 2; }
__host__ __device__ __forceinline__ int perm32(int rho) { const int n = rho >> 4, i = rho & 15; return 8 * (i >> 2) + 4 * n + (i & 3); }

struct Unit { int pm, pn; };
struct Gemm { const bf16_t* A; const bf16_t* Bt; int M, N, K, lda; };

struct StaticOrder {
    int nM, nN, nwg, G, c;
    __host__ __device__ void init(int M, int N, int G_, int c_) { nM = M / BM; nN = N / BM; nwg = nM * nN; G = G_; c = c_; }
    __host__ __device__ bool next(int i, Unit& u) const {
        const long L = (long)i * G + c; if (L >= nwg) return false;
        int wgid = (int)L; { const int q = nwg / NXCD, r = nwg % NXCD, xcd = wgid % NXCD, off = wgid / NXCD; wgid = (xcd < r ? xcd * (q + 1) : r * (q + 1) + (xcd - r) * q) + off; }
        const int nig = WGM * nN, gid = wgid / nig, fm = gid * WGM, gsz = (nM - fm) < WGM ? (nM - fm) : WGM;
        u.pm = fm + ((wgid % nig) % gsz); u.pn = (wgid % nig) / gsz; return true;
    }
    __device__ __forceinline__ void a_ready(const Unit&) const {}
    __device__ __forceinline__ void done(const Unit&) const {}
};

__device__ __forceinline__ unsigned cvt_pk_bf16(float lo, float hi) { unsigned r; asm volatile("v_cvt_pk_bf16_f32 %0, %1, %2" : "=v"(r) : "v"(lo), "v"(hi)); return r; }
typedef float f32x2 __attribute__((ext_vector_type(2)));
struct EpiB16 {
    static constexpr bool PERM = true, AFTER_DRAIN = false;
    bf16_t* O; int ldc; const float* rs;
    __device__ __forceinline__ void operator()(const f32x4 (&acc)[2][2][4][2], const Unit& u, int wr, int wc, int fr, int fq) const {
        const int row0 = u.pm * BM + wr * 64 + fr, col0 = u.pn * BM + wc * 32 + 8 * fq;
#pragma unroll
        for (int ai = 0; ai < 2; ++ai)
#pragma unroll
            for (int m = 0; m < 4; ++m) { const int row = row0 + ai * HALF + m * 16; const float sc = rs ? rs[row] : 1.f; bf16_t* rowp = O + (size_t)row * ldc + col0;
#pragma unroll
                for (int bj = 0; bj < 2; ++bj) { const f32x4 v0 = acc[ai][bj][m][0] * sc, v1 = acc[ai][bj][m][1] * sc;
                    u32x4 w; w.x = cvt_pk_bf16(v0[0], v0[1]); w.y = cvt_pk_bf16(v0[2], v0[3]); w.z = cvt_pk_bf16(v1[0], v1[1]); w.w = cvt_pk_bf16(v1[2], v1[3]);
                    *(u32x4*)(rowp + bj * HALF) = w; } }
    }
};
struct EpiProj {
    static constexpr bool PERM = true, AFTER_DRAIN = false;
    bf16_t* O; int ldc; float* S; int nb16; const float* rs;
    __device__ __forceinline__ void operator()(const f32x4 (&acc)[2][2][4][2], const Unit& u, int wr, int wc, int fr, int fq) const {
        const int row0 = u.pm * BM + wr * 64 + fr;
        if (u.pn < nb16) {
            const int col0 = u.pn * BM + wc * 32 + 8 * fq;
#pragma unroll
            for (int ai = 0; ai < 2; ++ai)
#pragma unroll
                for (int m = 0; m < 4; ++m) { const int row = row0 + ai * HALF + m * 16; const float sc = rs[row]; bf16_t* rowp = O + (size_t)row * ldc + col0;
#pragma unroll
                    for (int bj = 0; bj < 2; ++bj) { const f32x4 v0 = acc[ai][bj][m][0] * sc, v1 = acc[ai][bj][m][1] * sc;
                        u32x4 w; w.x = cvt_pk_bf16(v0[0], v0[1]); w.y = cvt_pk_bf16(v0[2], v0[3]); w.z = cvt_pk_bf16(v1[0], v1[1]); w.w = cvt_pk_bf16(v1[2], v1[3]);
                        *(u32x4*)(rowp + bj * HALF) = w; } }
        } else {
            const int col0 = wc * 32 + 8 * fq;
#pragma unroll
            for (int ai = 0; ai < 2; ++ai)
#pragma unroll
                for (int m = 0; m < 4; ++m) { const int row = row0 + ai * HALF + m * 16; const float sc = rs[row]; float* rowp = S + (size_t)row * 256 + col0;
#pragma unroll
                    for (int bj = 0; bj < 2; ++bj) { *(f32x4*)(rowp + bj * HALF) = acc[ai][bj][m][0] * sc; *(f32x4*)(rowp + bj * HALF + 4) = acc[ai][bj][m][1] * sc; } }
        }
    }
};
struct EpiGate {
    static constexpr bool PERM = true, AFTER_DRAIN = false;
    bf16_t* C; const bf16_t* PP; int ldc; const float* rs;
    __device__ __forceinline__ void operator()(const f32x4 (&acc)[2][2][4][2], const Unit& u, int wr, int wc, int fr, int fq) const {
        const int row0 = u.pm * BM + wr * 64 + fr, col0 = u.pn * BM + wc * 32 + 8 * fq;
#pragma unroll
        for (int ai = 0; ai < 2; ++ai)
#pragma unroll
            for (int m = 0; m < 4; ++m) { const int row = row0 + ai * HALF + m * 16; const float sc = rs[row]; const size_t off = (size_t)row * ldc + col0;
#pragma unroll
                for (int bj = 0; bj < 2; ++bj) { const u32x4 pw = *(const u32x4*)(PP + off + bj * HALF); const f32x4 a = acc[ai][bj][m][0] * sc, b = acc[ai][bj][m][1] * sc; u32x4 w;
                    w.x = cvt_pk_bf16(__uint_as_float(pw.x << 16) / (1.f + __expf(-a[0])), __uint_as_float(pw.x & 0xffff0000u) / (1.f + __expf(-a[1])));
                    w.y = cvt_pk_bf16(__uint_as_float(pw.y << 16) / (1.f + __expf(-a[2])), __uint_as_float(pw.y & 0xffff0000u) / (1.f + __expf(-a[3])));
                    w.z = cvt_pk_bf16(__uint_as_float(pw.z << 16) / (1.f + __expf(-b[0])), __uint_as_float(pw.z & 0xffff0000u) / (1.f + __expf(-b[1])));
                    w.w = cvt_pk_bf16(__uint_as_float(pw.w << 16) / (1.f + __expf(-b[2])), __uint_as_float(pw.w & 0xffff0000u) / (1.f + __expf(-b[3])));
                    *(u32x4*)(C + off + bj * HALF) = w; } }
    }
};
template <class Epi, class Sched, bool ALIGN_EPI = false, bool SP2 = false>
__device__ __forceinline__ void gemm_phase(PG8_LAS unsigned char* lds, const Gemm g, const Sched& S, const Epi& E) {
    const int tid = threadIdx.x, wid = __builtin_amdgcn_readfirstlane(tid >> 6), lane = tid & 63, wr = wid >> 2, wc = wid & 3, fr = lane & 15, fq = lane >> 4;
    const int K = g.K, nt = K / BK;
    unsigned voffA[2], voffB[2];
#pragma unroll
    for (int i = 0; i < 2; ++i) { int R, C; stage_rc(tid * 16 + i * 8192, R, C); const int Rb = Epi::PERM ? ((R & ~31) + perm32(R & 31)) : R;
        voffA[i] = (unsigned)(R * g.lda + C) * 2u; voffB[i] = (unsigned)(Rb * K + C) * 2u; }
    const size_t kstep = (size_t)(BK * 2);
    const size_t hstepA = (size_t)HALF * g.lda * 2, hstepB = (size_t)HALF * K * 2;
    const size_t tstepA = 2 * hstepA, tstepB = 2 * hstepB;
    const unsigned ldsw = (unsigned)wid * 1024u;
    const int aoff = lds_byte(wr * 64 + fr, fq * 8), boff = lds_byte(wc * 32 + fr, fq * 8);
#define PG8_SA(b, h) (((b) * 2 + (h)) * HTB)
#define PG8_SB(b, h) ((4 + (b) * 2 + (h)) * HTB)
#define PG8_STAGE(bufoff, gbase, voff) do { _Pragma("unroll") for (int _i = 0; _i < 2; ++_i) \
        __builtin_amdgcn_global_load_lds((const unsigned*)((const char*)(gbase) + (voff)[_i]), (PG8_LAS unsigned*)(lds + (bufoff) + ldsw + _i * 8192), 16, 0, 0); } while (0)
#define PG8_LDA(dst, b, h) do { _Pragma("unroll") for (int m = 0; m < 4; ++m) _Pragma("unroll") for (int k = 0; k < 2; ++k) dst[m][k] = *(const PG8_LAS bf16x8*)(lds + PG8_SA(b, h) + aoff + m * 2048 + k * 1024); } while (0)
#define PG8_LDB(dst, b, h) do { _Pragma("unroll") for (int n = 0; n < 2; ++n) _Pragma("unroll") for (int k = 0; k < 2; ++k) dst[n][k] = *(const PG8_LAS bf16x8*)(lds + PG8_SB(b, h) + boff + n * 2048 + k * 1024); } while (0)
#define PG8_MMA(ai, bj, At, Bt) do { __builtin_amdgcn_s_setprio(1); _Pragma("unroll") for (int m = 0; m < 4; ++m) _Pragma("unroll") for (int n = 0; n < 2; ++n) _Pragma("unroll") for (int k = 0; k < 2; ++k) \
        acc[ai][bj][m][n] = __builtin_amdgcn_mfma_f32_16x16x32_bf16(Bt[n][k], At[m][k], acc[ai][bj][m][n], 0, 0, 0); __builtin_amdgcn_s_setprio(0); } while (0)
#define PG8_WAIT_V(n) asm volatile("s_waitcnt vmcnt(" #n ")" ::: "memory")
#define PG8_WAIT_L(n) asm volatile("s_waitcnt lgkmcnt(" #n ")" ::: "memory")
#define PG8_BAR __builtin_amdgcn_s_barrier()
#define PG8_SCHED __builtin_amdgcn_sched_barrier(0)
    Unit cur, nxt; int ui = 0;
    if (!S.next(0, cur)) return;
    f32x4 acc[2][2][4][2];
#pragma unroll
    for (int a = 0; a < 2; ++a)
#pragma unroll
        for (int b = 0; b < 2; ++b)
#pragma unroll
            for (int m = 0; m < 4; ++m)
#pragma unroll
                for (int n = 0; n < 2; ++n) acc[a][b][m][n] = (f32x4){0.f, 0.f, 0.f, 0.f};
    bf16x8 At[4][2], B0[2][2], B1[2][2];
    const char* cA = (const char*)g.A + (size_t)cur.pm * tstepA; const char* cB = (const char*)g.Bt + (size_t)cur.pn * tstepB;
    S.a_ready(cur);
    if constexpr (SP2) {
        PG8_STAGE(PG8_SB(0, 0), cB, voffB); PG8_STAGE(PG8_SB(0, 1), cB + hstepB, voffB); PG8_STAGE(PG8_SA(0, 0), cA, voffA); PG8_STAGE(PG8_SA(0, 1), cA + hstepA, voffA);
        if (wr == 1) PG8_BAR;
        PG8_WAIT_V(2); PG8_BAR;
        PG8_STAGE(PG8_SB(1, 0), cB + kstep, voffB); PG8_STAGE(PG8_SA(1, 0), cA + kstep, voffA); PG8_STAGE(PG8_SB(1, 1), cB + hstepB + kstep, voffB);
        PG8_WAIT_V(6); PG8_BAR;
    } else {
        PG8_STAGE(PG8_SB(0, 0), cB, voffB); PG8_STAGE(PG8_SA(0, 0), cA, voffA); PG8_STAGE(PG8_SB(0, 1), cB + hstepB, voffB); PG8_STAGE(PG8_SA(0, 1), cA + hstepA, voffA);
        if (wr == 1) PG8_BAR;
        PG8_WAIT_V(4); PG8_BAR;
        PG8_STAGE(PG8_SB(1, 0), cB + kstep, voffB); PG8_STAGE(PG8_SA(1, 0), cA + kstep, voffA); PG8_STAGE(PG8_SB(1, 1), cB + hstepB + kstep, voffB);
        PG8_WAIT_V(6); PG8_BAR;
    }
    for (;;) {
        const bool has_next = S.next(ui + 1, nxt);
        const char* nA = has_next ? (const char*)g.A + (size_t)nxt.pm * tstepA : cA; const char* nB = has_next ? (const char*)g.Bt + (size_t)nxt.pn * tstepB : cB;
        for (int t = 0; t < nt; t += 2) {
            const bool last = (t == nt - 2);
            const char* a1 = cA + (size_t)(t + 1) * kstep;
            const char* a2 = last ? nA : cA + (size_t)(t + 2) * kstep; const char* b2 = last ? nB : cB + (size_t)(t + 2) * kstep;
            const char* a3 = a2 + kstep; const char* b3 = b2 + kstep;
            if (last && has_next) S.a_ready(nxt);
            if constexpr (SP2) {
            PG8_LDB(B0, 0, 0); PG8_LDB(B1, 0, 1); PG8_SCHED; PG8_LDA(At, 0, 0); PG8_STAGE(PG8_SA(1, 1), a1 + hstepA, voffA);
            PG8_WAIT_V(8); PG8_WAIT_L(0); PG8_BAR; PG8_MMA(0, 0, At, B0); PG8_MMA(0, 1, At, B1); PG8_BAR; PG8_SCHED;
            PG8_LDA(At, 0, 1); PG8_STAGE(PG8_SB(0, 0), b2, voffB); PG8_STAGE(PG8_SB(0, 1), b2 + hstepB, voffB); PG8_STAGE(PG8_SA(0, 0), a2, voffA);
            PG8_WAIT_V(8); PG8_WAIT_L(0); PG8_BAR; PG8_MMA(1, 0, At, B0); PG8_MMA(1, 1, At, B1); PG8_BAR; PG8_SCHED;
            PG8_LDB(B0, 1, 0); PG8_LDB(B1, 1, 1); PG8_SCHED; PG8_LDA(At, 1, 0); PG8_STAGE(PG8_SA(0, 1), a2 + hstepA, voffA);
            PG8_WAIT_V(8); PG8_WAIT_L(0); PG8_BAR; PG8_MMA(0, 0, At, B0); PG8_MMA(0, 1, At, B1); PG8_BAR; PG8_SCHED;
            PG8_LDA(At, 1, 1); PG8_STAGE(PG8_SB(1, 0), b3, voffB); PG8_STAGE(PG8_SB(1, 1), b3 + hstepB, voffB); PG8_STAGE(PG8_SA(1, 0), a3, voffA);
            PG8_WAIT_V(8); PG8_WAIT_L(0); PG8_BAR; PG8_MMA(1, 0, At, B0); PG8_MMA(1, 1, At, B1); PG8_BAR; PG8_SCHED;
            } else {
            PG8_LDB(B0, 0, 0); PG8_SCHED; PG8_LDA(At, 0, 0); PG8_STAGE(PG8_SA(1, 1), a1 + hstepA, voffA);
            PG8_WAIT_L(8); PG8_BAR; PG8_WAIT_L(0); PG8_MMA(0, 0, At, B0); PG8_BAR; PG8_SCHED;
            PG8_LDB(B1, 0, 1); PG8_STAGE(PG8_SB(0, 0), b2, voffB);
            PG8_BAR; PG8_WAIT_L(0); PG8_MMA(0, 1, At, B1); PG8_BAR;
            PG8_LDA(At, 0, 1); PG8_STAGE(PG8_SA(0, 0), a2, voffA);
            PG8_BAR; PG8_WAIT_L(0); PG8_MMA(1, 0, At, B0); PG8_BAR; PG8_SCHED;
            PG8_STAGE(PG8_SB(0, 1), b2 + hstepB, voffB);
            PG8_WAIT_V(6); PG8_BAR; PG8_MMA(1, 1, At, B1); PG8_BAR;
            PG8_LDB(B0, 1, 0); PG8_SCHED; PG8_LDA(At, 1, 0); PG8_STAGE(PG8_SA(0, 1), a2 + hstepA, voffA);
            PG8_WAIT_L(8); PG8_BAR; PG8_WAIT_L(0); PG8_MMA(0, 0, At, B0); PG8_BAR; PG8_SCHED;
            PG8_LDB(B1, 1, 1); PG8_STAGE(PG8_SB(1, 0), b3, voffB);
            PG8_BAR; PG8_WAIT_L(0); PG8_MMA(0, 1, At, B1); PG8_BAR;
            PG8_LDA(At, 1, 1); PG8_STAGE(PG8_SA(1, 0), a3, voffA);
            PG8_BAR; PG8_WAIT_L(0); PG8_MMA(1, 0, At, B0); PG8_BAR; PG8_SCHED;
            PG8_STAGE(PG8_SB(1, 1), b3 + hstepB, voffB);
            PG8_WAIT_V(6); PG8_BAR; PG8_MMA(1, 1, At, B1); PG8_BAR;
            }
        }
        if constexpr (ALIGN_EPI) { if (wr == 0) PG8_BAR; }
        if constexpr (!Epi::AFTER_DRAIN) { E(acc, cur, wr, wc, fr, fq); S.done(cur); }
        if (!has_next) break;
#pragma unroll
        for (int a = 0; a < 2; ++a)
#pragma unroll
            for (int b = 0; b < 2; ++b)
#pragma unroll
                for (int m = 0; m < 4; ++m)
#pragma unroll
                    for (int n = 0; n < 2; ++n) acc[a][b][m][n] = (f32x4){0.f, 0.f, 0.f, 0.f};
        cur = nxt; cA = nA; cB = nB; ++ui;
        if constexpr (ALIGN_EPI) { if (wr == 1) PG8_BAR; }
    }
    PG8_WAIT_V(0);
    if constexpr (!ALIGN_EPI) { if (wr == 0) PG8_BAR; }
    PG8_BAR;
    if constexpr (Epi::AFTER_DRAIN) { E.fused(acc, cur, wr, wc, fr, fq, lds, wid, lane); S.done(cur); }
#undef PG8_SA
#undef PG8_SB
#undef PG8_STAGE
#undef PG8_LDA
#undef PG8_LDB
#undef PG8_MMA
#undef PG8_WAIT_V
#undef PG8_WAIT_L
#undef PG8_BAR
#undef PG8_SCHED
}
}
constexpr int NB = 4, T = 2048, DM = 4096, M = NB * T, HD = 128, NH = 16, DFF = 11008, DPLE = 256;
constexpr int AB_IN = 13392, CD_IN = 14352;
constexpr int AB_LDP = 13312, AB_NPAD = 13568;
constexpr int CD_LDP = 14336, CD_NPAD = 14592;
constexpr int A_QKV = 0, A_GATE = 6144, A_NQ = 8192, A_NKV = 10240;
constexpr int C_HQ = 0, C_HF = 2048, C_HI = 4096, C_HG = 6144, C_FQ = 8192, C_FK = 10240, C_FV = 12288;
constexpr int NCMP = 127;
constexpr float EPS = 1e-6f, QSCALE = 0.08838834764831845f;
constexpr size_t MiB = 1u << 20;
constexpr size_t WS_CTL = 0, CTL_BYTES = 65536;
constexpr size_t WS_WABIN = 1 * MiB;
constexpr size_t WS_WABOUT = WS_WABIN + 106 * MiB;
constexpr size_t WS_WCDIN = WS_WABOUT + 32 * MiB;
constexpr size_t WS_WCDOUT = WS_WCDIN + 114 * MiB;
constexpr size_t WS_WUP = WS_WCDOUT + 32 * MiB;
constexpr size_t WS_WDOWN = WS_WUP + 2 * 172 * MiB;
constexpr size_t WS_WGATE = WS_WDOWN + 2 * 86 * MiB;
constexpr size_t WS_WPROJ = WS_WGATE + 2 * 32 * MiB;
constexpr size_t WS_XRES = WS_WPROJ + 2 * 2 * MiB;
constexpr size_t WS_H = WS_XRES + 128 * MiB;
constexpr size_t WS_PROJ = WS_H + 64 * MiB;
constexpr size_t WS_SMALL = WS_PROJ + 224 * MiB;
constexpr size_t WS_Y = WS_SMALL + 8 * MiB;
constexpr size_t WS_OBUF = WS_Y + 128 * MiB;
constexpr size_t WS_Z = WS_OBUF + 64 * MiB;
constexpr size_t WS_ACT = WS_Z + 344 * MiB;
constexpr size_t WS_PP = WS_ACT + 172 * MiB;
constexpr size_t WS_PBF = WS_PP + 64 * MiB;
constexpr size_t WS_MISC = WS_PBF + 8 * MiB;
constexpr size_t WS_END = WS_MISC + 8 * MiB;
constexpr size_t WS_QN = WS_Z, WS_KN = WS_Z + 64 * MiB, WS_VV = WS_Z + 128 * MiB, WS_ORAW = WS_Z + 192 * MiB, WS_OCMP = WS_Z + 256 * MiB;
constexpr size_t MS_KC = 0, MS_VC = 1 * MiB  , MS_GG = 2 * MiB, MS_BB = 2 * MiB + 512 * 1024, MS_SEL = 3 * MiB, MS_CUM = 4 * MiB, MS_PEB = 5 * MiB;
constexpr int CW_BAR = 4096;

constexpr int NWAVES = 8, NTHR = 512;
constexpr int RING_BYTES = 131072, LDSCTL_OFF = RING_BYTES, MISC_OFF = LDSCTL_OFF + 320, LDS_BYTES = 147456;

#define GAS __attribute__((address_space(1)))
#define LAS __attribute__((address_space(3)))
typedef unsigned short bf16;
typedef unsigned v4u __attribute__((ext_vector_type(4)));
typedef unsigned v2u __attribute__((ext_vector_type(2)));
typedef float f32x4 __attribute__((ext_vector_type(4)));
#define LDS_WAIT() asm volatile("s_waitcnt lgkmcnt(0)" ::: "memory")
__device__ __forceinline__ unsigned f2bf(float f) { unsigned u = __float_as_uint(f); return (u + 0x7fffu + ((u >> 16) & 1u)) >> 16; }
__device__ __forceinline__ unsigned pk2(float lo, float hi) { return f2bf(lo) | (f2bf(hi) << 16); }
__device__ __forceinline__ float bflo(unsigned w) { return __uint_as_float(w << 16); }
__device__ __forceinline__ float bfhi(unsigned w) { return __uint_as_float(w & 0xffff0000u); }
__device__ __forceinline__ float bf2f(bf16 b) { return __uint_as_float(((unsigned)b) << 16); }
__device__ __forceinline__ float wave_sum(float v) {
#pragma unroll
    for (int o = 1; o < 64; o <<= 1) v += __shfl_xor(v, o);
    return v; }
__device__ __forceinline__ float wave_max(float v) {
#pragma unroll
    for (int o = 1; o < 64; o <<= 1) v = fmaxf(v, __shfl_xor(v, o));
    return v; }
__device__ __forceinline__ float sigm(float x) { return 1.f / (1.f + __expf(-x)); }
__device__ __forceinline__ float silu(float x) { return x / (1.f + __expf(-x)); }
__device__ __forceinline__ float softplus(float x) { return x > 20.f ? x : log1pf(__expf(x)); }
__device__ __forceinline__ float logsigm(float x) { return fminf(x, 0.f) - log1pf(__expf(-fabsf(x))); }

#define XB_TMO      128
#define XB_XCNT(j)  (256  + 64 * (j))
#define XB_XSUB(j)  (1280 + 64 * (j))
#define XB_XGEN(j)  (2304 + 64 * (j))
#define XB_TOP      3328
#define XB_TOPGEN   3392
#define XCD_BAR_WORDS 3456
#define XB_SPIN_CAP (1u << 18)
__device__ __forceinline__ unsigned xb_ld(unsigned* p)              { return __hip_atomic_load(p, __ATOMIC_RELAXED, __HIP_MEMORY_SCOPE_AGENT); }
__device__ __forceinline__ unsigned xb_add(unsigned* p, unsigned v) { return __hip_atomic_fetch_add(p, v, __ATOMIC_RELAXED, __HIP_MEMORY_SCOPE_AGENT); }
__device__ __forceinline__ unsigned xb_xcc_id() { return (unsigned)__builtin_amdgcn_s_getreg((3 << 11) | 20) & 0xFu; }
#define XB_SPIN(cond, bar) do { unsigned _sp = 0; while (cond) { __builtin_amdgcn_s_sleep(1); \
    if ((++_sp & 255u) == 0u) { if (xb_ld(&(bar)[XB_TMO])) break; if (_sp > XB_SPIN_CAP) { atomicAdd(&(bar)[XB_TMO], 1u); break; } } } } while (0)
struct XcdBarrier { unsigned* bar; unsigned x; volatile LAS unsigned* st; };
__device__ __forceinline__ XcdBarrier xcd_barrier_post(unsigned* bar, volatile LAS unsigned* st) {
    XcdBarrier b; b.bar = bar; b.x = xb_xcc_id(); b.st = st;
    if (threadIdx.x == 0) (void)xb_add(&bar[XB_XCNT(b.x)], 1u);
    return b;
}
__device__ __forceinline__ void xcd_barrier_complete(unsigned* bar, unsigned x, unsigned& nloc, unsigned& nx) {
    const unsigned G = gridDim.x * gridDim.y * gridDim.z;
    unsigned sum, cnt, mine, sp = 0u;
    for (;;) {
        sum = 0u; cnt = 0u; mine = 0u;
#pragma unroll
        for (unsigned j = 0; j < 16; ++j) { const unsigned c = xb_ld(&bar[XB_XCNT(j)]); sum += c; cnt += (c > 0u) ? 1u : 0u; mine = (j == x) ? c : mine; }
        if (sum == G) break;
        __builtin_amdgcn_s_sleep(1);
        if ((++sp & 255u) == 0u) { if (xb_ld(&bar[XB_TMO])) break; if (sp > XB_SPIN_CAP) { atomicAdd(&bar[XB_TMO], 1u); break; } }
    }
    nloc = mine > 0u ? mine : 1u; nx = cnt > 0u ? cnt : 1u;
}
__device__ __forceinline__ void xcd_barrier(const XcdBarrier& b) {
    asm volatile("s_waitcnt vmcnt(0)" ::: "memory");
    __syncthreads();
    if (threadIdx.x == 0) {
        unsigned* bar = b.bar;
        __builtin_amdgcn_s_waitcnt(0);
        unsigned nloc = b.st[0], nx = b.st[1];
        if (nloc == 0u) { xcd_barrier_complete(bar, b.x, nloc, nx); b.st[0] = nloc; b.st[1] = nx; }
        const unsigned old = xb_add(&bar[XB_XSUB(b.x)], 1u);
        const unsigned gen = old / nloc;
        if (old + 1u == (gen + 1u) * nloc) {
            __builtin_amdgcn_fence(__ATOMIC_RELEASE, "agent");
            asm volatile("s_waitcnt vmcnt(0)" ::: "memory");
            const unsigned og = xb_add(&bar[XB_TOP], 1u);
            const unsigned tg = og / nx;
            if (og + 1u == (tg + 1u) * nx) xb_add(&bar[XB_TOPGEN], 1u);
            else XB_SPIN(xb_ld(&bar[XB_TOPGEN]) == tg, bar);
            __builtin_amdgcn_fence(__ATOMIC_ACQUIRE, "agent");
            xb_add(&bar[XB_XGEN(b.x)], 1u);
            asm volatile("s_waitcnt vmcnt(0)" ::: "memory");
        } else {
            XB_SPIN(xb_ld(&bar[XB_XGEN(b.x)]) == gen, bar);
            __builtin_amdgcn_fence(__ATOMIC_ACQUIRE, "agent");
            asm volatile("s_waitcnt vmcnt(0)" ::: "memory");
        }
    }
    __syncthreads();
}

__device__ __forceinline__ void transpose_seg(const float* W, int K, int ldw, int c0, int nvalid, int npad, bf16* Wt, int r0, LAS float* scr, int gw, int ngw, int lane, const float* kscale = nullptr) {
    const int nblk = npad / 32, nitems = (K / 64) * nblk;
    const int nkb = K / 64, GK = (nkb % 8 == 0) ? 8 : ((nkb % 4 == 0) ? 4 : 1), GN = 64 / GK; const bool blocked = (GK > 1) && (nblk % GN == 0);
    for (int item = gw; item < nitems; item += ngw) {
        int kb, nb;
        if (blocked) { const int grp = item >> 6, w = item & 63, gpr = nblk / GN; kb = GK * (grp / gpr) + w / GN; nb = GN * (grp % gpr) + w % GN; }
        else { kb = item / nblk; nb = item % nblk; }
        const int k0 = 64 * kb, n0 = 32 * nb;
        const int nn = n0 + (lane & 31); const bool ok = nn < nvalid;
        const float* src = W + (size_t)k0 * ldw + c0 + (ok ? nn : 0);
#pragma unroll 8
        for (int i = 0; i < 32; ++i) { const int kk = 2 * i + (lane >> 5); const float v = src[(size_t)kk * ldw]; scr[kk * 33 + (lane & 31)] = ok ? v : 0.f; }
        LDS_WAIT(); asm volatile("" ::: "memory");
        const int c = lane & 7;
        f32x4 ka = (f32x4){1.f, 1.f, 1.f, 1.f}, kb2 = ka;
        if (kscale) { ka = *(const f32x4*)(kscale + k0 + 8 * c); kb2 = *(const f32x4*)(kscale + k0 + 8 * c + 4); }
#pragma unroll
        for (int j = 0; j < 4; ++j) { const int n = (lane >> 3) + 8 * j; const LAS float* s = scr + (8 * c) * 33 + n;
            v4u o; o.x = pk2(s[0 * 33] * ka.x, s[1 * 33] * ka.y); o.y = pk2(s[2 * 33] * ka.z, s[3 * 33] * ka.w); o.z = pk2(s[4 * 33] * kb2.x, s[5 * 33] * kb2.y); o.w = pk2(s[6 * 33] * kb2.z, s[7 * 33] * kb2.w);
            *(v4u*)(Wt + (size_t)(r0 + n0 + n) * K + k0 + 8 * c) = o; }
        LDS_WAIT(); asm volatile("" ::: "memory");
    }
}
__device__ __forceinline__ void prep_row(const float* xrow, bf16* orow, float* rs, int lane) {
    asm volatile("" : "+v"(lane));
    const f32x4* xr = (const f32x4*)xrow; v4u* o = (v4u*)orow; float s = 0.f;
#pragma unroll
    for (int j = 0; j < 8; ++j) { const int c = lane + 64 * j; const f32x4 a = xr[2 * c], b = xr[2 * c + 1];
        s += (a.x * a.x + a.y * a.y) + (a.z * a.z + a.w * a.w) + (b.x * b.x + b.y * b.y) + (b.z * b.z + b.w * b.w);
        v4u w; w.x = pk2(a.x, a.y); w.y = pk2(a.z, a.w); w.z = pk2(b.x, b.y); w.w = pk2(b.z, b.w); o[c] = w; }
    s = wave_sum(s); if (lane == 0) *rs = rsqrtf(s * (1.f / DM) + EPS);
}
template <bool FINAL>
__device__ __forceinline__ void post_row(const bf16* yrow, bf16* xrow, float* fout, const float* wpost, float* rs, int lane) {
    asm volatile("" : "+v"(lane));
    const v4u* yr = (const v4u*)yrow; v4u* xr = (v4u*)xrow; const f32x4* wp = (const f32x4*)wpost; v4u yv[8]; float s = 0.f;
#pragma unroll
    for (int j = 0; j < 8; ++j) { yv[j] = yr[lane + 64 * j]; const v4u w = yv[j];
        s += (bflo(w.x) * bflo(w.x) + bfhi(w.x) * bfhi(w.x)) + (bflo(w.y) * bflo(w.y) + bfhi(w.y) * bfhi(w.y)) + (bflo(w.z) * bflo(w.z) + bfhi(w.z) * bfhi(w.z)) + (bflo(w.w) * bflo(w.w) + bfhi(w.w) * bfhi(w.w)); }
    const float rstd = rsqrtf(wave_sum(s) * (1.f / DM) + EPS); float s2 = 0.f;
#pragma unroll
    for (int j = 0; j < 8; ++j) { const int c = lane + 64 * j; const v4u xw = xr[c], yw = yv[j]; const f32x4 wa = wp[2 * c], wb = wp[2 * c + 1];
        f32x4 a, b;
        a.x = bflo(xw.x) + bflo(yw.x) * rstd * wa.x; a.y = bfhi(xw.x) + bfhi(yw.x) * rstd * wa.y; a.z = bflo(xw.y) + bflo(yw.y) * rstd * wa.z; a.w = bfhi(xw.y) + bfhi(yw.y) * rstd * wa.w;
        b.x = bflo(xw.z) + bflo(yw.z) * rstd * wb.x; b.y = bfhi(xw.z) + bfhi(yw.z) * rstd * wb.y; b.z = bflo(xw.w) + bflo(yw.w) * rstd * wb.z; b.w = bfhi(xw.w) + bfhi(yw.w) * rstd * wb.w;
        if (FINAL) { ((f32x4*)fout)[2 * c] = a; ((f32x4*)fout)[2 * c + 1] = b; }
        else { s2 += (a.x * a.x + a.y * a.y) + (a.z * a.z + a.w * a.w) + (b.x * b.x + b.y * b.y) + (b.z * b.z + b.w * b.w);
            v4u w; w.x = pk2(a.x, a.y); w.y = pk2(a.z, a.w); w.z = pk2(b.x, b.y); w.w = pk2(b.z, b.w); xr[c] = w; } }
    if (!FINAL) { s2 = wave_sum(s2); if (lane == 0) *rs = rsqrtf(s2 * (1.f / DM) + EPS); }
}
__device__ __forceinline__ void ff_rows_mfma(const bf16* X, const bf16* WT, const float* RS, float* SMALLp, LAS unsigned char* lds, int tid, int lane, int wave) {
    typedef short bf16x8_ __attribute__((ext_vector_type(8))); typedef float f32x16_ __attribute__((ext_vector_type(16)));
    const int r = lane & 31, hh = lane >> 5; const int m = 8 * (int)blockIdx.x + (r & 7) + 2048 * (r >> 3);
    const bf16* xa = X + (size_t)m * DM + 512 * wave + 8 * hh; const bf16* wb = WT + (size_t)(r & 15) * DM + 512 * wave + 8 * hh;
    f32x16_ acc;
#pragma unroll
    for (int i = 0; i < 16; ++i) acc[i] = 0.f;
#pragma unroll 8
    for (int ks = 0; ks < 32; ++ks) { const bf16x8_ a = *(const bf16x8_*)(xa + 16 * ks); bf16x8_ b = *(const bf16x8_*)(wb + 16 * ks); if (r >= 16) b = (bf16x8_){0, 0, 0, 0, 0, 0, 0, 0};
        acc = __builtin_amdgcn_mfma_f32_32x32x16_bf16(a, b, acc, 0, 0, 0); }
    LAS float* P = (LAS float*)lds;
    if (r < 16) {
#pragma unroll
        for (int i = 0; i < 16; ++i) { const int rr = (i & 3) + 8 * (i >> 2) + 4 * hh; P[(wave * 32 + rr) * 16 + r] = acc[i]; } }
    __syncthreads();
    { const int rr = tid >> 4, c = tid & 15; float sacc = 0.f;
#pragma unroll
      for (int w = 0; w < 8; ++w) sacc += P[(w * 32 + rr) * 16 + c];
      const int mm = 8 * (int)blockIdx.x + (rr & 7) + 2048 * (rr >> 3);
      SMALLp[(size_t)mm * 256 + c] = sacc * RS[mm]; }
    __syncthreads();
}
__device__ __forceinline__ void convact_phase(const bf16* Z, const float* cw, const float* cb, bf16* ACT, int gtid, int ngt) {
    constexpr int CG = DFF / 8, RG = M / 8;
    for (int item = gtid; item < CG * RG; item += ngt) {
        const int cg = item % CG, rg = item / CG, c = cg * 8, r0 = rg * 8, t0 = r0 & (T - 1);
        float w[2][3][8], bb[2][8];
#pragma unroll
        for (int s = 0; s < 2; ++s) {
#pragma unroll
            for (int j = 0; j < 3; ++j) { const f32x4 a = *(const f32x4*)(cw + (size_t)j * 2 * DFF + s * DFF + c), b = *(const f32x4*)(cw + (size_t)j * 2 * DFF + s * DFF + c + 4);
                w[s][j][0] = a.x; w[s][j][1] = a.y; w[s][j][2] = a.z; w[s][j][3] = a.w; w[s][j][4] = b.x; w[s][j][5] = b.y; w[s][j][6] = b.z; w[s][j][7] = b.w; }
            const f32x4 a = *(const f32x4*)(cb + s * DFF + c), b = *(const f32x4*)(cb + s * DFF + c + 4);
            bb[s][0] = a.x; bb[s][1] = a.y; bb[s][2] = a.z; bb[s][3] = a.w; bb[s][4] = b.x; bb[s][5] = b.y; bb[s][6] = b.z; bb[s][7] = b.w; }
        float zm2[2][8], zm1[2][8];
#pragma unroll
        for (int s = 0; s < 2; ++s) {
            v4u a = (v4u){0u, 0u, 0u, 0u}, b = (v4u){0u, 0u, 0u, 0u};
            if (t0 >= 2) a = *(const v4u*)(Z + (size_t)(r0 - 2) * (2 * DFF) + s * DFF + c);
            if (t0 >= 1) b = *(const v4u*)(Z + (size_t)(r0 - 1) * (2 * DFF) + s * DFF + c);
            zm2[s][0] = bflo(a.x); zm2[s][1] = bfhi(a.x); zm2[s][2] = bflo(a.y); zm2[s][3] = bfhi(a.y); zm2[s][4] = bflo(a.z); zm2[s][5] = bfhi(a.z); zm2[s][6] = bflo(a.w); zm2[s][7] = bfhi(a.w);
            zm1[s][0] = bflo(b.x); zm1[s][1] = bfhi(b.x); zm1[s][2] = bflo(b.y); zm1[s][3] = bfhi(b.y); zm1[s][4] = bflo(b.z); zm1[s][5] = bfhi(b.z); zm1[s][6] = bflo(b.w); zm1[s][7] = bfhi(b.w); }
#pragma unroll
        for (int i = 0; i < 8; ++i) {
            float z0[2][8], u[2][8];
#pragma unroll
            for (int s = 0; s < 2; ++s) { const v4u a = *(const v4u*)(Z + (size_t)(r0 + i) * (2 * DFF) + s * DFF + c);
                z0[s][0] = bflo(a.x); z0[s][1] = bfhi(a.x); z0[s][2] = bflo(a.y); z0[s][3] = bfhi(a.y); z0[s][4] = bflo(a.z); z0[s][5] = bfhi(a.z); z0[s][6] = bflo(a.w); z0[s][7] = bfhi(a.w);
#pragma unroll
                for (int e = 0; e < 8; ++e) { u[s][e] = bb[s][e] + w[s][0][e] * zm2[s][e] + w[s][1][e] * zm1[s][e] + w[s][2][e] * z0[s][e]; zm2[s][e] = zm1[s][e]; zm1[s][e] = z0[s][e]; } }
            v4u o; o.x = pk2(silu(u[0][0]) * u[1][0], silu(u[0][1]) * u[1][1]); o.y = pk2(silu(u[0][2]) * u[1][2], silu(u[0][3]) * u[1][3]);
            o.z = pk2(silu(u[0][4]) * u[1][4], silu(u[0][5]) * u[1][5]); o.w = pk2(silu(u[0][6]) * u[1][6], silu(u[0][7]) * u[1][7]);
            *(v4u*)(ACT + (size_t)(r0 + i) * DFF + c) = o;
        }
    }
}
__device__ __forceinline__ void gdn_prep_naive(const bf16* proj, const float* small, const float* cw, const float* a_log, const float* dt_bias,
                                               float* QN, float* KN, float* VV, float* GG, float* BB, int gw, int ngw, int lane) {
    for (int item = gw; item < M * NH; item += ngw) {
        const int row = item >> 4, h = item & 15, t = row & (T - 1), b = row >> 11;
        float val[3][2];
#pragma unroll
        for (int s = 0; s < 3; ++s)
#pragma unroll
            for (int dd = 0; dd < 2; ++dd) { const int ch = s * 2048 + h * HD + lane + 64 * dd; float acc = 0.f;
#pragma unroll
                for (int j = 0; j < 4; ++j) { const int tt = t - 3 + j; if (tt >= 0) acc += cw[j * 6144 + ch] * bf2f(proj[(size_t)(row - 3 + j) * AB_LDP + A_QKV + ch]); }
                val[s][dd] = silu(acc); }
        const float qi = rsqrtf(wave_sum(val[0][0] * val[0][0] + val[0][1] * val[0][1]) + EPS) * QSCALE;
        const float ki = rsqrtf(wave_sum(val[1][0] * val[1][0] + val[1][1] * val[1][1]) + EPS);
        const size_t o = ((size_t)(b * NH + h) * T + t) * HD + lane;
        QN[o] = val[0][0] * qi; QN[o + 64] = val[0][1] * qi; KN[o] = val[1][0] * ki; KN[o + 64] = val[1][1] * ki; VV[o] = val[2][0]; VV[o + 64] = val[2][1];
        if (lane == 0) { const float a = small[(size_t)row * 256 + h]; GG[(b * NH + h) * T + t] = -__expf(a_log[h]) * softplus(a + dt_bias[h]); BB[(b * NH + h) * T + t] = sigm(small[(size_t)row * 256 + 16 + h]); }
    }
}
__device__ __forceinline__ void gdn_scan_naive(const float* QN, const float* KN, const float* VV, const float* GG, const float* BB, float* ORAW, int item, int lane) {
    const int bh = item >> 2, e = (item & 3) * 32 + (lane & 31), dh = (lane >> 5) * 64, b = bh >> 4, h = bh & 15;
    float S[64];
#pragma unroll
    for (int d = 0; d < 64; ++d) S[d] = 0.f;
    const float* qp = QN + (size_t)bh * T * HD + dh; const float* kp = KN + (size_t)bh * T * HD + dh; const float* vp = VV + (size_t)bh * T * HD;
    for (int t = 0; t < T; ++t) {
        const float eg = __expf(GG[bh * T + t]), beta = BB[bh * T + t], ve = vp[(size_t)t * HD + e];
        float k[64]; float dot = 0.f;
#pragma unroll
        for (int d4 = 0; d4 < 16; ++d4) { const f32x4 k4 = *(const f32x4*)(kp + (size_t)t * HD + 4 * d4);
#pragma unroll
            for (int i = 0; i < 4; ++i) { k[4 * d4 + i] = k4[i]; S[4 * d4 + i] *= eg; dot += S[4 * d4 + i] * k4[i]; } }
        dot += __shfl_xor(dot, 32);
        const float u = beta * (ve - dot); float o = 0.f;
#pragma unroll
        for (int d4 = 0; d4 < 16; ++d4) { const f32x4 q4 = *(const f32x4*)(qp + (size_t)t * HD + 4 * d4);
#pragma unroll
            for (int i = 0; i < 4; ++i) { S[4 * d4 + i] += k[4 * d4 + i] * u; o += S[4 * d4 + i] * q4[i]; } }
        o += __shfl_xor(o, 32);
        if (lane < 32) ORAW[(size_t)(b * T + t) * 2048 + h * HD + e] = o;
    }
}
__device__ __forceinline__ void headnorm_gate(const float* ORAW, const float* nw, const bf16* gate, int ldg, bf16* OBUF, int gw, int ngw, int lane) {
    for (int item = gw; item < M * NH; item += ngw) {
        const int row = item >> 4, h = item & 15;
        const float o0 = ORAW[(size_t)row * 2048 + h * HD + 2 * lane], o1 = ORAW[(size_t)row * 2048 + h * HD + 2 * lane + 1];
        const float rstd = rsqrtf(wave_sum(o0 * o0 + o1 * o1) * (1.f / HD) + EPS);
        const unsigned gwd = *(const unsigned*)(gate + (size_t)row * ldg + h * HD + 2 * lane);
        *(unsigned*)(OBUF + (size_t)row * DM + h * HD + 2 * lane) = pk2(o0 * rstd * nw[2 * lane] * silu(bflo(gwd)), o1 * rstd * nw[2 * lane + 1] * silu(bfhi(gwd)));
    }
}
__device__ __forceinline__ void hgrn_prep_naive(const bf16* proj, const float* lbl, float* FB, float* QB, int gw, int ngw, int lane) {
    for (int item = gw; item < M * NH; item += ngw) {
        const int row = item >> 4, h = item & 15, t = row & (T - 1), b = row >> 11;
#pragma unroll
        for (int dd = 0; dd < 2; ++dd) { const int c = h * HD + lane + 64 * dd; const float lb = sigm(lbl[2048 + c] - lbl[c]);
            const float fx = bf2f(proj[(size_t)row * CD_LDP + C_HF + c]), qx = bf2f(proj[(size_t)row * CD_LDP + C_HQ + c]);
            const size_t o = ((size_t)(b * NH + h) * T + t) * HD + lane + 64 * dd; FB[o] = lb + (1.f - lb) * sigm(fx); QB[o] = silu(qx); }
    }
}
__device__ __forceinline__ void hgrn_scan_naive(const float* FB, const float* QB, const bf16* proj, float* ORAW, int item, int lane) {
    const int bh = item >> 1, e = (item & 1) * 64 + lane, b = bh >> 4, h = bh & 15;
    float S[HD];
#pragma unroll
    for (int d = 0; d < HD; ++d) S[d] = 0.f;
    const float* fp = FB + (size_t)bh * T * HD; const float* qp = QB + (size_t)bh * T * HD;
    for (int t = 0; t < T; ++t) {
        const float ve = bf2f(proj[(size_t)(b * T + t) * CD_LDP + C_HI + h * HD + e]); float o = 0.f;
#pragma unroll
        for (int d4 = 0; d4 < HD / 4; ++d4) { const f32x4 f4 = *(const f32x4*)(fp + (size_t)t * HD + 4 * d4), q4 = *(const f32x4*)(qp + (size_t)t * HD + 4 * d4);
#pragma unroll
            for (int i = 0; i < 4; ++i) { S[4 * d4 + i] = f4[i] * S[4 * d4 + i] + (1.f - f4[i]) * ve; o += S[4 * d4 + i] * q4[i]; } }
        ORAW[(size_t)(b * T + t) * 2048 + h * HD + e] = o;
    }
}
__device__ __forceinline__ void fox_cum(const float* small, const float* fbias, float* CUM, int item, int lane) {
    const int b = item >> 4, h = item & 15; float loc[32]; float run = 0.f;
#pragma unroll
    for (int i = 0; i < 32; ++i) { run += logsigm(small[(size_t)(b * T + 32 * lane + i) * 256 + h] + fbias[h]); loc[i] = run; }
    float incl = run;
#pragma unroll
    for (int o = 1; o < 64; o <<= 1) { const float v = __shfl_up(incl, o); if (lane >= o) incl += v; }
    const float excl = incl - run;
#pragma unroll
    for (int i = 0; i < 32; ++i) CUM[(size_t)item * T + 32 * lane + i] = excl + loc[i];
}
struct RowAcc { float m, l, a0, a1; };
__device__ __forceinline__ float dot128(const LAS float* qs, const bf16* krow) {
    const v4u* kr = (const v4u*)krow; float dot = 0.f;
#pragma unroll
    for (int c = 0; c < 16; ++c) { const v4u w = kr[c]; const f32x4 qa = *(const LAS f32x4*)(qs + 8 * c), qb = *(const LAS f32x4*)(qs + 8 * c + 4);
        dot += bflo(w.x) * qa[0] + bfhi(w.x) * qa[1] + bflo(w.y) * qa[2] + bfhi(w.y) * qa[3] + bflo(w.z) * qb[0] + bfhi(w.z) * qb[1] + bflo(w.w) * qb[2] + bfhi(w.w) * qb[3]; }
    return dot;
}
__device__ __forceinline__ void attend_chunk(RowAcc& st, const LAS float* qs, const bf16* Kb, const bf16* Vb, size_t ld, int kb, int kmax, bool valid, float bias, LAS float* pbuf, int lane) {
    int key = kb + lane; key = key < 0 ? 0 : (key > kmax ? kmax : key);
    const float dot = dot128(qs, Kb + (size_t)key * ld);
    const float s = valid ? dot + bias : -INFINITY;
    const float cm = wave_max(s);
    if (cm == -INFINITY) return;
    const float mn = fmaxf(st.m, cm), corr = __expf(st.m - mn), p = valid ? __expf(s - mn) : 0.f;
    st.l = st.l * corr + wave_sum(p); st.m = mn; st.a0 *= corr; st.a1 *= corr;
    asm volatile("s_waitcnt lgkmcnt(0)" ::: "memory"); pbuf[lane] = p; asm volatile("s_waitcnt lgkmcnt(0)" ::: "memory");
    for (int j = 0; j < 64; ++j) { const float pj = pbuf[j]; int kj = kb + j; kj = kj < 0 ? 0 : (kj > kmax ? kmax : kj);
        const unsigned w = *(const unsigned*)(Vb + (size_t)kj * ld + 2 * lane); st.a0 += pj * bflo(w); st.a1 += pj * bfhi(w); }
    asm volatile("s_waitcnt lgkmcnt(0)" ::: "memory");
}
__device__ __forceinline__ void fox_attn_naive(const bf16* proj, const float* CUM, bf16* OBUF, LAS float* wl, int gw, int ngw, int lane) {
    LAS float* qs = wl; LAS float* pbuf = wl + 128;
    for (int item = gw; item < M * NH; item += ngw) {
        const int row = item >> 4, h = item & 15, t = row & (T - 1), b = row >> 11;
        const unsigned qw = *(const unsigned*)(proj + (size_t)row * CD_LDP + C_FQ + h * HD + 2 * lane);
        asm volatile("s_waitcnt lgkmcnt(0)" ::: "memory"); qs[2 * lane] = bflo(qw) * QSCALE; qs[2 * lane + 1] = bfhi(qw) * QSCALE; asm volatile("s_waitcnt lgkmcnt(0)" ::: "memory");
        const bf16* Kb = proj + (size_t)b * T * CD_LDP + C_FK + h * HD; const bf16* Vb = proj + (size_t)b * T * CD_LDP + C_FV + h * HD;
        const float* cum = CUM + (size_t)(b * NH + h) * T; const float cq = cum[t];
        RowAcc st{-INFINITY, 0.f, 0.f, 0.f};
        for (int kb = 0; kb <= t; kb += 64) { const int key = kb + lane; const bool valid = key <= t; attend_chunk(st, qs, Kb, Vb, CD_LDP, kb, T - 1, valid, cq - cum[key > T - 1 ? T - 1 : key], pbuf, lane); }
        const float il = 1.f / st.l;
        *(unsigned*)(OBUF + (size_t)row * DM + 2048 + h * HD + 2 * lane) = pk2(st.a0 * il, st.a1 * il);
    }
}
__device__ __forceinline__ void nsa_compress_naive(const bf16* proj, const float* pe_k, const float* pe_v, const float* wk1, const float* wk2, const float* wv1, const float* wv2,
                                                   bf16* KC, bf16* VC, LAS float* lf, int tid) {
    for (int item = blockIdx.x; item < 16 * NCMP * 2; item += gridDim.x) {
        const int kv = item & 1, r = item >> 1, n = r % NCMP, bg = r / NCMP, b = bg >> 2, g = bg & 3;
        const float* pe = kv ? pe_v : pe_k; const float* w1 = kv ? wv1 : wk1; const float* w2 = kv ? wv2 : wk2;
        const int j = tid & 127, part = tid >> 7; float acc = 0.f;
        for (int i = part * 1024; i < part * 1024 + 1024; ++i) { const int l = i >> 7, d = i & 127;
            const float z = bf2f(proj[(size_t)(b * T + 16 * n + l) * AB_LDP + A_NKV + kv * 512 + g * HD + d]) + pe[i];
            acc += z * w1[(size_t)i * HD + j]; }
        lf[part * 128 + j] = acc;
        __syncthreads();
        if (tid < 128) { const float hsum = lf[j] + lf[128 + j] + lf[256 + j] + lf[384 + j]; lf[512 + j] = silu(hsum); }
        __syncthreads();
        if (tid < 128) { float o = 0.f; for (int i = 0; i < 128; ++i) o += lf[512 + i] * w2[i * HD + j]; if (kv) VC[((size_t)bg * 128 + j) * 128 + (n & ~15) + ((n >> 2) & 1) * 8 + ((n & 15) >> 3) * 4 + (n & 3)] = (bf16)f2bf(o); else KC[((size_t)bg * 128 + n) * HD + j] = (bf16)f2bf(o); }
        __syncthreads();
    }
}
__device__ __forceinline__ void nsa_cmp_naive(const bf16* proj, const bf16* KC, const bf16* VC, float* OCMP, unsigned* SEL, LAS float* wl, int gw, int ngw, int lane) {
    LAS float* qs = wl; LAS float* pbuf = wl + 128;
    for (int item = gw; item < M * 4; item += ngw) {
        const int row = item >> 2, g = item & 3, t = row & (T - 1), b = row >> 11, bg = b * 4 + g;
        const bf16* Kb = KC + (size_t)bg * 128 * HD; const bf16* Vb = VC + (size_t)bg * 128 * HD;
        const int n0 = lane, n1 = lane + 64; const bool v0 = 16 * n0 + 31 <= t, v1 = (n1 < NCMP) && (16 * n1 + 31 <= t);
        float ps0 = 0.f, ps1 = 0.f;
        for (int p = 0; p < 4; ++p) {
            const int head = g * 4 + p;
            const unsigned qw = *(const unsigned*)(proj + (size_t)row * AB_LDP + A_NQ + head * HD + 2 * lane);
            asm volatile("s_waitcnt lgkmcnt(0)" ::: "memory"); qs[2 * lane] = bflo(qw) * QSCALE; qs[2 * lane + 1] = bfhi(qw) * QSCALE; asm volatile("s_waitcnt lgkmcnt(0)" ::: "memory");
            const float s0 = v0 ? dot128(qs, Kb + (size_t)n0 * HD) : -INFINITY, s1 = v1 ? dot128(qs, Kb + (size_t)(n1 < 128 ? n1 : 127) * HD) : -INFINITY;
            const float mx = wave_max(fmaxf(s0, s1)); float p0 = 0.f, p1 = 0.f;
            if (mx != -INFINITY) { const float e0 = v0 ? __expf(s0 - mx) : 0.f, e1 = v1 ? __expf(s1 - mx) : 0.f; const float il = 1.f / wave_sum(e0 + e1); p0 = e0 * il; p1 = e1 * il; }
            ps0 += p0; ps1 += p1;
            pbuf[lane] = p0; pbuf[64 + lane] = p1; asm volatile("s_waitcnt lgkmcnt(0)" ::: "memory");
            float a0 = 0.f, a1 = 0.f;
            for (int n = 0; n < NCMP; ++n) { const float pj = pbuf[n]; const unsigned w = *(const unsigned*)(Vb + (size_t)n * HD + 2 * lane); a0 += pj * bflo(w); a1 += pj * bfhi(w); }
            *(float2*)(OCMP + (size_t)row * 2048 + head * HD + 2 * lane) = make_float2(a0, a1);
            asm volatile("s_waitcnt lgkmcnt(0)" ::: "memory");
        }
        pbuf[lane] = ps0; pbuf[64 + lane] = ps1; asm volatile("s_waitcnt lgkmcnt(0)" ::: "memory");
        const int cur = t >> 6, m = lane; float sc = -INFINITY;
        if (m < 32 && m <= cur) {
            if (m == 0 || m == cur || m == cur - 1) sc = 1e4f;
            else { float im = 0.f; for (int n = 4 * m - 1; n <= 4 * m + 3; ++n) if (n >= 0 && n < NCMP) im += pbuf[n]; sc = im; }
        }
        unsigned mask = 0u;
        for (int r = 0; r < 8; ++r) { const float mx = wave_max(sc); if (mx == -INFINITY) break;
            const unsigned long long ball = __ballot(sc == mx); const int idx = __ffsll((long long)ball) - 1; mask |= 1u << idx; if (lane == idx) sc = -INFINITY; }
        if (lane == 0) SEL[(size_t)bg * T + t] = mask;
        asm volatile("s_waitcnt lgkmcnt(0)" ::: "memory");
    }
}
__device__ __forceinline__ void nsa_slcwin_naive(const bf16* proj, const float* small, const float* OCMP, const unsigned* SEL, bf16* OBUF, LAS float* wl, int gw, int ngw, int lane) {
    LAS float* qs = wl; LAS float* pbuf = wl + 128;
    for (int item = gw; item < M * NH; item += ngw) {
        const int row = item >> 4, head = item & 15, g = head >> 2, t = row & (T - 1), b = row >> 11;
        const unsigned qw = *(const unsigned*)(proj + (size_t)row * AB_LDP + A_NQ + head * HD + 2 * lane);
        asm volatile("s_waitcnt lgkmcnt(0)" ::: "memory"); qs[2 * lane] = bflo(qw) * QSCALE; qs[2 * lane + 1] = bfhi(qw) * QSCALE; asm volatile("s_waitcnt lgkmcnt(0)" ::: "memory");
        const bf16* base = proj + (size_t)b * T * AB_LDP + A_NKV + g * HD;
        const unsigned sel = SEL[(size_t)(b * 4 + g) * T + t]; const int cur = t >> 6;
        RowAcc ss{-INFINITY, 0.f, 0.f, 0.f};
        for (int m = 0; m <= cur; ++m) if ((sel >> m) & 1u) { const int key = 64 * m + lane; attend_chunk(ss, qs, base + 2 * 512, base + 3 * 512, AB_LDP, 64 * m, T - 1, key <= t, 0.f, pbuf, lane); }
        RowAcc sw{-INFINITY, 0.f, 0.f, 0.f};
        const int first = t - 511 > 0 ? t - 511 : 0;
        for (int kb = first & ~63; kb <= t; kb += 64) { const int key = kb + lane; attend_chunk(sw, qs, base + 4 * 512, base + 5 * 512, AB_LDP, kb, T - 1, key >= first && key <= t, 0.f, pbuf, lane); }
        const float gc = sigm(small[(size_t)row * 256 + 32 + head]), gs = sigm(small[(size_t)row * 256 + 48 + head]), gwn = sigm(small[(size_t)row * 256 + 64 + head]);
        const float2 oc = *(const float2*)(OCMP + (size_t)row * 2048 + head * HD + 2 * lane);
        const float is = gs / ss.l, iw = gwn / sw.l;
        *(unsigned*)(OBUF + (size_t)row * DM + 2048 + head * HD + 2 * lane) = pk2(gc * oc.x + is * ss.a0 + iw * sw.a0, gc * oc.y + is * ss.a1 + iw * sw.a1);
    }
}
typedef short bf16x8 __attribute__((ext_vector_type(8)));
typedef float f32x16 __attribute__((ext_vector_type(16)));
typedef __bf16 bf16x2_t __attribute__((ext_vector_type(2)));
typedef float f32x2_t __attribute__((ext_vector_type(2)));
__device__ __forceinline__ unsigned cvtpk(float lo, float hi) { f32x2_t v = {lo, hi}; return __builtin_bit_cast(unsigned, __builtin_convertvector(v, bf16x2_t)); }
#define MFMA32(a, b, c) __builtin_amdgcn_mfma_f32_32x32x16_bf16((a), (b), (c), 0, 0, 0)
constexpr float LOG2E = 1.4426950408889634f, C1 = QSCALE * LOG2E;
constexpr int AT_K = 0, AT_V = 16384, AT_CK = 32768;
__device__ __forceinline__ void vt_transpose(const bf16* src, int ld, int col0, int nh, bf16* VT, int gtid, int ngt) {
    const int total = NB * nh * 128 * (T / 8);
    for (int idx = gtid; idx < total; idx += ngt) {
        const int d = idx & 127, tc = (idx >> 7) & 255, bh = idx >> 15, b = bh / nh, hh = bh % nh;
        unsigned short e[8];
#pragma unroll
        for (int j = 0; j < 8; ++j) { const int p = 8 * tc + j, pp = p & 15, h2 = pp >> 3, jj = pp & 7, t = (p & ~15) + 8 * (jj >> 2) + 4 * h2 + (jj & 3);
            e[j] = src[(size_t)(b * T + t) * ld + col0 + hh * 128 + d]; }
        v4u o; o.x = e[0] | ((unsigned)e[1] << 16); o.y = e[2] | ((unsigned)e[3] << 16); o.z = e[4] | ((unsigned)e[5] << 16); o.w = e[6] | ((unsigned)e[7] << 16);
        *(v4u*)(VT + ((size_t)bh * 128 + d) * T + 8 * tc) = o;
    }
}
__device__ __forceinline__ void qk_tile(const LAS unsigned char* ldk, const bf16x8 (&qf)[8], f32x16 (&s)[2], int lane) {
    const int r = lane & 31; int y = (lane >> 5) ^ (r & 15); asm volatile("" : "+v"(y));
    const LAS unsigned char* base = ldk + r * 256;
#pragma unroll
    for (int i = 0; i < 16; ++i) { s[0][i] = 0.f; s[1][i] = 0.f; }
#pragma unroll
    for (int ks = 0; ks < 8; ++ks)
#pragma unroll
        for (int rb = 0; rb < 2; ++rb) {
            const bf16x8 a = *(const LAS bf16x8*)(base + rb * 8192 + (((2 * ks) ^ y) << 4));
            s[rb] = MFMA32(a, qf[ks], s[rb]); }
}
__device__ __forceinline__ void qk_tile_lq(const LAS unsigned char* ldk, const LAS unsigned char* ldq, f32x16 (&s)[2], int lane) {
    const int r = lane & 31; int y = (lane >> 5) ^ (r & 15); asm volatile("" : "+v"(y));
    const LAS unsigned char* base = ldk + r * 256; const LAS unsigned char* qb = ldq + r * 256;
#pragma unroll
    for (int i = 0; i < 16; ++i) { s[0][i] = 0.f; s[1][i] = 0.f; }
#pragma unroll
    for (int ks = 0; ks < 8; ++ks) { const bf16x8 q = *(const LAS bf16x8*)(qb + (((2 * ks) ^ y) << 4));
#pragma unroll
        for (int rb = 0; rb < 2; ++rb) {
            const bf16x8 a = *(const LAS bf16x8*)(base + rb * 8192 + (((2 * ks) ^ y) << 4));
            s[rb] = MFMA32(a, q, s[rb]); }
        if ((ks & 3) == 3) __builtin_amdgcn_sched_barrier(0); }
}
__device__ __forceinline__ void pv_tile(const LAS unsigned char* ldv, const f32x16 (&p)[2], f32x16 (&O)[4], int lane) {
    const int r = lane & 31; int y = (lane >> 5) ^ ((r >> 1) & 7); asm volatile("" : "+v"(y));
    const LAS unsigned char* base = ldv + r * 128;
    bf16x8 pf[2][2];
#pragma unroll
    for (int rb = 0; rb < 2; ++rb)
#pragma unroll
        for (int st = 0; st < 2; ++st) { v4u w; w.x = cvtpk(p[rb][8 * st + 0], p[rb][8 * st + 1]); w.y = cvtpk(p[rb][8 * st + 2], p[rb][8 * st + 3]); w.z = cvtpk(p[rb][8 * st + 4], p[rb][8 * st + 5]); w.w = cvtpk(p[rb][8 * st + 6], p[rb][8 * st + 7]);
            pf[rb][st] = __builtin_bit_cast(bf16x8, w); }
#pragma unroll
    for (int db = 0; db < 4; ++db) {
#pragma unroll
        for (int kk = 0; kk < 4; ++kk) { const bf16x8 a = *(const LAS bf16x8*)(base + db * 4096 + (((2 * kk) ^ y) << 4));
            O[db] = MFMA32(a, pf[kk >> 1][kk & 1], O[db]); } }
}
struct TileRegs { v4u k[2], v[2]; float ck; };
__device__ __forceinline__ void tile_fetch(TileRegs& R, const bf16* Kg  , size_t ldk, const bf16* Vg  , size_t ldv, const float* ckg, int tid) {
#pragma unroll
    for (int i = 0; i < 2; ++i) { const int id = tid + 512 * i; R.k[i] = *(const v4u*)(Kg + (size_t)(id >> 4) * ldk + (id & 15) * 8); R.v[i] = *(const v4u*)(Vg + (size_t)(id >> 3) * ldv + (id & 7) * 8); }
    R.ck = (ckg && tid < 64) ? ckg[tid] * LOG2E : 0.f;
}
__device__ __forceinline__ void tile_commit(const TileRegs& R, LAS unsigned char* ldk, LAS unsigned char* ldv, LAS unsigned char* ldc, int tid) {
#pragma unroll
    for (int i = 0; i < 2; ++i) { const int id = tid + 512 * i; const int key = id >> 4, c = id & 15, d = id >> 3, c2 = id & 7;
        *(LAS v4u*)(ldk + key * 256 + ((c ^ (key & 15)) * 16)) = R.k[i];
        *(LAS v4u*)(ldv + d * 128 + ((c2 ^ ((d >> 1) & 7)) * 16)) = R.v[i]; }
    if (ldc && tid < 64) *(LAS float*)(ldc + tid * 4) = R.ck;
}
__device__ __forceinline__ void tile_dma(const bf16* Kg, size_t ldk, const bf16* Vg, size_t ldv, LAS unsigned char* dk, LAS unsigned char* dv, int wave, int lane) {
#pragma unroll
    for (int i = 0; i < 2; ++i) { const int piece = wave * 2 + i;
        const int krow = 4 * piece + (lane >> 4), kc = (lane & 15) ^ (krow & 15);
        __builtin_amdgcn_global_load_lds((const unsigned*)(Kg + (size_t)krow * ldk + kc * 8), (LAS unsigned*)(dk + piece * 1024), 16, 0, 0);
        const int d = 8 * piece + (lane >> 3), vc = (lane & 7) ^ ((d >> 1) & 7);
        __builtin_amdgcn_global_load_lds((const unsigned*)(Vg + (size_t)d * ldv + vc * 8), (LAS unsigned*)(dv + piece * 1024), 16, 0, 0); }
}
constexpr int AT3_CK = 3 * 32768;
constexpr int AT_B1 = 32768, AT_CK0 = 65536, AT_CK1 = 65536 + 256;
__device__ __forceinline__ void fox_attn_mfma(const bf16* proj, const bf16* VTG, const float* CUM, bf16* OBUF, LAS unsigned char* lds, int tid, int lane, int wave) {
    const int r = lane & 31, hh = lane >> 5;
    for (int idx = blockIdx.x; idx < 512; idx += gridDim.x) {
        const int bh = idx & 63, qq = idx >> 6, qt = qq < 4 ? qq : 11 - qq, b = bh >> 4, h = bh & 15, q0 = qt * 256, wq0 = q0 + 32 * wave, qi = wq0 + r;
        bf16x8 qf[8];
#pragma unroll
        for (int ks = 0; ks < 8; ++ks) qf[ks] = *(const bf16x8*)(proj + (size_t)(b * T + qi) * CD_LDP + C_FQ + h * HD + 16 * ks + 8 * hh);
        const float cq2 = CUM[(size_t)bh * T + qi] * LOG2E;
        float m = -INFINITY, l = 0.f; f32x16 O[4];
#pragma unroll
        for (int db = 0; db < 4; ++db)
#pragma unroll
            for (int i = 0; i < 16; ++i) O[db][i] = 0.f;
        const bf16* Kg = proj + (size_t)b * T * CD_LDP + C_FK + h * HD; const bf16* Vg = VTG + (size_t)bh * 128 * T; const float* ckg = CUM + (size_t)bh * T;
        const int ntiles = 4 * qt + 4;
        __syncthreads();
        tile_dma(Kg, CD_LDP, Vg, T, lds + AT_K, lds + AT_V, wave, lane);
        if (wave == 0) __builtin_amdgcn_global_load_lds((const unsigned*)(ckg + lane), (LAS unsigned*)(lds + AT3_CK), 4, 0, 0);
        tile_dma(Kg + (size_t)64 * CD_LDP, CD_LDP, Vg + 64, T, lds + AT_K + AT_B1, lds + AT_V + AT_B1, wave, lane);
        if (wave == 0) __builtin_amdgcn_global_load_lds((const unsigned*)(ckg + 64 + lane), (LAS unsigned*)(lds + AT3_CK + 256), 4, 0, 0);
        for (int kt = 0, buf = 0; kt < ntiles; ++kt, buf = buf == 2 ? 0 : buf + 1) {
            const int bo = buf * AT_B1, cko = AT3_CK + buf * 256;
            if (kt + 1 < ntiles) { if (wave == 0) asm volatile("s_waitcnt vmcnt(5)" ::: "memory"); else asm volatile("s_waitcnt vmcnt(4)" ::: "memory"); }
            else asm volatile("s_waitcnt vmcnt(0)" ::: "memory");
            __syncthreads();
            if (kt + 2 < ntiles) { const int b2 = buf == 0 ? 2 : buf - 1;
                tile_dma(Kg + (size_t)(kt + 2) * 64 * CD_LDP, CD_LDP, Vg + (kt + 2) * 64, T, lds + AT_K + b2 * AT_B1, lds + AT_V + b2 * AT_B1, wave, lane);
                if (wave == 0) __builtin_amdgcn_global_load_lds((const unsigned*)(ckg + (kt + 2) * 64 + lane), (LAS unsigned*)(lds + AT3_CK + b2 * 256), 4, 0, 0); }
            if (kt * 64 <= wq0 + 31) {
                f32x16 s[2]; qk_tile(lds + AT_K + bo, qf, s, lane);
                const bool full = kt * 64 + 63 <= wq0; float mx = -INFINITY;
#pragma unroll
                for (int rb = 0; rb < 2; ++rb)
#pragma unroll
                    for (int g4 = 0; g4 < 4; ++g4) { const f32x4 ck4 = *(const LAS f32x4*)(lds + cko + (32 * rb + 8 * g4 + 4 * hh) * 4);
#pragma unroll
                        for (int e = 0; e < 4; ++e) { const int i = 4 * g4 + e, key = kt * 64 + 32 * rb + 8 * g4 + 4 * hh + e;
                            float v = s[rb][i] * C1 + (cq2 - ck4[e] * LOG2E); if (!full && key > qi) v = -INFINITY; s[rb][i] = v; mx = fmaxf(mx, v); } }
                mx = fmaxf(mx, __shfl_xor(mx, 32));
                if (!__all(mx - m <= 8.f)) {
                    const float mn = fmaxf(m, mx), corr = __builtin_amdgcn_exp2f(m - mn); m = mn; l *= corr;
#pragma unroll
                    for (int db = 0; db < 4; ++db)
#pragma unroll
                        for (int i = 0; i < 16; ++i) O[db][i] *= corr;
                }
                float ls = 0.f;
#pragma unroll
                for (int rb = 0; rb < 2; ++rb)
#pragma unroll
                    for (int i = 0; i < 16; ++i) { const float p = __builtin_amdgcn_exp2f(s[rb][i] - m); s[rb][i] = p; ls += p; }
                l += ls;
                pv_tile(lds + AT_V + bo, s, O, lane);
            }
        }
        l += __shfl_xor(l, 32); const float il = 1.f / l;
        bf16* orow = OBUF + (size_t)(b * T + qi) * DM + 2048 + h * HD;
#pragma unroll
        for (int db = 0; db < 4; ++db)
#pragma unroll
            for (int g4 = 0; g4 < 4; ++g4) { v2u w; w.x = cvtpk(O[db][4 * g4] * il, O[db][4 * g4 + 1] * il); w.y = cvtpk(O[db][4 * g4 + 2] * il, O[db][4 * g4 + 3] * il);
                *(v2u*)(orow + 32 * db + 8 * g4 + 4 * hh) = w; }
    }
}

__device__ __forceinline__ void softmax_update(f32x16 (&s)[2], float& m, float& l, f32x16 (&O)[4]) {
    float mx = -INFINITY;
#pragma unroll
    for (int rb = 0; rb < 2; ++rb)
#pragma unroll
        for (int i = 0; i < 16; ++i) mx = fmaxf(mx, s[rb][i]);
    mx = fmaxf(mx, __shfl_xor(mx, 32));
    if (!__all(mx - m <= 8.f)) {
        const float mn = fmaxf(m, mx), ms = (mn == -INFINITY) ? 0.f : mn, corr = __builtin_amdgcn_exp2f(m - ms); m = mn; l *= corr;
#pragma unroll
        for (int db = 0; db < 4; ++db)
#pragma unroll
            for (int i = 0; i < 16; ++i) O[db][i] *= corr;
    }
    const float ms = (m == -INFINITY) ? 0.f : m; float ls = 0.f;
#pragma unroll
    for (int rb = 0; rb < 2; ++rb)
#pragma unroll
        for (int i = 0; i < 16; ++i) { const float p = __builtin_amdgcn_exp2f(s[rb][i] - ms); s[rb][i] = p; ls += p; }
    l += ls;
}
#define NS_ROWPTRS() int rr_ = lane & 31; asm volatile("" : "+v"(rr_)); const size_t row_ = (size_t)(b * T + 64 * c + 32 * th + rr_); bf16* oacc = OACC + row_ * 2048 + head * HD; const float* smr = small + row_ * 256 + head
constexpr int NS_K0 = 0, NS_V0 = 16384, NS_K1 = 32768, NS_V1 = 49152, NS_Q = 65536, NS_IMP = 131072 + 512, NS_SEL = NS_IMP + 64 * 33 * 4, NS_UNI = NS_SEL + 256;
static_assert(NS_UNI + 4 <= LDS_BYTES, "NSA LDS map");
__device__ __forceinline__ void nsa_attn_mfma(const bf16* proj, const float* small, const bf16* KC, const bf16* VCT, const bf16* VTS, const bf16* VTW, bf16* OACC, bf16* OBUF, LAS unsigned char* lds, int tid, int lane, int wave) {
    const int p = wave >> 1, th = wave & 1;
    LAS float* IMP = (LAS float*)(lds + NS_IMP); LAS unsigned* SELM = (LAS unsigned*)(lds + NS_SEL); LAS unsigned* UNI = (LAS unsigned*)(lds + NS_UNI);
    for (int idx = blockIdx.x; idx < 512; idx += gridDim.x) {
        asm volatile("" : "+v"(lane), "+v"(tid));
        const int r = lane & 31, hh = lane >> 5;
        const int bg = idx & 15, cc = idx >> 4, c = cc < 16 ? cc : 47 - cc, b = bg >> 2, g = bg & 3, head = 4 * g + p, tok = 32 * th + r, t = 64 * c + tok;
        __syncthreads();
        bf16x8 qf[8];
#pragma unroll
        for (int ks = 0; ks < 8; ++ks) qf[ks] = *(const bf16x8*)(proj + (size_t)(b * T + t) * AB_LDP + A_NQ + head * HD + 16 * ks + 8 * hh);
        for (int i = tid; i < 64 * 33; i += NTHR) IMP[i] = 0.f;
        if (tid == 0) UNI[0] = 0u;
        const int ncmp_t = c >= 16 ? 2 : 1;
        { TileRegs R;
          tile_fetch(R, KC + (size_t)bg * 128 * HD, HD, VCT + (size_t)bg * 128 * 128, 128, nullptr, tid); tile_commit(R, lds + NS_K0, lds + NS_V0, nullptr, tid);
          if (ncmp_t == 2) { tile_fetch(R, KC + (size_t)bg * 128 * HD + 64 * HD, HD, VCT + (size_t)bg * 128 * 128 + 64, 128, nullptr, tid); tile_commit(R, lds + NS_K1, lds + NS_V1, nullptr, tid); } }
        __syncthreads();
        float mC = -INFINITY, lC = 0.f;
        for (int tl = 0; tl < ncmp_t; ++tl) {
            f32x16 s[2]; qk_tile(lds + (tl ? NS_K1 : NS_K0), qf, s, lane); float mx = -INFINITY;
#pragma unroll
            for (int rb = 0; rb < 2; ++rb)
#pragma unroll
                for (int i = 0; i < 16; ++i) { const int n = 64 * tl + 32 * rb + (i & 3) + 8 * (i >> 2) + 4 * hh; float v = s[rb][i] * C1; if (16 * n + 31 > t) v = -INFINITY; s[rb][i] = v; mx = fmaxf(mx, v); }
            mx = fmaxf(mx, __shfl_xor(mx, 32));
            const float mn = fmaxf(mC, mx), ms = (mn == -INFINITY) ? 0.f : mn; float ls = 0.f;
#pragma unroll
            for (int rb = 0; rb < 2; ++rb)
#pragma unroll
                for (int i = 0; i < 16; ++i) ls += __builtin_amdgcn_exp2f(s[rb][i] - ms);
            ls += __shfl_xor(ls, 32);
            lC = lC * __builtin_amdgcn_exp2f(mC - ms) + ls; mC = mn;
        }
        { const float ms = (mC == -INFINITY) ? 0.f : mC, il = lC > 0.f ? 1.f / lC : 0.f; float gc; { NS_ROWPTRS(); gc = sigm(smr[32]); }
          f32x16 OC[4];
#pragma unroll
          for (int db = 0; db < 4; ++db)
#pragma unroll
              for (int i = 0; i < 16; ++i) OC[db][i] = 0.f;
          for (int tl = 0; tl < ncmp_t; ++tl) {
            f32x16 s[2]; qk_tile(lds + (tl ? NS_K1 : NS_K0), qf, s, lane);
#pragma unroll
            for (int rb = 0; rb < 2; ++rb)
#pragma unroll
                for (int g4 = 0; g4 < 4; ++g4) { float grp = 0.f, last = 0.f;
#pragma unroll
                    for (int e = 0; e < 4; ++e) { const int i = 4 * g4 + e, n = 64 * tl + 32 * rb + 8 * g4 + 4 * hh + e; float v = s[rb][i] * C1; if (16 * n + 31 > t) v = -INFINITY;
                        const float pr = __builtin_amdgcn_exp2f(v - ms) * il; s[rb][i] = pr * gc; grp += pr; last = pr; }
                    const int mb = 16 * tl + 8 * rb + 2 * g4 + hh;
                    __hip_atomic_fetch_add(&IMP[tok * 33 + mb], grp, __ATOMIC_RELAXED, __HIP_MEMORY_SCOPE_WORKGROUP); if (mb + 1 < 32) __hip_atomic_fetch_add(&IMP[tok * 33 + mb + 1], last, __ATOMIC_RELAXED, __HIP_MEMORY_SCOPE_WORKGROUP); }
            pv_tile(lds + (tl ? NS_V1 : NS_V0), s, OC, lane);
          }
          NS_ROWPTRS();
#pragma unroll
          for (int db = 0; db < 4; ++db)
#pragma unroll
              for (int g4 = 0; g4 < 4; ++g4) { v2u w; w.x = cvtpk(OC[db][4 * g4], OC[db][4 * g4 + 1]); w.y = cvtpk(OC[db][4 * g4 + 2], OC[db][4 * g4 + 3]); *(v2u*)(oacc + 32 * db + 8 * g4 + 4 * hh) = w; }
        }
        __syncthreads();
        if (tid < 64) {
            unsigned sel = 1u | (1u << c) | (c >= 1 ? (1u << (c - 1)) : 0u); const int need = 8 - __popc(sel);
            for (int rr = 0; rr < need; ++rr) { int best = -1; float bv = -1.f;
                for (int mm = 1; mm <= c - 2; ++mm) if (!((sel >> mm) & 1u)) { const float v = IMP[tid * 33 + mm]; if (v > bv) { bv = v; best = mm; } }
                if (best < 0) break; sel |= 1u << best; }
            SELM[tid] = sel; __hip_atomic_fetch_or(UNI, sel, __ATOMIC_RELAXED, __HIP_MEMORY_SCOPE_WORKGROUP);
        }
        __syncthreads();
        const unsigned uni = UNI[0], mysel = SELM[tok];
        const bf16* kvb = proj + (size_t)b * T * AB_LDP + A_NKV + g * HD;
        {
            float m = -INFINITY, l = 0.f; f32x16 O[4];
#pragma unroll
            for (int db = 0; db < 4; ++db)
#pragma unroll
                for (int i = 0; i < 16; ++i) O[db][i] = 0.f;
            const bf16* Vg = VTS + (size_t)bg * 128 * T;
            tile_dma(kvb + 2 * 512, AB_LDP, Vg, T, lds + NS_K0, lds + NS_V0, wave, lane);
            for (int mt = 0, bo = 0; mt >= 0; bo ^= AT_B1) {
                const unsigned rest = (mt >= 31) ? 0u : ((uni >> (mt + 1)) << (mt + 1)); const int nx = rest ? (int)__builtin_ctz(rest) : -1;
                asm volatile("s_waitcnt vmcnt(0)" ::: "memory"); __syncthreads();
                if (nx >= 0) tile_dma(kvb + 2 * 512 + (size_t)nx * 64 * AB_LDP, AB_LDP, Vg + nx * 64, T, lds + NS_K0 + (bo ^ AT_B1), lds + NS_V0 + (bo ^ AT_B1), wave, lane);
                const bool mine = (mysel >> mt) & 1u;
                if (__ballot(mine) != 0ull) {
                    f32x16 s[2]; qk_tile(lds + NS_K0 + bo, qf, s, lane);
                    const float mbias = mine ? 0.f : -INFINITY;
                    if (mt == c) {
#pragma unroll
                        for (int rb = 0; rb < 2; ++rb)
#pragma unroll
                            for (int i = 0; i < 16; ++i) { const int key = 64 * mt + 32 * rb + (i & 3) + 8 * (i >> 2) + 4 * hh; float v = fmaf(s[rb][i], C1, mbias); if (key > t) v = -INFINITY; s[rb][i] = v; }
                    } else {
#pragma unroll
                        for (int rb = 0; rb < 2; ++rb)
#pragma unroll
                            for (int i = 0; i < 16; ++i) s[rb][i] = fmaf(s[rb][i], C1, mbias);
                    }
                    softmax_update(s, m, l, O);
                    pv_tile(lds + NS_V0 + bo, s, O, lane);
                }
                mt = nx;
            }
            l += __shfl_xor(l, 32); NS_ROWPTRS(); const float sc = sigm(smr[48]) / l;
#pragma unroll
            for (int db = 0; db < 4; ++db)
#pragma unroll
                for (int g4 = 0; g4 < 4; ++g4) { v2u* pa = (v2u*)(oacc + 32 * db + 8 * g4 + 4 * hh); const v2u a = *pa; v2u w;
                    w.x = cvtpk(bflo(a.x) + O[db][4 * g4] * sc, bfhi(a.x) + O[db][4 * g4 + 1] * sc); w.y = cvtpk(bflo(a.y) + O[db][4 * g4 + 2] * sc, bfhi(a.y) + O[db][4 * g4 + 3] * sc); *pa = w; }
        }
        {
            float m = -INFINITY, l = 0.f; f32x16 O[4];
#pragma unroll
            for (int db = 0; db < 4; ++db)
#pragma unroll
                for (int i = 0; i < 16; ++i) O[db][i] = 0.f;
            const bf16* Vg = VTW + (size_t)bg * 128 * T;
            const int kt0 = c >= 8 ? c - 8 : 0;
            __syncthreads();
            tile_dma(kvb + 4 * 512 + (size_t)kt0 * 64 * AB_LDP, AB_LDP, Vg + kt0 * 64, T, lds + NS_K0, lds + NS_V0, wave, lane);
            for (int kt = kt0, bo = 0; kt <= c; ++kt, bo ^= AT_B1) {
                asm volatile("s_waitcnt vmcnt(0)" ::: "memory"); __syncthreads();
                if (kt < c) tile_dma(kvb + 4 * 512 + (size_t)(kt + 1) * 64 * AB_LDP, AB_LDP, Vg + (kt + 1) * 64, T, lds + NS_K0 + (bo ^ AT_B1), lds + NS_V0 + (bo ^ AT_B1), wave, lane);
                f32x16 s[2]; qk_tile(lds + NS_K0 + bo, qf, s, lane);
                const bool edge = (kt == c) || (kt == c - 8);
                if (edge) {
#pragma unroll
                    for (int rb = 0; rb < 2; ++rb)
#pragma unroll
                        for (int i = 0; i < 16; ++i) { const int key = 64 * kt + 32 * rb + (i & 3) + 8 * (i >> 2) + 4 * hh; float v = s[rb][i] * C1; if (key > t || key < t - 511) v = -INFINITY; s[rb][i] = v; }
                } else {
#pragma unroll
                    for (int rb = 0; rb < 2; ++rb)
#pragma unroll
                        for (int i = 0; i < 16; ++i) s[rb][i] *= C1;
                }
                softmax_update(s, m, l, O);
                pv_tile(lds + NS_V0 + bo, s, O, lane);
            }
            l += __shfl_xor(l, 32); NS_ROWPTRS(); const float sc = sigm(smr[64]) / l;
            bf16* orow = OBUF + row_ * DM + 2048 + head * HD;
#pragma unroll
            for (int db = 0; db < 4; ++db)
#pragma unroll
                for (int g4 = 0; g4 < 4; ++g4) { const v2u a = *(const v2u*)(oacc + 32 * db + 8 * g4 + 4 * hh);
                    v2u w; w.x = cvtpk(bflo(a.x) + O[db][4 * g4] * sc, bfhi(a.x) + O[db][4 * g4 + 1] * sc); w.y = cvtpk(bflo(a.y) + O[db][4 * g4 + 2] * sc, bfhi(a.y) + O[db][4 * g4 + 3] * sc);
                    *(v2u*)(orow + 32 * db + 8 * g4 + 4 * hh) = w; }
        }
    }
}
__device__ __forceinline__ int perm16(int k) { return ((k >> 2) & 1) * 8 + (k >> 3) * 4 + (k & 3); }
__device__ __forceinline__ int crow(int i, int hh) { return (i & 3) + 8 * (i >> 2) + 4 * hh; }
__device__ __forceinline__ bf16x8 pack8(const f32x16& x, int s) { v4u w; w.x = cvtpk(x[8 * s + 0], x[8 * s + 1]); w.y = cvtpk(x[8 * s + 2], x[8 * s + 3]); w.z = cvtpk(x[8 * s + 4], x[8 * s + 5]); w.w = cvtpk(x[8 * s + 6], x[8 * s + 7]); return __builtin_bit_cast(bf16x8, w); }
constexpr int CH_QT = 0, CH_KT = 16384, CH_VT = 32768, CH_KD = 49152, CH_PS = 65536, CH_OT = 0;
constexpr size_t SZ_QH = (size_t)64 * 128, SZ_DS = (size_t)128 * 128, SZ_SN = (size_t)128 * 128;
__device__ __forceinline__ void hgrn_chunk_prep(const bf16* proj, const float* lbl, bf16* QH, bf16* OI, bf16* DS, float* DEC, LAS unsigned char* lds, int tid, int lane, int wave) {
    const int d = tid & 127, pt = tid >> 7, r = lane & 31, hh = lane >> 5;
    unsigned short rf[16], rq[16], rv[16];
#define HG_LOAD_RAW(IDX) do { const int bh_ = (IDX) >> 5, n_ = (IDX) & 31; const bf16* pr_ = proj + ((size_t)(bh_ >> 4) * T + n_ * 64 + 16 * pt) * CD_LDP + (bh_ & 15) * HD + d; \
        _Pragma("unroll") for (int i_ = 0; i_ < 16; ++i_) { rf[i_] = pr_[(size_t)i_ * CD_LDP + C_HF]; rq[i_] = pr_[(size_t)i_ * CD_LDP + C_HQ]; rv[i_] = pr_[(size_t)i_ * CD_LDP + C_HI]; } } while (0)
    if ((int)blockIdx.x < 2048) HG_LOAD_RAW((int)blockIdx.x);
    for (int idx = blockIdx.x; idx < 2048; idx += gridDim.x) {
        const int bh = idx >> 5, n = idx & 31, b = bh >> 4, h = bh & 15; const size_t row0 = (size_t)b * T + n * 64;
        __syncthreads();
        const float lb = sigm(lbl[2048 + h * HD + d] - lbl[h * HD + d]);
        float cs[16], kk[16], qv[16]; unsigned short vb[16]; float run = 0.f;
#pragma unroll
        for (int i = 0; i < 16; ++i) {
            const float sg = sigm(bf2f(rf[i])), f = lb + (1.f - lb) * sg; run += __logf(f); cs[i] = run; kk[i] = (1.f - lb) * (1.f - sg); qv[i] = silu(bf2f(rq[i])); vb[i] = rv[i]; }
        LAS float* PS = (LAS float*)(lds + CH_PS);
        PS[pt * 128 + d] = run;
        __syncthreads();
        const float p0 = PS[d], p1 = PS[128 + d], p2 = PS[256 + d], p3 = PS[384 + d];
        const float pre = pt == 0 ? 0.f : (pt == 1 ? p0 : (pt == 2 ? p0 + p1 : p0 + p1 + p2)), bmid = p0 + p1, tot = (p0 + p1) + (p2 + p3);
        if (pt == 0) DEC[(size_t)idx * 128 + d] = __expf(tot);
        unsigned short kdb[16];
#pragma unroll
        for (int i = 0; i < 16; ++i) { const int rr = 16 * pt + i; const float bb = pre + cs[i];
            const float dmid = fminf(fmaxf(bb - bmid, -80.f), 80.f);
            const unsigned qt = f2bf(qv[i] * __expf(dmid)), kt = f2bf(kk[i] * __expf(-dmid)), qh = f2bf(qv[i] * __expf(bb));
            kdb[i] = (unsigned short)f2bf(kk[i] * __expf(tot - bb));
            const int sw = rr * 256 + (((d >> 3) ^ (rr & 15)) << 4) + (d & 7) * 2;
            *(LAS unsigned short*)(lds + CH_QT + sw) = (unsigned short)qt; *(LAS unsigned short*)(lds + CH_KT + sw) = (unsigned short)kt;
            QH[(size_t)idx * SZ_QH + rr * 128 + (d & ~15) + perm16(d & 15)] = (bf16)qh; }
#pragma unroll
        for (int h2 = 0; h2 < 2; ++h2) { v4u wk, wv; unsigned ek[8], ev[8];
#pragma unroll
            for (int j = 0; j < 8; ++j) { const int i = 8 * (j >> 2) + 4 * h2 + (j & 3); ek[j] = kdb[i]; ev[j] = vb[i]; }
            wk.x = ek[0] | (ek[1] << 16); wk.y = ek[2] | (ek[3] << 16); wk.z = ek[4] | (ek[5] << 16); wk.w = ek[6] | (ek[7] << 16);
            wv.x = ev[0] | (ev[1] << 16); wv.y = ev[2] | (ev[3] << 16); wv.z = ev[4] | (ev[5] << 16); wv.w = ev[6] | (ev[7] << 16);
            const int sw = d * 128 + (((2 * pt + h2) ^ ((d >> 1) & 7)) << 4);
            *(LAS v4u*)(lds + CH_KD + sw) = wk; *(LAS v4u*)(lds + CH_VT + sw) = wv; }
        __syncthreads();
        if (idx + (int)gridDim.x < 2048) HG_LOAD_RAW(idx + (int)gridDim.x);
        const int rbk = wave & 1, eb = wave >> 1;
        int yk = hh ^ (r & 15); asm volatile("" : "+v"(yk)); int yv = hh ^ ((r >> 1) & 7); asm volatile("" : "+v"(yv));
        f32x16 oi;
#pragma unroll
        for (int i = 0; i < 16; ++i) oi[i] = 0.f;
#pragma unroll
        for (int jb = 0; jb < 2; ++jb) {
            if (jb > rbk) continue;
            f32x16 s;
#pragma unroll
            for (int i = 0; i < 16; ++i) s[i] = 0.f;
#pragma unroll
            for (int ks = 0; ks < 8; ++ks) { const bf16x8 a = *(const LAS bf16x8*)(lds + CH_KT + (32 * jb + r) * 256 + (((2 * ks) ^ yk) << 4)), q = *(const LAS bf16x8*)(lds + CH_QT + (32 * rbk + r) * 256 + (((2 * ks) ^ yk) << 4));
                s = MFMA32(a, q, s); }
            if (jb == rbk) {
#pragma unroll
                for (int i = 0; i < 16; ++i) if (crow(i, hh) > r) s[i] = 0.f; }
#pragma unroll
            for (int st = 0; st < 2; ++st) { const bf16x8 a = *(const LAS bf16x8*)(lds + CH_VT + (32 * eb + r) * 128 + (((2 * (2 * jb + st)) ^ yv) << 4));
                oi = MFMA32(a, pack8(s, st), oi); }
        }
        { bf16* op = OI + ((size_t)idx * 64 + 32 * rbk + r) * 128 + 32 * eb + 4 * hh;
#pragma unroll
          for (int g4 = 0; g4 < 4; ++g4) { v2u w; w.x = cvtpk(oi[4 * g4], oi[4 * g4 + 1]); w.y = cvtpk(oi[4 * g4 + 2], oi[4 * g4 + 3]); *(v2u*)(op + 8 * g4) = w; } }
#pragma unroll
        for (int tt = 0; tt < 2; ++tt) { const int tile = 2 * wave + tt, db = tile >> 2, eb2 = tile & 3; f32x16 acc;
#pragma unroll
            for (int i = 0; i < 16; ++i) acc[i] = 0.f;
#pragma unroll
            for (int kq = 0; kq < 4; ++kq) { const bf16x8 a = *(const LAS bf16x8*)(lds + CH_KD + (32 * db + r) * 128 + (((2 * kq) ^ yv) << 4)), bq = *(const LAS bf16x8*)(lds + CH_VT + (32 * eb2 + r) * 128 + (((2 * kq) ^ yv) << 4));
                acc = MFMA32(a, bq, acc); }
            bf16* dp = DS + (size_t)idx * SZ_DS + ((size_t)tile * 4 * 64 + lane) * 4;
#pragma unroll
            for (int g4 = 0; g4 < 4; ++g4) { v2u w; w.x = cvtpk(acc[4 * g4], acc[4 * g4 + 1]); w.y = cvtpk(acc[4 * g4 + 2], acc[4 * g4 + 3]); *(v2u*)(dp + g4 * 256) = w; } }
    }
}
__device__ __forceinline__ void hgrn_state_scan(const bf16* DS, const float* DEC, bf16* SN, int item, int lane) {
    const int bh = item >> 2, eb = item & 3, hh = lane >> 5;
    f32x16 S[4];
#pragma unroll
    for (int rb = 0; rb < 4; ++rb)
#pragma unroll
        for (int i = 0; i < 16; ++i) S[rb][i] = 0.f;
    for (int n = 0; n < 32; ++n) {
        const size_t idx = (size_t)bh * 32 + n;
        f32x4 ds[4][4], dc[4][4];
#pragma unroll
        for (int rb = 0; rb < 4; ++rb)
#pragma unroll
            for (int g4 = 0; g4 < 4; ++g4) { const v2u w = *(const v2u*)(DS + idx * SZ_DS + ((size_t)((rb * 4 + eb) * 4 + g4) * 64 + lane) * 4); ds[rb][g4] = (f32x4){bflo(w.x), bfhi(w.x), bflo(w.y), bfhi(w.y)}; dc[rb][g4] = *(const f32x4*)(DEC + idx * 128 + 32 * rb + 8 * g4 + 4 * hh); }
        bf16* sp = SN + idx * SZ_SN + (size_t)eb * 8 * 512 + lane * 8;
#pragma unroll
        for (int rb = 0; rb < 4; ++rb)
#pragma unroll
            for (int st = 0; st < 2; ++st) *(bf16x8*)(sp + (rb * 2 + st) * 512) = pack8(S[rb], st);
#pragma unroll
        for (int rb = 0; rb < 4; ++rb)
#pragma unroll
            for (int i = 0; i < 16; ++i) S[rb][i] = S[rb][i] * dc[rb][i >> 2][i & 3] + ds[rb][i >> 2][i & 3];
    }
}
__device__ __forceinline__ void chunk_output(const bf16* QH, const bf16* SN, const bf16* OI, const float* nw, const bf16* gate, int ldg, bf16* OBUF, LAS unsigned char* lds, int tid, int lane, int wave) {
    const int r = lane & 31, hh = lane >> 5, rbk = wave & 1, eb = wave >> 1;
    LAS float* OT = (LAS float*)(lds + CH_OT);
    bf16x8 qf[8], sf[8]; unsigned short oi[16]; unsigned gw8[8];
#define CO_LOAD(IDX) do { const int bh_ = (IDX) >> 5, n_ = (IDX) & 31; const size_t row0_ = (size_t)(bh_ >> 4) * T + n_ * 64; \
        const bf16* qa_ = QH + (size_t)(IDX) * SZ_QH + (32 * rbk + r) * 128 + 8 * hh; const bf16* sb_ = SN + (size_t)(IDX) * SZ_SN + (size_t)eb * 8 * 512 + lane * 8; \
        _Pragma("unroll") for (int k8 = 0; k8 < 8; ++k8) { qf[k8] = *(const bf16x8*)(qa_ + 16 * k8); sf[k8] = *(const bf16x8*)(sb_ + k8 * 512); } \
        const bf16* op_ = OI + ((size_t)(IDX) * 64 + 32 * rbk) * 128 + 32 * eb + r; \
        _Pragma("unroll") for (int i = 0; i < 16; ++i) oi[i] = op_[crow(i, hh) * 128]; \
        _Pragma("unroll") for (int j = 0; j < 8; ++j) gw8[j] = *(const unsigned*)(gate + (row0_ + 8 * wave + j) * ldg + (bh_ & 15) * HD + 2 * lane); } while (0)
    if ((int)blockIdx.x < 2048) CO_LOAD((int)blockIdx.x);
    for (int idx = blockIdx.x; idx < 2048; idx += gridDim.x) {
        const int bh = idx >> 5, n = idx & 31, b = bh >> 4, h = bh & 15; const size_t row0 = (size_t)b * T + n * 64;
        f32x16 acc;
#pragma unroll
        for (int i = 0; i < 16; ++i) acc[i] = 0.f;
#pragma unroll
        for (int k8 = 0; k8 < 8; ++k8) acc = MFMA32(qf[k8], sf[k8], acc);
        float ov[16]; unsigned gcur[8];
#pragma unroll
        for (int i = 0; i < 16; ++i) ov[i] = acc[i] + bf2f(oi[i]);
#pragma unroll
        for (int j = 0; j < 8; ++j) gcur[j] = gw8[j];
        __syncthreads();
#pragma unroll
        for (int i = 0; i < 16; ++i) OT[(32 * rbk + crow(i, hh)) * 128 + 32 * eb + r] = ov[i];
        if (idx + (int)gridDim.x < 2048) CO_LOAD(idx + (int)gridDim.x);
        __syncthreads();
#pragma unroll
        for (int j = 0; j < 8; ++j) { const int rr = 8 * wave + j; const float o0 = OT[rr * 128 + 2 * lane], o1 = OT[rr * 128 + 2 * lane + 1];
            const float rstd = rsqrtf(wave_sum(o0 * o0 + o1 * o1) * (1.f / HD) + EPS);
            *(unsigned*)(OBUF + (row0 + rr) * DM + h * HD + 2 * lane) = pk2(o0 * rstd * nw[2 * lane] * silu(bflo(gcur[j])), o1 * rstd * nw[2 * lane + 1] * silu(bfhi(gcur[j]))); }
    }
#undef CO_LOAD
}
__device__ __forceinline__ int img256(int row, int c) { return row * 256 + ((c ^ (row & 15)) << 4); }
__device__ __forceinline__ int img128(int row, int c) { return row * 128 + ((c ^ ((row >> 1) & 7)) << 4); }
constexpr int G1_KT = 0, G1_SS = 16384, G1_GAM = 16384 + 1024, G1_BET = G1_GAM + 256;
constexpr int G3_KT = 0, G3_QT = 16384, G3_TT = 32768, G3_KBG = 40960, G3_VB = 57344, G3_KD = 73728, G3_QK = 90112, G3_GAM = 98304, G3_BET = G3_GAM + 256;
__device__ __forceinline__ void gdn_pass1(int idx, const bf16* proj, const float* small, const float* cw, const float* a_log, const float* dt_bias,
                                          bf16* QS, bf16* KS, bf16* VS, float* GB, float* AM, LAS unsigned char* lds, int tid, int lane, int wave) {
    asm volatile("" : "+v"(tid), "+v"(lane));
    const int d = tid & 127, pt = tid >> 7, r = lane & 31, hh = lane >> 5;
    const int bh = idx >> 5, n = idx & 31, b = bh >> 4, h = bh & 15; const size_t row0 = (size_t)b * T + n * 64;
    LAS float* SS = (LAS float*)(lds + G1_SS); LAS float* GAM = (LAS float*)(lds + G1_GAM); LAS float* BET = (LAS float*)(lds + G1_BET);
    __syncthreads();
    if (tid < 64) { float g = -__expf(a_log[h]) * softplus(small[(row0 + tid) * 256 + h] + dt_bias[h]);
#pragma unroll
        for (int o = 1; o < 64; o <<= 1) { const float v = __shfl_up(g, o); if (lane >= o) g += v; }
        const float be = sigm(small[(row0 + tid) * 256 + 16 + h]); GAM[tid] = g; BET[tid] = be; GB[(size_t)idx * 128 + tid] = g; GB[(size_t)idx * 128 + 64 + tid] = be; }
    { const int o = tid & 15;
#pragma unroll
      for (int s = 0; s < 3; ++s) { const int ch0 = s * 2048 + h * HD + 8 * o; float w[4][8];
#pragma unroll
          for (int j = 0; j < 4; ++j) { const f32x4 wa = *(const f32x4*)(cw + j * 6144 + ch0), wb = *(const f32x4*)(cw + j * 6144 + ch0 + 4);
              w[j][0] = wa.x; w[j][1] = wa.y; w[j][2] = wa.z; w[j][3] = wa.w; w[j][4] = wb.x; w[j][5] = wb.y; w[j][6] = wb.z; w[j][7] = wb.w; }
#pragma unroll
          for (int it = 0; it < 2; ++it) { const int rr = (tid >> 4) + 32 * it; float val[8];
#pragma unroll
              for (int e = 0; e < 8; ++e) val[e] = 0.f;
#pragma unroll
              for (int j = 0; j < 4; ++j) { const int rj = rr - 3 + j; v4u x = (v4u){0u, 0u, 0u, 0u};
                  if (n * 64 + rj >= 0) x = *(const v4u*)(proj + (row0 + rj) * AB_LDP + A_QKV + ch0);
                  val[0] += w[j][0] * bflo(x.x); val[1] += w[j][1] * bfhi(x.x); val[2] += w[j][2] * bflo(x.y); val[3] += w[j][3] * bfhi(x.y);
                  val[4] += w[j][4] * bflo(x.z); val[5] += w[j][5] * bfhi(x.z); val[6] += w[j][6] * bflo(x.w); val[7] += w[j][7] * bfhi(x.w); }
              float ssq = 0.f;
#pragma unroll
              for (int e = 0; e < 8; ++e) { val[e] = silu(val[e]); ssq += val[e] * val[e]; }
              if (s < 2) { ssq += __shfl_xor(ssq, 1); ssq += __shfl_xor(ssq, 2); ssq += __shfl_xor(ssq, 4); ssq += __shfl_xor(ssq, 8);
                  const float inv = rsqrtf(ssq + EPS) * (s == 0 ? QSCALE : 1.f);
#pragma unroll
                  for (int e = 0; e < 8; ++e) val[e] *= inv; }
              v4u pk; pk.x = pk2(val[0], val[1]); pk.y = pk2(val[2], val[3]); pk.z = pk2(val[4], val[5]); pk.w = pk2(val[6], val[7]);
              if (s == 1) *(LAS v4u*)(lds + G1_KT + img256(rr, o)) = pk;
              *(v4u*)((s == 0 ? QS : (s == 1 ? KS : VS)) + (size_t)idx * SZ_QH + rr * 128 + 8 * o) = pk; } } }
    __syncthreads();
    if (wave < 3) {
        const int jb = wave >> 1, rbk = (wave + 1) >> 1; int yk = hh ^ (r & 15); asm volatile("" : "+v"(yk));
        f32x16 acc;
#pragma unroll
        for (int i = 0; i < 16; ++i) acc[i] = 0.f;
#pragma unroll
        for (int ks = 0; ks < 8; ++ks) acc = MFMA32(*(const LAS bf16x8*)(lds + G1_KT + (32 * jb + r) * 256 + (((2 * ks) ^ yk) << 4)), *(const LAS bf16x8*)(lds + G1_KT + (32 * rbk + r) * 256 + (((2 * ks) ^ yk) << 4)), acc);
        const int rr = 32 * rbk + r; const float gr = GAM[rr], br = BET[rr];
#pragma unroll
        for (int g4 = 0; g4 < 4; ++g4) { const int j0 = 32 * jb + 8 * g4 + 4 * hh; const f32x4 gj = *(const LAS f32x4*)(GAM + j0); f32x4 o;
#pragma unroll
            for (int e = 0; e < 4; ++e) o[e] = (j0 + e < rr) ? br * __expf(gr - gj[e]) * acc[4 * g4 + e] : 0.f;
            *(f32x4*)(AM + (size_t)idx * 4096 + rr * 64 + j0) = o; }
    } else if (wave == 3) {
#pragma unroll
        for (int g4 = 0; g4 < 4; ++g4) *(f32x4*)(AM + (size_t)idx * 4096 + r * 64 + 32 + 8 * g4 + 4 * hh) = (f32x4){0.f, 0.f, 0.f, 0.f};
    }
}
__device__ __forceinline__ void gdn_pass2(int idx, const float* AM, bf16* TM, LAS unsigned char* wlds, int lane) {
    float Ar[64], Tr[64];
    { const f32x4* src = (const f32x4*)(AM + (size_t)idx * 4096 + lane * 64);
#pragma unroll
      for (int i = 0; i < 16; ++i) { const f32x4 v = src[i]; Ar[4 * i] = v[0]; Ar[4 * i + 1] = v[1]; Ar[4 * i + 2] = v[2]; Ar[4 * i + 3] = v[3]; } }
#pragma unroll
    for (int c = 0; c < 64; ++c) Tr[c] = (lane == c) ? 1.f : 0.f;
#pragma unroll
    for (int j = 0; j < 63; ++j) {
        const float na = -Ar[j];
#pragma unroll
        for (int c = 0; c <= j; ++c) { const float tj = __builtin_bit_cast(float, __builtin_amdgcn_readlane(__builtin_bit_cast(int, Tr[c]), j)); Tr[c] = fmaf(na, tj, Tr[c]); }
    }
    v4u* out = (v4u*)(TM + (size_t)idx * 4096 + lane * 64);
#pragma unroll
    for (int i = 0; i < 8; ++i) { v4u w; w.x = cvtpk(Tr[8 * i], Tr[8 * i + 1]); w.y = cvtpk(Tr[8 * i + 2], Tr[8 * i + 3]); w.z = cvtpk(Tr[8 * i + 4], Tr[8 * i + 5]); w.w = cvtpk(Tr[8 * i + 6], Tr[8 * i + 7]); out[i] = w; }
}
struct G3Pre { float g; v4u t[5]; unsigned short kc[16], vc[16]; };
__device__ __forceinline__ void g3_load(G3Pre& P, int idx, const bf16* QS, const bf16* KS, const bf16* VS, const float* GB, const bf16* TM, int tid) {
    const int d = tid & 127, pt = tid >> 7;
    P.g = tid < 128 ? GB[(size_t)idx * 128 + tid] : 0.f;
#pragma unroll
    for (int i = 0; i < 2; ++i) { const int id = tid + 512 * i, rw = id >> 4, c = id & 15; P.t[2 * i] = *(const v4u*)(KS + (size_t)idx * SZ_QH + rw * 128 + c * 8); P.t[2 * i + 1] = *(const v4u*)(QS + (size_t)idx * SZ_QH + rw * 128 + c * 8); }
    { const int rw = tid >> 3, c = tid & 7; P.t[4] = *(const v4u*)(TM + (size_t)idx * 4096 + rw * 64 + c * 8); }
#pragma unroll
    for (int i = 0; i < 16; ++i) { const size_t o = (size_t)idx * SZ_QH + (16 * pt + i) * 128 + d; P.kc[i] = KS[o]; P.vc[i] = VS[o]; }
}
__device__ __forceinline__ void gdn_pass3(int idx, int idx_next, G3Pre& P, const bf16* QS, const bf16* KS, const bf16* VS, const float* GB, const bf16* TM, bf16* QH, bf16* OI, bf16* AN, bf16* DS,
                                          LAS unsigned char* lds, int tid, int lane, int wave) {
    asm volatile("" : "+v"(tid), "+v"(lane));
    const int d = tid & 127, pt = tid >> 7, r = lane & 31, hh = lane >> 5;
    LAS float* GAM = (LAS float*)(lds + G3_GAM); LAS float* BET = (LAS float*)(lds + G3_BET);
    __syncthreads();
    if (tid < 128) GAM[tid] = P.g;
#pragma unroll
    for (int i = 0; i < 2; ++i) { const int id = tid + 512 * i, rw = id >> 4, c = id & 15;
        *(LAS v4u*)(lds + G3_KT + img256(rw, c)) = P.t[2 * i];
        *(LAS v4u*)(lds + G3_QT + img256(rw, c)) = P.t[2 * i + 1]; }
    { const int rw = tid >> 3, c = tid & 7; *(LAS v4u*)(lds + G3_TT + img128(rw, c)) = P.t[4]; }
    float kv[16], vv[16];
#pragma unroll
    for (int i = 0; i < 16; ++i) { kv[i] = bf2f(P.kc[i]); vv[i] = bf2f(P.vc[i]); }
    if (idx_next < 2048) g3_load(P, idx_next, QS, KS, VS, GB, TM, tid);
    __syncthreads();
    { const float glast = GAM[63]; unsigned kbg[16], vb[16], kd[16];
#pragma unroll
      for (int i = 0; i < 16; ++i) { const float gm = GAM[16 * pt + i], bm = BET[16 * pt + i]; kbg[i] = f2bf(kv[i] * bm * __expf(gm)); vb[i] = f2bf(vv[i] * bm); kd[i] = f2bf(kv[i] * __expf(glast - gm)); }
#pragma unroll
      for (int h2 = 0; h2 < 2; ++h2) { v4u a, bq, c;
          a.x = kbg[8 * h2] | (kbg[8 * h2 + 1] << 16); a.y = kbg[8 * h2 + 2] | (kbg[8 * h2 + 3] << 16); a.z = kbg[8 * h2 + 4] | (kbg[8 * h2 + 5] << 16); a.w = kbg[8 * h2 + 6] | (kbg[8 * h2 + 7] << 16);
          bq.x = vb[8 * h2] | (vb[8 * h2 + 1] << 16); bq.y = vb[8 * h2 + 2] | (vb[8 * h2 + 3] << 16); bq.z = vb[8 * h2 + 4] | (vb[8 * h2 + 5] << 16); bq.w = vb[8 * h2 + 6] | (vb[8 * h2 + 7] << 16);
          unsigned e[8];
#pragma unroll
          for (int j = 0; j < 8; ++j) e[j] = kd[8 * (j >> 2) + 4 * h2 + (j & 3)];
          c.x = e[0] | (e[1] << 16); c.y = e[2] | (e[3] << 16); c.z = e[4] | (e[5] << 16); c.w = e[6] | (e[7] << 16);
          const int sw = img128(d, 2 * pt + h2);
          *(LAS v4u*)(lds + G3_KBG + sw) = a; *(LAS v4u*)(lds + G3_VB + sw) = bq; *(LAS v4u*)(lds + G3_KD + sw) = c; } }
    int yk = hh ^ (r & 15); asm volatile("" : "+v"(yk)); int yv = hh ^ ((r >> 1) & 7); asm volatile("" : "+v"(yv));
    if (wave < 3) {
        const int jb = wave >> 1, rbk = (wave + 1) >> 1; f32x16 acc;
#pragma unroll
        for (int i = 0; i < 16; ++i) acc[i] = 0.f;
#pragma unroll
        for (int ks = 0; ks < 8; ++ks) acc = MFMA32(*(const LAS bf16x8*)(lds + G3_KT + (32 * jb + r) * 256 + (((2 * ks) ^ yk) << 4)), *(const LAS bf16x8*)(lds + G3_QT + (32 * rbk + r) * 256 + (((2 * ks) ^ yk) << 4)), acc);
        const int rr = 32 * rbk + r; const float gr = GAM[rr];
#pragma unroll
        for (int g4 = 0; g4 < 4; ++g4) { const int j0 = 32 * jb + 8 * g4 + 4 * hh; const f32x4 gj = *(const LAS f32x4*)(GAM + j0); float o[4];
#pragma unroll
            for (int e = 0; e < 4; ++e) o[e] = (j0 + e <= rr) ? __expf(gr - gj[e]) * acc[4 * g4 + e] : 0.f;
            v2u w; w.x = cvtpk(o[0], o[1]); w.y = cvtpk(o[2], o[3]);
            *(LAS v2u*)(lds + G3_QK + img128(rr, 2 * (j0 >> 4) + hh) + 8 * (g4 & 1)) = w; }
    } else if (wave == 3) {
        const v2u z = (v2u){0u, 0u};
#pragma unroll
        for (int g4 = 0; g4 < 4; ++g4) { const int j0 = 32 + 8 * g4 + 4 * hh; *(LAS v2u*)(lds + G3_QK + img128(r, 2 * (j0 >> 4) + hh) + 8 * (g4 & 1)) = z; }
    }
    __syncthreads();
    const int cb = wave & 3; const bool isw = wave < 4; const int boff = isw ? G3_KBG : G3_VB;
    f32x16 X[2];
#pragma unroll
    for (int jb = 0; jb < 2; ++jb) {
#pragma unroll
        for (int i = 0; i < 16; ++i) X[jb][i] = 0.f;
#pragma unroll
        for (int ms = 0; ms < 4; ++ms) X[jb] = MFMA32(*(const LAS bf16x8*)(lds + G3_TT + (32 * jb + r) * 128 + (((2 * ms) ^ yv) << 4)), *(const LAS bf16x8*)(lds + boff + (32 * cb + r) * 128 + (((2 * ms) ^ yv) << 4)), X[jb]); }
    bf16x8 xf[4];
#pragma unroll
    for (int kq = 0; kq < 4; ++kq) xf[kq] = pack8(X[kq >> 1], kq & 1);
    __syncthreads();
#pragma unroll 1
    for (int rbk = 0; rbk < 2; ++rbk) { f32x16 acc;
#pragma unroll
        for (int i = 0; i < 16; ++i) acc[i] = 0.f;
#pragma unroll
        for (int kq = 0; kq < 4; ++kq) acc = MFMA32(*(const LAS bf16x8*)(lds + G3_QK + (32 * rbk + r) * 128 + (((2 * kq) ^ yv) << 4)), xf[kq], acc);
        const int col = 32 * cb + r;
        if (isw) {
#pragma unroll
            for (int i = 0; i < 16; ++i) { const int rr = 32 * rbk + crow(i, hh); const float qv = bf2f(*(const LAS unsigned short*)(lds + G3_QT + img256(rr, col >> 3) + (col & 7) * 2));
                *(LAS unsigned short*)(lds + G3_KT + rr * 256 + ((col & ~15) + perm16(col & 15)) * 2) = (unsigned short)f2bf(qv * __expf(GAM[rr]) - acc[i]); }
        } else {
#pragma unroll
            for (int i = 0; i < 16; ++i) { const int rr = 32 * rbk + crow(i, hh); OI[((size_t)idx * 64 + rr) * 128 + col] = (bf16)f2bf(acc[i]); }
        } }
    const float gl = __expf(GAM[63]);
#pragma unroll 1
    for (int rb = 0; rb < 4; ++rb) { f32x16 acc;
#pragma unroll
        for (int i = 0; i < 16; ++i) acc[i] = 0.f;
#pragma unroll
        for (int kq = 0; kq < 4; ++kq) acc = MFMA32(*(const LAS bf16x8*)(lds + G3_KD + (32 * rb + r) * 128 + (((2 * kq) ^ yv) << 4)), xf[kq], acc);
        const int col = 32 * cb + r;
        if (isw) {
#pragma unroll
            for (int i = 0; i < 16; ++i) { const int dr = 32 * rb + crow(i, hh); *(LAS unsigned short*)(lds + G3_TT + dr * 256 + ((col & ~15) + perm16(col & 15)) * 2) = (unsigned short)f2bf((dr == col ? gl : 0.f) - acc[i]); }
        } else {
            bf16* dp = DS + (size_t)idx * SZ_DS + ((size_t)(rb * 4 + cb) * 4 * 64 + lane) * 4;
#pragma unroll
            for (int g4 = 0; g4 < 4; ++g4) { v2u w; w.x = cvtpk(acc[4 * g4], acc[4 * g4 + 1]); w.y = cvtpk(acc[4 * g4 + 2], acc[4 * g4 + 3]); *(v2u*)(dp + g4 * 256) = w; }
        } }
    __syncthreads();
#pragma unroll
    for (int i = 0; i < 2; ++i) { const int id = tid + 512 * i; *(v4u*)(QH + (size_t)idx * SZ_QH + id * 8) = *(const LAS v4u*)(lds + G3_KT + id * 16); }
#pragma unroll
    for (int i = 0; i < 4; ++i) { const int id = tid + 512 * i; *(v4u*)(AN + (size_t)idx * SZ_DS + id * 8) = *(const LAS v4u*)(lds + G3_TT + id * 16); }
}
__device__ __forceinline__ void gdn_prep_a(const bf16* proj, const float* small, const float* cw, const float* a_log, const float* dt_bias, bf16* QS, bf16* KS, bf16* VS, float* GB, float* AM, LAS unsigned char* lds, int tid, int lane, int wave) {
#pragma unroll 1
    for (int k = 0; k < 8; ++k) { const int idx = blockIdx.x + k * gridDim.x; if (idx < 2048) gdn_pass1(idx, proj, small, cw, a_log, dt_bias, QS, KS, VS, GB, AM, lds, tid, lane, wave); }
    asm volatile("s_waitcnt vmcnt(0)" ::: "memory"); __syncthreads();
}
__device__ __forceinline__ void gdn_prep_b(const float* AM, bf16* TM, LAS unsigned char* lds, int lane, int wave) {
    { const int idx = blockIdx.x + wave * gridDim.x; if (idx < 2048) gdn_pass2(idx, AM, TM, lds + wave * 16384, lane); }
    asm volatile("s_waitcnt vmcnt(0)" ::: "memory"); __syncthreads();
}
__device__ __forceinline__ void gdn_prep_c(const bf16* QS, const bf16* KS, const bf16* VS, const float* GB, const bf16* TM, bf16* QH, bf16* OI, bf16* AN, bf16* DS, LAS unsigned char* lds, int tid, int lane, int wave) {
    G3Pre P; if ((int)blockIdx.x < 2048) g3_load(P, (int)blockIdx.x, QS, KS, VS, GB, TM, tid);
#pragma unroll 1
    for (int k = 0; k < 8; ++k) { const int idx = blockIdx.x + k * gridDim.x; if (idx < 2048) gdn_pass3(idx, k < 7 ? idx + (int)gridDim.x : 2048, P, QS, KS, VS, GB, TM, QH, OI, AN, DS, lds, tid, lane, wave); }
}
__device__ __forceinline__ void gdn_state_scan(const bf16* AN, const bf16* DS, bf16* SN, int item, int lane) {
    const int bh = item >> 2, eb = item & 3, r = lane & 31, hh = lane >> 5;
    f32x16 S[4];
#pragma unroll
    for (int rb = 0; rb < 4; ++rb)
#pragma unroll
        for (int i = 0; i < 16; ++i) S[rb][i] = 0.f;
    for (int n = 0; n < 32; ++n) {
        const size_t idx = (size_t)bh * 32 + n;
        bf16x8 sf[8];
#pragma unroll
        for (int k8 = 0; k8 < 8; ++k8) sf[k8] = pack8(S[k8 >> 1], k8 & 1);
        bf16* sp = SN + idx * SZ_SN + (size_t)eb * 8 * 512 + lane * 8;
#pragma unroll
        for (int k8 = 0; k8 < 8; ++k8) *(bf16x8*)(sp + k8 * 512) = sf[k8];
#pragma unroll
        for (int rb = 0; rb < 4; ++rb) {
#pragma unroll
            for (int g4 = 0; g4 < 4; ++g4) { const v2u w = *(const v2u*)(DS + idx * SZ_DS + ((size_t)((rb * 4 + eb) * 4 + g4) * 64 + lane) * 4); S[rb][4 * g4] = bflo(w.x); S[rb][4 * g4 + 1] = bfhi(w.x); S[rb][4 * g4 + 2] = bflo(w.y); S[rb][4 * g4 + 3] = bfhi(w.y); }
            const bf16* ap = AN + idx * SZ_DS + (32 * rb + r) * 128 + 8 * hh;
#pragma unroll
            for (int k8 = 0; k8 < 8; ++k8) S[rb] = MFMA32(*(const bf16x8*)(ap + 16 * k8), sf[k8], S[rb]);
        }
    }
}

constexpr size_t MS_BIAS = 5 * MiB, MS_W2T = 5 * MiB + 65536, MS_WFF = 5 * MiB + 131072, MS_W1T = 6 * MiB;
constexpr int CP_PART = 0, CP_HID = 16384;
__device__ __forceinline__ void nsa_compress_mfma(const bf16* proj, const bf16* W1T, const bf16* W2T, const float* BIAS, bf16* KC, bf16* VCT, LAS unsigned char* lds, int tid, int lane, int wave) {
    const int r = lane & 31, hh = lane >> 5, jb = wave & 3, kh = wave >> 2;
    for (int item = (int)blockIdx.x - ((int)gridDim.x - 128); item < 128; item += gridDim.x) {
        if (item < 0) break;
        const int nb = item & 3, kv = (item >> 2) & 1, bg = item >> 3, b = bg >> 2, g = bg & 3;
        const int n = 32 * nb + r, ne = n < NCMP ? n : NCMP - 1;
        const bf16* ap = proj + (size_t)(b * T + 16 * ne) * AB_LDP + A_NKV + kv * 512 + g * HD + 8 * hh;
        const bf16* bp = W1T + ((size_t)kv * 128 + 32 * jb + r) * 4096 + 8 * hh;
        f32x16 acc;
#pragma unroll
        for (int i = 0; i < 16; ++i) acc[i] = 0.f;
#pragma unroll 4
        for (int l = 16 * kh; l < 16 * kh + 16; ++l) {
#pragma unroll
            for (int q = 0; q < 8; ++q) acc = MFMA32(*(const bf16x8*)(ap + (size_t)l * AB_LDP + 16 * q), *(const bf16x8*)(bp + l * 128 + 16 * q), acc); }
        __syncthreads();
        LAS float* PART = (LAS float*)(lds + CP_PART);
        if (kh == 1) {
#pragma unroll
            for (int i = 0; i < 16; ++i) PART[crow(i, hh) * 128 + 32 * jb + r] = acc[i]; }
        __syncthreads();
        if (kh == 0) { const float bs = BIAS[kv * 128 + 32 * jb + r]; const int col = 32 * jb + r;
#pragma unroll
            for (int i = 0; i < 16; ++i) { const int rr = crow(i, hh); const float hv = silu(acc[i] + PART[rr * 128 + col] + bs);
                *(LAS unsigned short*)(lds + CP_HID + img256(rr, col >> 3) + (col & 7) * 2) = (unsigned short)f2bf(hv); } }
        __syncthreads();
        if (wave < 4) { int yk = hh ^ (r & 15); asm volatile("" : "+v"(yk));
            const bf16* wp = W2T + ((size_t)kv * 128 + 32 * wave + r) * 128 + 8 * hh; f32x16 o;
#pragma unroll
            for (int i = 0; i < 16; ++i) o[i] = 0.f;
#pragma unroll
            for (int ks = 0; ks < 8; ++ks) o = MFMA32(*(const LAS bf16x8*)(lds + CP_HID + r * 256 + (((2 * ks) ^ yk) << 4)), *(const bf16x8*)(wp + 16 * ks), o);
            const int j = 32 * wave + r;
#pragma unroll
            for (int i = 0; i < 16; ++i) { const int nn = 32 * nb + crow(i, hh); const bf16 v = nn < NCMP ? (bf16)f2bf(o[i]) : (bf16)0;
                if (kv) VCT[((size_t)bg * 128 + j) * 128 + (nn & ~15) + perm16(nn & 15)] = v; else KC[((size_t)bg * 128 + nn) * HD + j] = v; } }
    }
}
#ifndef MK_SINGLE
#define MK_SINGLE 1
#endif
constexpr int NPHASE = 28;
struct Args { const float* in[33]; float* out; unsigned char* ws; int ph_lo, ph_hi; };
enum { I_X = 0, I_P, I_AB_NPRE, I_AB_NPOST, I_AB_WIN, I_GDN_CW, I_GDN_ALOG, I_GDN_DTB, I_GDN_NORM, I_PE_K, I_PE_V, I_K1, I_K2, I_V1, I_V2, I_AB_WOUT, I_CD_NPRE, I_CD_NPOST, I_CD_WIN,
       I_LB, I_HGRN_NORM, I_FOX_B, I_CD_WOUT, I_FFN_NPRE, I_FFN_NPOST, I_FFN_WUP, I_FFN_CW, I_FFN_CB, I_FFN_WDOWN, I_PLE_WPROJ, I_PLE_GNORM, I_PLE_WGATE, I_PLE_NPOST };

__global__ void __launch_bounds__(NTHR, 2) fwd(Args args) {
    extern __shared__ __attribute__((aligned(16))) unsigned char lds_raw[];
    LAS unsigned char* lds = (LAS unsigned char*)lds_raw;
    volatile LAS unsigned* MISC = (volatile LAS unsigned*)(lds + MISC_OFF);
    const int tid = threadIdx.x, lane = tid & 63, wave = __builtin_amdgcn_readfirstlane(tid >> 6);
    const int G = gridDim.x, gw = blockIdx.x * NWAVES + wave, ngw = G * NWAVES, gw2 = wave * G + blockIdx.x;
    unsigned char* ws = args.ws;
    unsigned* ctl = (unsigned*)(ws + WS_CTL);
    for (int u = tid; u < (LDS_BYTES - LDSCTL_OFF) / 4; u += NTHR) ((LAS unsigned*)(lds + LDSCTL_OFF))[u] = 0u;
    __syncthreads();
    const int lo = args.ph_lo, hi = args.ph_hi;
    XcdBarrier bar; bar.bar = ctl + CW_BAR; bar.x = 0; bar.st = nullptr;
    if (hi - lo > 1) bar = xcd_barrier_post(ctl + CW_BAR, MISC + 8);
#ifndef PH_MASK
#define PH_MASK 0xFFFFFFFFu
#endif
#define IN(k) (((PH_MASK >> (k)) & 1u) && lo <= (k) && (k) < hi)
#define SEAM(k) do { if (IN(k) && IN((k) + 1)) xcd_barrier(bar); } while (0)
    bf16* WABIN = (bf16*)(ws + WS_WABIN); bf16* WABOUT = (bf16*)(ws + WS_WABOUT); bf16* WCDIN = (bf16*)(ws + WS_WCDIN); bf16* WCDOUT = (bf16*)(ws + WS_WCDOUT);
    bf16* WUP = (bf16*)(ws + WS_WUP); bf16* WDOWN = (bf16*)(ws + WS_WDOWN); bf16* WGATE = (bf16*)(ws + WS_WGATE); bf16* WPROJ = (bf16*)(ws + WS_WPROJ);
    float* XRES = (float*)(ws + WS_XRES); bf16* H = (bf16*)(ws + WS_H); bf16* PROJ = (bf16*)(ws + WS_PROJ); float* SMALL = (float*)(ws + WS_SMALL); float* Y = (float*)(ws + WS_Y);
    bf16* OBUF = (bf16*)(ws + WS_OBUF); bf16* Z = (bf16*)(ws + WS_Z); bf16* ACT = (bf16*)(ws + WS_ACT); bf16* PP = (bf16*)(ws + WS_PP); bf16* PBF = (bf16*)(ws + WS_PBF);
    float* QN = (float*)(ws + WS_QN); float* KN = (float*)(ws + WS_KN); float* VV = (float*)(ws + WS_VV); float* ORAW = (float*)(ws + WS_ORAW); float* OCMP = (float*)(ws + WS_OCMP);
    unsigned char* ms = ws + WS_MISC;
    bf16* KC = (bf16*)(ms + MS_KC); bf16* VC = (bf16*)(ms + MS_VC); float* GG = (float*)(ms + MS_GG); float* BB = (float*)(ms + MS_BB); unsigned* SEL = (unsigned*)(ms + MS_SEL); float* CUM = (float*)(ms + MS_CUM);
    bf16* QH = (bf16*)(ws + WS_Z); bf16* OI = (bf16*)(ws + WS_Z + 32 * MiB); bf16* SN = (bf16*)(ws + WS_Z + 96 * MiB); bf16* AN = (bf16*)(ws + WS_Z + 160 * MiB); float* DEC = (float*)(ws + WS_Z + 224 * MiB); bf16* DS = (bf16*)(ws + WS_ACT + 32 * MiB);
    bf16* QS = (bf16*)(ws + WS_Z + 225 * MiB); bf16* KS = (bf16*)(ws + WS_Z + 257 * MiB); bf16* VS = (bf16*)(ws + WS_Z + 289 * MiB); float* AMX = (float*)(ws + WS_PP); float* GB = (float*)(ws + WS_PP + 32 * MiB); bf16* TM = (bf16*)(ws + WS_ACT + 16 * MiB);
    float* RS = (float*)(ws + WS_MISC + 4 * MiB + 768 * 1024); bf16* YB = (bf16*)(ws + WS_Y);
    LAS float* wl = (LAS float*)(lds + wave * 1024);
    constexpr size_t SZ_UP = (size_t)2 * DFF * DM, SZ_DOWN = (size_t)DFF * DM, SZ_SQ = (size_t)DM * DM, SZ_PJ = (size_t)DPLE * DM;

    if (IN(0)) {
        LAS float* scr = (LAS float*)(lds + wave * 16384);
        transpose_seg(args.in[I_AB_WIN], DM, AB_IN, 0, 6144, 6144, WABIN, 0, scr, gw, ngw, lane, args.in[I_AB_NPRE]);
        transpose_seg(args.in[I_AB_WIN], DM, AB_IN, 6176, 7168, 7168, WABIN, 6144, scr, gw, ngw, lane, args.in[I_AB_NPRE]);
        transpose_seg(args.in[I_AB_WIN], DM, AB_IN, 6144, 32, 32, WABIN, 13312, scr, gw, ngw, lane, args.in[I_AB_NPRE]);
        transpose_seg(args.in[I_AB_WIN], DM, AB_IN, 13344, 48, 64, WABIN, 13344, scr, gw, ngw, lane, args.in[I_AB_NPRE]);
        transpose_seg(args.in[I_AB_WIN], DM, AB_IN, 0, 0, 160, WABIN, 13408, scr, gw, ngw, lane);
        transpose_seg(args.in[I_AB_WOUT], DM, DM, 0, DM, DM, WABOUT, 0, scr, gw, ngw, lane);
        transpose_seg(args.in[I_CD_WIN], DM, CD_IN, 0, 14336, 14336, WCDIN, 0, scr, gw, ngw, lane, args.in[I_CD_NPRE]);
        for (int i = blockIdx.x * NTHR + tid; i < DM * 16; i += G * NTHR) { const int cc = i & 15, k = i >> 4;
            ((bf16*)(ms + MS_WFF))[(size_t)cc * DM + k] = (bf16)f2bf(args.in[I_CD_WIN][(size_t)k * CD_IN + 14336 + cc] * args.in[I_CD_NPRE][k]); }
        for (int l = 0; l < 2; ++l) {
            transpose_seg(args.in[I_FFN_WUP] + l * SZ_UP, DM, 2 * DFF, 0, 2 * DFF, 2 * DFF, WUP + l * SZ_UP, 0, scr, gw, ngw, lane, args.in[I_FFN_NPRE] + l * DM);
            if (l == 0) transpose_seg(args.in[I_FFN_WDOWN] + l * SZ_DOWN, DFF, DM, 0, DM, DM, WDOWN + l * SZ_DOWN, 0, scr, gw, ngw, lane);
            if (l == 0) transpose_seg(args.in[I_PLE_WGATE] + l * SZ_SQ, DM, DM, 0, DM, DM, WGATE + l * SZ_SQ, 0, scr, gw, ngw, lane, args.in[I_PLE_GNORM] + l * DM);
            transpose_seg(args.in[I_PLE_WPROJ] + l * SZ_PJ, DPLE, DM, 0, DM, DM, WPROJ + l * SZ_PJ, 0, scr, gw, ngw, lane);
        }
        for (int m = gw; m < M; m += ngw) prep_row(args.in[I_X] + (size_t)m * DM, H + (size_t)m * DM, RS + m, lane);
        transpose_seg(args.in[I_K1], 4096, 128, 0, 128, 128, (bf16*)(ms + MS_W1T), 0, scr, gw, ngw, lane);
        transpose_seg(args.in[I_V1], 4096, 128, 0, 128, 128, (bf16*)(ms + MS_W1T) + (size_t)128 * 4096, 0, scr, gw, ngw, lane);
        transpose_seg(args.in[I_K2], 128, 128, 0, 128, 128, (bf16*)(ms + MS_W2T), 0, scr, gw, ngw, lane);
        transpose_seg(args.in[I_V2], 128, 128, 0, 128, 128, (bf16*)(ms + MS_W2T) + 128 * 128, 0, scr, gw, ngw, lane);
        if (gw < 256) { const int kv = gw >> 7, j = gw & 127; const float* pe = args.in[kv ? I_PE_V : I_PE_K]; const float* w1 = args.in[kv ? I_V1 : I_K1]; float sacc = 0.f;
            for (int i = lane; i < 4096; i += 64) sacc += pe[i] * w1[(size_t)i * 128 + j];
            sacc = wave_sum(sacc); if (lane == 0) ((float*)(ms + MS_BIAS))[gw] = sacc; }
        { const float* p = args.in[I_P]; for (size_t i = (size_t)blockIdx.x * NTHR + tid; i < (size_t)2 * M * DPLE / 4; i += (size_t)G * NTHR) { const f32x4 v = ((const f32x4*)p)[i]; v2u o; o.x = pk2(v.x, v.y); o.y = pk2(v.z, v.w); ((v2u*)PBF)[i] = o; } }
        for (int i = blockIdx.x * NTHR + tid; i < 16 * HD; i += G * NTHR) { const int bg = i >> 7, d = i & 127; KC[((size_t)bg * 128 + 127) * HD + d] = 0; VC[((size_t)bg * 128 + d) * 128 + 127] = 0; }
    }
    SEAM(0);
    if (IN(1)) { pg8::Gemm g{H, WABIN, M, AB_NPAD, DM, DM}; pg8::StaticOrder S; S.init(M, AB_NPAD, G, (int)blockIdx.x); pg8::EpiProj E{PROJ, AB_LDP, SMALL, AB_LDP / 256, RS};
        pg8::gemm_phase<pg8::EpiProj, pg8::StaticOrder, true, true>(lds, g, S, E); }
    SEAM(1);
    if (IN(2)) gdn_prep_a(PROJ, SMALL, args.in[I_GDN_CW], args.in[I_GDN_ALOG], args.in[I_GDN_DTB], QS, KS, VS, GB, AMX, lds, tid, lane, wave);
    if (IN(2)) gdn_prep_b(AMX, TM, lds, lane, wave);
    if (IN(2)) { gdn_prep_c(QS, KS, VS, GB, TM, QH, OI, AN, DS, lds, tid, lane, wave); __syncthreads(); }
    if (IN(2)) {
        nsa_compress_mfma(PROJ, (const bf16*)(ms + MS_W1T), (const bf16*)(ms + MS_W2T), (const float*)(ms + MS_BIAS), KC, VC, lds, tid, lane, wave);
        if (G == 256) { if (blockIdx.x < 128) { vt_transpose(PROJ, AB_LDP, A_NKV + 3 * 512, 4, (bf16*)(ws + WS_ACT), blockIdx.x * NTHR + tid, 128 * NTHR);
                vt_transpose(PROJ, AB_LDP, A_NKV + 5 * 512, 4, (bf16*)(ws + WS_ACT + 8 * MiB), blockIdx.x * NTHR + tid, 128 * NTHR); } }
        else { vt_transpose(PROJ, AB_LDP, A_NKV + 3 * 512, 4, (bf16*)(ws + WS_ACT), blockIdx.x * NTHR + tid, G * NTHR);
            vt_transpose(PROJ, AB_LDP, A_NKV + 5 * 512, 4, (bf16*)(ws + WS_ACT + 8 * MiB), blockIdx.x * NTHR + tid, G * NTHR); }
    }
    SEAM(2);
    if (IN(3)) { if (wave == 0) { if (gw2 < 256) gdn_state_scan(AN, DS, SN, gw2, lane); }
        else transpose_seg(args.in[I_FFN_WDOWN] + SZ_DOWN, DFF, DM, 0, DM, DM, WDOWN + SZ_DOWN, 0, (LAS float*)(lds + wave * 16384), (int)blockIdx.x * 7 + wave - 1, G * 7, lane); }
    SEAM(3);
    if (IN(4)) { nsa_attn_mfma(PROJ, SMALL, KC, VC, (const bf16*)(ws + WS_ACT), (const bf16*)(ws + WS_ACT + 8 * MiB), (bf16*)Y, OBUF, lds, tid, lane, wave); __syncthreads(); }
    if (IN(5)) {
        chunk_output(QH, SN, OI, args.in[I_GDN_NORM], PROJ + A_GATE, AB_LDP, OBUF, lds, tid, lane, wave);
    }
    SEAM(5);
    if (IN(6)) { pg8::Gemm g{OBUF, WABOUT, M, DM, DM, DM}; pg8::StaticOrder S; S.init(M, DM, G, (int)blockIdx.x); pg8::EpiB16 E{YB, DM, nullptr};
        pg8::gemm_phase<pg8::EpiB16, pg8::StaticOrder, true, true>(lds, g, S, E); }
    SEAM(6);
    if (IN(7)) for (int m = gw; m < M; m += ngw) post_row<false>(YB + (size_t)m * DM, H + (size_t)m * DM, nullptr, args.in[I_AB_NPOST], RS + m, lane);
    SEAM(7);
#define FFN_PLE(P0, L, FINALP) \
    if (IN(P0)) { pg8::Gemm g{H, WUP + (L) * SZ_UP, M, 2 * DFF, DM, DM}; pg8::StaticOrder S; S.init(M, 2 * DFF, G, (int)blockIdx.x); pg8::EpiB16 E{Z, 2 * DFF, RS}; \
        pg8::gemm_phase<pg8::EpiB16, pg8::StaticOrder, true, true>(lds, g, S, E); } \
    SEAM(P0); \
    if (IN(P0 + 1)) convact_phase(Z, args.in[I_FFN_CW] + (size_t)(L) * 3 * 2 * DFF, args.in[I_FFN_CB] + (size_t)(L) * 2 * DFF, ACT, blockIdx.x * NTHR + tid, G * NTHR); \
    SEAM(P0 + 1); \
    if (IN(P0 + 2)) { pg8::Gemm g{ACT, WDOWN + (L) * SZ_DOWN, M, DM, DFF, DFF}; pg8::StaticOrder S; S.init(M, DM, G, (int)blockIdx.x); pg8::EpiB16 E{YB, DM, nullptr}; \
        pg8::gemm_phase<pg8::EpiB16, pg8::StaticOrder, true, true>(lds, g, S, E); } \
    SEAM(P0 + 2); \
    if (IN(P0 + 3)) for (int m = gw; m < M; m += ngw) post_row<false>(YB + (size_t)m * DM, H + (size_t)m * DM, nullptr, args.in[I_FFN_NPOST] + (L) * DM, RS + m, lane); \
    SEAM(P0 + 3); \
    if (IN(P0 + 4)) { pg8::Gemm g{PBF + (size_t)(L) * M * DPLE, WPROJ + (L) * SZ_PJ, M, DM, DPLE, DPLE}; pg8::StaticOrder S; S.init(M, DM, G, (int)blockIdx.x); pg8::EpiB16 E{PP, DM, nullptr}; \
        pg8::gemm_phase<pg8::EpiB16, pg8::StaticOrder, true, true>(lds, g, S, E); } \
    SEAM(P0 + 4); \
    if (IN(P0 + 5)) { pg8::Gemm g{H, WGATE + (L) * SZ_SQ, M, DM, DM, DM}; pg8::StaticOrder S; S.init(M, DM, G, (int)blockIdx.x); pg8::EpiGate E{YB, PP, DM, RS}; \
        pg8::gemm_phase<pg8::EpiGate, pg8::StaticOrder, true, true>(lds, g, S, E); } \
    SEAM(P0 + 5); \
    if (IN(P0 + 6)) { \
        for (int m = gw; m < M; m += ngw) post_row<FINALP>(YB + (size_t)m * DM, H + (size_t)m * DM, FINALP ? args.out + (size_t)m * DM : (float*)nullptr, args.in[I_PLE_NPOST] + (L) * DM, RS + m, lane); \
        if (!(FINALP) && G == 256) { asm volatile("s_waitcnt vmcnt(0)" ::: "memory"); __syncthreads(); ff_rows_mfma(H, (const bf16*)(ms + MS_WFF), RS, SMALL, lds, tid, lane, wave); } }

    FFN_PLE(8, 0, false)
    SEAM(14);
    if (IN(15)) { pg8::Gemm g{H, WCDIN, M, CD_LDP, DM, DM}; pg8::StaticOrder S; S.init(M, CD_LDP, G, (int)blockIdx.x); pg8::EpiProj E{PROJ, CD_LDP, SMALL, CD_LDP / 256, RS};
        pg8::gemm_phase<pg8::EpiProj, pg8::StaticOrder, true, true>(lds, g, S, E); }
    SEAM(15);
    if (IN(16)) {
        hgrn_chunk_prep(PROJ, args.in[I_LB], QH, OI, DS, DEC, lds, tid, lane, wave);
        if (gw2 < 64) fox_cum(SMALL, args.in[I_FOX_B], CUM, gw2, lane);
        vt_transpose(PROJ, CD_LDP, C_FV, NH, (bf16*)(ws + WS_ACT), blockIdx.x * NTHR + tid, G * NTHR);
    }
    SEAM(16);
    if (IN(17)) { if (wave == 0) { if (gw2 < 256) hgrn_state_scan(DS, DEC, SN, gw2, lane); }
        else { LAS float* scr7 = (LAS float*)(lds + wave * 16384);
            transpose_seg(args.in[I_CD_WOUT], DM, DM, 0, DM, DM, WCDOUT, 0, scr7, (int)blockIdx.x * 7 + wave - 1, G * 7, lane);
            transpose_seg(args.in[I_PLE_WGATE] + SZ_SQ, DM, DM, 0, DM, DM, WGATE + SZ_SQ, 0, scr7, (int)blockIdx.x * 7 + wave - 1, G * 7, lane, args.in[I_PLE_GNORM] + DM); } }
    SEAM(17);
    if (IN(18)) {
        fox_attn_mfma(PROJ, (const bf16*)(ws + WS_ACT), CUM, OBUF, lds, tid, lane, wave);
        __syncthreads();
        chunk_output(QH, SN, OI, args.in[I_HGRN_NORM], PROJ + C_HG, CD_LDP, OBUF, lds, tid, lane, wave);
    }
    SEAM(18);
    if (IN(19)) { pg8::Gemm g{OBUF, WCDOUT, M, DM, DM, DM}; pg8::StaticOrder S; S.init(M, DM, G, (int)blockIdx.x); pg8::EpiB16 E{YB, DM, nullptr};
        pg8::gemm_phase<pg8::EpiB16, pg8::StaticOrder, true, true>(lds, g, S, E); }
    SEAM(19);
    if (IN(20)) for (int m = gw; m < M; m += ngw) post_row<false>(YB + (size_t)m * DM, H + (size_t)m * DM, nullptr, args.in[I_CD_NPOST], RS + m, lane);
    SEAM(20);
    FFN_PLE(21, 1, true)
#undef IN
#undef SEAM
}

extern "C" void kernel_launch(void* const* d_in, const int* in_sizes, int n_in, void* d_out, int out_size, void* d_ws, size_t ws_size, hipStream_t stream) {
    static int grid = 0;
    if (grid == 0) {
        if (n_in != 33 || out_size != M * DM || ws_size < WS_END) { fprintf(stderr, "kernel_launch: unexpected problem (n_in %d, out %d, ws %zu < %zu)\n", n_in, out_size, ws_size, (size_t)WS_END); grid = -1; return; }
        int dev = 0, cus = 0, per_cu = 0;
        if (hipGetDevice(&dev) != hipSuccess || hipDeviceGetAttribute(&cus, hipDeviceAttributeMultiprocessorCount, dev) != hipSuccess) { grid = -1; return; }
        if (hipFuncSetAttribute((const void*)fwd, hipFuncAttributeMaxDynamicSharedMemorySize, LDS_BYTES) != hipSuccess) { fprintf(stderr, "kernel_launch: hipFuncSetAttribute failed\n"); grid = -1; return; }
        if (hipOccupancyMaxActiveBlocksPerMultiprocessor(&per_cu, (const void*)fwd, NTHR, LDS_BYTES) != hipSuccess || per_cu < 1) fprintf(stderr, "kernel_launch: occupancy query says %d\n", per_cu);
        (void)hipGetLastError();
        if (cus * 8 < 2048) { fprintf(stderr, "kernel_launch: needs >= 256 CUs (GDN chunk prep owns 8 chunks per workgroup)\n"); grid = -1; return; }
        grid = 256;
    }
    if (grid < 0) return;
    (void)hipMemsetAsync((char*)d_ws + WS_CTL, 0, CTL_BYTES, stream);
    Args a{};
    for (int i = 0; i < 33; ++i) a.in[i] = (const float*)d_in[i];
    a.out = (float*)d_out; a.ws = (unsigned char*)d_ws;
#if MK_SINGLE
    a.ph_lo = 0; a.ph_hi = NPHASE;
    hipLaunchKernelGGL(fwd, dim3(grid), dim3(NTHR), LDS_BYTES, stream, a);
#else
    for (int ph = 0; ph < NPHASE; ++ph) { a.ph_lo = ph; a.ph_hi = ph + 1; hipLaunchKernelGGL(fwd, dim3(grid), dim3(NTHR), LDS_BYTES, stream, a); }
#endif
}
```

```cpp
#include <hip/hip_runtime.h>
#include <cstdio>
#include <cstdint>
namespace pg8 {
#define PG8_LAS __attribute__((address_space(3)))
typedef unsigned short bf16_t;
typedef short bf16x8 __attribute__((ext_vector_type(8)));
typedef float f32x4 __attribute__((ext_vector_type(4)));
typedef unsigned u32x4 __attribute__((ext_vector_type(4)));
constexpr int BM = 256, BK = 64, HALF = 128, HTB = HALF * BK * 2  , STAGE_BYTES = 8 * HTB, NXCD = 8, WGM = 8;

__host__ __device__ __forceinline__ int lds_byte(int r, int c) { const int st = (r >> 4) * 2 + (c >> 5), rr = r & 15, cc = c & 31, ob = rr * 64 + cc * 2; return st * 1024 + (ob ^ (((ob >> 9) & 1) << 5)); }
__host__ __device__ __forceinline__ void stage_rc(int b, int& R, int& C) { const int st = b / 1024, sb = b % 1024, swz = sb ^ (((sb >> 9) & 1) << 5); R = (st >> 1) * 16 + swz / 64; C = (st & 1) * 32 + (swz % 64) / 2; }
__host__ __device__ __forceinline__ int perm32(int rho) { const int n = rho >> 4, i = rho & 15; return 8 * (i >> 2) + 4 * n + (i & 3); }

struct Unit { int pm, pn; };
struct Gemm { const bf16_t* A; const bf16_t* Bt; int M, N, K, lda; };

struct StaticOrder {
    int nM, nN, nwg, G, c;
    __host__ __device__ void init(int M, int N, int G_, int c_) { nM = M / BM; nN = N / BM; nwg = nM * nN; G = G_; c = c_; }
    __host__ __device__ bool next(int i, Unit& u) const {
        const long L = (long)i * G + c; if (L >= nwg) return false;
        int wgid = (int)L; { const int q = nwg / NXCD, r = nwg % NXCD, xcd = wgid % NXCD, off = wgid / NXCD; wgid = (xcd < r ? xcd * (q + 1) : r * (q + 1) + (xcd - r) * q) + off; }
        const int nig = WGM * nN, gid = wgid / nig, fm = gid * WGM, gsz = (nM - fm) < WGM ? (nM - fm) : WGM;
        u.pm = fm + ((wgid % nig) % gsz); u.pn = (wgid % nig) / gsz; return true;
    }
    __device__ __forceinline__ void a_ready(const Unit&) const {}
    __device__ __forceinline__ void done(const Unit&) const {}
};

__device__ __forceinline__ unsigned cvt_pk_bf16(float lo, float hi) { unsigned r; asm volatile("v_cvt_pk_bf16_f32 %0, %1, %2" : "=v"(r) : "v"(lo), "v"(hi)); return r; }
typedef float f32x2 __attribute__((ext_vector_type(2)));
struct EpiB16 {
    static constexpr bool PERM = true, AFTER_DRAIN = false;
    bf16_t* O; int ldc; const float* rs;
    __device__ __forceinline__ void operator()(const f32x4 (&acc)[2][2][4][2], const Unit& u, int wr, int wc, int fr, int fq) const {
        const int row0 = u.pm * BM + wr * 64 + fr, col0 = u.pn * BM + wc * 32 + 8 * fq;
#pragma unroll
        for (int ai = 0; ai < 2; ++ai)
#pragma unroll
            for (int m = 0; m < 4; ++m) { const int row = row0 + ai * HALF + m * 16; const float sc = rs ? rs[row] : 1.f; bf16_t* rowp = O + (size_t)row * ldc + col0;
#pragma unroll
                for (int bj = 0; bj < 2; ++bj) { const f32x4 v0 = acc[ai][bj][m][0] * sc, v1 = acc[ai][bj][m][1] * sc;
                    u32x4 w; w.x = cvt_pk_bf16(v0[0], v0[1]); w.y = cvt_pk_bf16(v0[2], v0[3]); w.z = cvt_pk_bf16(v1[0], v1[1]); w.w = cvt_pk_bf16(v1[2], v1[3]);
                    *(u32x4*)(rowp + bj * HALF) = w; } }
    }
};
struct EpiProj {
    static constexpr bool PERM = true, AFTER_DRAIN = false;
    bf16_t* O; int ldc; float* S; int nb16; const float* rs;
    __device__ __forceinline__ void operator()(const f32x4 (&acc)[2][2][4][2], const Unit& u, int wr, int wc, int fr, int fq) const {
        const int row0 = u.pm * BM + wr * 64 + fr;
        if (u.pn < nb16) {
            const int col0 = u.pn * BM + wc * 32 + 8 * fq;
#pragma unroll
            for (int ai = 0; ai < 2; ++ai)
#pragma unroll
                for (int m = 0; m < 4; ++m) { const int row = row0 + ai * HALF + m * 16; const float sc = rs[row]; bf16_t* rowp = O + (size_t)row * ldc + col0;
#pragma unroll
                    for (int bj = 0; bj < 2; ++bj) { const f32x4 v0 = acc[ai][bj][m][0] * sc, v1 = acc[ai][bj][m][1] * sc;
                        u32x4 w; w.x = cvt_pk_bf16(v0[0], v0[1]); w.y = cvt_pk_bf16(v0[2], v0[3]); w.z = cvt_pk_bf16(v1[0], v1[1]); w.w = cvt_pk_bf16(v1[2], v1[3]);
                        *(u32x4*)(rowp + bj * HALF) = w; } }
        } else {
            const int col0 = wc * 32 + 8 * fq;
#pragma unroll
            for (int ai = 0; ai < 2; ++ai)
#pragma unroll
                for (int m = 0; m < 4; ++m) { const int row = row0 + ai * HALF + m * 16; const float sc = rs[row]; float* rowp = S + (size_t)row * 256 + col0;
#pragma unroll
                    for (int bj = 0; bj < 2; ++bj) { *(f32x4*)(rowp + bj * HALF) = acc[ai][bj][m][0] * sc; *(f32x4*)(rowp + bj * HALF + 4) = acc[ai][bj][m][1] * sc; } }
        }
    }
};
struct EpiGate {
    static constexpr bool PERM = true, AFTER_DRAIN = false;
    bf16_t* C; const bf16_t* PP; int ldc; const float* rs;
    __device__ __forceinline__ void operator()(const f32x4 (&acc)[2][2][4][2], const Unit& u, int wr, int wc, int fr, int fq) const {
        const int row0 = u.pm * BM + wr * 64 + fr, col0 = u.pn * BM + wc * 32 + 8 * fq;
#pragma unroll
        for (int ai = 0; ai < 2; ++ai)
#pragma unroll
            for (int m = 0; m < 4; ++m) { const int row = row0 + ai * HALF + m * 16; const float sc = rs[row]; const size_t off = (size_t)row * ldc + col0;
#pragma unroll
                for (int bj = 0; bj < 2; ++bj) { const u32x4 pw = *(const u32x4*)(PP + off + bj * HALF); const f32x4 a = acc[ai][bj][m][0] * sc, b = acc[ai][bj][m][1] * sc; u32x4 w;
                    w.x = cvt_pk_bf16(__uint_as_float(pw.x << 16) * __builtin_amdgcn_rcpf(1.f + __expf(-a[0])), __uint_as_float(pw.x & 0xffff0000u) * __builtin_amdgcn_rcpf(1.f + __expf(-a[1])));
                    w.y = cvt_pk_bf16(__uint_as_float(pw.y << 16) * __builtin_amdgcn_rcpf(1.f + __expf(-a[2])), __uint_as_float(pw.y & 0xffff0000u) * __builtin_amdgcn_rcpf(1.f + __expf(-a[3])));
                    w.z = cvt_pk_bf16(__uint_as_float(pw.z << 16) * __builtin_amdgcn_rcpf(1.f + __expf(-b[0])), __uint_as_float(pw.z & 0xffff0000u) * __builtin_amdgcn_rcpf(1.f + __expf(-b[1])));
                    w.w = cvt_pk_bf16(__uint_as_float(pw.w << 16) * __builtin_amdgcn_rcpf(1.f + __expf(-b[2])), __uint_as_float(pw.w & 0xffff0000u) * __builtin_amdgcn_rcpf(1.f + __expf(-b[3])));
                    *(u32x4*)(C + off + bj * HALF) = w; } }
    }
};
template <class Epi, class Sched, bool ALIGN_EPI = false, bool SP2 = false>
__device__ __forceinline__ void gemm_phase(PG8_LAS unsigned char* lds, const Gemm g, const Sched& S, const Epi& E) {
    const int tid = threadIdx.x, wid = __builtin_amdgcn_readfirstlane(tid >> 6), lane = tid & 63, wr = wid >> 2, wc = wid & 3, fr = lane & 15, fq = lane >> 4;
    const int K = g.K, nt = K / BK;
    unsigned voffA[2], voffB[2];
#pragma unroll
    for (int i = 0; i < 2; ++i) { int R, C; stage_rc(tid * 16 + i * 8192, R, C); const int Rb = Epi::PERM ? ((R & ~31) + perm32(R & 31)) : R;
        voffA[i] = (unsigned)(R * g.lda + C) * 2u; voffB[i] = (unsigned)(Rb * K + C) * 2u; }
    const size_t kstep = (size_t)(BK * 2);
    const size_t hstepA = (size_t)HALF * g.lda * 2, hstepB = (size_t)HALF * K * 2;
    const size_t tstepA = 2 * hstepA, tstepB = 2 * hstepB;
    const unsigned ldsw = (unsigned)wid * 1024u;
    const int aoff = lds_byte(wr * 64 + fr, fq * 8), boff = lds_byte(wc * 32 + fr, fq * 8);
#define PG8_SA(b, h) (((b) * 2 + (h)) * HTB)
#define PG8_SB(b, h) ((4 + (b) * 2 + (h)) * HTB)
#define PG8_STAGE(bufoff, gbase, voff) do { _Pragma("unroll") for (int _i = 0; _i < 2; ++_i) \
        __builtin_amdgcn_global_load_lds((const unsigned*)((const char*)(gbase) + (voff)[_i]), (PG8_LAS unsigned*)(lds + (bufoff) + ldsw + _i * 8192), 16, 0, 0); } while (0)
#define PG8_LDA(dst, b, h) do { _Pragma("unroll") for (int m = 0; m < 4; ++m) _Pragma("unroll") for (int k = 0; k < 2; ++k) dst[m][k] = *(const PG8_LAS bf16x8*)(lds + PG8_SA(b, h) + aoff + m * 2048 + k * 1024); } while (0)
#define PG8_LDB(dst, b, h) do { _Pragma("unroll") for (int n = 0; n < 2; ++n) _Pragma("unroll") for (int k = 0; k < 2; ++k) dst[n][k] = *(const PG8_LAS bf16x8*)(lds + PG8_SB(b, h) + boff + n * 2048 + k * 1024); } while (0)
#define PG8_MMA(ai, bj, At, Bt) do { __builtin_amdgcn_s_setprio(1); _Pragma("unroll") for (int m = 0; m < 4; ++m) _Pragma("unroll") for (int n = 0; n < 2; ++n) _Pragma("unroll") for (int k = 0; k < 2; ++k) \
        acc[ai][bj][m][n] = __builtin_amdgcn_mfma_f32_16x16x32_bf16(Bt[n][k], At[m][k], acc[ai][bj][m][n], 0, 0, 0); __builtin_amdgcn_s_setprio(0); } while (0)
#define PG8_WAIT_V(n) asm volatile("s_waitcnt vmcnt(" #n ")" ::: "memory")
#define PG8_WAIT_L(n) asm volatile("s_waitcnt lgkmcnt(" #n ")" ::: "memory")
#define PG8_BAR __builtin_amdgcn_s_barrier()
#define PG8_SCHED __builtin_amdgcn_sched_barrier(0)
    Unit cur, nxt; int ui = 0;
    if (!S.next(0, cur)) return;
    f32x4 acc[2][2][4][2];
#pragma unroll
    for (int a = 0; a < 2; ++a)
#pragma unroll
        for (int b = 0; b < 2; ++b)
#pragma unroll
            for (int m = 0; m < 4; ++m)
#pragma unroll
                for (int n = 0; n < 2; ++n) acc[a][b][m][n] = (f32x4){0.f, 0.f, 0.f, 0.f};
    bf16x8 At[4][2], B0[2][2], B1[2][2];
    const char* cA = (const char*)g.A + (size_t)cur.pm * tstepA; const char* cB = (const char*)g.Bt + (size_t)cur.pn * tstepB;
    S.a_ready(cur);
    if constexpr (SP2) {
        PG8_STAGE(PG8_SB(0, 0), cB, voffB); PG8_STAGE(PG8_SB(0, 1), cB + hstepB, voffB); PG8_STAGE(PG8_SA(0, 0), cA, voffA); PG8_STAGE(PG8_SA(0, 1), cA + hstepA, voffA);
        if (wr == 1) PG8_BAR;
        PG8_WAIT_V(2); PG8_BAR;
        PG8_STAGE(PG8_SB(1, 0), cB + kstep, voffB); PG8_STAGE(PG8_SA(1, 0), cA + kstep, voffA); PG8_STAGE(PG8_SB(1, 1), cB + hstepB + kstep, voffB);
        PG8_WAIT_V(6); PG8_BAR;
    } else {
        PG8_STAGE(PG8_SB(0, 0), cB, voffB); PG8_STAGE(PG8_SA(0, 0), cA, voffA); PG8_STAGE(PG8_SB(0, 1), cB + hstepB, voffB); PG8_STAGE(PG8_SA(0, 1), cA + hstepA, voffA);
        if (wr == 1) PG8_BAR;
        PG8_WAIT_V(4); PG8_BAR;
        PG8_STAGE(PG8_SB(1, 0), cB + kstep, voffB); PG8_STAGE(PG8_SA(1, 0), cA + kstep, voffA); PG8_STAGE(PG8_SB(1, 1), cB + hstepB + kstep, voffB);
        PG8_WAIT_V(6); PG8_BAR;
    }
    for (;;) {
        const bool has_next = S.next(ui + 1, nxt);
        const char* nA = has_next ? (const char*)g.A + (size_t)nxt.pm * tstepA : cA; const char* nB = has_next ? (const char*)g.Bt + (size_t)nxt.pn * tstepB : cB;
        for (int t = 0; t < nt; t += 2) {
            const bool last = (t == nt - 2);
            const char* a1 = cA + (size_t)(t + 1) * kstep;
            const char* a2 = last ? nA : cA + (size_t)(t + 2) * kstep; const char* b2 = last ? nB : cB + (size_t)(t + 2) * kstep;
            const char* a3 = a2 + kstep; const char* b3 = b2 + kstep;
            if (last && has_next) S.a_ready(nxt);
            if constexpr (SP2) {
            PG8_LDB(B0, 0, 0); PG8_LDB(B1, 0, 1); PG8_SCHED; PG8_LDA(At, 0, 0); PG8_STAGE(PG8_SA(1, 1), a1 + hstepA, voffA);
            PG8_WAIT_V(8); PG8_WAIT_L(0); PG8_BAR; PG8_MMA(0, 0, At, B0); PG8_MMA(0, 1, At, B1); PG8_BAR; PG8_SCHED;
            PG8_LDA(At, 0, 1); PG8_STAGE(PG8_SB(0, 0), b2, voffB); PG8_STAGE(PG8_SB(0, 1), b2 + hstepB, voffB); PG8_STAGE(PG8_SA(0, 0), a2, voffA);
            PG8_WAIT_V(8); PG8_WAIT_L(0); PG8_BAR; PG8_MMA(1, 0, At, B0); PG8_MMA(1, 1, At, B1); PG8_BAR; PG8_SCHED;
            PG8_LDB(B0, 1, 0); PG8_LDB(B1, 1, 1); PG8_SCHED; PG8_LDA(At, 1, 0); PG8_STAGE(PG8_SA(0, 1), a2 + hstepA, voffA);
            PG8_WAIT_V(8); PG8_WAIT_L(0); PG8_BAR; PG8_MMA(0, 0, At, B0); PG8_MMA(0, 1, At, B1); PG8_BAR; PG8_SCHED;
            PG8_LDA(At, 1, 1); PG8_STAGE(PG8_SB(1, 0), b3, voffB); PG8_STAGE(PG8_SB(1, 1), b3 + hstepB, voffB); PG8_STAGE(PG8_SA(1, 0), a3, voffA);
            PG8_WAIT_V(8); PG8_WAIT_L(0); PG8_BAR; PG8_MMA(1, 0, At, B0); PG8_MMA(1, 1, At, B1); PG8_BAR; PG8_SCHED;
            } else {
            PG8_LDB(B0, 0, 0); PG8_SCHED; PG8_LDA(At, 0, 0); PG8_STAGE(PG8_SA(1, 1), a1 + hstepA, voffA);
            PG8_WAIT_L(8); PG8_BAR; PG8_WAIT_L(0); PG8_MMA(0, 0, At, B0); PG8_BAR; PG8_SCHED;
            PG8_LDB(B1, 0, 1); PG8_STAGE(PG8_SB(0, 0), b2, voffB);
            PG8_BAR; PG8_WAIT_L(0); PG8_MMA(0, 1, At, B1); PG8_BAR;
            PG8_LDA(At, 0, 1); PG8_STAGE(PG8_SA(0, 0), a2, voffA);
            PG8_BAR; PG8_WAIT_L(0); PG8_MMA(1, 0, At, B0); PG8_BAR; PG8_SCHED;
            PG8_STAGE(PG8_SB(0, 1), b2 + hstepB, voffB);
            PG8_WAIT_V(6); PG8_BAR; PG8_MMA(1, 1, At, B1); PG8_BAR;
            PG8_LDB(B0, 1, 0); PG8_SCHED; PG8_LDA(At, 1, 0); PG8_STAGE(PG8_SA(0, 1), a2 + hstepA, voffA);
            PG8_WAIT_L(8); PG8_BAR; PG8_WAIT_L(0); PG8_MMA(0, 0, At, B0); PG8_BAR; PG8_SCHED;
            PG8_LDB(B1, 1, 1); PG8_STAGE(PG8_SB(1, 0), b3, voffB);
            PG8_BAR; PG8_WAIT_L(0); PG8_MMA(0, 1, At, B1); PG8_BAR;
            PG8_LDA(At, 1, 1); PG8_STAGE(PG8_SA(1, 0), a3, voffA);
            PG8_BAR; PG8_WAIT_L(0); PG8_MMA(1, 0, At, B0); PG8_BAR; PG8_SCHED;
            PG8_STAGE(PG8_SB(1, 1), b3 + hstepB, voffB);
            PG8_WAIT_V(6); PG8_BAR; PG8_MMA(1, 1, At, B1); PG8_BAR;
            }
        }
        if constexpr (ALIGN_EPI) { if (wr == 0) PG8_BAR; }
        if constexpr (!Epi::AFTER_DRAIN) { E(acc, cur, wr, wc, fr, fq); S.done(cur); }
        if (!has_next) break;
#pragma unroll
        for (int a = 0; a < 2; ++a)
#pragma unroll
            for (int b = 0; b < 2; ++b)
#pragma unroll
                for (int m = 0; m < 4; ++m)
#pragma unroll
                    for (int n = 0; n < 2; ++n) acc[a][b][m][n] = (f32x4){0.f, 0.f, 0.f, 0.f};
        cur = nxt; cA = nA; cB = nB; ++ui;
        if constexpr (ALIGN_EPI) { if (wr == 1) PG8_BAR; }
    }
    PG8_WAIT_V(0);
    if constexpr (!ALIGN_EPI) { if (wr == 0) PG8_BAR; }
    PG8_BAR;
    if constexpr (Epi::AFTER_DRAIN) { E.fused(acc, cur, wr, wc, fr, fq, lds, wid, lane); S.done(cur); }
#undef PG8_SA
#undef PG8_SB
#undef PG8_STAGE
#undef PG8_LDA
#undef PG8_LDB
#undef PG8_MMA
#undef PG8_WAIT_V
#undef PG8_WAIT_L
#undef PG8_BAR
#undef PG8_SCHED
}
}
constexpr int NB = 4, T = 2048, DM = 4096, M = NB * T, HD = 128, NH = 16, DFF = 11008, DPLE = 256;
constexpr int AB_IN = 13392, CD_IN = 14352;
constexpr int AB_LDP = 13312, AB_NPAD = 13568;
constexpr int CD_LDP = 14336, CD_NPAD = 14592;
constexpr int A_QKV = 0, A_GATE = 6144, A_NQ = 8192, A_NKV = 10240;
constexpr int C_HQ = 0, C_HF = 2048, C_HI = 4096, C_HG = 6144, C_FQ = 8192, C_FK = 10240, C_FV = 12288;
constexpr int NCMP = 127;
constexpr float EPS = 1e-6f, QSCALE = 0.08838834764831845f;
constexpr size_t MiB = 1u << 20;
constexpr size_t WS_CTL = 0, CTL_BYTES = 65536;
constexpr size_t WS_WABIN = 1 * MiB;
constexpr size_t WS_WABOUT = WS_WABIN + 106 * MiB;
constexpr size_t WS_WCDIN = WS_WABOUT + 32 * MiB;
constexpr size_t WS_WCDOUT = WS_WCDIN + 114 * MiB;
constexpr size_t WS_WUP = WS_WCDOUT + 32 * MiB;
constexpr size_t WS_WDOWN = WS_WUP + 2 * 172 * MiB;
constexpr size_t WS_WGATE = WS_WDOWN + 2 * 86 * MiB;
constexpr size_t WS_WPROJ = WS_WGATE + 2 * 32 * MiB;
constexpr size_t WS_XRES = WS_WPROJ + 2 * 2 * MiB;
constexpr size_t WS_H = WS_XRES + 128 * MiB;
constexpr size_t WS_PROJ = WS_H + 64 * MiB;
constexpr size_t WS_SMALL = WS_PROJ + 224 * MiB;
constexpr size_t WS_Y = WS_SMALL + 8 * MiB;
constexpr size_t WS_OBUF = WS_Y + 128 * MiB;
constexpr size_t WS_Z = WS_OBUF + 64 * MiB;
constexpr size_t WS_ACT = WS_Z + 344 * MiB;
constexpr size_t WS_PP = WS_ACT + 172 * MiB;
constexpr size_t WS_PBF = WS_PP + 64 * MiB;
constexpr size_t WS_MISC = WS_PBF + 8 * MiB;
constexpr size_t WS_END = WS_MISC + 8 * MiB;
constexpr size_t WS_QN = WS_Z, WS_KN = WS_Z + 64 * MiB, WS_VV = WS_Z + 128 * MiB, WS_ORAW = WS_Z + 192 * MiB, WS_OCMP = WS_Z + 256 * MiB;
constexpr size_t MS_KC = 0, MS_VC = 1 * MiB  , MS_GG = 2 * MiB, MS_BB = 2 * MiB + 512 * 1024, MS_SEL = 3 * MiB, MS_CUM = 4 * MiB, MS_PEB = 5 * MiB;
constexpr int CW_BAR = 4096;

constexpr int NWAVES = 8, NTHR = 512;
constexpr int RING_BYTES = 131072, LDSCTL_OFF = RING_BYTES, MISC_OFF = LDSCTL_OFF + 320, LDS_BYTES = 147456;

#define GAS __attribute__((address_space(1)))
#define LAS __attribute__((address_space(3)))
typedef unsigned short bf16;
typedef unsigned v4u __attribute__((ext_vector_type(4)));
typedef unsigned v2u __attribute__((ext_vector_type(2)));
typedef float f32x4 __attribute__((ext_vector_type(4)));
#define LDS_WAIT() asm volatile("s_waitcnt lgkmcnt(0)" ::: "memory")
__device__ __forceinline__ unsigned f2bf(float f) { unsigned u = __float_as_uint(f); return (u + 0x7fffu + ((u >> 16) & 1u)) >> 16; }
__device__ __forceinline__ unsigned pk2(float lo, float hi) { return f2bf(lo) | (f2bf(hi) << 16); }
__device__ __forceinline__ float bflo(unsigned w) { return __uint_as_float(w << 16); }
__device__ __forceinline__ float bfhi(unsigned w) { return __uint_as_float(w & 0xffff0000u); }
__device__ __forceinline__ float bf2f(bf16 b) { return __uint_as_float(((unsigned)b) << 16); }
__device__ __forceinline__ float wave_sum(float v) {
#pragma unroll
    for (int o = 1; o < 64; o <<= 1) v += __shfl_xor(v, o);
    return v; }
__device__ __forceinline__ float wave_max(float v) {
#pragma unroll
    for (int o = 1; o < 64; o <<= 1) v = fmaxf(v, __shfl_xor(v, o));
    return v; }
__device__ __forceinline__ float sigm(float x) { return __builtin_amdgcn_rcpf(1.f + __expf(-x)); }
__device__ __forceinline__ float silu(float x) { return x * __builtin_amdgcn_rcpf(1.f + __expf(-x)); }
__device__ __forceinline__ float softplus(float x) { return x > 20.f ? x : log1pf(__expf(x)); }
__device__ __forceinline__ float logsigm(float x) { return fminf(x, 0.f) - log1pf(__expf(-fabsf(x))); }

#define XB_TMO      128
#define XB_XCNT(j)  (256  + 64 * (j))
#define XB_XSUB(j)  (1280 + 64 * (j))
#define XB_XGEN(j)  (2304 + 64 * (j))
#define XB_TOP      3328
#define XB_TOPGEN   3392
#define XCD_BAR_WORDS 3456
#define XB_SPIN_CAP (1u << 18)
__device__ __forceinline__ unsigned xb_ld(unsigned* p)              { return __hip_atomic_load(p, __ATOMIC_RELAXED, __HIP_MEMORY_SCOPE_AGENT); }
__device__ __forceinline__ unsigned xb_add(unsigned* p, unsigned v) { return __hip_atomic_fetch_add(p, v, __ATOMIC_RELAXED, __HIP_MEMORY_SCOPE_AGENT); }
__device__ __forceinline__ unsigned xb_xcc_id() { return (unsigned)__builtin_amdgcn_s_getreg((3 << 11) | 20) & 0xFu; }
#define XB_SPIN(cond, bar) do { unsigned _sp = 0; while (cond) { __builtin_amdgcn_s_sleep(1); \
    if ((++_sp & 255u) == 0u) { if (xb_ld(&(bar)[XB_TMO])) break; if (_sp > XB_SPIN_CAP) { atomicAdd(&(bar)[XB_TMO], 1u); break; } } } } while (0)
struct XcdBarrier { unsigned* bar; unsigned x; volatile LAS unsigned* st; };
__device__ __forceinline__ XcdBarrier xcd_barrier_post(unsigned* bar, volatile LAS unsigned* st) {
    XcdBarrier b; b.bar = bar; b.x = xb_xcc_id(); b.st = st;
    if (threadIdx.x == 0) (void)xb_add(&bar[XB_XCNT(b.x)], 1u);
    return b;
}
__device__ __forceinline__ void xcd_barrier_complete(unsigned* bar, unsigned x, unsigned& nloc, unsigned& nx) {
    const unsigned G = gridDim.x * gridDim.y * gridDim.z;
    unsigned sum, cnt, mine, sp = 0u;
    for (;;) {
        sum = 0u; cnt = 0u; mine = 0u;
#pragma unroll
        for (unsigned j = 0; j < 16; ++j) { const unsigned c = xb_ld(&bar[XB_XCNT(j)]); sum += c; cnt += (c > 0u) ? 1u : 0u; mine = (j == x) ? c : mine; }
        if (sum == G) break;
        __builtin_amdgcn_s_sleep(1);
        if ((++sp & 255u) == 0u) { if (xb_ld(&bar[XB_TMO])) break; if (sp > XB_SPIN_CAP) { atomicAdd(&bar[XB_TMO], 1u); break; } }
    }
    nloc = mine > 0u ? mine : 1u; nx = cnt > 0u ? cnt : 1u;
}
__device__ __forceinline__ void xcd_barrier(const XcdBarrier& b) {
    asm volatile("s_waitcnt vmcnt(0)" ::: "memory");
    __syncthreads();
    if (threadIdx.x == 0) {
        unsigned* bar = b.bar;
        __builtin_amdgcn_s_waitcnt(0);
        unsigned nloc = b.st[0], nx = b.st[1];
        if (nloc == 0u) { xcd_barrier_complete(bar, b.x, nloc, nx); b.st[0] = nloc; b.st[1] = nx; }
        const unsigned old = xb_add(&bar[XB_XSUB(b.x)], 1u);
        const unsigned gen = old / nloc;
        if (old + 1u == (gen + 1u) * nloc) {
            __builtin_amdgcn_fence(__ATOMIC_RELEASE, "agent");
            asm volatile("s_waitcnt vmcnt(0)" ::: "memory");
            const unsigned og = xb_add(&bar[XB_TOP], 1u);
            const unsigned tg = og / nx;
            if (og + 1u == (tg + 1u) * nx) xb_add(&bar[XB_TOPGEN], 1u);
            else XB_SPIN(xb_ld(&bar[XB_TOPGEN]) == tg, bar);
            __builtin_amdgcn_fence(__ATOMIC_ACQUIRE, "agent");
            xb_add(&bar[XB_XGEN(b.x)], 1u);
            asm volatile("s_waitcnt vmcnt(0)" ::: "memory");
        } else {
            XB_SPIN(xb_ld(&bar[XB_XGEN(b.x)]) == gen, bar);
            __builtin_amdgcn_fence(__ATOMIC_ACQUIRE, "agent");
            asm volatile("s_waitcnt vmcnt(0)" ::: "memory");
        }
    }
    __syncthreads();
}

__device__ __forceinline__ void transpose_seg(const float* W, int K, int ldw, int c0, int nvalid, int npad, bf16* Wt, int r0, LAS float* scr, int gw, int ngw, int lane, const float* kscale = nullptr) {
    const int nblk = npad / 32, nitems = (K / 64) * nblk;
    const int nkb = K / 64, GK = (nkb % 8 == 0) ? 8 : ((nkb % 4 == 0) ? 4 : 1), GN = 64 / GK; const bool blocked = (GK > 1) && (nblk % GN == 0);
    for (int item = gw; item < nitems; item += ngw) {
        int kb, nb;
        if (blocked) { const int grp = item >> 6, w = item & 63, gpr = nblk / GN; kb = GK * (grp / gpr) + w / GN; nb = GN * (grp % gpr) + w % GN; }
        else { kb = item / nblk; nb = item % nblk; }
        const int k0 = 64 * kb, n0 = 32 * nb;
        const int nn = n0 + (lane & 31); const bool ok = nn < nvalid;
        const float* src = W + (size_t)k0 * ldw + c0 + (ok ? nn : 0);
#pragma unroll 8
        for (int i = 0; i < 32; ++i) { const int kk = 2 * i + (lane >> 5); const float v = src[(size_t)kk * ldw]; scr[kk * 33 + (lane & 31)] = ok ? v : 0.f; }
        LDS_WAIT(); asm volatile("" ::: "memory");
        const int c = lane & 7;
        f32x4 ka = (f32x4){1.f, 1.f, 1.f, 1.f}, kb2 = ka;
        if (kscale) { ka = *(const f32x4*)(kscale + k0 + 8 * c); kb2 = *(const f32x4*)(kscale + k0 + 8 * c + 4); }
#pragma unroll
        for (int j = 0; j < 4; ++j) { const int n = (lane >> 3) + 8 * j; const LAS float* s = scr + (8 * c) * 33 + n;
            v4u o; o.x = pk2(s[0 * 33] * ka.x, s[1 * 33] * ka.y); o.y = pk2(s[2 * 33] * ka.z, s[3 * 33] * ka.w); o.z = pk2(s[4 * 33] * kb2.x, s[5 * 33] * kb2.y); o.w = pk2(s[6 * 33] * kb2.z, s[7 * 33] * kb2.w);
            *(v4u*)(Wt + (size_t)(r0 + n0 + n) * K + k0 + 8 * c) = o; }
        LDS_WAIT(); asm volatile("" ::: "memory");
    }
}
__device__ __forceinline__ void prep_row(const float* xrow, bf16* orow, float* rs, int lane) {
    asm volatile("" : "+v"(lane));
    const f32x4* xr = (const f32x4*)xrow; v4u* o = (v4u*)orow; float s = 0.f;
#pragma unroll
    for (int j = 0; j < 8; ++j) { const int c = lane + 64 * j; const f32x4 a = xr[2 * c], b = xr[2 * c + 1];
        s += (a.x * a.x + a.y * a.y) + (a.z * a.z + a.w * a.w) + (b.x * b.x + b.y * b.y) + (b.z * b.z + b.w * b.w);
        v4u w; w.x = pk2(a.x, a.y); w.y = pk2(a.z, a.w); w.z = pk2(b.x, b.y); w.w = pk2(b.z, b.w); o[c] = w; }
    s = wave_sum(s); if (lane == 0) *rs = rsqrtf(s * (1.f / DM) + EPS);
}
template <bool FINAL>
__device__ __forceinline__ void post_row(const bf16* yrow, bf16* xrow, float* fout, const float* wpost, float* rs, int lane) {
    asm volatile("" : "+v"(lane));
    const v4u* yr = (const v4u*)yrow; v4u* xr = (v4u*)xrow; const f32x4* wp = (const f32x4*)wpost; v4u yv[8]; float s = 0.f;
#pragma unroll
    for (int j = 0; j < 8; ++j) { yv[j] = yr[lane + 64 * j]; const v4u w = yv[j];
        s += (bflo(w.x) * bflo(w.x) + bfhi(w.x) * bfhi(w.x)) + (bflo(w.y) * bflo(w.y) + bfhi(w.y) * bfhi(w.y)) + (bflo(w.z) * bflo(w.z) + bfhi(w.z) * bfhi(w.z)) + (bflo(w.w) * bflo(w.w) + bfhi(w.w) * bfhi(w.w)); }
    const float rstd = rsqrtf(wave_sum(s) * (1.f / DM) + EPS); float s2 = 0.f;
#pragma unroll
    for (int j = 0; j < 8; ++j) { const int c = lane + 64 * j; const v4u xw = xr[c], yw = yv[j]; const f32x4 wa = wp[2 * c], wb = wp[2 * c + 1];
        f32x4 a, b;
        a.x = bflo(xw.x) + bflo(yw.x) * rstd * wa.x; a.y = bfhi(xw.x) + bfhi(yw.x) * rstd * wa.y; a.z = bflo(xw.y) + bflo(yw.y) * rstd * wa.z; a.w = bfhi(xw.y) + bfhi(yw.y) * rstd * wa.w;
        b.x = bflo(xw.z) + bflo(yw.z) * rstd * wb.x; b.y = bfhi(xw.z) + bfhi(yw.z) * rstd * wb.y; b.z = bflo(xw.w) + bflo(yw.w) * rstd * wb.z; b.w = bfhi(xw.w) + bfhi(yw.w) * rstd * wb.w;
        if (FINAL) { ((f32x4*)fout)[2 * c] = a; ((f32x4*)fout)[2 * c + 1] = b; }
        else { s2 += (a.x * a.x + a.y * a.y) + (a.z * a.z + a.w * a.w) + (b.x * b.x + b.y * b.y) + (b.z * b.z + b.w * b.w);
            v4u w; w.x = pk2(a.x, a.y); w.y = pk2(a.z, a.w); w.z = pk2(b.x, b.y); w.w = pk2(b.z, b.w); xr[c] = w; } }
    if (!FINAL) { s2 = wave_sum(s2); if (lane == 0) *rs = rsqrtf(s2 * (1.f / DM) + EPS); }
}
__device__ __forceinline__ void ff_rows_mfma(const bf16* X, const bf16* WT, const float* RS, float* SMALLp, LAS unsigned char* lds, int tid, int lane, int wave) {
    typedef short bf16x8_ __attribute__((ext_vector_type(8))); typedef float f32x16_ __attribute__((ext_vector_type(16)));
    const int r = lane & 31, hh = lane >> 5; const int m = 8 * (int)blockIdx.x + (r & 7) + 2048 * (r >> 3);
    const bf16* xa = X + (size_t)m * DM + 512 * wave + 8 * hh; const bf16* wb = WT + (size_t)(r & 15) * DM + 512 * wave + 8 * hh;
    f32x16_ acc;
#pragma unroll
    for (int i = 0; i < 16; ++i) acc[i] = 0.f;
#pragma unroll 8
    for (int ks = 0; ks < 32; ++ks) { const bf16x8_ a = *(const bf16x8_*)(xa + 16 * ks); bf16x8_ b = *(const bf16x8_*)(wb + 16 * ks); if (r >= 16) b = (bf16x8_){0, 0, 0, 0, 0, 0, 0, 0};
        acc = __builtin_amdgcn_mfma_f32_32x32x16_bf16(a, b, acc, 0, 0, 0); }
    LAS float* P = (LAS float*)lds;
    if (r < 16) {
#pragma unroll
        for (int i = 0; i < 16; ++i) { const int rr = (i & 3) + 8 * (i >> 2) + 4 * hh; P[(wave * 32 + rr) * 16 + r] = acc[i]; } }
    __syncthreads();
    { const int rr = tid >> 4, c = tid & 15; float sacc = 0.f;
#pragma unroll
      for (int w = 0; w < 8; ++w) sacc += P[(w * 32 + rr) * 16 + c];
      const int mm = 8 * (int)blockIdx.x + (rr & 7) + 2048 * (rr >> 3);
      SMALLp[(size_t)mm * 256 + c] = sacc * RS[mm]; }
    __syncthreads();
}
__device__ __forceinline__ void convact_phase(const bf16* Z, const float* cw, const float* cb, bf16* ACT, int gtid, int ngt) {
    constexpr int CG = DFF / 8, RG = M / 8;
    for (int item = gtid; item < CG * RG; item += ngt) {
        const int cg = item % CG, rg = item / CG, c = cg * 8, r0 = rg * 8, t0 = r0 & (T - 1);
        float w[2][3][8], bb[2][8];
#pragma unroll
        for (int s = 0; s < 2; ++s) {
#pragma unroll
            for (int j = 0; j < 3; ++j) { const f32x4 a = *(const f32x4*)(cw + (size_t)j * 2 * DFF + s * DFF + c), b = *(const f32x4*)(cw + (size_t)j * 2 * DFF + s * DFF + c + 4);
                w[s][j][0] = a.x; w[s][j][1] = a.y; w[s][j][2] = a.z; w[s][j][3] = a.w; w[s][j][4] = b.x; w[s][j][5] = b.y; w[s][j][6] = b.z; w[s][j][7] = b.w; }
            const f32x4 a = *(const f32x4*)(cb + s * DFF + c), b = *(const f32x4*)(cb + s * DFF + c + 4);
            bb[s][0] = a.x; bb[s][1] = a.y; bb[s][2] = a.z; bb[s][3] = a.w; bb[s][4] = b.x; bb[s][5] = b.y; bb[s][6] = b.z; bb[s][7] = b.w; }
        float zm2[2][8], zm1[2][8];
#pragma unroll
        for (int s = 0; s < 2; ++s) {
            v4u a = (v4u){0u, 0u, 0u, 0u}, b = (v4u){0u, 0u, 0u, 0u};
            if (t0 >= 2) a = *(const v4u*)(Z + (size_t)(r0 - 2) * (2 * DFF) + s * DFF + c);
            if (t0 >= 1) b = *(const v4u*)(Z + (size_t)(r0 - 1) * (2 * DFF) + s * DFF + c);
            zm2[s][0] = bflo(a.x); zm2[s][1] = bfhi(a.x); zm2[s][2] = bflo(a.y); zm2[s][3] = bfhi(a.y); zm2[s][4] = bflo(a.z); zm2[s][5] = bfhi(a.z); zm2[s][6] = bflo(a.w); zm2[s][7] = bfhi(a.w);
            zm1[s][0] = bflo(b.x); zm1[s][1] = bfhi(b.x); zm1[s][2] = bflo(b.y); zm1[s][3] = bfhi(b.y); zm1[s][4] = bflo(b.z); zm1[s][5] = bfhi(b.z); zm1[s][6] = bflo(b.w); zm1[s][7] = bfhi(b.w); }
#pragma unroll
        for (int i = 0; i < 8; ++i) {
            float z0[2][8], u[2][8];
#pragma unroll
            for (int s = 0; s < 2; ++s) { const v4u a = *(const v4u*)(Z + (size_t)(r0 + i) * (2 * DFF) + s * DFF + c);
                z0[s][0] = bflo(a.x); z0[s][1] = bfhi(a.x); z0[s][2] = bflo(a.y); z0[s][3] = bfhi(a.y); z0[s][4] = bflo(a.z); z0[s][5] = bfhi(a.z); z0[s][6] = bflo(a.w); z0[s][7] = bfhi(a.w);
#pragma unroll
                for (int e = 0; e < 8; ++e) { u[s][e] = bb[s][e] + w[s][0][e] * zm2[s][e] + w[s][1][e] * zm1[s][e] + w[s][2][e] * z0[s][e]; zm2[s][e] = zm1[s][e]; zm1[s][e] = z0[s][e]; } }
            v4u o; o.x = pk2(silu(u[0][0]) * u[1][0], silu(u[0][1]) * u[1][1]); o.y = pk2(silu(u[0][2]) * u[1][2], silu(u[0][3]) * u[1][3]);
            o.z = pk2(silu(u[0][4]) * u[1][4], silu(u[0][5]) * u[1][5]); o.w = pk2(silu(u[0][6]) * u[1][6], silu(u[0][7]) * u[1][7]);
            *(v4u*)(ACT + (size_t)(r0 + i) * DFF + c) = o;
        }
    }
}
__device__ __forceinline__ void gdn_prep_naive(const bf16* proj, const float* small, const float* cw, const float* a_log, const float* dt_bias,
                                               float* QN, float* KN, float* VV, float* GG, float* BB, int gw, int ngw, int lane) {
    for (int item = gw; item < M * NH; item += ngw) {
        const int row = item >> 4, h = item & 15, t = row & (T - 1), b = row >> 11;
        float val[3][2];
#pragma unroll
        for (int s = 0; s < 3; ++s)
#pragma unroll
            for (int dd = 0; dd < 2; ++dd) { const int ch = s * 2048 + h * HD + lane + 64 * dd; float acc = 0.f;
#pragma unroll
                for (int j = 0; j < 4; ++j) { const int tt = t - 3 + j; if (tt >= 0) acc += cw[j * 6144 + ch] * bf2f(proj[(size_t)(row - 3 + j) * AB_LDP + A_QKV + ch]); }
                val[s][dd] = silu(acc); }
        const float qi = rsqrtf(wave_sum(val[0][0] * val[0][0] + val[0][1] * val[0][1]) + EPS) * QSCALE;
        const float ki = rsqrtf(wave_sum(val[1][0] * val[1][0] + val[1][1] * val[1][1]) + EPS);
        const size_t o = ((size_t)(b * NH + h) * T + t) * HD + lane;
        QN[o] = val[0][0] * qi; QN[o + 64] = val[0][1] * qi; KN[o] = val[1][0] * ki; KN[o + 64] = val[1][1] * ki; VV[o] = val[2][0]; VV[o + 64] = val[2][1];
        if (lane == 0) { const float a = small[(size_t)row * 256 + h]; GG[(b * NH + h) * T + t] = -__expf(a_log[h]) * softplus(a + dt_bias[h]); BB[(b * NH + h) * T + t] = sigm(small[(size_t)row * 256 + 16 + h]); }
    }
}
__device__ __forceinline__ void gdn_scan_naive(const float* QN, const float* KN, const float* VV, const float* GG, const float* BB, float* ORAW, int item, int lane) {
    const int bh = item >> 2, e = (item & 3) * 32 + (lane & 31), dh = (lane >> 5) * 64, b = bh >> 4, h = bh & 15;
    float S[64];
#pragma unroll
    for (int d = 0; d < 64; ++d) S[d] = 0.f;
    const float* qp = QN + (size_t)bh * T * HD + dh; const float* kp = KN + (size_t)bh * T * HD + dh; const float* vp = VV + (size_t)bh * T * HD;
    for (int t = 0; t < T; ++t) {
        const float eg = __expf(GG[bh * T + t]), beta = BB[bh * T + t], ve = vp[(size_t)t * HD + e];
        float k[64]; float dot = 0.f;
#pragma unroll
        for (int d4 = 0; d4 < 16; ++d4) { const f32x4 k4 = *(const f32x4*)(kp + (size_t)t * HD + 4 * d4);
#pragma unroll
            for (int i = 0; i < 4; ++i) { k[4 * d4 + i] = k4[i]; S[4 * d4 + i] *= eg; dot += S[4 * d4 + i] * k4[i]; } }
        dot += __shfl_xor(dot, 32);
        const float u = beta * (ve - dot); float o = 0.f;
#pragma unroll
        for (int d4 = 0; d4 < 16; ++d4) { const f32x4 q4 = *(const f32x4*)(qp + (size_t)t * HD + 4 * d4);
#pragma unroll
            for (int i = 0; i < 4; ++i) { S[4 * d4 + i] += k[4 * d4 + i] * u; o += S[4 * d4 + i] * q4[i]; } }
        o += __shfl_xor(o, 32);
        if (lane < 32) ORAW[(size_t)(b * T + t) * 2048 + h * HD + e] = o;
    }
}
__device__ __forceinline__ void headnorm_gate(const float* ORAW, const float* nw, const bf16* gate, int ldg, bf16* OBUF, int gw, int ngw, int lane) {
    for (int item = gw; item < M * NH; item += ngw) {
        const int row = item >> 4, h = item & 15;
        const float o0 = ORAW[(size_t)row * 2048 + h * HD + 2 * lane], o1 = ORAW[(size_t)row * 2048 + h * HD + 2 * lane + 1];
        const float rstd = rsqrtf(wave_sum(o0 * o0 + o1 * o1) * (1.f / HD) + EPS);
        const unsigned gwd = *(const unsigned*)(gate + (size_t)row * ldg + h * HD + 2 * lane);
        *(unsigned*)(OBUF + (size_t)row * DM + h * HD + 2 * lane) = pk2(o0 * rstd * nw[2 * lane] * silu(bflo(gwd)), o1 * rstd * nw[2 * lane + 1] * silu(bfhi(gwd)));
    }
}
__device__ __forceinline__ void hgrn_prep_naive(const bf16* proj, const float* lbl, float* FB, float* QB, int gw, int ngw, int lane) {
    for (int item = gw; item < M * NH; item += ngw) {
        const int row = item >> 4, h = item & 15, t = row & (T - 1), b = row >> 11;
#pragma unroll
        for (int dd = 0; dd < 2; ++dd) { const int c = h * HD + lane + 64 * dd; const float lb = sigm(lbl[2048 + c] - lbl[c]);
            const float fx = bf2f(proj[(size_t)row * CD_LDP + C_HF + c]), qx = bf2f(proj[(size_t)row * CD_LDP + C_HQ + c]);
            const size_t o = ((size_t)(b * NH + h) * T + t) * HD + lane + 64 * dd; FB[o] = lb + (1.f - lb) * sigm(fx); QB[o] = silu(qx); }
    }
}
__device__ __forceinline__ void hgrn_scan_naive(const float* FB, const float* QB, const bf16* proj, float* ORAW, int item, int lane) {
    const int bh = item >> 1, e = (item & 1) * 64 + lane, b = bh >> 4, h = bh & 15;
    float S[HD];
#pragma unroll
    for (int d = 0; d < HD; ++d) S[d] = 0.f;
    const float* fp = FB + (size_t)bh * T * HD; const float* qp = QB + (size_t)bh * T * HD;
    for (int t = 0; t < T; ++t) {
        const float ve = bf2f(proj[(size_t)(b * T + t) * CD_LDP + C_HI + h * HD + e]); float o = 0.f;
#pragma unroll
        for (int d4 = 0; d4 < HD / 4; ++d4) { const f32x4 f4 = *(const f32x4*)(fp + (size_t)t * HD + 4 * d4), q4 = *(const f32x4*)(qp + (size_t)t * HD + 4 * d4);
#pragma unroll
            for (int i = 0; i < 4; ++i) { S[4 * d4 + i] = f4[i] * S[4 * d4 + i] + (1.f - f4[i]) * ve; o += S[4 * d4 + i] * q4[i]; } }
        ORAW[(size_t)(b * T + t) * 2048 + h * HD + e] = o;
    }
}
__device__ __forceinline__ void fox_cum(const float* small, const float* fbias, float* CUM, int item, int lane) {
    const int b = item >> 4, h = item & 15; float loc[32]; float run = 0.f;
#pragma unroll
    for (int i = 0; i < 32; ++i) { run += logsigm(small[(size_t)(b * T + 32 * lane + i) * 256 + h] + fbias[h]); loc[i] = run; }
    float incl = run;
#pragma unroll
    for (int o = 1; o < 64; o <<= 1) { const float v = __shfl_up(incl, o); if (lane >= o) incl += v; }
    const float excl = incl - run;
#pragma unroll
    for (int i = 0; i < 32; ++i) CUM[(size_t)item * T + 32 * lane + i] = excl + loc[i];
}
struct RowAcc { float m, l, a0, a1; };
__device__ __forceinline__ float dot128(const LAS float* qs, const bf16* krow) {
    const v4u* kr = (const v4u*)krow; float dot = 0.f;
#pragma unroll
    for (int c = 0; c < 16; ++c) { const v4u w = kr[c]; const f32x4 qa = *(const LAS f32x4*)(qs + 8 * c), qb = *(const LAS f32x4*)(qs + 8 * c + 4);
        dot += bflo(w.x) * qa[0] + bfhi(w.x) * qa[1] + bflo(w.y) * qa[2] + bfhi(w.y) * qa[3] + bflo(w.z) * qb[0] + bfhi(w.z) * qb[1] + bflo(w.w) * qb[2] + bfhi(w.w) * qb[3]; }
    return dot;
}
__device__ __forceinline__ void attend_chunk(RowAcc& st, const LAS float* qs, const bf16* Kb, const bf16* Vb, size_t ld, int kb, int kmax, bool valid, float bias, LAS float* pbuf, int lane) {
    int key = kb + lane; key = key < 0 ? 0 : (key > kmax ? kmax : key);
    const float dot = dot128(qs, Kb + (size_t)key * ld);
    const float s = valid ? dot + bias : -INFINITY;
    const float cm = wave_max(s);
    if (cm == -INFINITY) return;
    const float mn = fmaxf(st.m, cm), corr = __expf(st.m - mn), p = valid ? __expf(s - mn) : 0.f;
    st.l = st.l * corr + wave_sum(p); st.m = mn; st.a0 *= corr; st.a1 *= corr;
    asm volatile("s_waitcnt lgkmcnt(0)" ::: "memory"); pbuf[lane] = p; asm volatile("s_waitcnt lgkmcnt(0)" ::: "memory");
    for (int j = 0; j < 64; ++j) { const float pj = pbuf[j]; int kj = kb + j; kj = kj < 0 ? 0 : (kj > kmax ? kmax : kj);
        const unsigned w = *(const unsigned*)(Vb + (size_t)kj * ld + 2 * lane); st.a0 += pj * bflo(w); st.a1 += pj * bfhi(w); }
    asm volatile("s_waitcnt lgkmcnt(0)" ::: "memory");
}
__device__ __forceinline__ void fox_attn_naive(const bf16* proj, const float* CUM, bf16* OBUF, LAS float* wl, int gw, int ngw, int lane) {
    LAS float* qs = wl; LAS float* pbuf = wl + 128;
    for (int item = gw; item < M * NH; item += ngw) {
        const int row = item >> 4, h = item & 15, t = row & (T - 1), b = row >> 11;
        const unsigned qw = *(const unsigned*)(proj + (size_t)row * CD_LDP + C_FQ + h * HD + 2 * lane);
        asm volatile("s_waitcnt lgkmcnt(0)" ::: "memory"); qs[2 * lane] = bflo(qw) * QSCALE; qs[2 * lane + 1] = bfhi(qw) * QSCALE; asm volatile("s_waitcnt lgkmcnt(0)" ::: "memory");
        const bf16* Kb = proj + (size_t)b * T * CD_LDP + C_FK + h * HD; const bf16* Vb = proj + (size_t)b * T * CD_LDP + C_FV + h * HD;
        const float* cum = CUM + (size_t)(b * NH + h) * T; const float cq = cum[t];
        RowAcc st{-INFINITY, 0.f, 0.f, 0.f};
        for (int kb = 0; kb <= t; kb += 64) { const int key = kb + lane; const bool valid = key <= t; attend_chunk(st, qs, Kb, Vb, CD_LDP, kb, T - 1, valid, cq - cum[key > T - 1 ? T - 1 : key], pbuf, lane); }
        const float il = 1.f / st.l;
        *(unsigned*)(OBUF + (size_t)row * DM + 2048 + h * HD + 2 * lane) = pk2(st.a0 * il, st.a1 * il);
    }
}
__device__ __forceinline__ void nsa_compress_naive(const bf16* proj, const float* pe_k, const float* pe_v, const float* wk1, const float* wk2, const float* wv1, const float* wv2,
                                                   bf16* KC, bf16* VC, LAS float* lf, int tid) {
    for (int item = blockIdx.x; item < 16 * NCMP * 2; item += gridDim.x) {
        const int kv = item & 1, r = item >> 1, n = r % NCMP, bg = r / NCMP, b = bg >> 2, g = bg & 3;
        const float* pe = kv ? pe_v : pe_k; const float* w1 = kv ? wv1 : wk1; const float* w2 = kv ? wv2 : wk2;
        const int j = tid & 127, part = tid >> 7; float acc = 0.f;
        for (int i = part * 1024; i < part * 1024 + 1024; ++i) { const int l = i >> 7, d = i & 127;
            const float z = bf2f(proj[(size_t)(b * T + 16 * n + l) * AB_LDP + A_NKV + kv * 512 + g * HD + d]) + pe[i];
            acc += z * w1[(size_t)i * HD + j]; }
        lf[part * 128 + j] = acc;
        __syncthreads();
        if (tid < 128) { const float hsum = lf[j] + lf[128 + j] + lf[256 + j] + lf[384 + j]; lf[512 + j] = silu(hsum); }
        __syncthreads();
        if (tid < 128) { float o = 0.f; for (int i = 0; i < 128; ++i) o += lf[512 + i] * w2[i * HD + j]; if (kv) VC[((size_t)bg * 128 + j) * 128 + (n & ~15) + ((n >> 2) & 1) * 8 + ((n & 15) >> 3) * 4 + (n & 3)] = (bf16)f2bf(o); else KC[((size_t)bg * 128 + n) * HD + j] = (bf16)f2bf(o); }
        __syncthreads();
    }
}
__device__ __forceinline__ void nsa_cmp_naive(const bf16* proj, const bf16* KC, const bf16* VC, float* OCMP, unsigned* SEL, LAS float* wl, int gw, int ngw, int lane) {
    LAS float* qs = wl; LAS float* pbuf = wl + 128;
    for (int item = gw; item < M * 4; item += ngw) {
        const int row = item >> 2, g = item & 3, t = row & (T - 1), b = row >> 11, bg = b * 4 + g;
        const bf16* Kb = KC + (size_t)bg * 128 * HD; const bf16* Vb = VC + (size_t)bg * 128 * HD;
        const int n0 = lane, n1 = lane + 64; const bool v0 = 16 * n0 + 31 <= t, v1 = (n1 < NCMP) && (16 * n1 + 31 <= t);
        float ps0 = 0.f, ps1 = 0.f;
        for (int p = 0; p < 4; ++p) {
            const int head = g * 4 + p;
            const unsigned qw = *(const unsigned*)(proj + (size_t)row * AB_LDP + A_NQ + head * HD + 2 * lane);
            asm volatile("s_waitcnt lgkmcnt(0)" ::: "memory"); qs[2 * lane] = bflo(qw) * QSCALE; qs[2 * lane + 1] = bfhi(qw) * QSCALE; asm volatile("s_waitcnt lgkmcnt(0)" ::: "memory");
            const float s0 = v0 ? dot128(qs, Kb + (size_t)n0 * HD) : -INFINITY, s1 = v1 ? dot128(qs, Kb + (size_t)(n1 < 128 ? n1 : 127) * HD) : -INFINITY;
            const float mx = wave_max(fmaxf(s0, s1)); float p0 = 0.f, p1 = 0.f;
            if (mx != -INFINITY) { const float e0 = v0 ? __expf(s0 - mx) : 0.f, e1 = v1 ? __expf(s1 - mx) : 0.f; const float il = 1.f / wave_sum(e0 + e1); p0 = e0 * il; p1 = e1 * il; }
            ps0 += p0; ps1 += p1;
            pbuf[lane] = p0; pbuf[64 + lane] = p1; asm volatile("s_waitcnt lgkmcnt(0)" ::: "memory");
            float a0 = 0.f, a1 = 0.f;
            for (int n = 0; n < NCMP; ++n) { const float pj = pbuf[n]; const unsigned w = *(const unsigned*)(Vb + (size_t)n * HD + 2 * lane); a0 += pj * bflo(w); a1 += pj * bfhi(w); }
            *(float2*)(OCMP + (size_t)row * 2048 + head * HD + 2 * lane) = make_float2(a0, a1);
            asm volatile("s_waitcnt lgkmcnt(0)" ::: "memory");
        }
        pbuf[lane] = ps0; pbuf[64 + lane] = ps1; asm volatile("s_waitcnt lgkmcnt(0)" ::: "memory");
        const int cur = t >> 6, m = lane; float sc = -INFINITY;
        if (m < 32 && m <= cur) {
            if (m == 0 || m == cur || m == cur - 1) sc = 1e4f;
            else { float im = 0.f; for (int n = 4 * m - 1; n <= 4 * m + 3; ++n) if (n >= 0 && n < NCMP) im += pbuf[n]; sc = im; }
        }
        unsigned mask = 0u;
        for (int r = 0; r < 8; ++r) { const float mx = wave_max(sc); if (mx == -INFINITY) break;
            const unsigned long long ball = __ballot(sc == mx); const int idx = __ffsll((long long)ball) - 1; mask |= 1u << idx; if (lane == idx) sc = -INFINITY; }
        if (lane == 0) SEL[(size_t)bg * T + t] = mask;
        asm volatile("s_waitcnt lgkmcnt(0)" ::: "memory");
    }
}
__device__ __forceinline__ void nsa_slcwin_naive(const bf16* proj, const float* small, const float* OCMP, const unsigned* SEL, bf16* OBUF, LAS float* wl, int gw, int ngw, int lane) {
    LAS float* qs = wl; LAS float* pbuf = wl + 128;
    for (int item = gw; item < M * NH; item += ngw) {
        const int row = item >> 4, head = item & 15, g = head >> 2, t = row & (T - 1), b = row >> 11;
        const unsigned qw = *(const unsigned*)(proj + (size_t)row * AB_LDP + A_NQ + head * HD + 2 * lane);
        asm volatile("s_waitcnt lgkmcnt(0)" ::: "memory"); qs[2 * lane] = bflo(qw) * QSCALE; qs[2 * lane + 1] = bfhi(qw) * QSCALE; asm volatile("s_waitcnt lgkmcnt(0)" ::: "memory");
        const bf16* base = proj + (size_t)b * T * AB_LDP + A_NKV + g * HD;
        const unsigned sel = SEL[(size_t)(b * 4 + g) * T + t]; const int cur = t >> 6;
        RowAcc ss{-INFINITY, 0.f, 0.f, 0.f};
        for (int m = 0; m <= cur; ++m) if ((sel >> m) & 1u) { const int key = 64 * m + lane; attend_chunk(ss, qs, base + 2 * 512, base + 3 * 512, AB_LDP, 64 * m, T - 1, key <= t, 0.f, pbuf, lane); }
        RowAcc sw{-INFINITY, 0.f, 0.f, 0.f};
        const int first = t - 511 > 0 ? t - 511 : 0;
        for (int kb = first & ~63; kb <= t; kb += 64) { const int key = kb + lane; attend_chunk(sw, qs, base + 4 * 512, base + 5 * 512, AB_LDP, kb, T - 1, key >= first && key <= t, 0.f, pbuf, lane); }
        const float gc = sigm(small[(size_t)row * 256 + 32 + head]), gs = sigm(small[(size_t)row * 256 + 48 + head]), gwn = sigm(small[(size_t)row * 256 + 64 + head]);
        const float2 oc = *(const float2*)(OCMP + (size_t)row * 2048 + head * HD + 2 * lane);
        const float is = gs / ss.l, iw = gwn / sw.l;
        *(unsigned*)(OBUF + (size_t)row * DM + 2048 + head * HD + 2 * lane) = pk2(gc * oc.x + is * ss.a0 + iw * sw.a0, gc * oc.y + is * ss.a1 + iw * sw.a1);
    }
}
typedef short bf16x8 __attribute__((ext_vector_type(8)));
typedef float f32x16 __attribute__((ext_vector_type(16)));
typedef __bf16 bf16x2_t __attribute__((ext_vector_type(2)));
typedef float f32x2_t __attribute__((ext_vector_type(2)));
__device__ __forceinline__ unsigned cvtpk(float lo, float hi) { f32x2_t v = {lo, hi}; return __builtin_bit_cast(unsigned, __builtin_convertvector(v, bf16x2_t)); }
#define MFMA32(a, b, c) __builtin_amdgcn_mfma_f32_32x32x16_bf16((a), (b), (c), 0, 0, 0)
constexpr float LOG2E = 1.4426950408889634f, C1 = QSCALE * LOG2E;
constexpr int AT_K = 0, AT_V = 16384, AT_CK = 32768;
__device__ __forceinline__ void vt_transpose(const bf16* src, int ld, int col0, int nh, bf16* VT, int gtid, int ngt) {
    const int total = NB * nh * 128 * (T / 8);
    for (int idx = gtid; idx < total; idx += ngt) {
        const int d = idx & 127, tc = (idx >> 7) & 255, bh = idx >> 15, b = bh / nh, hh = bh % nh;
        unsigned short e[8];
#pragma unroll
        for (int j = 0; j < 8; ++j) { const int p = 8 * tc + j, pp = p & 15, h2 = pp >> 3, jj = pp & 7, t = (p & ~15) + 8 * (jj >> 2) + 4 * h2 + (jj & 3);
            e[j] = src[(size_t)(b * T + t) * ld + col0 + hh * 128 + d]; }
        v4u o; o.x = e[0] | ((unsigned)e[1] << 16); o.y = e[2] | ((unsigned)e[3] << 16); o.z = e[4] | ((unsigned)e[5] << 16); o.w = e[6] | ((unsigned)e[7] << 16);
        *(v4u*)(VT + ((size_t)bh * 128 + d) * T + 8 * tc) = o;
    }
}
__device__ __forceinline__ void qk_tile(const LAS unsigned char* ldk, const bf16x8 (&qf)[8], f32x16 (&s)[2], int lane) {
    const int r = lane & 31; int y = (lane >> 5) ^ (r & 15); asm volatile("" : "+v"(y));
    const LAS unsigned char* base = ldk + r * 256;
#pragma unroll
    for (int i = 0; i < 16; ++i) { s[0][i] = 0.f; s[1][i] = 0.f; }
#pragma unroll
    for (int ks = 0; ks < 8; ++ks)
#pragma unroll
        for (int rb = 0; rb < 2; ++rb) {
            const bf16x8 a = *(const LAS bf16x8*)(base + rb * 8192 + (((2 * ks) ^ y) << 4));
            s[rb] = MFMA32(a, qf[ks], s[rb]); }
}
__device__ __forceinline__ void qk_tile_lq(const LAS unsigned char* ldk, const LAS unsigned char* ldq, f32x16 (&s)[2], int lane) {
    const int r = lane & 31; int y = (lane >> 5) ^ (r & 15); asm volatile("" : "+v"(y));
    const LAS unsigned char* base = ldk + r * 256; const LAS unsigned char* qb = ldq + r * 256;
#pragma unroll
    for (int i = 0; i < 16; ++i) { s[0][i] = 0.f; s[1][i] = 0.f; }
#pragma unroll
    for (int ks = 0; ks < 8; ++ks) { const bf16x8 q = *(const LAS bf16x8*)(qb + (((2 * ks) ^ y) << 4));
#pragma unroll
        for (int rb = 0; rb < 2; ++rb) {
            const bf16x8 a = *(const LAS bf16x8*)(base + rb * 8192 + (((2 * ks) ^ y) << 4));
            s[rb] = MFMA32(a, q, s[rb]); }
        if ((ks & 3) == 3) __builtin_amdgcn_sched_barrier(0); }
}
__device__ __forceinline__ void pv_tile(const LAS unsigned char* ldv, const f32x16 (&p)[2], f32x16 (&O)[4], int lane) {
    const int r = lane & 31; int y = (lane >> 5) ^ ((r >> 1) & 7); asm volatile("" : "+v"(y));
    const LAS unsigned char* base = ldv + r * 128;
    bf16x8 pf[2][2];
#pragma unroll
    for (int rb = 0; rb < 2; ++rb)
#pragma unroll
        for (int st = 0; st < 2; ++st) { v4u w; w.x = cvtpk(p[rb][8 * st + 0], p[rb][8 * st + 1]); w.y = cvtpk(p[rb][8 * st + 2], p[rb][8 * st + 3]); w.z = cvtpk(p[rb][8 * st + 4], p[rb][8 * st + 5]); w.w = cvtpk(p[rb][8 * st + 6], p[rb][8 * st + 7]);
            pf[rb][st] = __builtin_bit_cast(bf16x8, w); }
#pragma unroll
    for (int db = 0; db < 4; ++db) {
#pragma unroll
        for (int kk = 0; kk < 4; ++kk) { const bf16x8 a = *(const LAS bf16x8*)(base + db * 4096 + (((2 * kk) ^ y) << 4));
            O[db] = MFMA32(a, pf[kk >> 1][kk & 1], O[db]); } }
}
struct TileRegs { v4u k[2], v[2]; float ck; };
__device__ __forceinline__ void tile_fetch(TileRegs& R, const bf16* Kg  , size_t ldk, const bf16* Vg  , size_t ldv, const float* ckg, int tid) {
#pragma unroll
    for (int i = 0; i < 2; ++i) { const int id = tid + 512 * i; R.k[i] = *(const v4u*)(Kg + (size_t)(id >> 4) * ldk + (id & 15) * 8); R.v[i] = *(const v4u*)(Vg + (size_t)(id >> 3) * ldv + (id & 7) * 8); }
    R.ck = (ckg && tid < 64) ? ckg[tid] * LOG2E : 0.f;
}
__device__ __forceinline__ void tile_commit(const TileRegs& R, LAS unsigned char* ldk, LAS unsigned char* ldv, LAS unsigned char* ldc, int tid) {
#pragma unroll
    for (int i = 0; i < 2; ++i) { const int id = tid + 512 * i; const int key = id >> 4, c = id & 15, d = id >> 3, c2 = id & 7;
        *(LAS v4u*)(ldk + key * 256 + ((c ^ (key & 15)) * 16)) = R.k[i];
        *(LAS v4u*)(ldv + d * 128 + ((c2 ^ ((d >> 1) & 7)) * 16)) = R.v[i]; }
    if (ldc && tid < 64) *(LAS float*)(ldc + tid * 4) = R.ck;
}
__device__ __forceinline__ void tile_dma(const bf16* Kg, size_t ldk, const bf16* Vg, size_t ldv, LAS unsigned char* dk, LAS unsigned char* dv, int wave, int lane) {
#pragma unroll
    for (int i = 0; i < 2; ++i) { const int piece = wave * 2 + i;
        const int krow = 4 * piece + (lane >> 4), kc = (lane & 15) ^ (krow & 15);
        __builtin_amdgcn_global_load_lds((const unsigned*)(Kg + (size_t)krow * ldk + kc * 8), (LAS unsigned*)(dk + piece * 1024), 16, 0, 0);
        const int d = 8 * piece + (lane >> 3), vc = (lane & 7) ^ ((d >> 1) & 7);
        __builtin_amdgcn_global_load_lds((const unsigned*)(Vg + (size_t)d * ldv + vc * 8), (LAS unsigned*)(dv + piece * 1024), 16, 0, 0); }
}
constexpr int AT3_CK = 3 * 32768;
constexpr int AT_B1 = 32768, AT_CK0 = 65536, AT_CK1 = 65536 + 256;
__device__ __forceinline__ void fox_attn_mfma(const bf16* proj, const bf16* VTG, const float* CUM, bf16* OBUF, LAS unsigned char* lds, int tid, int lane, int wave) {
    const int r = lane & 31, hh = lane >> 5;
    for (int idx = blockIdx.x; idx < 512; idx += gridDim.x) {
        const int bh = idx & 63, qq = idx >> 6, qt = qq < 4 ? qq : 11 - qq, b = bh >> 4, h = bh & 15, q0 = qt * 256, wq0 = q0 + 32 * wave, qi = wq0 + r;
        bf16x8 qf[8];
#pragma unroll
        for (int ks = 0; ks < 8; ++ks) qf[ks] = *(const bf16x8*)(proj + (size_t)(b * T + qi) * CD_LDP + C_FQ + h * HD + 16 * ks + 8 * hh);
        const float cq2 = CUM[(size_t)bh * T + qi] * LOG2E;
        float m = -INFINITY, l = 0.f; f32x16 O[4];
#pragma unroll
        for (int db = 0; db < 4; ++db)
#pragma unroll
            for (int i = 0; i < 16; ++i) O[db][i] = 0.f;
        const bf16* Kg = proj + (size_t)b * T * CD_LDP + C_FK + h * HD; const bf16* Vg = VTG + (size_t)bh * 128 * T; const float* ckg = CUM + (size_t)bh * T;
        const int ntiles = 4 * qt + 4;
        __syncthreads();
        tile_dma(Kg, CD_LDP, Vg, T, lds + AT_K, lds + AT_V, wave, lane);
        if (wave == 0) __builtin_amdgcn_global_load_lds((const unsigned*)(ckg + lane), (LAS unsigned*)(lds + AT3_CK), 4, 0, 0);
        tile_dma(Kg + (size_t)64 * CD_LDP, CD_LDP, Vg + 64, T, lds + AT_K + AT_B1, lds + AT_V + AT_B1, wave, lane);
        if (wave == 0) __builtin_amdgcn_global_load_lds((const unsigned*)(ckg + 64 + lane), (LAS unsigned*)(lds + AT3_CK + 256), 4, 0, 0);
        for (int kt = 0, buf = 0; kt < ntiles; ++kt, buf = buf == 2 ? 0 : buf + 1) {
            const int bo = buf * AT_B1, cko = AT3_CK + buf * 256;
            if (kt + 1 < ntiles) { if (wave == 0) asm volatile("s_waitcnt vmcnt(5)" ::: "memory"); else asm volatile("s_waitcnt vmcnt(4)" ::: "memory"); }
            else asm volatile("s_waitcnt vmcnt(0)" ::: "memory");
            __syncthreads();
            if (kt + 2 < ntiles) { const int b2 = buf == 0 ? 2 : buf - 1;
                tile_dma(Kg + (size_t)(kt + 2) * 64 * CD_LDP, CD_LDP, Vg + (kt + 2) * 64, T, lds + AT_K + b2 * AT_B1, lds + AT_V + b2 * AT_B1, wave, lane);
                if (wave == 0) __builtin_amdgcn_global_load_lds((const unsigned*)(ckg + (kt + 2) * 64 + lane), (LAS unsigned*)(lds + AT3_CK + b2 * 256), 4, 0, 0); }
            if (kt * 64 <= wq0 + 31) {
                f32x16 s[2]; qk_tile(lds + AT_K + bo, qf, s, lane);
                const bool full = kt * 64 + 63 <= wq0; float mx = -INFINITY;
#pragma unroll
                for (int rb = 0; rb < 2; ++rb)
#pragma unroll
                    for (int g4 = 0; g4 < 4; ++g4) { const f32x4 ck4 = *(const LAS f32x4*)(lds + cko + (32 * rb + 8 * g4 + 4 * hh) * 4);
#pragma unroll
                        for (int e = 0; e < 4; ++e) { const int i = 4 * g4 + e, key = kt * 64 + 32 * rb + 8 * g4 + 4 * hh + e;
                            float v = s[rb][i] * C1 + (cq2 - ck4[e] * LOG2E); if (!full && key > qi) v = -INFINITY; s[rb][i] = v; mx = fmaxf(mx, v); } }
                mx = fmaxf(mx, __shfl_xor(mx, 32));
                if (!__all(mx - m <= 8.f)) {
                    const float mn = fmaxf(m, mx), corr = __builtin_amdgcn_exp2f(m - mn); m = mn; l *= corr;
#pragma unroll
                    for (int db = 0; db < 4; ++db)
#pragma unroll
                        for (int i = 0; i < 16; ++i) O[db][i] *= corr;
                }
                float ls = 0.f;
#pragma unroll
                for (int rb = 0; rb < 2; ++rb)
#pragma unroll
                    for (int i = 0; i < 16; ++i) { const float p = __builtin_amdgcn_exp2f(s[rb][i] - m); s[rb][i] = p; ls += p; }
                l += ls;
                pv_tile(lds + AT_V + bo, s, O, lane);
            }
        }
        l += __shfl_xor(l, 32); const float il = 1.f / l;
        bf16* orow = OBUF + (size_t)(b * T + qi) * DM + 2048 + h * HD;
#pragma unroll
        for (int db = 0; db < 4; ++db)
#pragma unroll
            for (int g4 = 0; g4 < 4; ++g4) { v2u w; w.x = cvtpk(O[db][4 * g4] * il, O[db][4 * g4 + 1] * il); w.y = cvtpk(O[db][4 * g4 + 2] * il, O[db][4 * g4 + 3] * il);
                *(v2u*)(orow + 32 * db + 8 * g4 + 4 * hh) = w; }
    }
}

__device__ __forceinline__ void softmax_update(f32x16 (&s)[2], float& m, float& l, f32x16 (&O)[4]) {
    float mx = -INFINITY;
#pragma unroll
    for (int rb = 0; rb < 2; ++rb)
#pragma unroll
        for (int i = 0; i < 16; ++i) mx = fmaxf(mx, s[rb][i]);
    mx = fmaxf(mx, __shfl_xor(mx, 32));
    if (!__all(mx - m <= 8.f)) {
        const float mn = fmaxf(m, mx), ms = (mn == -INFINITY) ? 0.f : mn, corr = __builtin_amdgcn_exp2f(m - ms); m = mn; l *= corr;
#pragma unroll
        for (int db = 0; db < 4; ++db)
#pragma unroll
            for (int i = 0; i < 16; ++i) O[db][i] *= corr;
    }
    const float ms = (m == -INFINITY) ? 0.f : m; float ls = 0.f;
#pragma unroll
    for (int rb = 0; rb < 2; ++rb)
#pragma unroll
        for (int i = 0; i < 16; ++i) { const float p = __builtin_amdgcn_exp2f(s[rb][i] - ms); s[rb][i] = p; ls += p; }
    l += ls;
}
#define NS_ROWPTRS() int rr_ = lane & 31; asm volatile("" : "+v"(rr_)); const size_t row_ = (size_t)(b * T + 64 * c + 32 * th + rr_); bf16* oacc = OACC + row_ * 2048 + head * HD; const float* smr = small + row_ * 256 + head
constexpr int NS_K0 = 0, NS_V0 = 16384, NS_K1 = 32768, NS_V1 = 49152, NS_Q = 65536, NS_IMP = 131072 + 512, NS_SEL = NS_IMP + 64 * 33 * 4, NS_UNI = NS_SEL + 256;
static_assert(NS_UNI + 4 <= LDS_BYTES, "NSA LDS map");
__device__ __forceinline__ void nsa_attn_mfma(const bf16* proj, const float* small, const bf16* KC, const bf16* VCT, const bf16* VTS, const bf16* VTW, bf16* OACC, bf16* OBUF, LAS unsigned char* lds, int tid, int lane, int wave) {
    const int p = wave >> 1, th = wave & 1;
    LAS float* IMP = (LAS float*)(lds + NS_IMP); LAS unsigned* SELM = (LAS unsigned*)(lds + NS_SEL); LAS unsigned* UNI = (LAS unsigned*)(lds + NS_UNI);
    for (int idx = blockIdx.x; idx < 512; idx += gridDim.x) {
        asm volatile("" : "+v"(lane), "+v"(tid));
        const int r = lane & 31, hh = lane >> 5;
        const int bg = idx & 15, cc = idx >> 4, c = cc < 16 ? cc : 47 - cc, b = bg >> 2, g = bg & 3, head = 4 * g + p, tok = 32 * th + r, t = 64 * c + tok;
        __syncthreads();
        bf16x8 qf[8];
#pragma unroll
        for (int ks = 0; ks < 8; ++ks) qf[ks] = *(const bf16x8*)(proj + (size_t)(b * T + t) * AB_LDP + A_NQ + head * HD + 16 * ks + 8 * hh);
        for (int i = tid; i < 64 * 33; i += NTHR) IMP[i] = 0.f;
        if (tid == 0) UNI[0] = 0u;
        const int ncmp_t = c >= 16 ? 2 : 1;
        { TileRegs R;
          tile_fetch(R, KC + (size_t)bg * 128 * HD, HD, VCT + (size_t)bg * 128 * 128, 128, nullptr, tid); tile_commit(R, lds + NS_K0, lds + NS_V0, nullptr, tid);
          if (ncmp_t == 2) { tile_fetch(R, KC + (size_t)bg * 128 * HD + 64 * HD, HD, VCT + (size_t)bg * 128 * 128 + 64, 128, nullptr, tid); tile_commit(R, lds + NS_K1, lds + NS_V1, nullptr, tid); } }
        __syncthreads();
        float mC = -INFINITY, lC = 0.f;
        for (int tl = 0; tl < ncmp_t; ++tl) {
            f32x16 s[2]; qk_tile(lds + (tl ? NS_K1 : NS_K0), qf, s, lane); float mx = -INFINITY;
#pragma unroll
            for (int rb = 0; rb < 2; ++rb)
#pragma unroll
                for (int i = 0; i < 16; ++i) { const int n = 64 * tl + 32 * rb + (i & 3) + 8 * (i >> 2) + 4 * hh; float v = s[rb][i] * C1; if (16 * n + 31 > t) v = -INFINITY; s[rb][i] = v; mx = fmaxf(mx, v); }
            mx = fmaxf(mx, __shfl_xor(mx, 32));
            const float mn = fmaxf(mC, mx), ms = (mn == -INFINITY) ? 0.f : mn; float ls = 0.f;
#pragma unroll
            for (int rb = 0; rb < 2; ++rb)
#pragma unroll
                for (int i = 0; i < 16; ++i) ls += __builtin_amdgcn_exp2f(s[rb][i] - ms);
            ls += __shfl_xor(ls, 32);
            lC = lC * __builtin_amdgcn_exp2f(mC - ms) + ls; mC = mn;
        }
        { const float ms = (mC == -INFINITY) ? 0.f : mC, il = lC > 0.f ? 1.f / lC : 0.f; float gc; { NS_ROWPTRS(); gc = sigm(smr[32]); }
          f32x16 OC[4];
#pragma unroll
          for (int db = 0; db < 4; ++db)
#pragma unroll
              for (int i = 0; i < 16; ++i) OC[db][i] = 0.f;
          for (int tl = 0; tl < ncmp_t; ++tl) {
            f32x16 s[2]; qk_tile(lds + (tl ? NS_K1 : NS_K0), qf, s, lane);
#pragma unroll
            for (int rb = 0; rb < 2; ++rb)
#pragma unroll
                for (int g4 = 0; g4 < 4; ++g4) { float grp = 0.f, last = 0.f;
#pragma unroll
                    for (int e = 0; e < 4; ++e) { const int i = 4 * g4 + e, n = 64 * tl + 32 * rb + 8 * g4 + 4 * hh + e; float v = s[rb][i] * C1; if (16 * n + 31 > t) v = -INFINITY;
                        const float pr = __builtin_amdgcn_exp2f(v - ms) * il; s[rb][i] = pr * gc; grp += pr; last = pr; }
                    const int mb = 16 * tl + 8 * rb + 2 * g4 + hh;
                    __hip_atomic_fetch_add(&IMP[tok * 33 + mb], grp, __ATOMIC_RELAXED, __HIP_MEMORY_SCOPE_WORKGROUP); if (mb + 1 < 32) __hip_atomic_fetch_add(&IMP[tok * 33 + mb + 1], last, __ATOMIC_RELAXED, __HIP_MEMORY_SCOPE_WORKGROUP); }
            pv_tile(lds + (tl ? NS_V1 : NS_V0), s, OC, lane);
          }
          NS_ROWPTRS();
#pragma unroll
          for (int db = 0; db < 4; ++db)
#pragma unroll
              for (int g4 = 0; g4 < 4; ++g4) { v2u w; w.x = cvtpk(OC[db][4 * g4], OC[db][4 * g4 + 1]); w.y = cvtpk(OC[db][4 * g4 + 2], OC[db][4 * g4 + 3]); *(v2u*)(oacc + 32 * db + 8 * g4 + 4 * hh) = w; }
        }
        __syncthreads();
        if (tid < 64) {
            unsigned sel = 1u | (1u << c) | (c >= 1 ? (1u << (c - 1)) : 0u); const int need = 8 - __popc(sel);
            for (int rr = 0; rr < need; ++rr) { int best = -1; float bv = -1.f;
                for (int mm = 1; mm <= c - 2; ++mm) if (!((sel >> mm) & 1u)) { const float v = IMP[tid * 33 + mm]; if (v > bv) { bv = v; best = mm; } }
                if (best < 0) break; sel |= 1u << best; }
            SELM[tid] = sel; __hip_atomic_fetch_or(UNI, sel, __ATOMIC_RELAXED, __HIP_MEMORY_SCOPE_WORKGROUP);
        }
        __syncthreads();
        const unsigned uni = UNI[0], mysel = SELM[tok];
        const bf16* kvb = proj + (size_t)b * T * AB_LDP + A_NKV + g * HD;
        {
            float m = -INFINITY, l = 0.f; f32x16 O[4];
#pragma unroll
            for (int db = 0; db < 4; ++db)
#pragma unroll
                for (int i = 0; i < 16; ++i) O[db][i] = 0.f;
            const bf16* Vg = VTS + (size_t)bg * 128 * T;
            tile_dma(kvb + 2 * 512, AB_LDP, Vg, T, lds + NS_K0, lds + NS_V0, wave, lane);
            for (int mt = 0, bo = 0; mt >= 0; bo ^= AT_B1) {
                const unsigned rest = (mt >= 31) ? 0u : ((uni >> (mt + 1)) << (mt + 1)); const int nx = rest ? (int)__builtin_ctz(rest) : -1;
                asm volatile("s_waitcnt vmcnt(0)" ::: "memory"); __syncthreads();
                if (nx >= 0) tile_dma(kvb + 2 * 512 + (size_t)nx * 64 * AB_LDP, AB_LDP, Vg + nx * 64, T, lds + NS_K0 + (bo ^ AT_B1), lds + NS_V0 + (bo ^ AT_B1), wave, lane);
                const bool mine = (mysel >> mt) & 1u;
                if (__ballot(mine) != 0ull) {
                    f32x16 s[2]; qk_tile(lds + NS_K0 + bo, qf, s, lane);
                    const float mbias = mine ? 0.f : -INFINITY;
                    if (mt == c) {
#pragma unroll
                        for (int rb = 0; rb < 2; ++rb)
#pragma unroll
                            for (int i = 0; i < 16; ++i) { const int key = 64 * mt + 32 * rb + (i & 3) + 8 * (i >> 2) + 4 * hh; float v = fmaf(s[rb][i], C1, mbias); if (key > t) v = -INFINITY; s[rb][i] = v; }
                    } else {
#pragma unroll
                        for (int rb = 0; rb < 2; ++rb)
#pragma unroll
                            for (int i = 0; i < 16; ++i) s[rb][i] = fmaf(s[rb][i], C1, mbias);
                    }
                    softmax_update(s, m, l, O);
                    pv_tile(lds + NS_V0 + bo, s, O, lane);
                }
                mt = nx;
            }
            l += __shfl_xor(l, 32); NS_ROWPTRS(); const float sc = sigm(smr[48]) / l;
#pragma unroll
            for (int db = 0; db < 4; ++db)
#pragma unroll
                for (int g4 = 0; g4 < 4; ++g4) { v2u* pa = (v2u*)(oacc + 32 * db + 8 * g4 + 4 * hh); const v2u a = *pa; v2u w;
                    w.x = cvtpk(bflo(a.x) + O[db][4 * g4] * sc, bfhi(a.x) + O[db][4 * g4 + 1] * sc); w.y = cvtpk(bflo(a.y) + O[db][4 * g4 + 2] * sc, bfhi(a.y) + O[db][4 * g4 + 3] * sc); *pa = w; }
        }
        {
            float m = -INFINITY, l = 0.f; f32x16 O[4];
#pragma unroll
            for (int db = 0; db < 4; ++db)
#pragma unroll
                for (int i = 0; i < 16; ++i) O[db][i] = 0.f;
            const bf16* Vg = VTW + (size_t)bg * 128 * T;
            const int kt0 = c >= 8 ? c - 8 : 0;
            __syncthreads();
            tile_dma(kvb + 4 * 512 + (size_t)kt0 * 64 * AB_LDP, AB_LDP, Vg + kt0 * 64, T, lds + NS_K0, lds + NS_V0, wave, lane);
            for (int kt = kt0, bo = 0; kt <= c; ++kt, bo ^= AT_B1) {
                asm volatile("s_waitcnt vmcnt(0)" ::: "memory"); __syncthreads();
                if (kt < c) tile_dma(kvb + 4 * 512 + (size_t)(kt + 1) * 64 * AB_LDP, AB_LDP, Vg + (kt + 1) * 64, T, lds + NS_K0 + (bo ^ AT_B1), lds + NS_V0 + (bo ^ AT_B1), wave, lane);
                f32x16 s[2]; qk_tile(lds + NS_K0 + bo, qf, s, lane);
                const bool edge = (kt == c) || (kt == c - 8);
                if (edge) {
#pragma unroll
                    for (int rb = 0; rb < 2; ++rb)
#pragma unroll
                        for (int i = 0; i < 16; ++i) { const int key = 64 * kt + 32 * rb + (i & 3) + 8 * (i >> 2) + 4 * hh; float v = s[rb][i] * C1; if (key > t || key < t - 511) v = -INFINITY; s[rb][i] = v; }
                } else {
#pragma unroll
                    for (int rb = 0; rb < 2; ++rb)
#pragma unroll
                        for (int i = 0; i < 16; ++i) s[rb][i] *= C1;
                }
                softmax_update(s, m, l, O);
                pv_tile(lds + NS_V0 + bo, s, O, lane);
            }
            l += __shfl_xor(l, 32); NS_ROWPTRS(); const float sc = sigm(smr[64]) / l;
            bf16* orow = OBUF + row_ * DM + 2048 + head * HD;
#pragma unroll
            for (int db = 0; db < 4; ++db)
#pragma unroll
                for (int g4 = 0; g4 < 4; ++g4) { const v2u a = *(const v2u*)(oacc + 32 * db + 8 * g4 + 4 * hh);
                    v2u w; w.x = cvtpk(bflo(a.x) + O[db][4 * g4] * sc, bfhi(a.x) + O[db][4 * g4 + 1] * sc); w.y = cvtpk(bflo(a.y) + O[db][4 * g4 + 2] * sc, bfhi(a.y) + O[db][4 * g4 + 3] * sc);
                    *(v2u*)(orow + 32 * db + 8 * g4 + 4 * hh) = w; }
        }
    }
}
__device__ __forceinline__ int perm16(int k) { return ((k >> 2) & 1) * 8 + (k >> 3) * 4 + (k & 3); }
__device__ __forceinline__ int crow(int i, int hh) { return (i & 3) + 8 * (i >> 2) + 4 * hh; }
__device__ __forceinline__ bf16x8 pack8(const f32x16& x, int s) { v4u w; w.x = cvtpk(x[8 * s + 0], x[8 * s + 1]); w.y = cvtpk(x[8 * s + 2], x[8 * s + 3]); w.z = cvtpk(x[8 * s + 4], x[8 * s + 5]); w.w = cvtpk(x[8 * s + 6], x[8 * s + 7]); return __builtin_bit_cast(bf16x8, w); }
constexpr int CH_QT = 0, CH_KT = 16384, CH_VT = 32768, CH_KD = 49152, CH_PS = 65536, CH_OT = 0;
constexpr size_t SZ_QH = (size_t)64 * 128, SZ_DS = (size_t)128 * 128, SZ_SN = (size_t)128 * 128;
__device__ __forceinline__ void hgrn_chunk_prep(const bf16* proj, const float* lbl, bf16* QH, bf16* OI, bf16* DS, float* DEC, LAS unsigned char* lds, int tid, int lane, int wave) {
    const int d = tid & 127, pt = tid >> 7, r = lane & 31, hh = lane >> 5;
    unsigned short rf[16], rq[16], rv[16];
#define HG_LOAD_RAW(IDX) do { const int bh_ = (IDX) >> 5, n_ = (IDX) & 31; const bf16* pr_ = proj + ((size_t)(bh_ >> 4) * T + n_ * 64 + 16 * pt) * CD_LDP + (bh_ & 15) * HD + d; \
        _Pragma("unroll") for (int i_ = 0; i_ < 16; ++i_) { rf[i_] = pr_[(size_t)i_ * CD_LDP + C_HF]; rq[i_] = pr_[(size_t)i_ * CD_LDP + C_HQ]; rv[i_] = pr_[(size_t)i_ * CD_LDP + C_HI]; } } while (0)
    if ((int)blockIdx.x < 2048) HG_LOAD_RAW((int)blockIdx.x);
    for (int idx = blockIdx.x; idx < 2048; idx += gridDim.x) {
        const int bh = idx >> 5, n = idx & 31, b = bh >> 4, h = bh & 15; const size_t row0 = (size_t)b * T + n * 64;
        __syncthreads();
        const float lb = sigm(lbl[2048 + h * HD + d] - lbl[h * HD + d]);
        float cs[16], kk[16], qv[16]; unsigned short vb[16]; float run = 0.f;
#pragma unroll
        for (int i = 0; i < 16; ++i) {
            const float sg = sigm(bf2f(rf[i])), f = lb + (1.f - lb) * sg; run += __logf(f); cs[i] = run; kk[i] = (1.f - lb) * (1.f - sg); qv[i] = silu(bf2f(rq[i])); vb[i] = rv[i]; }
        LAS float* PS = (LAS float*)(lds + CH_PS);
        PS[pt * 128 + d] = run;
        __syncthreads();
        const float p0 = PS[d], p1 = PS[128 + d], p2 = PS[256 + d], p3 = PS[384 + d];
        const float pre = pt == 0 ? 0.f : (pt == 1 ? p0 : (pt == 2 ? p0 + p1 : p0 + p1 + p2)), bmid = p0 + p1, tot = (p0 + p1) + (p2 + p3);
        if (pt == 0) DEC[(size_t)idx * 128 + d] = __expf(tot);
        unsigned short kdb[16];
#pragma unroll
        for (int i = 0; i < 16; ++i) { const int rr = 16 * pt + i; const float bb = pre + cs[i];
            const float dmid = fminf(fmaxf(bb - bmid, -80.f), 80.f);
            const unsigned qt = f2bf(qv[i] * __expf(dmid)), kt = f2bf(kk[i] * __expf(-dmid)), qh = f2bf(qv[i] * __expf(bb));
            kdb[i] = (unsigned short)f2bf(kk[i] * __expf(tot - bb));
            const int sw = rr * 256 + (((d >> 3) ^ (rr & 15)) << 4) + (d & 7) * 2;
            *(LAS unsigned short*)(lds + CH_QT + sw) = (unsigned short)qt; *(LAS unsigned short*)(lds + CH_KT + sw) = (unsigned short)kt;
            QH[(size_t)idx * SZ_QH + rr * 128 + (d & ~15) + perm16(d & 15)] = (bf16)qh; }
#pragma unroll
        for (int h2 = 0; h2 < 2; ++h2) { v4u wk, wv; unsigned ek[8], ev[8];
#pragma unroll
            for (int j = 0; j < 8; ++j) { const int i = 8 * (j >> 2) + 4 * h2 + (j & 3); ek[j] = kdb[i]; ev[j] = vb[i]; }
            wk.x = ek[0] | (ek[1] << 16); wk.y = ek[2] | (ek[3] << 16); wk.z = ek[4] | (ek[5] << 16); wk.w = ek[6] | (ek[7] << 16);
            wv.x = ev[0] | (ev[1] << 16); wv.y = ev[2] | (ev[3] << 16); wv.z = ev[4] | (ev[5] << 16); wv.w = ev[6] | (ev[7] << 16);
            const int sw = d * 128 + (((2 * pt + h2) ^ ((d >> 1) & 7)) << 4);
            *(LAS v4u*)(lds + CH_KD + sw) = wk; *(LAS v4u*)(lds + CH_VT + sw) = wv; }
        __syncthreads();
        if (idx + (int)gridDim.x < 2048) HG_LOAD_RAW(idx + (int)gridDim.x);
        const int rbk = wave & 1, eb = wave >> 1;
        int yk = hh ^ (r & 15); asm volatile("" : "+v"(yk)); int yv = hh ^ ((r >> 1) & 7); asm volatile("" : "+v"(yv));
        f32x16 oi;
#pragma unroll
        for (int i = 0; i < 16; ++i) oi[i] = 0.f;
#pragma unroll
        for (int jb = 0; jb < 2; ++jb) {
            if (jb > rbk) continue;
            f32x16 s;
#pragma unroll
            for (int i = 0; i < 16; ++i) s[i] = 0.f;
#pragma unroll
            for (int ks = 0; ks < 8; ++ks) { const bf16x8 a = *(const LAS bf16x8*)(lds + CH_KT + (32 * jb + r) * 256 + (((2 * ks) ^ yk) << 4)), q = *(const LAS bf16x8*)(lds + CH_QT + (32 * rbk + r) * 256 + (((2 * ks) ^ yk) << 4));
                s = MFMA32(a, q, s); }
            if (jb == rbk) {
#pragma unroll
                for (int i = 0; i < 16; ++i) if (crow(i, hh) > r) s[i] = 0.f; }
#pragma unroll
            for (int st = 0; st < 2; ++st) { const bf16x8 a = *(const LAS bf16x8*)(lds + CH_VT + (32 * eb + r) * 128 + (((2 * (2 * jb + st)) ^ yv) << 4));
                oi = MFMA32(a, pack8(s, st), oi); }
        }
        { bf16* op = OI + ((size_t)idx * 64 + 32 * rbk + r) * 128 + 32 * eb + 4 * hh;
#pragma unroll
          for (int g4 = 0; g4 < 4; ++g4) { v2u w; w.x = cvtpk(oi[4 * g4], oi[4 * g4 + 1]); w.y = cvtpk(oi[4 * g4 + 2], oi[4 * g4 + 3]); *(v2u*)(op + 8 * g4) = w; } }
#pragma unroll
        for (int tt = 0; tt < 2; ++tt) { const int tile = 2 * wave + tt, db = tile >> 2, eb2 = tile & 3; f32x16 acc;
#pragma unroll
            for (int i = 0; i < 16; ++i) acc[i] = 0.f;
#pragma unroll
            for (int kq = 0; kq < 4; ++kq) { const bf16x8 a = *(const LAS bf16x8*)(lds + CH_KD + (32 * db + r) * 128 + (((2 * kq) ^ yv) << 4)), bq = *(const LAS bf16x8*)(lds + CH_VT + (32 * eb2 + r) * 128 + (((2 * kq) ^ yv) << 4));
                acc = MFMA32(a, bq, acc); }
            bf16* dp = DS + (size_t)idx * SZ_DS + ((size_t)tile * 4 * 64 + lane) * 4;
#pragma unroll
            for (int g4 = 0; g4 < 4; ++g4) { v2u w; w.x = cvtpk(acc[4 * g4], acc[4 * g4 + 1]); w.y = cvtpk(acc[4 * g4 + 2], acc[4 * g4 + 3]); *(v2u*)(dp + g4 * 256) = w; } }
    }
}
__device__ __forceinline__ void hgrn_state_scan(const bf16* DS, const float* DEC, bf16* SN, int item, int lane) {
    const int bh = item >> 2, eb = item & 3, hh = lane >> 5;
    f32x16 S[4];
#pragma unroll
    for (int rb = 0; rb < 4; ++rb)
#pragma unroll
        for (int i = 0; i < 16; ++i) S[rb][i] = 0.f;
    for (int n = 0; n < 32; ++n) {
        const size_t idx = (size_t)bh * 32 + n;
        f32x4 ds[4][4], dc[4][4];
#pragma unroll
        for (int rb = 0; rb < 4; ++rb)
#pragma unroll
            for (int g4 = 0; g4 < 4; ++g4) { const v2u w = *(const v2u*)(DS + idx * SZ_DS + ((size_t)((rb * 4 + eb) * 4 + g4) * 64 + lane) * 4); ds[rb][g4] = (f32x4){bflo(w.x), bfhi(w.x), bflo(w.y), bfhi(w.y)}; dc[rb][g4] = *(const f32x4*)(DEC + idx * 128 + 32 * rb + 8 * g4 + 4 * hh); }
        bf16* sp = SN + idx * SZ_SN + (size_t)eb * 8 * 512 + lane * 8;
#pragma unroll
        for (int rb = 0; rb < 4; ++rb)
#pragma unroll
            for (int st = 0; st < 2; ++st) *(bf16x8*)(sp + (rb * 2 + st) * 512) = pack8(S[rb], st);
#pragma unroll
        for (int rb = 0; rb < 4; ++rb)
#pragma unroll
            for (int i = 0; i < 16; ++i) S[rb][i] = S[rb][i] * dc[rb][i >> 2][i & 3] + ds[rb][i >> 2][i & 3];
    }
}
__device__ __forceinline__ void chunk_output(const bf16* QH, const bf16* SN, const bf16* OI, const float* nw, const bf16* gate, int ldg, bf16* OBUF, LAS unsigned char* lds, int tid, int lane, int wave) {
    const int r = lane & 31, hh = lane >> 5, rbk = wave & 1, eb = wave >> 1;
    LAS float* OT = (LAS float*)(lds + CH_OT);
    bf16x8 qf[8], sf[8]; unsigned short oi[16]; unsigned gw8[8];
#define CO_LOAD(IDX) do { const int bh_ = (IDX) >> 5, n_ = (IDX) & 31; const size_t row0_ = (size_t)(bh_ >> 4) * T + n_ * 64; \
        const bf16* qa_ = QH + (size_t)(IDX) * SZ_QH + (32 * rbk + r) * 128 + 8 * hh; const bf16* sb_ = SN + (size_t)(IDX) * SZ_SN + (size_t)eb * 8 * 512 + lane * 8; \
        _Pragma("unroll") for (int k8 = 0; k8 < 8; ++k8) { qf[k8] = *(const bf16x8*)(qa_ + 16 * k8); sf[k8] = *(const bf16x8*)(sb_ + k8 * 512); } \
        const bf16* op_ = OI + ((size_t)(IDX) * 64 + 32 * rbk) * 128 + 32 * eb + r; \
        _Pragma("unroll") for (int i = 0; i < 16; ++i) oi[i] = op_[crow(i, hh) * 128]; \
        _Pragma("unroll") for (int j = 0; j < 8; ++j) gw8[j] = *(const unsigned*)(gate + (row0_ + 8 * wave + j) * ldg + (bh_ & 15) * HD + 2 * lane); } while (0)
    if ((int)blockIdx.x < 2048) CO_LOAD((int)blockIdx.x);
    for (int idx = blockIdx.x; idx < 2048; idx += gridDim.x) {
        const int bh = idx >> 5, n = idx & 31, b = bh >> 4, h = bh & 15; const size_t row0 = (size_t)b * T + n * 64;
        f32x16 acc;
#pragma unroll
        for (int i = 0; i < 16; ++i) acc[i] = 0.f;
#pragma unroll
        for (int k8 = 0; k8 < 8; ++k8) acc = MFMA32(qf[k8], sf[k8], acc);
        float ov[16]; unsigned gcur[8];
#pragma unroll
        for (int i = 0; i < 16; ++i) ov[i] = acc[i] + bf2f(oi[i]);
#pragma unroll
        for (int j = 0; j < 8; ++j) gcur[j] = gw8[j];
        __syncthreads();
#pragma unroll
        for (int i = 0; i < 16; ++i) OT[(32 * rbk + crow(i, hh)) * 128 + 32 * eb + r] = ov[i];
        if (idx + (int)gridDim.x < 2048) CO_LOAD(idx + (int)gridDim.x);
        __syncthreads();
#pragma unroll
        for (int j = 0; j < 8; ++j) { const int rr = 8 * wave + j; const float o0 = OT[rr * 128 + 2 * lane], o1 = OT[rr * 128 + 2 * lane + 1];
            const float rstd = rsqrtf(wave_sum(o0 * o0 + o1 * o1) * (1.f / HD) + EPS);
            *(unsigned*)(OBUF + (row0 + rr) * DM + h * HD + 2 * lane) = pk2(o0 * rstd * nw[2 * lane] * silu(bflo(gcur[j])), o1 * rstd * nw[2 * lane + 1] * silu(bfhi(gcur[j]))); }
    }
#undef CO_LOAD
}
__device__ __forceinline__ int img256(int row, int c) { return row * 256 + ((c ^ (row & 15)) << 4); }
__device__ __forceinline__ int img128(int row, int c) { return row * 128 + ((c ^ ((row >> 1) & 7)) << 4); }
constexpr int G1_KT = 0, G1_SS = 16384, G1_GAM = 16384 + 1024, G1_BET = G1_GAM + 256;
constexpr int G3_KT = 0, G3_QT = 16384, G3_TT = 32768, G3_KBG = 40960, G3_VB = 57344, G3_KD = 73728, G3_QK = 90112, G3_GAM = 98304, G3_BET = G3_GAM + 256;
__device__ __forceinline__ void gdn_pass1(int idx, const bf16* proj, const float* small, const float* cw, const float* a_log, const float* dt_bias,
                                          bf16* QS, bf16* KS, bf16* VS, float* GB, float* AM, LAS unsigned char* lds, int tid, int lane, int wave) {
    asm volatile("" : "+v"(tid), "+v"(lane));
    const int d = tid & 127, pt = tid >> 7, r = lane & 31, hh = lane >> 5;
    const int bh = idx >> 5, n = idx & 31, b = bh >> 4, h = bh & 15; const size_t row0 = (size_t)b * T + n * 64;
    LAS float* SS = (LAS float*)(lds + G1_SS); LAS float* GAM = (LAS float*)(lds + G1_GAM); LAS float* BET = (LAS float*)(lds + G1_BET);
    __syncthreads();
    if (tid < 64) { float g = -__expf(a_log[h]) * softplus(small[(row0 + tid) * 256 + h] + dt_bias[h]);
#pragma unroll
        for (int o = 1; o < 64; o <<= 1) { const float v = __shfl_up(g, o); if (lane >= o) g += v; }
        const float be = sigm(small[(row0 + tid) * 256 + 16 + h]); GAM[tid] = g; BET[tid] = be; GB[(size_t)idx * 128 + tid] = g; GB[(size_t)idx * 128 + 64 + tid] = be; }
    { const int o = tid & 15;
#pragma unroll
      for (int s = 0; s < 3; ++s) { const int ch0 = s * 2048 + h * HD + 8 * o; float w[4][8];
#pragma unroll
          for (int j = 0; j < 4; ++j) { const f32x4 wa = *(const f32x4*)(cw + j * 6144 + ch0), wb = *(const f32x4*)(cw + j * 6144 + ch0 + 4);
              w[j][0] = wa.x; w[j][1] = wa.y; w[j][2] = wa.z; w[j][3] = wa.w; w[j][4] = wb.x; w[j][5] = wb.y; w[j][6] = wb.z; w[j][7] = wb.w; }
#pragma unroll
          for (int it = 0; it < 2; ++it) { const int rr = (tid >> 4) + 32 * it; float val[8];
#pragma unroll
              for (int e = 0; e < 8; ++e) val[e] = 0.f;
#pragma unroll
              for (int j = 0; j < 4; ++j) { const int rj = rr - 3 + j; v4u x = (v4u){0u, 0u, 0u, 0u};
                  if (n * 64 + rj >= 0) x = *(const v4u*)(proj + (row0 + rj) * AB_LDP + A_QKV + ch0);
                  val[0] += w[j][0] * bflo(x.x); val[1] += w[j][1] * bfhi(x.x); val[2] += w[j][2] * bflo(x.y); val[3] += w[j][3] * bfhi(x.y);
                  val[4] += w[j][4] * bflo(x.z); val[5] += w[j][5] * bfhi(x.z); val[6] += w[j][6] * bflo(x.w); val[7] += w[j][7] * bfhi(x.w); }
              float ssq = 0.f;
#pragma unroll
              for (int e = 0; e < 8; ++e) { val[e] = silu(val[e]); ssq += val[e] * val[e]; }
              if (s < 2) { ssq += __shfl_xor(ssq, 1); ssq += __shfl_xor(ssq, 2); ssq += __shfl_xor(ssq, 4); ssq += __shfl_xor(ssq, 8);
                  const float inv = rsqrtf(ssq + EPS) * (s == 0 ? QSCALE : 1.f);
#pragma unroll
                  for (int e = 0; e < 8; ++e) val[e] *= inv; }
              v4u pk; pk.x = pk2(val[0], val[1]); pk.y = pk2(val[2], val[3]); pk.z = pk2(val[4], val[5]); pk.w = pk2(val[6], val[7]);
              if (s == 1) *(LAS v4u*)(lds + G1_KT + img256(rr, o)) = pk;
              *(v4u*)((s == 0 ? QS : (s == 1 ? KS : VS)) + (size_t)idx * SZ_QH + rr * 128 + 8 * o) = pk; } } }
    __syncthreads();
    if (wave < 3) {
        const int jb = wave >> 1, rbk = (wave + 1) >> 1; int yk = hh ^ (r & 15); asm volatile("" : "+v"(yk));
        f32x16 acc;
#pragma unroll
        for (int i = 0; i < 16; ++i) acc[i] = 0.f;
#pragma unroll
        for (int ks = 0; ks < 8; ++ks) acc = MFMA32(*(const LAS bf16x8*)(lds + G1_KT + (32 * jb + r) * 256 + (((2 * ks) ^ yk) << 4)), *(const LAS bf16x8*)(lds + G1_KT + (32 * rbk + r) * 256 + (((2 * ks) ^ yk) << 4)), acc);
        const int rr = 32 * rbk + r; const float gr = GAM[rr], br = BET[rr];
#pragma unroll
        for (int g4 = 0; g4 < 4; ++g4) { const int j0 = 32 * jb + 8 * g4 + 4 * hh; const f32x4 gj = *(const LAS f32x4*)(GAM + j0); f32x4 o;
#pragma unroll
            for (int e = 0; e < 4; ++e) o[e] = (j0 + e < rr) ? br * __expf(gr - gj[e]) * acc[4 * g4 + e] : 0.f;
            *(f32x4*)(AM + (size_t)idx * 4096 + rr * 64 + j0) = o; }
    } else if (wave == 3) {
#pragma unroll
        for (int g4 = 0; g4 < 4; ++g4) *(f32x4*)(AM + (size_t)idx * 4096 + r * 64 + 32 + 8 * g4 + 4 * hh) = (f32x4){0.f, 0.f, 0.f, 0.f};
    }
}
__device__ __forceinline__ void gdn_pass2(int idx, const float* AM, bf16* TM, LAS unsigned char* wlds, int lane) {
    float Ar[64], Tr[64];
    { const f32x4* src = (const f32x4*)(AM + (size_t)idx * 4096 + lane * 64);
#pragma unroll
      for (int i = 0; i < 16; ++i) { const f32x4 v = src[i]; Ar[4 * i] = v[0]; Ar[4 * i + 1] = v[1]; Ar[4 * i + 2] = v[2]; Ar[4 * i + 3] = v[3]; } }
#pragma unroll
    for (int c = 0; c < 64; ++c) Tr[c] = (lane == c) ? 1.f : 0.f;
#pragma unroll
    for (int j = 0; j < 63; ++j) {
        const float na = -Ar[j];
#pragma unroll
        for (int c = 0; c <= j; ++c) { const float tj = __builtin_bit_cast(float, __builtin_amdgcn_readlane(__builtin_bit_cast(int, Tr[c]), j)); Tr[c] = fmaf(na, tj, Tr[c]); }
    }
    v4u* out = (v4u*)(TM + (size_t)idx * 4096 + lane * 64);
#pragma unroll
    for (int i = 0; i < 8; ++i) { v4u w; w.x = cvtpk(Tr[8 * i], Tr[8 * i + 1]); w.y = cvtpk(Tr[8 * i + 2], Tr[8 * i + 3]); w.z = cvtpk(Tr[8 * i + 4], Tr[8 * i + 5]); w.w = cvtpk(Tr[8 * i + 6], Tr[8 * i + 7]); out[i] = w; }
}
struct G3Pre { float g; v4u t[5]; unsigned short kc[16], vc[16]; };
__device__ __forceinline__ void g3_load(G3Pre& P, int idx, const bf16* QS, const bf16* KS, const bf16* VS, const float* GB, const bf16* TM, int tid) {
    const int d = tid & 127, pt = tid >> 7;
    P.g = tid < 128 ? GB[(size_t)idx * 128 + tid] : 0.f;
#pragma unroll
    for (int i = 0; i < 2; ++i) { const int id = tid + 512 * i, rw = id >> 4, c = id & 15; P.t[2 * i] = *(const v4u*)(KS + (size_t)idx * SZ_QH + rw * 128 + c * 8); P.t[2 * i + 1] = *(const v4u*)(QS + (size_t)idx * SZ_QH + rw * 128 + c * 8); }
    { const int rw = tid >> 3, c = tid & 7; P.t[4] = *(const v4u*)(TM + (size_t)idx * 4096 + rw * 64 + c * 8); }
#pragma unroll
    for (int i = 0; i < 16; ++i) { const size_t o = (size_t)idx * SZ_QH + (16 * pt + i) * 128 + d; P.kc[i] = KS[o]; P.vc[i] = VS[o]; }
}
__device__ __forceinline__ void gdn_pass3(int idx, int idx_next, G3Pre& P, const bf16* QS, const bf16* KS, const bf16* VS, const float* GB, const bf16* TM, bf16* QH, bf16* OI, bf16* AN, bf16* DS,
                                          LAS unsigned char* lds, int tid, int lane, int wave) {
    asm volatile("" : "+v"(tid), "+v"(lane));
    const int d = tid & 127, pt = tid >> 7, r = lane & 31, hh = lane >> 5;
    LAS float* GAM = (LAS float*)(lds + G3_GAM); LAS float* BET = (LAS float*)(lds + G3_BET);
    __syncthreads();
    if (tid < 128) GAM[tid] = P.g;
#pragma unroll
    for (int i = 0; i < 2; ++i) { const int id = tid + 512 * i, rw = id >> 4, c = id & 15;
        *(LAS v4u*)(lds + G3_KT + img256(rw, c)) = P.t[2 * i];
        *(LAS v4u*)(lds + G3_QT + img256(rw, c)) = P.t[2 * i + 1]; }
    { const int rw = tid >> 3, c = tid & 7; *(LAS v4u*)(lds + G3_TT + img128(rw, c)) = P.t[4]; }
    float kv[16], vv[16];
#pragma unroll
    for (int i = 0; i < 16; ++i) { kv[i] = bf2f(P.kc[i]); vv[i] = bf2f(P.vc[i]); }
    if (idx_next < 2048) g3_load(P, idx_next, QS, KS, VS, GB, TM, tid);
    __syncthreads();
    { const float glast = GAM[63]; unsigned kbg[16], vb[16], kd[16];
#pragma unroll
      for (int i = 0; i < 16; ++i) { const float gm = GAM[16 * pt + i], bm = BET[16 * pt + i]; kbg[i] = f2bf(kv[i] * bm * __expf(gm)); vb[i] = f2bf(vv[i] * bm); kd[i] = f2bf(kv[i] * __expf(glast - gm)); }
#pragma unroll
      for (int h2 = 0; h2 < 2; ++h2) { v4u a, bq, c;
          a.x = kbg[8 * h2] | (kbg[8 * h2 + 1] << 16); a.y = kbg[8 * h2 + 2] | (kbg[8 * h2 + 3] << 16); a.z = kbg[8 * h2 + 4] | (kbg[8 * h2 + 5] << 16); a.w = kbg[8 * h2 + 6] | (kbg[8 * h2 + 7] << 16);
          bq.x = vb[8 * h2] | (vb[8 * h2 + 1] << 16); bq.y = vb[8 * h2 + 2] | (vb[8 * h2 + 3] << 16); bq.z = vb[8 * h2 + 4] | (vb[8 * h2 + 5] << 16); bq.w = vb[8 * h2 + 6] | (vb[8 * h2 + 7] << 16);
          unsigned e[8];
#pragma unroll
          for (int j = 0; j < 8; ++j) e[j] = kd[8 * (j >> 2) + 4 * h2 + (j & 3)];
          c.x = e[0] | (e[1] << 16); c.y = e[2] | (e[3] << 16); c.z = e[4] | (e[5] << 16); c.w = e[6] | (e[7] << 16);
          const int sw = img128(d, 2 * pt + h2);
          *(LAS v4u*)(lds + G3_KBG + sw) = a; *(LAS v4u*)(lds + G3_VB + sw) = bq; *(LAS v4u*)(lds + G3_KD + sw) = c; } }
    int yk = hh ^ (r & 15); asm volatile("" : "+v"(yk)); int yv = hh ^ ((r >> 1) & 7); asm volatile("" : "+v"(yv));
    if (wave < 3) {
        const int jb = wave >> 1, rbk = (wave + 1) >> 1; f32x16 acc;
#pragma unroll
        for (int i = 0; i < 16; ++i) acc[i] = 0.f;
#pragma unroll
        for (int ks = 0; ks < 8; ++ks) acc = MFMA32(*(const LAS bf16x8*)(lds + G3_KT + (32 * jb + r) * 256 + (((2 * ks) ^ yk) << 4)), *(const LAS bf16x8*)(lds + G3_QT + (32 * rbk + r) * 256 + (((2 * ks) ^ yk) << 4)), acc);
        const int rr = 32 * rbk + r; const float gr = GAM[rr];
#pragma unroll
        for (int g4 = 0; g4 < 4; ++g4) { const int j0 = 32 * jb + 8 * g4 + 4 * hh; const f32x4 gj = *(const LAS f32x4*)(GAM + j0); float o[4];
#pragma unroll
            for (int e = 0; e < 4; ++e) o[e] = (j0 + e <= rr) ? __expf(gr - gj[e]) * acc[4 * g4 + e] : 0.f;
            v2u w; w.x = cvtpk(o[0], o[1]); w.y = cvtpk(o[2], o[3]);
            *(LAS v2u*)(lds + G3_QK + img128(rr, 2 * (j0 >> 4) + hh) + 8 * (g4 & 1)) = w; }
    } else if (wave == 3) {
        const v2u z = (v2u){0u, 0u};
#pragma unroll
        for (int g4 = 0; g4 < 4; ++g4) { const int j0 = 32 + 8 * g4 + 4 * hh; *(LAS v2u*)(lds + G3_QK + img128(r, 2 * (j0 >> 4) + hh) + 8 * (g4 & 1)) = z; }
    }
    __syncthreads();
    const int cb = wave & 3; const bool isw = wave < 4; const int boff = isw ? G3_KBG : G3_VB;
    f32x16 X[2];
#pragma unroll
    for (int jb = 0; jb < 2; ++jb) {
#pragma unroll
        for (int i = 0; i < 16; ++i) X[jb][i] = 0.f;
#pragma unroll
        for (int ms = 0; ms < 4; ++ms) X[jb] = MFMA32(*(const LAS bf16x8*)(lds + G3_TT + (32 * jb + r) * 128 + (((2 * ms) ^ yv) << 4)), *(const LAS bf16x8*)(lds + boff + (32 * cb + r) * 128 + (((2 * ms) ^ yv) << 4)), X[jb]); }
    bf16x8 xf[4];
#pragma unroll
    for (int kq = 0; kq < 4; ++kq) xf[kq] = pack8(X[kq >> 1], kq & 1);
    __syncthreads();
#pragma unroll 1
    for (int rbk = 0; rbk < 2; ++rbk) { f32x16 acc;
#pragma unroll
        for (int i = 0; i < 16; ++i) acc[i] = 0.f;
#pragma unroll
        for (int kq = 0; kq < 4; ++kq) acc = MFMA32(*(const LAS bf16x8*)(lds + G3_QK + (32 * rbk + r) * 128 + (((2 * kq) ^ yv) << 4)), xf[kq], acc);
        const int col = 32 * cb + r;
        if (isw) {
#pragma unroll
            for (int i = 0; i < 16; ++i) { const int rr = 32 * rbk + crow(i, hh); const float qv = bf2f(*(const LAS unsigned short*)(lds + G3_QT + img256(rr, col >> 3) + (col & 7) * 2));
                *(LAS unsigned short*)(lds + G3_KT + rr * 256 + ((col & ~15) + perm16(col & 15)) * 2) = (unsigned short)f2bf(qv * __expf(GAM[rr]) - acc[i]); }
        } else {
#pragma unroll
            for (int i = 0; i < 16; ++i) { const int rr = 32 * rbk + crow(i, hh); OI[((size_t)idx * 64 + rr) * 128 + col] = (bf16)f2bf(acc[i]); }
        } }
    const float gl = __expf(GAM[63]);
#pragma unroll 1
    for (int rb = 0; rb < 4; ++rb) { f32x16 acc;
#pragma unroll
        for (int i = 0; i < 16; ++i) acc[i] = 0.f;
#pragma unroll
        for (int kq = 0; kq < 4; ++kq) acc = MFMA32(*(const LAS bf16x8*)(lds + G3_KD + (32 * rb + r) * 128 + (((2 * kq) ^ yv) << 4)), xf[kq], acc);
        const int col = 32 * cb + r;
        if (isw) {
#pragma unroll
            for (int i = 0; i < 16; ++i) { const int dr = 32 * rb + crow(i, hh); *(LAS unsigned short*)(lds + G3_TT + dr * 256 + ((col & ~15) + perm16(col & 15)) * 2) = (unsigned short)f2bf((dr == col ? gl : 0.f) - acc[i]); }
        } else {
            bf16* dp = DS + (size_t)idx * SZ_DS + ((size_t)(rb * 4 + cb) * 4 * 64 + lane) * 4;
#pragma unroll
            for (int g4 = 0; g4 < 4; ++g4) { v2u w; w.x = cvtpk(acc[4 * g4], acc[4 * g4 + 1]); w.y = cvtpk(acc[4 * g4 + 2], acc[4 * g4 + 3]); *(v2u*)(dp + g4 * 256) = w; }
        } }
    __syncthreads();
#pragma unroll
    for (int i = 0; i < 2; ++i) { const int id = tid + 512 * i; *(v4u*)(QH + (size_t)idx * SZ_QH + id * 8) = *(const LAS v4u*)(lds + G3_KT + id * 16); }
#pragma unroll
    for (int i = 0; i < 4; ++i) { const int id = tid + 512 * i; *(v4u*)(AN + (size_t)idx * SZ_DS + id * 8) = *(const LAS v4u*)(lds + G3_TT + id * 16); }
}
__device__ __forceinline__ void gdn_prep_a(const bf16* proj, const float* small, const float* cw, const float* a_log, const float* dt_bias, bf16* QS, bf16* KS, bf16* VS, float* GB, float* AM, LAS unsigned char* lds, int tid, int lane, int wave) {
#pragma unroll 1
    for (int k = 0; k < 8; ++k) { const int idx = blockIdx.x + k * gridDim.x; if (idx < 2048) gdn_pass1(idx, proj, small, cw, a_log, dt_bias, QS, KS, VS, GB, AM, lds, tid, lane, wave); }
    asm volatile("s_waitcnt vmcnt(0)" ::: "memory"); __syncthreads();
}
__device__ __forceinline__ void gdn_prep_b(const float* AM, bf16* TM, LAS unsigned char* lds, int lane, int wave) {
    { const int idx = blockIdx.x + wave * gridDim.x; if (idx < 2048) gdn_pass2(idx, AM, TM, lds + wave * 16384, lane); }
    asm volatile("s_waitcnt vmcnt(0)" ::: "memory"); __syncthreads();
}
__device__ __forceinline__ void gdn_prep_c(const bf16* QS, const bf16* KS, const bf16* VS, const float* GB, const bf16* TM, bf16* QH, bf16* OI, bf16* AN, bf16* DS, LAS unsigned char* lds, int tid, int lane, int wave) {
    G3Pre P; if ((int)blockIdx.x < 2048) g3_load(P, (int)blockIdx.x, QS, KS, VS, GB, TM, tid);
#pragma unroll 1
    for (int k = 0; k < 8; ++k) { const int idx = blockIdx.x + k * gridDim.x; if (idx < 2048) gdn_pass3(idx, k < 7 ? idx + (int)gridDim.x : 2048, P, QS, KS, VS, GB, TM, QH, OI, AN, DS, lds, tid, lane, wave); }
}
__device__ __forceinline__ void gdn_state_scan(const bf16* AN, const bf16* DS, bf16* SN, int item, int lane) {
    const int bh = item >> 2, eb = item & 3, r = lane & 31, hh = lane >> 5;
    f32x16 S[4];
#pragma unroll
    for (int rb = 0; rb < 4; ++rb)
#pragma unroll
        for (int i = 0; i < 16; ++i) S[rb][i] = 0.f;
    for (int n = 0; n < 32; ++n) {
        const size_t idx = (size_t)bh * 32 + n;
        bf16x8 sf[8];
#pragma unroll
        for (int k8 = 0; k8 < 8; ++k8) sf[k8] = pack8(S[k8 >> 1], k8 & 1);
        bf16* sp = SN + idx * SZ_SN + (size_t)eb * 8 * 512 + lane * 8;
#pragma unroll
        for (int k8 = 0; k8 < 8; ++k8) *(bf16x8*)(sp + k8 * 512) = sf[k8];
#pragma unroll
        for (int rb = 0; rb < 4; ++rb) {
#pragma unroll
            for (int g4 = 0; g4 < 4; ++g4) { const v2u w = *(const v2u*)(DS + idx * SZ_DS + ((size_t)((rb * 4 + eb) * 4 + g4) * 64 + lane) * 4); S[rb][4 * g4] = bflo(w.x); S[rb][4 * g4 + 1] = bfhi(w.x); S[rb][4 * g4 + 2] = bflo(w.y); S[rb][4 * g4 + 3] = bfhi(w.y); }
            const bf16* ap = AN + idx * SZ_DS + (32 * rb + r) * 128 + 8 * hh;
#pragma unroll
            for (int k8 = 0; k8 < 8; ++k8) S[rb] = MFMA32(*(const bf16x8*)(ap + 16 * k8), sf[k8], S[rb]);
        }
    }
}

constexpr size_t MS_BIAS = 5 * MiB, MS_W2T = 5 * MiB + 65536, MS_WFF = 5 * MiB + 131072, MS_W1T = 6 * MiB;
constexpr int CP_PART = 0, CP_HID = 16384;
__device__ __forceinline__ void nsa_compress_mfma(const bf16* proj, const bf16* W1T, const bf16* W2T, const float* BIAS, bf16* KC, bf16* VCT, LAS unsigned char* lds, int tid, int lane, int wave) {
    const int r = lane & 31, hh = lane >> 5, jb = wave & 3, kh = wave >> 2;
    for (int item = (int)blockIdx.x - ((int)gridDim.x - 128); item < 128; item += gridDim.x) {
        if (item < 0) break;
        const int nb = item & 3, kv = (item >> 2) & 1, bg = item >> 3, b = bg >> 2, g = bg & 3;
        const int n = 32 * nb + r, ne = n < NCMP ? n : NCMP - 1;
        const bf16* ap = proj + (size_t)(b * T + 16 * ne) * AB_LDP + A_NKV + kv * 512 + g * HD + 8 * hh;
        const bf16* bp = W1T + ((size_t)kv * 128 + 32 * jb + r) * 4096 + 8 * hh;
        f32x16 acc;
#pragma unroll
        for (int i = 0; i < 16; ++i) acc[i] = 0.f;
#pragma unroll 4
        for (int l = 16 * kh; l < 16 * kh + 16; ++l) {
#pragma unroll
            for (int q = 0; q < 8; ++q) acc = MFMA32(*(const bf16x8*)(ap + (size_t)l * AB_LDP + 16 * q), *(const bf16x8*)(bp + l * 128 + 16 * q), acc); }
        __syncthreads();
        LAS float* PART = (LAS float*)(lds + CP_PART);
        if (kh == 1) {
#pragma unroll
            for (int i = 0; i < 16; ++i) PART[crow(i, hh) * 128 + 32 * jb + r] = acc[i]; }
        __syncthreads();
        if (kh == 0) { const float bs = BIAS[kv * 128 + 32 * jb + r]; const int col = 32 * jb + r;
#pragma unroll
            for (int i = 0; i < 16; ++i) { const int rr = crow(i, hh); const float hv = silu(acc[i] + PART[rr * 128 + col] + bs);
                *(LAS unsigned short*)(lds + CP_HID + img256(rr, col >> 3) + (col & 7) * 2) = (unsigned short)f2bf(hv); } }
        __syncthreads();
        if (wave < 4) { int yk = hh ^ (r & 15); asm volatile("" : "+v"(yk));
            const bf16* wp = W2T + ((size_t)kv * 128 + 32 * wave + r) * 128 + 8 * hh; f32x16 o;
#pragma unroll
            for (int i = 0; i < 16; ++i) o[i] = 0.f;
#pragma unroll
            for (int ks = 0; ks < 8; ++ks) o = MFMA32(*(const LAS bf16x8*)(lds + CP_HID + r * 256 + (((2 * ks) ^ yk) << 4)), *(const bf16x8*)(wp + 16 * ks), o);
            const int j = 32 * wave + r;
#pragma unroll
            for (int i = 0; i < 16; ++i) { const int nn = 32 * nb + crow(i, hh); const bf16 v = nn < NCMP ? (bf16)f2bf(o[i]) : (bf16)0;
                if (kv) VCT[((size_t)bg * 128 + j) * 128 + (nn & ~15) + perm16(nn & 15)] = v; else KC[((size_t)bg * 128 + nn) * HD + j] = v; } }
    }
}
#ifndef MK_SINGLE
#define MK_SINGLE 1
#endif
constexpr int NPHASE = 28;
struct Args { const float* in[33]; float* out; unsigned char* ws; int ph_lo, ph_hi; };
enum { I_X = 0, I_P, I_AB_NPRE, I_AB_NPOST, I_AB_WIN, I_GDN_CW, I_GDN_ALOG, I_GDN_DTB, I_GDN_NORM, I_PE_K, I_PE_V, I_K1, I_K2, I_V1, I_V2, I_AB_WOUT, I_CD_NPRE, I_CD_NPOST, I_CD_WIN,
       I_LB, I_HGRN_NORM, I_FOX_B, I_CD_WOUT, I_FFN_NPRE, I_FFN_NPOST, I_FFN_WUP, I_FFN_CW, I_FFN_CB, I_FFN_WDOWN, I_PLE_WPROJ, I_PLE_GNORM, I_PLE_WGATE, I_PLE_NPOST };

__global__ void __launch_bounds__(NTHR, 2) fwd(Args args) {
    extern __shared__ __attribute__((aligned(16))) unsigned char lds_raw[];
    LAS unsigned char* lds = (LAS unsigned char*)lds_raw;
    volatile LAS unsigned* MISC = (volatile LAS unsigned*)(lds + MISC_OFF);
    const int tid = threadIdx.x, lane = tid & 63, wave = __builtin_amdgcn_readfirstlane(tid >> 6);
    const int G = gridDim.x, gw = blockIdx.x * NWAVES + wave, ngw = G * NWAVES, gw2 = wave * G + blockIdx.x;
    unsigned char* ws = args.ws;
    unsigned* ctl = (unsigned*)(ws + WS_CTL);
    for (int u = tid; u < (LDS_BYTES - LDSCTL_OFF) / 4; u += NTHR) ((LAS unsigned*)(lds + LDSCTL_OFF))[u] = 0u;
    __syncthreads();
    const int lo = args.ph_lo, hi = args.ph_hi;
    XcdBarrier bar; bar.bar = ctl + CW_BAR; bar.x = 0; bar.st = nullptr;
    if (hi - lo > 1) bar = xcd_barrier_post(ctl + CW_BAR, MISC + 8);
#ifndef PH_MASK
#define PH_MASK 0xFFFFFFFFu
#endif
#define IN(k) (((PH_MASK >> (k)) & 1u) && lo <= (k) && (k) < hi)
#define SEAM(k) do { if (IN(k) && IN((k) + 1)) xcd_barrier(bar); } while (0)
    bf16* WABIN = (bf16*)(ws + WS_WABIN); bf16* WABOUT = (bf16*)(ws + WS_WABOUT); bf16* WCDIN = (bf16*)(ws + WS_WCDIN); bf16* WCDOUT = (bf16*)(ws + WS_WCDOUT);
    bf16* WUP = (bf16*)(ws + WS_WUP); bf16* WDOWN = (bf16*)(ws + WS_WDOWN); bf16* WGATE = (bf16*)(ws + WS_WGATE); bf16* WPROJ = (bf16*)(ws + WS_WPROJ);
    float* XRES = (float*)(ws + WS_XRES); bf16* H = (bf16*)(ws + WS_H); bf16* PROJ = (bf16*)(ws + WS_PROJ); float* SMALL = (float*)(ws + WS_SMALL); float* Y = (float*)(ws + WS_Y);
    bf16* OBUF = (bf16*)(ws + WS_OBUF); bf16* Z = (bf16*)(ws + WS_Z); bf16* ACT = (bf16*)(ws + WS_ACT); bf16* PP = (bf16*)(ws + WS_PP); bf16* PBF = (bf16*)(ws + WS_PBF);
    float* QN = (float*)(ws + WS_QN); float* KN = (float*)(ws + WS_KN); float* VV = (float*)(ws + WS_VV); float* ORAW = (float*)(ws + WS_ORAW); float* OCMP = (float*)(ws + WS_OCMP);
    unsigned char* ms = ws + WS_MISC;
    bf16* KC = (bf16*)(ms + MS_KC); bf16* VC = (bf16*)(ms + MS_VC); float* GG = (float*)(ms + MS_GG); float* BB = (float*)(ms + MS_BB); unsigned* SEL = (unsigned*)(ms + MS_SEL); float* CUM = (float*)(ms + MS_CUM);
    bf16* QH = (bf16*)(ws + WS_Z); bf16* OI = (bf16*)(ws + WS_Z + 32 * MiB); bf16* SN = (bf16*)(ws + WS_Z + 96 * MiB); bf16* AN = (bf16*)(ws + WS_Z + 160 * MiB); float* DEC = (float*)(ws + WS_Z + 224 * MiB); bf16* DS = (bf16*)(ws + WS_ACT + 32 * MiB);
    bf16* QS = (bf16*)(ws + WS_Z + 225 * MiB); bf16* KS = (bf16*)(ws + WS_Z + 257 * MiB); bf16* VS = (bf16*)(ws + WS_Z + 289 * MiB); float* AMX = (float*)(ws + WS_PP); float* GB = (float*)(ws + WS_PP + 32 * MiB); bf16* TM = (bf16*)(ws + WS_ACT + 16 * MiB);
    float* RS = (float*)(ws + WS_MISC + 4 * MiB + 768 * 1024); bf16* YB = (bf16*)(ws + WS_Y);
    LAS float* wl = (LAS float*)(lds + wave * 1024);
    constexpr size_t SZ_UP = (size_t)2 * DFF * DM, SZ_DOWN = (size_t)DFF * DM, SZ_SQ = (size_t)DM * DM, SZ_PJ = (size_t)DPLE * DM;

    if (IN(0)) {
        LAS float* scr = (LAS float*)(lds + wave * 16384);
        transpose_seg(args.in[I_AB_WIN], DM, AB_IN, 0, 6144, 6144, WABIN, 0, scr, gw, ngw, lane, args.in[I_AB_NPRE]);
        transpose_seg(args.in[I_AB_WIN], DM, AB_IN, 6176, 7168, 7168, WABIN, 6144, scr, gw, ngw, lane, args.in[I_AB_NPRE]);
        transpose_seg(args.in[I_AB_WIN], DM, AB_IN, 6144, 32, 32, WABIN, 13312, scr, gw, ngw, lane, args.in[I_AB_NPRE]);
        transpose_seg(args.in[I_AB_WIN], DM, AB_IN, 13344, 48, 64, WABIN, 13344, scr, gw, ngw, lane, args.in[I_AB_NPRE]);
        transpose_seg(args.in[I_AB_WIN], DM, AB_IN, 0, 0, 160, WABIN, 13408, scr, gw, ngw, lane);
        transpose_seg(args.in[I_AB_WOUT], DM, DM, 0, DM, DM, WABOUT, 0, scr, gw, ngw, lane);
        transpose_seg(args.in[I_CD_WIN], DM, CD_IN, 0, 14336, 14336, WCDIN, 0, scr, gw, ngw, lane, args.in[I_CD_NPRE]);
        for (int i = blockIdx.x * NTHR + tid; i < DM * 16; i += G * NTHR) { const int cc = i & 15, k = i >> 4;
            ((bf16*)(ms + MS_WFF))[(size_t)cc * DM + k] = (bf16)f2bf(args.in[I_CD_WIN][(size_t)k * CD_IN + 14336 + cc] * args.in[I_CD_NPRE][k]); }
        for (int l = 0; l < 2; ++l) {
            transpose_seg(args.in[I_FFN_WUP] + l * SZ_UP, DM, 2 * DFF, 0, 2 * DFF, 2 * DFF, WUP + l * SZ_UP, 0, scr, gw, ngw, lane, args.in[I_FFN_NPRE] + l * DM);
            if (l == 0) transpose_seg(args.in[I_FFN_WDOWN] + l * SZ_DOWN, DFF, DM, 0, DM, DM, WDOWN + l * SZ_DOWN, 0, scr, gw, ngw, lane);
            if (l == 0) transpose_seg(args.in[I_PLE_WGATE] + l * SZ_SQ, DM, DM, 0, DM, DM, WGATE + l * SZ_SQ, 0, scr, gw, ngw, lane, args.in[I_PLE_GNORM] + l * DM);
            transpose_seg(args.in[I_PLE_WPROJ] + l * SZ_PJ, DPLE, DM, 0, DM, DM, WPROJ + l * SZ_PJ, 0, scr, gw, ngw, lane);
        }
        for (int m = gw; m < M; m += ngw) prep_row(args.in[I_X] + (size_t)m * DM, H + (size_t)m * DM, RS + m, lane);
        transpose_seg(args.in[I_K1], 4096, 128, 0, 128, 128, (bf16*)(ms + MS_W1T), 0, scr, gw, ngw, lane);
        transpose_seg(args.in[I_V1], 4096, 128, 0, 128, 128, (bf16*)(ms + MS_W1T) + (size_t)128 * 4096, 0, scr, gw, ngw, lane);
        transpose_seg(args.in[I_K2], 128, 128, 0, 128, 128, (bf16*)(ms + MS_W2T), 0, scr, gw, ngw, lane);
        transpose_seg(args.in[I_V2], 128, 128, 0, 128, 128, (bf16*)(ms + MS_W2T) + 128 * 128, 0, scr, gw, ngw, lane);
        if (gw < 256) { const int kv = gw >> 7, j = gw & 127; const float* pe = args.in[kv ? I_PE_V : I_PE_K]; const float* w1 = args.in[kv ? I_V1 : I_K1]; float sacc = 0.f;
            for (int i = lane; i < 4096; i += 64) sacc += pe[i] * w1[(size_t)i * 128 + j];
            sacc = wave_sum(sacc); if (lane == 0) ((float*)(ms + MS_BIAS))[gw] = sacc; }
        { const float* p = args.in[I_P]; for (size_t i = (size_t)blockIdx.x * NTHR + tid; i < (size_t)2 * M * DPLE / 4; i += (size_t)G * NTHR) { const f32x4 v = ((const f32x4*)p)[i]; v2u o; o.x = pk2(v.x, v.y); o.y = pk2(v.z, v.w); ((v2u*)PBF)[i] = o; } }
        for (int i = blockIdx.x * NTHR + tid; i < 16 * HD; i += G * NTHR) { const int bg = i >> 7, d = i & 127; KC[((size_t)bg * 128 + 127) * HD + d] = 0; VC[((size_t)bg * 128 + d) * 128 + 127] = 0; }
    }
    SEAM(0);
    if (IN(1)) { pg8::Gemm g{H, WABIN, M, AB_NPAD, DM, DM}; pg8::StaticOrder S; S.init(M, AB_NPAD, G, (int)blockIdx.x); pg8::EpiProj E{PROJ, AB_LDP, SMALL, AB_LDP / 256, RS};
        pg8::gemm_phase<pg8::EpiProj, pg8::StaticOrder, true, true>(lds, g, S, E); }
    SEAM(1);
    if (IN(2)) gdn_prep_a(PROJ, SMALL, args.in[I_GDN_CW], args.in[I_GDN_ALOG], args.in[I_GDN_DTB], QS, KS, VS, GB, AMX, lds, tid, lane, wave);
    if (IN(2)) gdn_prep_b(AMX, TM, lds, lane, wave);
    if (IN(2)) { gdn_prep_c(QS, KS, VS, GB, TM, QH, OI, AN, DS, lds, tid, lane, wave); __syncthreads(); }
    if (IN(2)) {
        nsa_compress_mfma(PROJ, (const bf16*)(ms + MS_W1T), (const bf16*)(ms + MS_W2T), (const float*)(ms + MS_BIAS), KC, VC, lds, tid, lane, wave);
        if (G == 256) { if (blockIdx.x < 128) { vt_transpose(PROJ, AB_LDP, A_NKV + 3 * 512, 4, (bf16*)(ws + WS_ACT), blockIdx.x * NTHR + tid, 128 * NTHR);
                vt_transpose(PROJ, AB_LDP, A_NKV + 5 * 512, 4, (bf16*)(ws + WS_ACT + 8 * MiB), blockIdx.x * NTHR + tid, 128 * NTHR); } }
        else { vt_transpose(PROJ, AB_LDP, A_NKV + 3 * 512, 4, (bf16*)(ws + WS_ACT), blockIdx.x * NTHR + tid, G * NTHR);
            vt_transpose(PROJ, AB_LDP, A_NKV + 5 * 512, 4, (bf16*)(ws + WS_ACT + 8 * MiB), blockIdx.x * NTHR + tid, G * NTHR); }
    }
    SEAM(2);
    if (IN(3)) { if (wave == 0) { if (gw2 < 256) gdn_state_scan(AN, DS, SN, gw2, lane); }
        else transpose_seg(args.in[I_FFN_WDOWN] + SZ_DOWN, DFF, DM, 0, DM, DM, WDOWN + SZ_DOWN, 0, (LAS float*)(lds + wave * 16384), (int)blockIdx.x * 7 + wave - 1, G * 7, lane); }
    SEAM(3);
    if (IN(4)) { nsa_attn_mfma(PROJ, SMALL, KC, VC, (const bf16*)(ws + WS_ACT), (const bf16*)(ws + WS_ACT + 8 * MiB), (bf16*)Y, OBUF, lds, tid, lane, wave); __syncthreads(); }
    if (IN(5)) {
        chunk_output(QH, SN, OI, args.in[I_GDN_NORM], PROJ + A_GATE, AB_LDP, OBUF, lds, tid, lane, wave);
    }
    SEAM(5);
    if (IN(6)) { pg8::Gemm g{OBUF, WABOUT, M, DM, DM, DM}; pg8::StaticOrder S; S.init(M, DM, G, (int)blockIdx.x); pg8::EpiB16 E{YB, DM, nullptr};
        pg8::gemm_phase<pg8::EpiB16, pg8::StaticOrder, true, true>(lds, g, S, E); }
    SEAM(6);
    if (IN(7)) for (int m = gw; m < M; m += ngw) post_row<false>(YB + (size_t)m * DM, H + (size_t)m * DM, nullptr, args.in[I_AB_NPOST], RS + m, lane);
    SEAM(7);
#define FFN_PLE(P0, L, FINALP) \
    if (IN(P0)) { pg8::Gemm g{H, WUP + (L) * SZ_UP, M, 2 * DFF, DM, DM}; pg8::StaticOrder S; S.init(M, 2 * DFF, G, (int)blockIdx.x); pg8::EpiB16 E{Z, 2 * DFF, RS}; \
        pg8::gemm_phase<pg8::EpiB16, pg8::StaticOrder, true, true>(lds, g, S, E); } \
    SEAM(P0); \
    if (IN(P0 + 1)) convact_phase(Z, args.in[I_FFN_CW] + (size_t)(L) * 3 * 2 * DFF, args.in[I_FFN_CB] + (size_t)(L) * 2 * DFF, ACT, blockIdx.x * NTHR + tid, G * NTHR); \
    SEAM(P0 + 1); \
    if (IN(P0 + 2)) { pg8::Gemm g{ACT, WDOWN + (L) * SZ_DOWN, M, DM, DFF, DFF}; pg8::StaticOrder S; S.init(M, DM, G, (int)blockIdx.x); pg8::EpiB16 E{YB, DM, nullptr}; \
        pg8::gemm_phase<pg8::EpiB16, pg8::StaticOrder, true, true>(lds, g, S, E); } \
    SEAM(P0 + 2); \
    if (IN(P0 + 3)) for (int m = gw; m < M; m += ngw) post_row<false>(YB + (size_t)m * DM, H + (size_t)m * DM, nullptr, args.in[I_FFN_NPOST] + (L) * DM, RS + m, lane); \
    SEAM(P0 + 3); \
    if (IN(P0 + 4)) { pg8::Gemm g{PBF + (size_t)(L) * M * DPLE, WPROJ + (L) * SZ_PJ, M, DM, DPLE, DPLE}; pg8::StaticOrder S; S.init(M, DM, G, (int)blockIdx.x); pg8::EpiB16 E{PP, DM, nullptr}; \
        pg8::gemm_phase<pg8::EpiB16, pg8::StaticOrder, true, true>(lds, g, S, E); } \
    SEAM(P0 + 4); \
    if (IN(P0 + 5)) { pg8::Gemm g{H, WGATE + (L) * SZ_SQ, M, DM, DM, DM}; pg8::StaticOrder S; S.init(M, DM, G, (int)blockIdx.x); pg8::EpiGate E{YB, PP, DM, RS}; \
        pg8::gemm_phase<pg8::EpiGate, pg8::StaticOrder, true, true>(lds, g, S, E); } \
    SEAM(P0 + 5); \
    if (IN(P0 + 6)) { \
        for (int m = gw; m < M; m += ngw) post_row<FINALP>(YB + (size_t)m * DM, H + (size_t)m * DM, FINALP ? args.out + (size_t)m * DM : (float*)nullptr, args.in[I_PLE_NPOST] + (L) * DM, RS + m, lane); \
        if (!(FINALP) && G == 256) { asm volatile("s_waitcnt vmcnt(0)" ::: "memory"); __syncthreads(); ff_rows_mfma(H, (const bf16*)(ms + MS_WFF), RS, SMALL, lds, tid, lane, wave); } }

    FFN_PLE(8, 0, false)
    SEAM(14);
    if (IN(15)) { pg8::Gemm g{H, WCDIN, M, CD_LDP, DM, DM}; pg8::StaticOrder S; S.init(M, CD_LDP, G, (int)blockIdx.x); pg8::EpiProj E{PROJ, CD_LDP, SMALL, CD_LDP / 256, RS};
        pg8::gemm_phase<pg8::EpiProj, pg8::StaticOrder, true, true>(lds, g, S, E); }
    SEAM(15);
    if (IN(16)) {
        hgrn_chunk_prep(PROJ, args.in[I_LB], QH, OI, DS, DEC, lds, tid, lane, wave);
        if (gw2 < 64) fox_cum(SMALL, args.in[I_FOX_B], CUM, gw2, lane);
        vt_transpose(PROJ, CD_LDP, C_FV, NH, (bf16*)(ws + WS_ACT), blockIdx.x * NTHR + tid, G * NTHR);
    }
    SEAM(16);
    if (IN(17)) { if (wave == 0) { if (gw2 < 256) hgrn_state_scan(DS, DEC, SN, gw2, lane); }
        else { LAS float* scr7 = (LAS float*)(lds + wave * 16384);
            transpose_seg(args.in[I_CD_WOUT], DM, DM, 0, DM, DM, WCDOUT, 0, scr7, (int)blockIdx.x * 7 + wave - 1, G * 7, lane);
            transpose_seg(args.in[I_PLE_WGATE] + SZ_SQ, DM, DM, 0, DM, DM, WGATE + SZ_SQ, 0, scr7, (int)blockIdx.x * 7 + wave - 1, G * 7, lane, args.in[I_PLE_GNORM] + DM); } }
    SEAM(17);
    if (IN(18)) {
        fox_attn_mfma(PROJ, (const bf16*)(ws + WS_ACT), CUM, OBUF, lds, tid, lane, wave);
        __syncthreads();
        chunk_output(QH, SN, OI, args.in[I_HGRN_NORM], PROJ + C_HG, CD_LDP, OBUF, lds, tid, lane, wave);
    }
    SEAM(18);
    if (IN(19)) { pg8::Gemm g{OBUF, WCDOUT, M, DM, DM, DM}; pg8::StaticOrder S; S.init(M, DM, G, (int)blockIdx.x); pg8::EpiB16 E{YB, DM, nullptr};
        pg8::gemm_phase<pg8::EpiB16, pg8::StaticOrder, true, true>(lds, g, S, E); }
    SEAM(19);
    if (IN(20)) for (int m = gw; m < M; m += ngw) post_row<false>(YB + (size_t)m * DM, H + (size_t)m * DM, nullptr, args.in[I_CD_NPOST], RS + m, lane);
    SEAM(20);
    FFN_PLE(21, 1, true)
#undef IN
#undef SEAM
}

extern "C" void kernel_launch(void* const* d_in, const int* in_sizes, int n_in, void* d_out, int out_size, void* d_ws, size_t ws_size, hipStream_t stream) {
    static int grid = 0;
    if (grid == 0) {
        if (n_in != 33 || out_size != M * DM || ws_size < WS_END) { fprintf(stderr, "kernel_launch: unexpected problem (n_in %d, out %d, ws %zu < %zu)\n", n_in, out_size, ws_size, (size_t)WS_END); grid = -1; return; }
        int dev = 0, cus = 0, per_cu = 0;
        if (hipGetDevice(&dev) != hipSuccess || hipDeviceGetAttribute(&cus, hipDeviceAttributeMultiprocessorCount, dev) != hipSuccess) { grid = -1; return; }
        if (hipFuncSetAttribute((const void*)fwd, hipFuncAttributeMaxDynamicSharedMemorySize, LDS_BYTES) != hipSuccess) { fprintf(stderr, "kernel_launch: hipFuncSetAttribute failed\n"); grid = -1; return; }
        if (hipOccupancyMaxActiveBlocksPerMultiprocessor(&per_cu, (const void*)fwd, NTHR, LDS_BYTES) != hipSuccess || per_cu < 1) fprintf(stderr, "kernel_launch: occupancy query says %d\n", per_cu);
        (void)hipGetLastError();
        if (cus * 8 < 2048) { fprintf(stderr, "kernel_launch: needs >= 256 CUs (GDN chunk prep owns 8 chunks per workgroup)\n"); grid = -1; return; }
        grid = 256;
    }
    if (grid < 0) return;
    (void)hipMemsetAsync((char*)d_ws + WS_CTL, 0, CTL_BYTES, stream);
    Args a{};
    for (int i = 0; i < 33; ++i) a.in[i] = (const float*)d_in[i];
    a.out = (float*)d_out; a.ws = (unsigned char*)d_ws;
#if MK_SINGLE
    a.ph_lo = 0; a.ph_hi = NPHASE;
    hipLaunchKernelGGL(fwd, dim3(grid), dim3(NTHR), LDS_BYTES, stream, a);
#else
    for (int ph = 0; ph < NPHASE; ++ph) { a.ph_lo = ph; a.ph_hi = ph + 1; hipLaunchKernelGGL(fwd, dim3(grid), dim3(NTHR), LDS_BYTES, stream, a); }
#endif
}
```

```cpp
#include <hip/hip_runtime.h>
#include <cstdio>
#include <cstdint>
namespace pg8 {
#define PG8_LAS __attribute__((address_space(3)))
typedef unsigned short bf16_t;
typedef short bf16x8 __attribute__((ext_vector_type(8)));
typedef float f32x4 __attribute__((ext_vector_type(4)));
typedef unsigned u32x4 __attribute__((ext_vector_type(4)));
constexpr int BM = 256, BK = 64, HALF = 128, HTB = HALF * BK * 2  , STAGE_BYTES = 8 * HTB, NXCD = 8, WGM = 8;

__host__ __device__ __forceinline__ int lds_byte(int r, int c) { const int st = (r >> 4) * 2 + (c >> 5), rr = r & 15, cc = c & 31, ob = rr * 64 + cc * 2; return st * 1024 + (ob ^ (((ob >> 9) & 1) << 5)); }
__host__ __device__ __forceinline__ void stage_rc(int b, int& R, int& C) { const int st = b / 1024, sb = b % 1024, swz = sb ^ (((sb >> 9) & 1) << 5); R = (st >> 1) * 16 + swz / 64; C = (st & 1) * 32 + (swz % 64) / 2; }
__host__ __device__ __forceinline__ int perm32(int rho) { const int n = rho >> 4, i = rho & 15; return 8 * (i >> 2) + 4 * n + (i & 3); }

struct Unit { int pm, pn; };
struct Gemm { const bf16_t* A; const bf16_t* Bt; int M, N, K, lda; };

struct StaticOrder {
    int nM, nN, nwg, G, c;
    __host__ __device__ void init(int M, int N, int G_, int c_) { nM = M / BM; nN = N / BM; nwg = nM * nN; G = G_; c = c_; }
    __host__ __device__ bool next(int i, Unit& u) const {
        const long L = (long)i * G + c; if (L >= nwg) return false;
        int wgid = (int)L; { const int q = nwg / NXCD, r = nwg % NXCD, xcd = wgid % NXCD, off = wgid / NXCD; wgid = (xcd < r ? xcd * (q + 1) : r * (q + 1) + (xcd - r) * q) + off; }
        const int nig = WGM * nN, gid = wgid / nig, fm = gid * WGM, gsz = (nM - fm) < WGM ? (nM - fm) : WGM;
        u.pm = fm + ((wgid % nig) % gsz); u.pn = (wgid % nig) / gsz; return true;
    }
    __device__ __forceinline__ void a_ready(const Unit&) const {}
    __device__ __forceinline__ void done(const Unit&) const {}
};

__device__ __forceinline__ unsigned cvt_pk_bf16(float lo, float hi) { unsigned r; asm volatile("v_cvt_pk_bf16_f32 %0, %1, %2" : "=v"(r) : "v"(lo), "v"(hi)); return r; }
typedef float f32x2 __attribute__((ext_vector_type(2)));
struct EpiB16 {
    static constexpr bool PERM = true, AFTER_DRAIN = false;
    bf16_t* O; int ldc; const float* rs;
    __device__ __forceinline__ void operator()(const f32x4 (&acc)[2][2][4][2], const Unit& u, int wr, int wc, int fr, int fq) const {
        const int row0 = u.pm * BM + wr * 64 + fr, col0 = u.pn * BM + wc * 32 + 8 * fq;
#pragma unroll
        for (int ai = 0; ai < 2; ++ai)
#pragma unroll
            for (int m = 0; m < 4; ++m) { const int row = row0 + ai * HALF + m * 16; const float sc = rs ? rs[row] : 1.f; bf16_t* rowp = O + (size_t)row * ldc + col0;
#pragma unroll
                for (int bj = 0; bj < 2; ++bj) { const f32x4 v0 = acc[ai][bj][m][0] * sc, v1 = acc[ai][bj][m][1] * sc;
                    u32x4 w; w.x = cvt_pk_bf16(v0[0], v0[1]); w.y = cvt_pk_bf16(v0[2], v0[3]); w.z = cvt_pk_bf16(v1[0], v1[1]); w.w = cvt_pk_bf16(v1[2], v1[3]);
                    *(u32x4*)(rowp + bj * HALF) = w; } }
    }
};
struct EpiProj {
    static constexpr bool PERM = true, AFTER_DRAIN = false;
    bf16_t* O; int ldc; float* S; int nb16; const float* rs;
    __device__ __forceinline__ void operator()(const f32x4 (&acc)[2][2][4][2], const Unit& u, int wr, int wc, int fr, int fq) const {
        const int row0 = u.pm * BM + wr * 64 + fr;
        if (u.pn < nb16) {
            const int col0 = u.pn * BM + wc * 32 + 8 * fq;
#pragma unroll
            for (int ai = 0; ai < 2; ++ai)
#pragma unroll
                for (int m = 0; m < 4; ++m) { const int row = row0 + ai * HALF + m * 16; const float sc = rs[row]; bf16_t* rowp = O + (size_t)row * ldc + col0;
#pragma unroll
                    for (int bj = 0; bj < 2; ++bj) { const f32x4 v0 = acc[ai][bj][m][0] * sc, v1 = acc[ai][bj][m][1] * sc;
                        u32x4 w; w.x = cvt_pk_bf16(v0[0], v0[1]); w.y = cvt_pk_bf16(v0[2], v0[3]); w.z = cvt_pk_bf16(v1[0], v1[1]); w.w = cvt_pk_bf16(v1[2], v1[3]);
                        *(u32x4*)(rowp + bj * HALF) = w; } }
        } else {
            const int col0 = wc * 32 + 8 * fq;
#pragma unroll
            for (int ai = 0; ai < 2; ++ai)
#pragma unroll
                for (int m = 0; m < 4; ++m) { const int row = row0 + ai * HALF + m * 16; const float sc = rs[row]; float* rowp = S + (size_t)row * 256 + col0;
#pragma unroll
                    for (int bj = 0; bj < 2; ++bj) { *(f32x4*)(rowp + bj * HALF) = acc[ai][bj][m][0] * sc; *(f32x4*)(rowp + bj * HALF + 4) = acc[ai][bj][m][1] * sc; } }
        }
    }
};
struct EpiGate {
    static constexpr bool PERM = true, AFTER_DRAIN = false;
    bf16_t* C; const bf16_t* PP; int ldc; const float* rs;
    __device__ __forceinline__ void operator()(const f32x4 (&acc)[2][2][4][2], const Unit& u, int wr, int wc, int fr, int fq) const {
        const int row0 = u.pm * BM + wr * 64 + fr, col0 = u.pn * BM + wc * 32 + 8 * fq;
#pragma unroll
        for (int ai = 0; ai < 2; ++ai)
#pragma unroll
            for (int m = 0; m < 4; ++m) { const int row = row0 + ai * HALF + m * 16; const float sc = rs[row]; const size_t off = (size_t)row * ldc + col0;
#pragma unroll
                for (int bj = 0; bj < 2; ++bj) { const u32x4 pw = *(const u32x4*)(PP + off + bj * HALF); const f32x4 a = acc[ai][bj][m][0] * sc, b = acc[ai][bj][m][1] * sc; u32x4 w;
                    w.x = cvt_pk_bf16(__uint_as_float(pw.x << 16) * __builtin_amdgcn_rcpf(1.f + __expf(-a[0])), __uint_as_float(pw.x & 0xffff0000u) * __builtin_amdgcn_rcpf(1.f + __expf(-a[1])));
                    w.y = cvt_pk_bf16(__uint_as_float(pw.y << 16) * __builtin_amdgcn_rcpf(1.f + __expf(-a[2])), __uint_as_float(pw.y & 0xffff0000u) * __builtin_amdgcn_rcpf(1.f + __expf(-a[3])));
                    w.z = cvt_pk_bf16(__uint_as_float(pw.z << 16) * __builtin_amdgcn_rcpf(1.f + __expf(-b[0])), __uint_as_float(pw.z & 0xffff0000u) * __builtin_amdgcn_rcpf(1.f + __expf(-b[1])));
                    w.w = cvt_pk_bf16(__uint_as_float(pw.w << 16) * __builtin_amdgcn_rcpf(1.f + __expf(-b[2])), __uint_as_float(pw.w & 0xffff0000u) * __builtin_amdgcn_rcpf(1.f + __expf(-b[3])));
                    *(u32x4*)(C + off + bj * HALF) = w; } }
    }
};
template <class Epi, class Sched, bool ALIGN_EPI = false, bool SP2 = false>
__device__ __forceinline__ void gemm_phase(PG8_LAS unsigned char* lds, const Gemm g, const Sched& S, const Epi& E) {
    const int tid = threadIdx.x, wid = __builtin_amdgcn_readfirstlane(tid >> 6), lane = tid & 63, wr = wid >> 2, wc = wid & 3, fr = lane & 15, fq = lane >> 4;
    const int K = g.K, nt = K / BK;
    unsigned voffA[2], voffB[2];
#pragma unroll
    for (int i = 0; i < 2; ++i) { int R, C; stage_rc(tid * 16 + i * 8192, R, C); const int Rb = Epi::PERM ? ((R & ~31) + perm32(R & 31)) : R;
        voffA[i] = (unsigned)(R * g.lda + C) * 2u; voffB[i] = (unsigned)(Rb * K + C) * 2u; }
    const size_t kstep = (size_t)(BK * 2);
    const size_t hstepA = (size_t)HALF * g.lda * 2, hstepB = (size_t)HALF * K * 2;
    const size_t tstepA = 2 * hstepA, tstepB = 2 * hstepB;
    const unsigned ldsw = (unsigned)wid * 1024u;
    const int aoff = lds_byte(wr * 64 + fr, fq * 8), boff = lds_byte(wc * 32 + fr, fq * 8);
#define PG8_SA(b, h) (((b) * 2 + (h)) * HTB)
#define PG8_SB(b, h) ((4 + (b) * 2 + (h)) * HTB)
#define PG8_STAGE(bufoff, gbase, voff) do { _Pragma("unroll") for (int _i = 0; _i < 2; ++_i) \
        __builtin_amdgcn_global_load_lds((const unsigned*)((const char*)(gbase) + (voff)[_i]), (PG8_LAS unsigned*)(lds + (bufoff) + ldsw + _i * 8192), 16, 0, 0); } while (0)
#define PG8_LDA(dst, b, h) do { _Pragma("unroll") for (int m = 0; m < 4; ++m) _Pragma("unroll") for (int k = 0; k < 2; ++k) dst[m][k] = *(const PG8_LAS bf16x8*)(lds + PG8_SA(b, h) + aoff + m * 2048 + k * 1024); } while (0)
#define PG8_LDB(dst, b, h) do { _Pragma("unroll") for (int n = 0; n < 2; ++n) _Pragma("unroll") for (int k = 0; k < 2; ++k) dst[n][k] = *(const PG8_LAS bf16x8*)(lds + PG8_SB(b, h) + boff + n * 2048 + k * 1024); } while (0)
#define PG8_MMA(ai, bj, At, Bt) do { __builtin_amdgcn_s_setprio(1); _Pragma("unroll") for (int m = 0; m < 4; ++m) _Pragma("unroll") for (int n = 0; n < 2; ++n) _Pragma("unroll") for (int k = 0; k < 2; ++k) \
        acc[ai][bj][m][n] = __builtin_amdgcn_mfma_f32_16x16x32_bf16(Bt[n][k], At[m][k], acc[ai][bj][m][n], 0, 0, 0); __builtin_amdgcn_s_setprio(0); } while (0)
#define PG8_WAIT_V(n) asm volatile("s_waitcnt vmcnt(" #n ")" ::: "memory")
#define PG8_WAIT_L(n) asm volatile("s_waitcnt lgkmcnt(" #n ")" ::: "memory")
#define PG8_BAR __builtin_amdgcn_s_barrier()
#define PG8_SCHED __builtin_amdgcn_sched_barrier(0)
    Unit cur, nxt; int ui = 0;
    if (!S.next(0, cur)) return;
    f32x4 acc[2][2][4][2];
#pragma unroll
    for (int a = 0; a < 2; ++a)
#pragma unroll
        for (int b = 0; b < 2; ++b)
#pragma unroll
            for (int m = 0; m < 4; ++m)
#pragma unroll
                for (int n = 0; n < 2; ++n) acc[a][b][m][n] = (f32x4){0.f, 0.f, 0.f, 0.f};
    bf16x8 At[4][2], B0[2][2], B1[2][2];
    const char* cA = (const char*)g.A + (size_t)cur.pm * tstepA; const char* cB = (const char*)g.Bt + (size_t)cur.pn * tstepB;
    S.a_ready(cur);
    if constexpr (SP2) {
        PG8_STAGE(PG8_SB(0, 0), cB, voffB); PG8_STAGE(PG8_SB(0, 1), cB + hstepB, voffB); PG8_STAGE(PG8_SA(0, 0), cA, voffA); PG8_STAGE(PG8_SA(0, 1), cA + hstepA, voffA);
        if (wr == 1) PG8_BAR;
        PG8_WAIT_V(2); PG8_BAR;
        PG8_STAGE(PG8_SB(1, 0), cB + kstep, voffB); PG8_STAGE(PG8_SA(1, 0), cA + kstep, voffA); PG8_STAGE(PG8_SB(1, 1), cB + hstepB + kstep, voffB);
        PG8_WAIT_V(6); PG8_BAR;
    } else {
        PG8_STAGE(PG8_SB(0, 0), cB, voffB); PG8_STAGE(PG8_SA(0, 0), cA, voffA); PG8_STAGE(PG8_SB(0, 1), cB + hstepB, voffB); PG8_STAGE(PG8_SA(0, 1), cA + hstepA, voffA);
        if (wr == 1) PG8_BAR;
        PG8_WAIT_V(4); PG8_BAR;
        PG8_STAGE(PG8_SB(1, 0), cB + kstep, voffB); PG8_STAGE(PG8_SA(1, 0), cA + kstep, voffA); PG8_STAGE(PG8_SB(1, 1), cB + hstepB + kstep, voffB);
        PG8_WAIT_V(6); PG8_BAR;
    }
    for (;;) {
        const bool has_next = S.next(ui + 1, nxt);
        const char* nA = has_next ? (const char*)g.A + (size_t)nxt.pm * tstepA : cA; const char* nB = has_next ? (const char*)g.Bt + (size_t)nxt.pn * tstepB : cB;
        for (int t = 0; t < nt; t += 2) {
            const bool last = (t == nt - 2);
            const char* a1 = cA + (size_t)(t + 1) * kstep;
            const char* a2 = last ? nA : cA + (size_t)(t + 2) * kstep; const char* b2 = last ? nB : cB + (size_t)(t + 2) * kstep;
            const char* a3 = a2 + kstep; const char* b3 = b2 + kstep;
            if (last && has_next) S.a_ready(nxt);
            if constexpr (SP2) {
            PG8_LDB(B0, 0, 0); PG8_LDB(B1, 0, 1); PG8_SCHED; PG8_LDA(At, 0, 0); PG8_STAGE(PG8_SA(1, 1), a1 + hstepA, voffA);
            PG8_WAIT_V(8); PG8_WAIT_L(0); PG8_BAR; PG8_MMA(0, 0, At, B0); PG8_MMA(0, 1, At, B1); PG8_BAR; PG8_SCHED;
            PG8_LDA(At, 0, 1); PG8_STAGE(PG8_SB(0, 0), b2, voffB); PG8_STAGE(PG8_SB(0, 1), b2 + hstepB, voffB); PG8_STAGE(PG8_SA(0, 0), a2, voffA);
            PG8_WAIT_V(8); PG8_WAIT_L(0); PG8_BAR; PG8_MMA(1, 0, At, B0); PG8_MMA(1, 1, At, B1); PG8_BAR; PG8_SCHED;
            PG8_LDB(B0, 1, 0); PG8_LDB(B1, 1, 1); PG8_SCHED; PG8_LDA(At, 1, 0); PG8_STAGE(PG8_SA(0, 1), a2 + hstepA, voffA);
            PG8_WAIT_V(8); PG8_WAIT_L(0); PG8_BAR; PG8_MMA(0, 0, At, B0); PG8_MMA(0, 1, At, B1); PG8_BAR; PG8_SCHED;
            PG8_LDA(At, 1, 1); PG8_STAGE(PG8_SB(1, 0), b3, voffB); PG8_STAGE(PG8_SB(1, 1), b3 + hstepB, voffB); PG8_STAGE(PG8_SA(1, 0), a3, voffA);
            PG8_WAIT_V(8); PG8_WAIT_L(0); PG8_BAR; PG8_MMA(1, 0, At, B0); PG8_MMA(1, 1, At, B1); PG8_BAR; PG8_SCHED;
            } else {
            PG8_LDB(B0, 0, 0); PG8_SCHED; PG8_LDA(At, 0, 0); PG8_STAGE(PG8_SA(1, 1), a1 + hstepA, voffA);
            PG8_WAIT_L(8); PG8_BAR; PG8_WAIT_L(0); PG8_MMA(0, 0, At, B0); PG8_BAR; PG8_SCHED;
            PG8_LDB(B1, 0, 1); PG8_STAGE(PG8_SB(0, 0), b2, voffB);
            PG8_BAR; PG8_WAIT_L(0); PG8_MMA(0, 1, At, B1); PG8_BAR;
            PG8_LDA(At, 0, 1); PG8_STAGE(PG8_SA(0, 0), a2, voffA);
            PG8_BAR; PG8_WAIT_L(0); PG8_MMA(1, 0, At, B0); PG8_BAR; PG8_SCHED;
            PG8_STAGE(PG8_SB(0, 1), b2 + hstepB, voffB);
            PG8_WAIT_V(6); PG8_BAR; PG8_MMA(1, 1, At, B1); PG8_BAR;
            PG8_LDB(B0, 1, 0); PG8_SCHED; PG8_LDA(At, 1, 0); PG8_STAGE(PG8_SA(0, 1), a2 + hstepA, voffA);
            PG8_WAIT_L(8); PG8_BAR; PG8_WAIT_L(0); PG8_MMA(0, 0, At, B0); PG8_BAR; PG8_SCHED;
            PG8_LDB(B1, 1, 1); PG8_STAGE(PG8_SB(1, 0), b3, voffB);
            PG8_BAR; PG8_WAIT_L(0); PG8_MMA(0, 1, At, B1); PG8_BAR;
            PG8_LDA(At, 1, 1); PG8_STAGE(PG8_SA(1, 0), a3, voffA);
            PG8_BAR; PG8_WAIT_L(0); PG8_MMA(1, 0, At, B0); PG8_BAR; PG8_SCHED;
            PG8_STAGE(PG8_SB(1, 1), b3 + hstepB, voffB);
            PG8_WAIT_V(6); PG8_BAR; PG8_MMA(1, 1, At, B1); PG8_BAR;
            }
        }
        if constexpr (ALIGN_EPI) { if (wr == 0) PG8_BAR; }
        if constexpr (!Epi::AFTER_DRAIN) { E(acc, cur, wr, wc, fr, fq); S.done(cur); }
        if (!has_next) break;
#pragma unroll
        for (int a = 0; a < 2; ++a)
#pragma unroll
            for (int b = 0; b < 2; ++b)
#pragma unroll
                for (int m = 0; m < 4; ++m)
#pragma unroll
                    for (int n = 0; n < 2; ++n) acc[a][b][m][n] = (f32x4){0.f, 0.f, 0.f, 0.f};
        cur = nxt; cA = nA; cB = nB; ++ui;
        if constexpr (ALIGN_EPI) { if (wr == 1) PG8_BAR; }
    }
    PG8_WAIT_V(0);
    if constexpr (!ALIGN_EPI) { if (wr == 0) PG8_BAR; }
    PG8_BAR;
    if constexpr (Epi::AFTER_DRAIN) { E.fused(acc, cur, wr, wc, fr, fq, lds, wid, lane); S.done(cur); }
#undef PG8_SA
#undef PG8_SB
#undef PG8_STAGE
#undef PG8_LDA
#undef PG8_LDB
#undef PG8_MMA
#undef PG8_WAIT_V
#undef PG8_WAIT_L
#undef PG8_BAR
#undef PG8_SCHED
}
}
constexpr int NB = 4, T = 2048, DM = 4096, M = NB * T, HD = 128, NH = 16, DFF = 11008, DPLE = 256;
constexpr int AB_IN = 13392, CD_IN = 14352;
constexpr int AB_LDP = 13312, AB_NPAD = 13568;
constexpr int CD_LDP = 14336, CD_NPAD = 14592;
constexpr int A_QKV = 0, A_GATE = 6144, A_NQ = 8192, A_NKV = 10240;
constexpr int C_HQ = 0, C_HF = 2048, C_HI = 4096, C_HG = 6144, C_FQ = 8192, C_FK = 10240, C_FV = 12288;
constexpr int NCMP = 127;
constexpr float EPS = 1e-6f, QSCALE = 0.08838834764831845f;
constexpr size_t MiB = 1u << 20;
constexpr size_t WS_CTL = 0, CTL_BYTES = 65536;
constexpr size_t WS_WABIN = 1 * MiB;
constexpr size_t WS_WABOUT = WS_WABIN + 106 * MiB;
constexpr size_t WS_WCDIN = WS_WABOUT + 32 * MiB;
constexpr size_t WS_WCDOUT = WS_WCDIN + 114 * MiB;
constexpr size_t WS_WUP = WS_WCDOUT + 32 * MiB;
constexpr size_t WS_WDOWN = WS_WUP + 2 * 172 * MiB;
constexpr size_t WS_WGATE = WS_WDOWN + 2 * 86 * MiB;
constexpr size_t WS_WPROJ = WS_WGATE + 2 * 32 * MiB;
constexpr size_t WS_XRES = WS_WPROJ + 2 * 2 * MiB;
constexpr size_t WS_H = WS_XRES + 128 * MiB;
constexpr size_t WS_PROJ = WS_H + 64 * MiB;
constexpr size_t WS_SMALL = WS_PROJ + 224 * MiB;
constexpr size_t WS_Y = WS_SMALL + 8 * MiB;
constexpr size_t WS_OBUF = WS_Y + 128 * MiB;
constexpr size_t WS_Z = WS_OBUF + 64 * MiB;
constexpr size_t WS_ACT = WS_Z + 344 * MiB;
constexpr size_t WS_PP = WS_ACT + 172 * MiB;
constexpr size_t WS_PBF = WS_PP + 64 * MiB;
constexpr size_t WS_MISC = WS_PBF + 8 * MiB;
constexpr size_t WS_END = WS_MISC + 8 * MiB;
constexpr size_t WS_QN = WS_Z, WS_KN = WS_Z + 64 * MiB, WS_VV = WS_Z + 128 * MiB, WS_ORAW = WS_Z + 192 * MiB, WS_OCMP = WS_Z + 256 * MiB;
constexpr size_t MS_KC = 0, MS_VC = 1 * MiB  , MS_GG = 2 * MiB, MS_BB = 2 * MiB + 512 * 1024, MS_SEL = 3 * MiB, MS_CUM = 4 * MiB, MS_PEB = 5 * MiB;
constexpr int CW_BAR = 4096;

constexpr int NWAVES = 8, NTHR = 512;
constexpr int RING_BYTES = 131072, LDSCTL_OFF = RING_BYTES, MISC_OFF = LDSCTL_OFF + 320, LDS_BYTES = 147456;

#define GAS __attribute__((address_space(1)))
#define LAS __attribute__((address_space(3)))
typedef unsigned short bf16;
typedef unsigned v4u __attribute__((ext_vector_type(4)));
typedef unsigned v2u __attribute__((ext_vector_type(2)));
typedef float f32x4 __attribute__((ext_vector_type(4)));
#define LDS_WAIT() asm volatile("s_waitcnt lgkmcnt(0)" ::: "memory")
typedef __bf16 bf16x2_t __attribute__((ext_vector_type(2)));
typedef float f32x2_t __attribute__((ext_vector_type(2)));
__device__ __forceinline__ unsigned cvtpk(float lo, float hi) { f32x2_t v = {lo, hi}; return __builtin_bit_cast(unsigned, __builtin_convertvector(v, bf16x2_t)); }
__device__ __forceinline__ unsigned f2bf(float f) { return cvtpk(f, 0.f); }
__device__ __forceinline__ unsigned pk2(float lo, float hi) { return cvtpk(lo, hi); }
__device__ __forceinline__ float bflo(unsigned w) { return __uint_as_float(w << 16); }
__device__ __forceinline__ float bfhi(unsigned w) { return __uint_as_float(w & 0xffff0000u); }
__device__ __forceinline__ float bf2f(bf16 b) { return __uint_as_float(((unsigned)b) << 16); }
__device__ __forceinline__ float wave_sum(float v) {
#pragma unroll
    for (int o = 1; o < 64; o <<= 1) v += __shfl_xor(v, o);
    return v; }
__device__ __forceinline__ float wave_max(float v) {
#pragma unroll
    for (int o = 1; o < 64; o <<= 1) v = fmaxf(v, __shfl_xor(v, o));
    return v; }
__device__ __forceinline__ float sigm(float x) { return __builtin_amdgcn_rcpf(1.f + __expf(-x)); }
__device__ __forceinline__ float silu(float x) { return x * __builtin_amdgcn_rcpf(1.f + __expf(-x)); }
__device__ __forceinline__ float softplus(float x) { return x > 20.f ? x : log1pf(__expf(x)); }
__device__ __forceinline__ float logsigm(float x) { return fminf(x, 0.f) - log1pf(__expf(-fabsf(x))); }

#define XB_TMO      128
#define XB_XCNT(j)  (256  + 64 * (j))
#define XB_XSUB(j)  (1280 + 64 * (j))
#define XB_XGEN(j)  (2304 + 64 * (j))
#define XB_TOP      3328
#define XB_TOPGEN   3392
#define XCD_BAR_WORDS 3456
#define XB_SPIN_CAP (1u << 18)
__device__ __forceinline__ unsigned xb_ld(unsigned* p)              { return __hip_atomic_load(p, __ATOMIC_RELAXED, __HIP_MEMORY_SCOPE_AGENT); }
__device__ __forceinline__ unsigned xb_add(unsigned* p, unsigned v) { return __hip_atomic_fetch_add(p, v, __ATOMIC_RELAXED, __HIP_MEMORY_SCOPE_AGENT); }
__device__ __forceinline__ unsigned xb_xcc_id() { return (unsigned)__builtin_amdgcn_s_getreg((3 << 11) | 20) & 0xFu; }
#define XB_SPIN(cond, bar) do { unsigned _sp = 0; while (cond) { __builtin_amdgcn_s_sleep(1); \
    if ((++_sp & 255u) == 0u) { if (xb_ld(&(bar)[XB_TMO])) break; if (_sp > XB_SPIN_CAP) { atomicAdd(&(bar)[XB_TMO], 1u); break; } } } } while (0)
struct XcdBarrier { unsigned* bar; unsigned x; volatile LAS unsigned* st; };
__device__ __forceinline__ XcdBarrier xcd_barrier_post(unsigned* bar, volatile LAS unsigned* st) {
    XcdBarrier b; b.bar = bar; b.x = xb_xcc_id(); b.st = st;
    if (threadIdx.x == 0) (void)xb_add(&bar[XB_XCNT(b.x)], 1u);
    return b;
}
__device__ __forceinline__ void xcd_barrier_complete(unsigned* bar, unsigned x, unsigned& nloc, unsigned& nx) {
    const unsigned G = gridDim.x * gridDim.y * gridDim.z;
    unsigned sum, cnt, mine, sp = 0u;
    for (;;) {
        sum = 0u; cnt = 0u; mine = 0u;
#pragma unroll
        for (unsigned j = 0; j < 16; ++j) { const unsigned c = xb_ld(&bar[XB_XCNT(j)]); sum += c; cnt += (c > 0u) ? 1u : 0u; mine = (j == x) ? c : mine; }
        if (sum == G) break;
        __builtin_amdgcn_s_sleep(1);
        if ((++sp & 255u) == 0u) { if (xb_ld(&bar[XB_TMO])) break; if (sp > XB_SPIN_CAP) { atomicAdd(&bar[XB_TMO], 1u); break; } }
    }
    nloc = mine > 0u ? mine : 1u; nx = cnt > 0u ? cnt : 1u;
}
__device__ __forceinline__ void xcd_barrier(const XcdBarrier& b) {
    asm volatile("s_waitcnt vmcnt(0)" ::: "memory");
    __syncthreads();
    if (threadIdx.x == 0) {
        unsigned* bar = b.bar;
        __builtin_amdgcn_s_waitcnt(0);
        unsigned nloc = b.st[0], nx = b.st[1];
        if (nloc == 0u) { xcd_barrier_complete(bar, b.x, nloc, nx); b.st[0] = nloc; b.st[1] = nx; }
        const unsigned old = xb_add(&bar[XB_XSUB(b.x)], 1u);
        const unsigned gen = old / nloc;
        if (old + 1u == (gen + 1u) * nloc) {
            __builtin_amdgcn_fence(__ATOMIC_RELEASE, "agent");
            asm volatile("s_waitcnt vmcnt(0)" ::: "memory");
            const unsigned og = xb_add(&bar[XB_TOP], 1u);
            const unsigned tg = og / nx;
            if (og + 1u == (tg + 1u) * nx) xb_add(&bar[XB_TOPGEN], 1u);
            else XB_SPIN(xb_ld(&bar[XB_TOPGEN]) == tg, bar);
            __builtin_amdgcn_fence(__ATOMIC_ACQUIRE, "agent");
            xb_add(&bar[XB_XGEN(b.x)], 1u);
            asm volatile("s_waitcnt vmcnt(0)" ::: "memory");
        } else {
            XB_SPIN(xb_ld(&bar[XB_XGEN(b.x)]) == gen, bar);
            __builtin_amdgcn_fence(__ATOMIC_ACQUIRE, "agent");
            asm volatile("s_waitcnt vmcnt(0)" ::: "memory");
        }
    }
    __syncthreads();
}

__device__ __forceinline__ void transpose_seg(const float* W, int K, int ldw, int c0, int nvalid, int npad, bf16* Wt, int r0, LAS float* scr, int gw, int ngw, int lane, const float* kscale = nullptr) {
    const int nblk = npad / 32, nitems = (K / 64) * nblk;
    const int nkb = K / 64, GK = (nkb % 8 == 0) ? 8 : ((nkb % 4 == 0) ? 4 : 1), GN = 64 / GK; const bool blocked = (GK > 1) && (nblk % GN == 0);
    for (int item = gw; item < nitems; item += ngw) {
        int kb, nb;
        if (blocked) { const int grp = item >> 6, w = item & 63, gpr = nblk / GN; kb = GK * (grp / gpr) + w / GN; nb = GN * (grp % gpr) + w % GN; }
        else { kb = item / nblk; nb = item % nblk; }
        const int k0 = 64 * kb, n0 = 32 * nb;
        const int nn = n0 + (lane & 31); const bool ok = nn < nvalid;
        const float* src = W + (size_t)k0 * ldw + c0 + (ok ? nn : 0);
#pragma unroll 8
        for (int i = 0; i < 32; ++i) { const int kk = 2 * i + (lane >> 5); const float v = src[(size_t)kk * ldw]; scr[kk * 33 + (lane & 31)] = ok ? v : 0.f; }
        LDS_WAIT(); asm volatile("" ::: "memory");
        const int c = lane & 7;
        f32x4 ka = (f32x4){1.f, 1.f, 1.f, 1.f}, kb2 = ka;
        if (kscale) { ka = *(const f32x4*)(kscale + k0 + 8 * c); kb2 = *(const f32x4*)(kscale + k0 + 8 * c + 4); }
#pragma unroll
        for (int j = 0; j < 4; ++j) { const int n = (lane >> 3) + 8 * j; const LAS float* s = scr + (8 * c) * 33 + n;
            v4u o; o.x = pk2(s[0 * 33] * ka.x, s[1 * 33] * ka.y); o.y = pk2(s[2 * 33] * ka.z, s[3 * 33] * ka.w); o.z = pk2(s[4 * 33] * kb2.x, s[5 * 33] * kb2.y); o.w = pk2(s[6 * 33] * kb2.z, s[7 * 33] * kb2.w);
            *(v4u*)(Wt + (size_t)(r0 + n0 + n) * K + k0 + 8 * c) = o; }
        LDS_WAIT(); asm volatile("" ::: "memory");
    }
}
__device__ __forceinline__ void prep_row(const float* xrow, bf16* orow, float* rs, int lane) {
    asm volatile("" : "+v"(lane));
    const f32x4* xr = (const f32x4*)xrow; v4u* o = (v4u*)orow; float s = 0.f;
#pragma unroll
    for (int j = 0; j < 8; ++j) { const int c = lane + 64 * j; const f32x4 a = xr[2 * c], b = xr[2 * c + 1];
        s += (a.x * a.x + a.y * a.y) + (a.z * a.z + a.w * a.w) + (b.x * b.x + b.y * b.y) + (b.z * b.z + b.w * b.w);
        v4u w; w.x = pk2(a.x, a.y); w.y = pk2(a.z, a.w); w.z = pk2(b.x, b.y); w.w = pk2(b.z, b.w); o[c] = w; }
    s = wave_sum(s); if (lane == 0) *rs = rsqrtf(s * (1.f / DM) + EPS);
}
template <bool FINAL>
__device__ __forceinline__ void post_row(const bf16* yrow, bf16* xrow, float* fout, const float* wpost, float* rs, int lane) {
    asm volatile("" : "+v"(lane));
    const v4u* yr = (const v4u*)yrow; v4u* xr = (v4u*)xrow; const f32x4* wp = (const f32x4*)wpost; v4u yv[8]; float s = 0.f;
#pragma unroll
    for (int j = 0; j < 8; ++j) { yv[j] = yr[lane + 64 * j]; const v4u w = yv[j];
        s += (bflo(w.x) * bflo(w.x) + bfhi(w.x) * bfhi(w.x)) + (bflo(w.y) * bflo(w.y) + bfhi(w.y) * bfhi(w.y)) + (bflo(w.z) * bflo(w.z) + bfhi(w.z) * bfhi(w.z)) + (bflo(w.w) * bflo(w.w) + bfhi(w.w) * bfhi(w.w)); }
    const float rstd = rsqrtf(wave_sum(s) * (1.f / DM) + EPS); float s2 = 0.f;
#pragma unroll
    for (int j = 0; j < 8; ++j) { const int c = lane + 64 * j; const v4u xw = xr[c], yw = yv[j]; const f32x4 wa = wp[2 * c], wb = wp[2 * c + 1];
        f32x4 a, b;
        a.x = bflo(xw.x) + bflo(yw.x) * rstd * wa.x; a.y = bfhi(xw.x) + bfhi(yw.x) * rstd * wa.y; a.z = bflo(xw.y) + bflo(yw.y) * rstd * wa.z; a.w = bfhi(xw.y) + bfhi(yw.y) * rstd * wa.w;
        b.x = bflo(xw.z) + bflo(yw.z) * rstd * wb.x; b.y = bfhi(xw.z) + bfhi(yw.z) * rstd * wb.y; b.z = bflo(xw.w) + bflo(yw.w) * rstd * wb.z; b.w = bfhi(xw.w) + bfhi(yw.w) * rstd * wb.w;
        if (FINAL) { ((f32x4*)fout)[2 * c] = a; ((f32x4*)fout)[2 * c + 1] = b; }
        else { s2 += (a.x * a.x + a.y * a.y) + (a.z * a.z + a.w * a.w) + (b.x * b.x + b.y * b.y) + (b.z * b.z + b.w * b.w);
            v4u w; w.x = pk2(a.x, a.y); w.y = pk2(a.z, a.w); w.z = pk2(b.x, b.y); w.w = pk2(b.z, b.w); xr[c] = w; } }
    if (!FINAL) { s2 = wave_sum(s2); if (lane == 0) *rs = rsqrtf(s2 * (1.f / DM) + EPS); }
}
__device__ __forceinline__ void ff_rows_mfma(const bf16* X, const bf16* WT, const float* RS, float* SMALLp, LAS unsigned char* lds, int tid, int lane, int wave) {
    typedef short bf16x8_ __attribute__((ext_vector_type(8))); typedef float f32x16_ __attribute__((ext_vector_type(16)));
    const int r = lane & 31, hh = lane >> 5; const int m = 8 * (int)blockIdx.x + (r & 7) + 2048 * (r >> 3);
    const bf16* xa = X + (size_t)m * DM + 512 * wave + 8 * hh; const bf16* wb = WT + (size_t)(r & 15) * DM + 512 * wave + 8 * hh;
    f32x16_ acc;
#pragma unroll
    for (int i = 0; i < 16; ++i) acc[i] = 0.f;
#pragma unroll 8
    for (int ks = 0; ks < 32; ++ks) { const bf16x8_ a = *(const bf16x8_*)(xa + 16 * ks); bf16x8_ b = *(const bf16x8_*)(wb + 16 * ks); if (r >= 16) b = (bf16x8_){0, 0, 0, 0, 0, 0, 0, 0};
        acc = __builtin_amdgcn_mfma_f32_32x32x16_bf16(a, b, acc, 0, 0, 0); }
    LAS float* P = (LAS float*)lds;
    if (r < 16) {
#pragma unroll
        for (int i = 0; i < 16; ++i) { const int rr = (i & 3) + 8 * (i >> 2) + 4 * hh; P[(wave * 32 + rr) * 16 + r] = acc[i]; } }
    __syncthreads();
    { const int rr = tid >> 4, c = tid & 15; float sacc = 0.f;
#pragma unroll
      for (int w = 0; w < 8; ++w) sacc += P[(w * 32 + rr) * 16 + c];
      const int mm = 8 * (int)blockIdx.x + (rr & 7) + 2048 * (rr >> 3);
      SMALLp[(size_t)mm * 256 + c] = sacc * RS[mm]; }
    __syncthreads();
}
__device__ __forceinline__ void convact_phase(const bf16* Z, const float* cw, const float* cb, bf16* ACT, int gtid, int ngt) {
    constexpr int CG = DFF / 8, RG = M / 8;
    for (int item = gtid; item < CG * RG; item += ngt) {
        const int cg = item % CG, rg = item / CG, c = cg * 8, r0 = rg * 8, t0 = r0 & (T - 1);
        float w[2][3][8], bb[2][8];
#pragma unroll
        for (int s = 0; s < 2; ++s) {
#pragma unroll
            for (int j = 0; j < 3; ++j) { const f32x4 a = *(const f32x4*)(cw + (size_t)j * 2 * DFF + s * DFF + c), b = *(const f32x4*)(cw + (size_t)j * 2 * DFF + s * DFF + c + 4);
                w[s][j][0] = a.x; w[s][j][1] = a.y; w[s][j][2] = a.z; w[s][j][3] = a.w; w[s][j][4] = b.x; w[s][j][5] = b.y; w[s][j][6] = b.z; w[s][j][7] = b.w; }
            const f32x4 a = *(const f32x4*)(cb + s * DFF + c), b = *(const f32x4*)(cb + s * DFF + c + 4);
            bb[s][0] = a.x; bb[s][1] = a.y; bb[s][2] = a.z; bb[s][3] = a.w; bb[s][4] = b.x; bb[s][5] = b.y; bb[s][6] = b.z; bb[s][7] = b.w; }
        float zm2[2][8], zm1[2][8];
#pragma unroll
        for (int s = 0; s < 2; ++s) {
            v4u a = (v4u){0u, 0u, 0u, 0u}, b = (v4u){0u, 0u, 0u, 0u};
            if (t0 >= 2) a = *(const v4u*)(Z + (size_t)(r0 - 2) * (2 * DFF) + s * DFF + c);
            if (t0 >= 1) b = *(const v4u*)(Z + (size_t)(r0 - 1) * (2 * DFF) + s * DFF + c);
            zm2[s][0] = bflo(a.x); zm2[s][1] = bfhi(a.x); zm2[s][2] = bflo(a.y); zm2[s][3] = bfhi(a.y); zm2[s][4] = bflo(a.z); zm2[s][5] = bfhi(a.z); zm2[s][6] = bflo(a.w); zm2[s][7] = bfhi(a.w);
            zm1[s][0] = bflo(b.x); zm1[s][1] = bfhi(b.x); zm1[s][2] = bflo(b.y); zm1[s][3] = bfhi(b.y); zm1[s][4] = bflo(b.z); zm1[s][5] = bfhi(b.z); zm1[s][6] = bflo(b.w); zm1[s][7] = bfhi(b.w); }
#pragma unroll
        for (int i = 0; i < 8; ++i) {
            float z0[2][8], u[2][8];
#pragma unroll
            for (int s = 0; s < 2; ++s) { const v4u a = *(const v4u*)(Z + (size_t)(r0 + i) * (2 * DFF) + s * DFF + c);
                z0[s][0] = bflo(a.x); z0[s][1] = bfhi(a.x); z0[s][2] = bflo(a.y); z0[s][3] = bfhi(a.y); z0[s][4] = bflo(a.z); z0[s][5] = bfhi(a.z); z0[s][6] = bflo(a.w); z0[s][7] = bfhi(a.w);
#pragma unroll
                for (int e = 0; e < 8; ++e) { u[s][e] = bb[s][e] + w[s][0][e] * zm2[s][e] + w[s][1][e] * zm1[s][e] + w[s][2][e] * z0[s][e]; zm2[s][e] = zm1[s][e]; zm1[s][e] = z0[s][e]; } }
            v4u o; o.x = pk2(silu(u[0][0]) * u[1][0], silu(u[0][1]) * u[1][1]); o.y = pk2(silu(u[0][2]) * u[1][2], silu(u[0][3]) * u[1][3]);
            o.z = pk2(silu(u[0][4]) * u[1][4], silu(u[0][5]) * u[1][5]); o.w = pk2(silu(u[0][6]) * u[1][6], silu(u[0][7]) * u[1][7]);
            *(v4u*)(ACT + (size_t)(r0 + i) * DFF + c) = o;
        }
    }
}
__device__ __forceinline__ void gdn_prep_naive(const bf16* proj, const float* small, const float* cw, const float* a_log, const float* dt_bias,
                                               float* QN, float* KN, float* VV, float* GG, float* BB, int gw, int ngw, int lane) {
    for (int item = gw; item < M * NH; item += ngw) {
        const int row = item >> 4, h = item & 15, t = row & (T - 1), b = row >> 11;
        float val[3][2];
#pragma unroll
        for (int s = 0; s < 3; ++s)
#pragma unroll
            for (int dd = 0; dd < 2; ++dd) { const int ch = s * 2048 + h * HD + lane + 64 * dd; float acc = 0.f;
#pragma unroll
                for (int j = 0; j < 4; ++j) { const int tt = t - 3 + j; if (tt >= 0) acc += cw[j * 6144 + ch] * bf2f(proj[(size_t)(row - 3 + j) * AB_LDP + A_QKV + ch]); }
                val[s][dd] = silu(acc); }
        const float qi = rsqrtf(wave_sum(val[0][0] * val[0][0] + val[0][1] * val[0][1]) + EPS) * QSCALE;
        const float ki = rsqrtf(wave_sum(val[1][0] * val[1][0] + val[1][1] * val[1][1]) + EPS);
        const size_t o = ((size_t)(b * NH + h) * T + t) * HD + lane;
        QN[o] = val[0][0] * qi; QN[o + 64] = val[0][1] * qi; KN[o] = val[1][0] * ki; KN[o + 64] = val[1][1] * ki; VV[o] = val[2][0]; VV[o + 64] = val[2][1];
        if (lane == 0) { const float a = small[(size_t)row * 256 + h]; GG[(b * NH + h) * T + t] = -__expf(a_log[h]) * softplus(a + dt_bias[h]); BB[(b * NH + h) * T + t] = sigm(small[(size_t)row * 256 + 16 + h]); }
    }
}
__device__ __forceinline__ void gdn_scan_naive(const float* QN, const float* KN, const float* VV, const float* GG, const float* BB, float* ORAW, int item, int lane) {
    const int bh = item >> 2, e = (item & 3) * 32 + (lane & 31), dh = (lane >> 5) * 64, b = bh >> 4, h = bh & 15;
    float S[64];
#pragma unroll
    for (int d = 0; d < 64; ++d) S[d] = 0.f;
    const float* qp = QN + (size_t)bh * T * HD + dh; const float* kp = KN + (size_t)bh * T * HD + dh; const float* vp = VV + (size_t)bh * T * HD;
    for (int t = 0; t < T; ++t) {
        const float eg = __expf(GG[bh * T + t]), beta = BB[bh * T + t], ve = vp[(size_t)t * HD + e];
        float k[64]; float dot = 0.f;
#pragma unroll
        for (int d4 = 0; d4 < 16; ++d4) { const f32x4 k4 = *(const f32x4*)(kp + (size_t)t * HD + 4 * d4);
#pragma unroll
            for (int i = 0; i < 4; ++i) { k[4 * d4 + i] = k4[i]; S[4 * d4 + i] *= eg; dot += S[4 * d4 + i] * k4[i]; } }
        dot += __shfl_xor(dot, 32);
        const float u = beta * (ve - dot); float o = 0.f;
#pragma unroll
        for (int d4 = 0; d4 < 16; ++d4) { const f32x4 q4 = *(const f32x4*)(qp + (size_t)t * HD + 4 * d4);
#pragma unroll
            for (int i = 0; i < 4; ++i) { S[4 * d4 + i] += k[4 * d4 + i] * u; o += S[4 * d4 + i] * q4[i]; } }
        o += __shfl_xor(o, 32);
        if (lane < 32) ORAW[(size_t)(b * T + t) * 2048 + h * HD + e] = o;
    }
}
__device__ __forceinline__ void headnorm_gate(const float* ORAW, const float* nw, const bf16* gate, int ldg, bf16* OBUF, int gw, int ngw, int lane) {
    for (int item = gw; item < M * NH; item += ngw) {
        const int row = item >> 4, h = item & 15;
        const float o0 = ORAW[(size_t)row * 2048 + h * HD + 2 * lane], o1 = ORAW[(size_t)row * 2048 + h * HD + 2 * lane + 1];
        const float rstd = rsqrtf(wave_sum(o0 * o0 + o1 * o1) * (1.f / HD) + EPS);
        const unsigned gwd = *(const unsigned*)(gate + (size_t)row * ldg + h * HD + 2 * lane);
        *(unsigned*)(OBUF + (size_t)row * DM + h * HD + 2 * lane) = pk2(o0 * rstd * nw[2 * lane] * silu(bflo(gwd)), o1 * rstd * nw[2 * lane + 1] * silu(bfhi(gwd)));
    }
}
__device__ __forceinline__ void hgrn_prep_naive(const bf16* proj, const float* lbl, float* FB, float* QB, int gw, int ngw, int lane) {
    for (int item = gw; item < M * NH; item += ngw) {
        const int row = item >> 4, h = item & 15, t = row & (T - 1), b = row >> 11;
#pragma unroll
        for (int dd = 0; dd < 2; ++dd) { const int c = h * HD + lane + 64 * dd; const float lb = sigm(lbl[2048 + c] - lbl[c]);
            const float fx = bf2f(proj[(size_t)row * CD_LDP + C_HF + c]), qx = bf2f(proj[(size_t)row * CD_LDP + C_HQ + c]);
            const size_t o = ((size_t)(b * NH + h) * T + t) * HD + lane + 64 * dd; FB[o] = lb + (1.f - lb) * sigm(fx); QB[o] = silu(qx); }
    }
}
__device__ __forceinline__ void hgrn_scan_naive(const float* FB, const float* QB, const bf16* proj, float* ORAW, int item, int lane) {
    const int bh = item >> 1, e = (item & 1) * 64 + lane, b = bh >> 4, h = bh & 15;
    float S[HD];
#pragma unroll
    for (int d = 0; d < HD; ++d) S[d] = 0.f;
    const float* fp = FB + (size_t)bh * T * HD; const float* qp = QB + (size_t)bh * T * HD;
    for (int t = 0; t < T; ++t) {
        const float ve = bf2f(proj[(size_t)(b * T + t) * CD_LDP + C_HI + h * HD + e]); float o = 0.f;
#pragma unroll
        for (int d4 = 0; d4 < HD / 4; ++d4) { const f32x4 f4 = *(const f32x4*)(fp + (size_t)t * HD + 4 * d4), q4 = *(const f32x4*)(qp + (size_t)t * HD + 4 * d4);
#pragma unroll
            for (int i = 0; i < 4; ++i) { S[4 * d4 + i] = f4[i] * S[4 * d4 + i] + (1.f - f4[i]) * ve; o += S[4 * d4 + i] * q4[i]; } }
        ORAW[(size_t)(b * T + t) * 2048 + h * HD + e] = o;
    }
}
__device__ __forceinline__ void fox_cum(const float* small, const float* fbias, float* CUM, int item, int lane) {
    const int b = item >> 4, h = item & 15; float loc[32]; float run = 0.f;
#pragma unroll
    for (int i = 0; i < 32; ++i) { run += logsigm(small[(size_t)(b * T + 32 * lane + i) * 256 + h] + fbias[h]); loc[i] = run; }
    float incl = run;
#pragma unroll
    for (int o = 1; o < 64; o <<= 1) { const float v = __shfl_up(incl, o); if (lane >= o) incl += v; }
    const float excl = incl - run;
#pragma unroll
    for (int i = 0; i < 32; ++i) CUM[(size_t)item * T + 32 * lane + i] = excl + loc[i];
}
struct RowAcc { float m, l, a0, a1; };
__device__ __forceinline__ float dot128(const LAS float* qs, const bf16* krow) {
    const v4u* kr = (const v4u*)krow; float dot = 0.f;
#pragma unroll
    for (int c = 0; c < 16; ++c) { const v4u w = kr[c]; const f32x4 qa = *(const LAS f32x4*)(qs + 8 * c), qb = *(const LAS f32x4*)(qs + 8 * c + 4);
        dot += bflo(w.x) * qa[0] + bfhi(w.x) * qa[1] + bflo(w.y) * qa[2] + bfhi(w.y) * qa[3] + bflo(w.z) * qb[0] + bfhi(w.z) * qb[1] + bflo(w.w) * qb[2] + bfhi(w.w) * qb[3]; }
    return dot;
}
__device__ __forceinline__ void attend_chunk(RowAcc& st, const LAS float* qs, const bf16* Kb, const bf16* Vb, size_t ld, int kb, int kmax, bool valid, float bias, LAS float* pbuf, int lane) {
    int key = kb + lane; key = key < 0 ? 0 : (key > kmax ? kmax : key);
    const float dot = dot128(qs, Kb + (size_t)key * ld);
    const float s = valid ? dot + bias : -INFINITY;
    const float cm = wave_max(s);
    if (cm == -INFINITY) return;
    const float mn = fmaxf(st.m, cm), corr = __expf(st.m - mn), p = valid ? __expf(s - mn) : 0.f;
    st.l = st.l * corr + wave_sum(p); st.m = mn; st.a0 *= corr; st.a1 *= corr;
    asm volatile("s_waitcnt lgkmcnt(0)" ::: "memory"); pbuf[lane] = p; asm volatile("s_waitcnt lgkmcnt(0)" ::: "memory");
    for (int j = 0; j < 64; ++j) { const float pj = pbuf[j]; int kj = kb + j; kj = kj < 0 ? 0 : (kj > kmax ? kmax : kj);
        const unsigned w = *(const unsigned*)(Vb + (size_t)kj * ld + 2 * lane); st.a0 += pj * bflo(w); st.a1 += pj * bfhi(w); }
    asm volatile("s_waitcnt lgkmcnt(0)" ::: "memory");
}
__device__ __forceinline__ void fox_attn_naive(const bf16* proj, const float* CUM, bf16* OBUF, LAS float* wl, int gw, int ngw, int lane) {
    LAS float* qs = wl; LAS float* pbuf = wl + 128;
    for (int item = gw; item < M * NH; item += ngw) {
        const int row = item >> 4, h = item & 15, t = row & (T - 1), b = row >> 11;
        const unsigned qw = *(const unsigned*)(proj + (size_t)row * CD_LDP + C_FQ + h * HD + 2 * lane);
        asm volatile("s_waitcnt lgkmcnt(0)" ::: "memory"); qs[2 * lane] = bflo(qw) * QSCALE; qs[2 * lane + 1] = bfhi(qw) * QSCALE; asm volatile("s_waitcnt lgkmcnt(0)" ::: "memory");
        const bf16* Kb = proj + (size_t)b * T * CD_LDP + C_FK + h * HD; const bf16* Vb = proj + (size_t)b * T * CD_LDP + C_FV + h * HD;
        const float* cum = CUM + (size_t)(b * NH + h) * T; const float cq = cum[t];
        RowAcc st{-INFINITY, 0.f, 0.f, 0.f};
        for (int kb = 0; kb <= t; kb += 64) { const int key = kb + lane; const bool valid = key <= t; attend_chunk(st, qs, Kb, Vb, CD_LDP, kb, T - 1, valid, cq - cum[key > T - 1 ? T - 1 : key], pbuf, lane); }
        const float il = 1.f / st.l;
        *(unsigned*)(OBUF + (size_t)row * DM + 2048 + h * HD + 2 * lane) = pk2(st.a0 * il, st.a1 * il);
    }
}
__device__ __forceinline__ void nsa_compress_naive(const bf16* proj, const float* pe_k, const float* pe_v, const float* wk1, const float* wk2, const float* wv1, const float* wv2,
                                                   bf16* KC, bf16* VC, LAS float* lf, int tid) {
    for (int item = blockIdx.x; item < 16 * NCMP * 2; item += gridDim.x) {
        const int kv = item & 1, r = item >> 1, n = r % NCMP, bg = r / NCMP, b = bg >> 2, g = bg & 3;
        const float* pe = kv ? pe_v : pe_k; const float* w1 = kv ? wv1 : wk1; const float* w2 = kv ? wv2 : wk2;
        const int j = tid & 127, part = tid >> 7; float acc = 0.f;
        for (int i = part * 1024; i < part * 1024 + 1024; ++i) { const int l = i >> 7, d = i & 127;
            const float z = bf2f(proj[(size_t)(b * T + 16 * n + l) * AB_LDP + A_NKV + kv * 512 + g * HD + d]) + pe[i];
            acc += z * w1[(size_t)i * HD + j]; }
        lf[part * 128 + j] = acc;
        __syncthreads();
        if (tid < 128) { const float hsum = lf[j] + lf[128 + j] + lf[256 + j] + lf[384 + j]; lf[512 + j] = silu(hsum); }
        __syncthreads();
        if (tid < 128) { float o = 0.f; for (int i = 0; i < 128; ++i) o += lf[512 + i] * w2[i * HD + j]; if (kv) VC[((size_t)bg * 128 + j) * 128 + (n & ~15) + ((n >> 2) & 1) * 8 + ((n & 15) >> 3) * 4 + (n & 3)] = (bf16)f2bf(o); else KC[((size_t)bg * 128 + n) * HD + j] = (bf16)f2bf(o); }
        __syncthreads();
    }
}
__device__ __forceinline__ void nsa_cmp_naive(const bf16* proj, const bf16* KC, const bf16* VC, float* OCMP, unsigned* SEL, LAS float* wl, int gw, int ngw, int lane) {
    LAS float* qs = wl; LAS float* pbuf = wl + 128;
    for (int item = gw; item < M * 4; item += ngw) {
        const int row = item >> 2, g = item & 3, t = row & (T - 1), b = row >> 11, bg = b * 4 + g;
        const bf16* Kb = KC + (size_t)bg * 128 * HD; const bf16* Vb = VC + (size_t)bg * 128 * HD;
        const int n0 = lane, n1 = lane + 64; const bool v0 = 16 * n0 + 31 <= t, v1 = (n1 < NCMP) && (16 * n1 + 31 <= t);
        float ps0 = 0.f, ps1 = 0.f;
        for (int p = 0; p < 4; ++p) {
            const int head = g * 4 + p;
            const unsigned qw = *(const unsigned*)(proj + (size_t)row * AB_LDP + A_NQ + head * HD + 2 * lane);
            asm volatile("s_waitcnt lgkmcnt(0)" ::: "memory"); qs[2 * lane] = bflo(qw) * QSCALE; qs[2 * lane + 1] = bfhi(qw) * QSCALE; asm volatile("s_waitcnt lgkmcnt(0)" ::: "memory");
            const float s0 = v0 ? dot128(qs, Kb + (size_t)n0 * HD) : -INFINITY, s1 = v1 ? dot128(qs, Kb + (size_t)(n1 < 128 ? n1 : 127) * HD) : -INFINITY;
            const float mx = wave_max(fmaxf(s0, s1)); float p0 = 0.f, p1 = 0.f;
            if (mx != -INFINITY) { const float e0 = v0 ? __expf(s0 - mx) : 0.f, e1 = v1 ? __expf(s1 - mx) : 0.f; const float il = 1.f / wave_sum(e0 + e1); p0 = e0 * il; p1 = e1 * il; }
            ps0 += p0; ps1 += p1;
            pbuf[lane] = p0; pbuf[64 + lane] = p1; asm volatile("s_waitcnt lgkmcnt(0)" ::: "memory");
            float a0 = 0.f, a1 = 0.f;
            for (int n = 0; n < NCMP; ++n) { const float pj = pbuf[n]; const unsigned w = *(const unsigned*)(Vb + (size_t)n * HD + 2 * lane); a0 += pj * bflo(w); a1 += pj * bfhi(w); }
            *(float2*)(OCMP + (size_t)row * 2048 + head * HD + 2 * lane) = make_float2(a0, a1);
            asm volatile("s_waitcnt lgkmcnt(0)" ::: "memory");
        }
        pbuf[lane] = ps0; pbuf[64 + lane] = ps1; asm volatile("s_waitcnt lgkmcnt(0)" ::: "memory");
        const int cur = t >> 6, m = lane; float sc = -INFINITY;
        if (m < 32 && m <= cur) {
            if (m == 0 || m == cur || m == cur - 1) sc = 1e4f;
            else { float im = 0.f; for (int n = 4 * m - 1; n <= 4 * m + 3; ++n) if (n >= 0 && n < NCMP) im += pbuf[n]; sc = im; }
        }
        unsigned mask = 0u;
        for (int r = 0; r < 8; ++r) { const float mx = wave_max(sc); if (mx == -INFINITY) break;
            const unsigned long long ball = __ballot(sc == mx); const int idx = __ffsll((long long)ball) - 1; mask |= 1u << idx; if (lane == idx) sc = -INFINITY; }
        if (lane == 0) SEL[(size_t)bg * T + t] = mask;
        asm volatile("s_waitcnt lgkmcnt(0)" ::: "memory");
    }
}
__device__ __forceinline__ void nsa_slcwin_naive(const bf16* proj, const float* small, const float* OCMP, const unsigned* SEL, bf16* OBUF, LAS float* wl, int gw, int ngw, int lane) {
    LAS float* qs = wl; LAS float* pbuf = wl + 128;
    for (int item = gw; item < M * NH; item += ngw) {
        const int row = item >> 4, head = item & 15, g = head >> 2, t = row & (T - 1), b = row >> 11;
        const unsigned qw = *(const unsigned*)(proj + (size_t)row * AB_LDP + A_NQ + head * HD + 2 * lane);
        asm volatile("s_waitcnt lgkmcnt(0)" ::: "memory"); qs[2 * lane] = bflo(qw) * QSCALE; qs[2 * lane + 1] = bfhi(qw) * QSCALE; asm volatile("s_waitcnt lgkmcnt(0)" ::: "memory");
        const bf16* base = proj + (size_t)b * T * AB_LDP + A_NKV + g * HD;
        const unsigned sel = SEL[(size_t)(b * 4 + g) * T + t]; const int cur = t >> 6;
        RowAcc ss{-INFINITY, 0.f, 0.f, 0.f};
        for (int m = 0; m <= cur; ++m) if ((sel >> m) & 1u) { const int key = 64 * m + lane; attend_chunk(ss, qs, base + 2 * 512, base + 3 * 512, AB_LDP, 64 * m, T - 1, key <= t, 0.f, pbuf, lane); }
        RowAcc sw{-INFINITY, 0.f, 0.f, 0.f};
        const int first = t - 511 > 0 ? t - 511 : 0;
        for (int kb = first & ~63; kb <= t; kb += 64) { const int key = kb + lane; attend_chunk(sw, qs, base + 4 * 512, base + 5 * 512, AB_LDP, kb, T - 1, key >= first && key <= t, 0.f, pbuf, lane); }
        const float gc = sigm(small[(size_t)row * 256 + 32 + head]), gs = sigm(small[(size_t)row * 256 + 48 + head]), gwn = sigm(small[(size_t)row * 256 + 64 + head]);
        const float2 oc = *(const float2*)(OCMP + (size_t)row * 2048 + head * HD + 2 * lane);
        const float is = gs / ss.l, iw = gwn / sw.l;
        *(unsigned*)(OBUF + (size_t)row * DM + 2048 + head * HD + 2 * lane) = pk2(gc * oc.x + is * ss.a0 + iw * sw.a0, gc * oc.y + is * ss.a1 + iw * sw.a1);
    }
}
typedef short bf16x8 __attribute__((ext_vector_type(8)));
typedef float f32x16 __attribute__((ext_vector_type(16)));
#define MFMA32(a, b, c) __builtin_amdgcn_mfma_f32_32x32x16_bf16((a), (b), (c), 0, 0, 0)
constexpr float LOG2E = 1.4426950408889634f, C1 = QSCALE * LOG2E;
constexpr int AT_K = 0, AT_V = 16384, AT_CK = 32768;
__device__ __forceinline__ void vt_transpose(const bf16* src, int ld, int col0, int nh, bf16* VT, int gtid, int ngt) {
    const int total = NB * nh * 128 * (T / 8);
    for (int idx = gtid; idx < total; idx += ngt) {
        const int d = idx & 127, tc = (idx >> 7) & 255, bh = idx >> 15, b = bh / nh, hh = bh % nh;
        unsigned short e[8];
#pragma unroll
        for (int j = 0; j < 8; ++j) { const int p = 8 * tc + j, pp = p & 15, h2 = pp >> 3, jj = pp & 7, t = (p & ~15) + 8 * (jj >> 2) + 4 * h2 + (jj & 3);
            e[j] = src[(size_t)(b * T + t) * ld + col0 + hh * 128 + d]; }
        v4u o; o.x = e[0] | ((unsigned)e[1] << 16); o.y = e[2] | ((unsigned)e[3] << 16); o.z = e[4] | ((unsigned)e[5] << 16); o.w = e[6] | ((unsigned)e[7] << 16);
        *(v4u*)(VT + ((size_t)bh * 128 + d) * T + 8 * tc) = o;
    }
}
__device__ __forceinline__ void qk_tile(const LAS unsigned char* ldk, const bf16x8 (&qf)[8], f32x16 (&s)[2], int lane) {
    const int r = lane & 31; int y = (lane >> 5) ^ (r & 15); asm volatile("" : "+v"(y));
    const LAS unsigned char* base = ldk + r * 256;
#pragma unroll
    for (int i = 0; i < 16; ++i) { s[0][i] = 0.f; s[1][i] = 0.f; }
#pragma unroll
    for (int ks = 0; ks < 8; ++ks)
#pragma unroll
        for (int rb = 0; rb < 2; ++rb) {
            const bf16x8 a = *(const LAS bf16x8*)(base + rb * 8192 + (((2 * ks) ^ y) << 4));
            s[rb] = MFMA32(a, qf[ks], s[rb]); }
}
__device__ __forceinline__ void qk_tile_lq(const LAS unsigned char* ldk, const LAS unsigned char* ldq, f32x16 (&s)[2], int lane) {
    const int r = lane & 31; int y = (lane >> 5) ^ (r & 15); asm volatile("" : "+v"(y));
    const LAS unsigned char* base = ldk + r * 256; const LAS unsigned char* qb = ldq + r * 256;
#pragma unroll
    for (int i = 0; i < 16; ++i) { s[0][i] = 0.f; s[1][i] = 0.f; }
#pragma unroll
    for (int ks = 0; ks < 8; ++ks) { const bf16x8 q = *(const LAS bf16x8*)(qb + (((2 * ks) ^ y) << 4));
#pragma unroll
        for (int rb = 0; rb < 2; ++rb) {
            const bf16x8 a = *(const LAS bf16x8*)(base + rb * 8192 + (((2 * ks) ^ y) << 4));
            s[rb] = MFMA32(a, q, s[rb]); }
        if ((ks & 3) == 3) __builtin_amdgcn_sched_barrier(0); }
}
__device__ __forceinline__ void pv_tile(const LAS unsigned char* ldv, const f32x16 (&p)[2], f32x16 (&O)[4], int lane) {
    const int r = lane & 31; int y = (lane >> 5) ^ ((r >> 1) & 7); asm volatile("" : "+v"(y));
    const LAS unsigned char* base = ldv + r * 128;
    bf16x8 pf[2][2];
#pragma unroll
    for (int rb = 0; rb < 2; ++rb)
#pragma unroll
        for (int st = 0; st < 2; ++st) { v4u w; w.x = cvtpk(p[rb][8 * st + 0], p[rb][8 * st + 1]); w.y = cvtpk(p[rb][8 * st + 2], p[rb][8 * st + 3]); w.z = cvtpk(p[rb][8 * st + 4], p[rb][8 * st + 5]); w.w = cvtpk(p[rb][8 * st + 6], p[rb][8 * st + 7]);
            pf[rb][st] = __builtin_bit_cast(bf16x8, w); }
#pragma unroll
    for (int db = 0; db < 4; ++db) {
#pragma unroll
        for (int kk = 0; kk < 4; ++kk) { const bf16x8 a = *(const LAS bf16x8*)(base + db * 4096 + (((2 * kk) ^ y) << 4));
            O[db] = MFMA32(a, pf[kk >> 1][kk & 1], O[db]); } }
}
struct TileRegs { v4u k[2], v[2]; float ck; };
__device__ __forceinline__ void tile_fetch(TileRegs& R, const bf16* Kg  , size_t ldk, const bf16* Vg  , size_t ldv, const float* ckg, int tid) {
#pragma unroll
    for (int i = 0; i < 2; ++i) { const int id = tid + 512 * i; R.k[i] = *(const v4u*)(Kg + (size_t)(id >> 4) * ldk + (id & 15) * 8); R.v[i] = *(const v4u*)(Vg + (size_t)(id >> 3) * ldv + (id & 7) * 8); }
    R.ck = (ckg && tid < 64) ? ckg[tid] * LOG2E : 0.f;
}
__device__ __forceinline__ void tile_commit(const TileRegs& R, LAS unsigned char* ldk, LAS unsigned char* ldv, LAS unsigned char* ldc, int tid) {
#pragma unroll
    for (int i = 0; i < 2; ++i) { const int id = tid + 512 * i; const int key = id >> 4, c = id & 15, d = id >> 3, c2 = id & 7;
        *(LAS v4u*)(ldk + key * 256 + ((c ^ (key & 15)) * 16)) = R.k[i];
        *(LAS v4u*)(ldv + d * 128 + ((c2 ^ ((d >> 1) & 7)) * 16)) = R.v[i]; }
    if (ldc && tid < 64) *(LAS float*)(ldc + tid * 4) = R.ck;
}
__device__ __forceinline__ void tile_dma(const bf16* Kg, size_t ldk, const bf16* Vg, size_t ldv, LAS unsigned char* dk, LAS unsigned char* dv, int wave, int lane) {
#pragma unroll
    for (int i = 0; i < 2; ++i) { const int piece = wave * 2 + i;
        const int krow = 4 * piece + (lane >> 4), kc = (lane & 15) ^ (krow & 15);
        __builtin_amdgcn_global_load_lds((const unsigned*)(Kg + (size_t)krow * ldk + kc * 8), (LAS unsigned*)(dk + piece * 1024), 16, 0, 0);
        const int d = 8 * piece + (lane >> 3), vc = (lane & 7) ^ ((d >> 1) & 7);
        __builtin_amdgcn_global_load_lds((const unsigned*)(Vg + (size_t)d * ldv + vc * 8), (LAS unsigned*)(dv + piece * 1024), 16, 0, 0); }
}
constexpr int AT3_CK = 3 * 32768;
constexpr int AT_B1 = 32768, AT_CK0 = 65536, AT_CK1 = 65536 + 256;
__device__ __forceinline__ void fox_attn_mfma(const bf16* proj, const bf16* VTG, const float* CUM, bf16* OBUF, LAS unsigned char* lds, int tid, int lane, int wave) {
    const int r = lane & 31, hh = lane >> 5;
    for (int idx = blockIdx.x; idx < 512; idx += gridDim.x) {
        const int bh = idx & 63, qq = idx >> 6, qt = qq < 4 ? qq : 11 - qq, b = bh >> 4, h = bh & 15, q0 = qt * 256, wq0 = q0 + 32 * wave, qi = wq0 + r;
        bf16x8 qf[8];
#pragma unroll
        for (int ks = 0; ks < 8; ++ks) qf[ks] = *(const bf16x8*)(proj + (size_t)(b * T + qi) * CD_LDP + C_FQ + h * HD + 16 * ks + 8 * hh);
        const float cq2 = CUM[(size_t)bh * T + qi] * LOG2E;
        float m = -INFINITY, l = 0.f; f32x16 O[4];
#pragma unroll
        for (int db = 0; db < 4; ++db)
#pragma unroll
            for (int i = 0; i < 16; ++i) O[db][i] = 0.f;
        const bf16* Kg = proj + (size_t)b * T * CD_LDP + C_FK + h * HD; const bf16* Vg = VTG + (size_t)bh * 128 * T; const float* ckg = CUM + (size_t)bh * T;
        const int ntiles = 4 * qt + 4;
        __syncthreads();
        tile_dma(Kg, CD_LDP, Vg, T, lds + AT_K, lds + AT_V, wave, lane);
        if (wave == 0) __builtin_amdgcn_global_load_lds((const unsigned*)(ckg + lane), (LAS unsigned*)(lds + AT3_CK), 4, 0, 0);
        tile_dma(Kg + (size_t)64 * CD_LDP, CD_LDP, Vg + 64, T, lds + AT_K + AT_B1, lds + AT_V + AT_B1, wave, lane);
        if (wave == 0) __builtin_amdgcn_global_load_lds((const unsigned*)(ckg + 64 + lane), (LAS unsigned*)(lds + AT3_CK + 256), 4, 0, 0);
        for (int kt = 0, buf = 0; kt < ntiles; ++kt, buf = buf == 2 ? 0 : buf + 1) {
            const int bo = buf * AT_B1, cko = AT3_CK + buf * 256;
            if (kt + 1 < ntiles) { if (wave == 0) asm volatile("s_waitcnt vmcnt(5)" ::: "memory"); else asm volatile("s_waitcnt vmcnt(4)" ::: "memory"); }
            else asm volatile("s_waitcnt vmcnt(0)" ::: "memory");
            __syncthreads();
            if (kt + 2 < ntiles) { const int b2 = buf == 0 ? 2 : buf - 1;
                tile_dma(Kg + (size_t)(kt + 2) * 64 * CD_LDP, CD_LDP, Vg + (kt + 2) * 64, T, lds + AT_K + b2 * AT_B1, lds + AT_V + b2 * AT_B1, wave, lane);
                if (wave == 0) __builtin_amdgcn_global_load_lds((const unsigned*)(ckg + (kt + 2) * 64 + lane), (LAS unsigned*)(lds + AT3_CK + b2 * 256), 4, 0, 0); }
            if (kt * 64 <= wq0 + 31) {
                f32x16 s[2]; qk_tile(lds + AT_K + bo, qf, s, lane);
                const bool full = kt * 64 + 63 <= wq0; float mx = -INFINITY;
#pragma unroll
                for (int rb = 0; rb < 2; ++rb)
#pragma unroll
                    for (int g4 = 0; g4 < 4; ++g4) { const f32x4 ck4 = *(const LAS f32x4*)(lds + cko + (32 * rb + 8 * g4 + 4 * hh) * 4);
#pragma unroll
                        for (int e = 0; e < 4; ++e) { const int i = 4 * g4 + e, key = kt * 64 + 32 * rb + 8 * g4 + 4 * hh + e;
                            float v = s[rb][i] * C1 + (cq2 - ck4[e] * LOG2E); if (!full && key > qi) v = -INFINITY; s[rb][i] = v; mx = fmaxf(mx, v); } }
                mx = fmaxf(mx, __shfl_xor(mx, 32));
                if (!__all(mx - m <= 8.f)) {
                    const float mn = fmaxf(m, mx), corr = __builtin_amdgcn_exp2f(m - mn); m = mn; l *= corr;
#pragma unroll
                    for (int db = 0; db < 4; ++db)
#pragma unroll
                        for (int i = 0; i < 16; ++i) O[db][i] *= corr;
                }
                float ls = 0.f;
#pragma unroll
                for (int rb = 0; rb < 2; ++rb)
#pragma unroll
                    for (int i = 0; i < 16; ++i) { const float p = __builtin_amdgcn_exp2f(s[rb][i] - m); s[rb][i] = p; ls += p; }
                l += ls;
                pv_tile(lds + AT_V + bo, s, O, lane);
            }
        }
        l += __shfl_xor(l, 32); const float il = 1.f / l;
        bf16* orow = OBUF + (size_t)(b * T + qi) * DM + 2048 + h * HD;
#pragma unroll
        for (int db = 0; db < 4; ++db)
#pragma unroll
            for (int g4 = 0; g4 < 4; ++g4) { v2u w; w.x = cvtpk(O[db][4 * g4] * il, O[db][4 * g4 + 1] * il); w.y = cvtpk(O[db][4 * g4 + 2] * il, O[db][4 * g4 + 3] * il);
                *(v2u*)(orow + 32 * db + 8 * g4 + 4 * hh) = w; }
    }
}

__device__ __forceinline__ void softmax_update(f32x16 (&s)[2], float& m, float& l, f32x16 (&O)[4]) {
    float mx = -INFINITY;
#pragma unroll
    for (int rb = 0; rb < 2; ++rb)
#pragma unroll
        for (int i = 0; i < 16; ++i) mx = fmaxf(mx, s[rb][i]);
    mx = fmaxf(mx, __shfl_xor(mx, 32));
    if (!__all(mx - m <= 8.f)) {
        const float mn = fmaxf(m, mx), ms = (mn == -INFINITY) ? 0.f : mn, corr = __builtin_amdgcn_exp2f(m - ms); m = mn; l *= corr;
#pragma unroll
        for (int db = 0; db < 4; ++db)
#pragma unroll
            for (int i = 0; i < 16; ++i) O[db][i] *= corr;
    }
    const float ms = (m == -INFINITY) ? 0.f : m; float ls = 0.f;
#pragma unroll
    for (int rb = 0; rb < 2; ++rb)
#pragma unroll
        for (int i = 0; i < 16; ++i) { const float p = __builtin_amdgcn_exp2f(s[rb][i] - ms); s[rb][i] = p; ls += p; }
    l += ls;
}
#define NS_ROWPTRS() int rr_ = lane & 31; asm volatile("" : "+v"(rr_)); const size_t row_ = (size_t)(b * T + 64 * c + 32 * th + rr_); bf16* oacc = OACC + row_ * 2048 + head * HD; const float* smr = small + row_ * 256 + head
constexpr int NS_K0 = 0, NS_V0 = 16384, NS_K1 = 32768, NS_V1 = 49152, NS_Q = 65536, NS_IMP = 131072 + 512, NS_SEL = NS_IMP + 64 * 33 * 4, NS_UNI = NS_SEL + 256;
static_assert(NS_UNI + 4 <= LDS_BYTES, "NSA LDS map");
__device__ __forceinline__ void nsa_attn_mfma(const bf16* proj, const float* small, const bf16* KC, const bf16* VCT, const bf16* VTS, const bf16* VTW, bf16* OACC, bf16* OBUF, LAS unsigned char* lds, int tid, int lane, int wave) {
    const int p = wave >> 1, th = wave & 1;
    LAS float* IMP = (LAS float*)(lds + NS_IMP); LAS unsigned* SELM = (LAS unsigned*)(lds + NS_SEL); LAS unsigned* UNI = (LAS unsigned*)(lds + NS_UNI);
    for (int idx = blockIdx.x; idx < 512; idx += gridDim.x) {
        asm volatile("" : "+v"(lane), "+v"(tid));
        const int r = lane & 31, hh = lane >> 5;
        const int bg = idx & 15, cc = idx >> 4, c = cc < 16 ? cc : 47 - cc, b = bg >> 2, g = bg & 3, head = 4 * g + p, tok = 32 * th + r, t = 64 * c + tok;
        __syncthreads();
        bf16x8 qf[8];
#pragma unroll
        for (int ks = 0; ks < 8; ++ks) qf[ks] = *(const bf16x8*)(proj + (size_t)(b * T + t) * AB_LDP + A_NQ + head * HD + 16 * ks + 8 * hh);
        for (int i = tid; i < 64 * 33; i += NTHR) IMP[i] = 0.f;
        if (tid == 0) UNI[0] = 0u;
        const int ncmp_t = c >= 16 ? 2 : 1;
        { TileRegs R;
          tile_fetch(R, KC + (size_t)bg * 128 * HD, HD, VCT + (size_t)bg * 128 * 128, 128, nullptr, tid); tile_commit(R, lds + NS_K0, lds + NS_V0, nullptr, tid);
          if (ncmp_t == 2) { tile_fetch(R, KC + (size_t)bg * 128 * HD + 64 * HD, HD, VCT + (size_t)bg * 128 * 128 + 64, 128, nullptr, tid); tile_commit(R, lds + NS_K1, lds + NS_V1, nullptr, tid); } }
        __syncthreads();
        float mC = -INFINITY, lC = 0.f;
        for (int tl = 0; tl < ncmp_t; ++tl) {
            f32x16 s[2]; qk_tile(lds + (tl ? NS_K1 : NS_K0), qf, s, lane); float mx = -INFINITY;
#pragma unroll
            for (int rb = 0; rb < 2; ++rb)
#pragma unroll
                for (int i = 0; i < 16; ++i) { const int n = 64 * tl + 32 * rb + (i & 3) + 8 * (i >> 2) + 4 * hh; float v = s[rb][i] * C1; if (16 * n + 31 > t) v = -INFINITY; s[rb][i] = v; mx = fmaxf(mx, v); }
            mx = fmaxf(mx, __shfl_xor(mx, 32));
            const float mn = fmaxf(mC, mx), ms = (mn == -INFINITY) ? 0.f : mn; float ls = 0.f;
#pragma unroll
            for (int rb = 0; rb < 2; ++rb)
#pragma unroll
                for (int i = 0; i < 16; ++i) ls += __builtin_amdgcn_exp2f(s[rb][i] - ms);
            ls += __shfl_xor(ls, 32);
            lC = lC * __builtin_amdgcn_exp2f(mC - ms) + ls; mC = mn;
        }
        { const float ms = (mC == -INFINITY) ? 0.f : mC, il = lC > 0.f ? 1.f / lC : 0.f; float gc; { NS_ROWPTRS(); gc = sigm(smr[32]); }
          f32x16 OC[4];
#pragma unroll
          for (int db = 0; db < 4; ++db)
#pragma unroll
              for (int i = 0; i < 16; ++i) OC[db][i] = 0.f;
          for (int tl = 0; tl < ncmp_t; ++tl) {
            f32x16 s[2]; qk_tile(lds + (tl ? NS_K1 : NS_K0), qf, s, lane);
#pragma unroll
            for (int rb = 0; rb < 2; ++rb)
#pragma unroll
                for (int g4 = 0; g4 < 4; ++g4) { float grp = 0.f, last = 0.f;
#pragma unroll
                    for (int e = 0; e < 4; ++e) { const int i = 4 * g4 + e, n = 64 * tl + 32 * rb + 8 * g4 + 4 * hh + e; float v = s[rb][i] * C1; if (16 * n + 31 > t) v = -INFINITY;
                        const float pr = __builtin_amdgcn_exp2f(v - ms) * il; s[rb][i] = pr * gc; grp += pr; last = pr; }
                    const int mb = 16 * tl + 8 * rb + 2 * g4 + hh;
                    __hip_atomic_fetch_add(&IMP[tok * 33 + mb], grp, __ATOMIC_RELAXED, __HIP_MEMORY_SCOPE_WORKGROUP); if (mb + 1 < 32) __hip_atomic_fetch_add(&IMP[tok * 33 + mb + 1], last, __ATOMIC_RELAXED, __HIP_MEMORY_SCOPE_WORKGROUP); }
            pv_tile(lds + (tl ? NS_V1 : NS_V0), s, OC, lane);
          }
          NS_ROWPTRS();
#pragma unroll
          for (int db = 0; db < 4; ++db)
#pragma unroll
              for (int g4 = 0; g4 < 4; ++g4) { v2u w; w.x = cvtpk(OC[db][4 * g4], OC[db][4 * g4 + 1]); w.y = cvtpk(OC[db][4 * g4 + 2], OC[db][4 * g4 + 3]); *(v2u*)(oacc + 32 * db + 8 * g4 + 4 * hh) = w; }
        }
        __syncthreads();
        if (tid < 64) {
            unsigned sel = 1u | (1u << c) | (c >= 1 ? (1u << (c - 1)) : 0u); const int need = 8 - __popc(sel);
            for (int rr = 0; rr < need; ++rr) { int best = -1; float bv = -1.f;
                for (int mm = 1; mm <= c - 2; ++mm) if (!((sel >> mm) & 1u)) { const float v = IMP[tid * 33 + mm]; if (v > bv) { bv = v; best = mm; } }
                if (best < 0) break; sel |= 1u << best; }
            SELM[tid] = sel; __hip_atomic_fetch_or(UNI, sel, __ATOMIC_RELAXED, __HIP_MEMORY_SCOPE_WORKGROUP);
        }
        __syncthreads();
        const unsigned uni = UNI[0], mysel = SELM[tok];
        const bf16* kvb = proj + (size_t)b * T * AB_LDP + A_NKV + g * HD;
        {
            float m = -INFINITY, l = 0.f; f32x16 O[4];
#pragma unroll
            for (int db = 0; db < 4; ++db)
#pragma unroll
                for (int i = 0; i < 16; ++i) O[db][i] = 0.f;
            const bf16* Vg = VTS + (size_t)bg * 128 * T;
            tile_dma(kvb + 2 * 512, AB_LDP, Vg, T, lds + NS_K0, lds + NS_V0, wave, lane);
            for (int mt = 0, bo = 0; mt >= 0; bo ^= AT_B1) {
                const unsigned rest = (mt >= 31) ? 0u : ((uni >> (mt + 1)) << (mt + 1)); const int nx = rest ? (int)__builtin_ctz(rest) : -1;
                asm volatile("s_waitcnt vmcnt(0)" ::: "memory"); __syncthreads();
                if (nx >= 0) tile_dma(kvb + 2 * 512 + (size_t)nx * 64 * AB_LDP, AB_LDP, Vg + nx * 64, T, lds + NS_K0 + (bo ^ AT_B1), lds + NS_V0 + (bo ^ AT_B1), wave, lane);
                const bool mine = (mysel >> mt) & 1u;
                if (__ballot(mine) != 0ull) {
                    f32x16 s[2]; qk_tile(lds + NS_K0 + bo, qf, s, lane);
                    const float mbias = mine ? 0.f : -INFINITY;
                    if (mt == c) {
#pragma unroll
                        for (int rb = 0; rb < 2; ++rb)
#pragma unroll
                            for (int i = 0; i < 16; ++i) { const int key = 64 * mt + 32 * rb + (i & 3) + 8 * (i >> 2) + 4 * hh; float v = fmaf(s[rb][i], C1, mbias); if (key > t) v = -INFINITY; s[rb][i] = v; }
                    } else {
#pragma unroll
                        for (int rb = 0; rb < 2; ++rb)
#pragma unroll
                            for (int i = 0; i < 16; ++i) s[rb][i] = fmaf(s[rb][i], C1, mbias);
                    }
                    softmax_update(s, m, l, O);
                    pv_tile(lds + NS_V0 + bo, s, O, lane);
                }
                mt = nx;
            }
            l += __shfl_xor(l, 32); NS_ROWPTRS(); const float sc = sigm(smr[48]) / l;
#pragma unroll
            for (int db = 0; db < 4; ++db)
#pragma unroll
                for (int g4 = 0; g4 < 4; ++g4) { v2u* pa = (v2u*)(oacc + 32 * db + 8 * g4 + 4 * hh); const v2u a = *pa; v2u w;
                    w.x = cvtpk(bflo(a.x) + O[db][4 * g4] * sc, bfhi(a.x) + O[db][4 * g4 + 1] * sc); w.y = cvtpk(bflo(a.y) + O[db][4 * g4 + 2] * sc, bfhi(a.y) + O[db][4 * g4 + 3] * sc); *pa = w; }
        }
        {
            float m = -INFINITY, l = 0.f; f32x16 O[4];
#pragma unroll
            for (int db = 0; db < 4; ++db)
#pragma unroll
                for (int i = 0; i < 16; ++i) O[db][i] = 0.f;
            const bf16* Vg = VTW + (size_t)bg * 128 * T;
            const int kt0 = c >= 8 ? c - 8 : 0;
            __syncthreads();
            tile_dma(kvb + 4 * 512 + (size_t)kt0 * 64 * AB_LDP, AB_LDP, Vg + kt0 * 64, T, lds + NS_K0, lds + NS_V0, wave, lane);
            for (int kt = kt0, bo = 0; kt <= c; ++kt, bo ^= AT_B1) {
                asm volatile("s_waitcnt vmcnt(0)" ::: "memory"); __syncthreads();
                if (kt < c) tile_dma(kvb + 4 * 512 + (size_t)(kt + 1) * 64 * AB_LDP, AB_LDP, Vg + (kt + 1) * 64, T, lds + NS_K0 + (bo ^ AT_B1), lds + NS_V0 + (bo ^ AT_B1), wave, lane);
                f32x16 s[2]; qk_tile(lds + NS_K0 + bo, qf, s, lane);
                const bool edge = (kt == c) || (kt == c - 8);
                if (edge) {
#pragma unroll
                    for (int rb = 0; rb < 2; ++rb)
#pragma unroll
                        for (int i = 0; i < 16; ++i) { const int key = 64 * kt + 32 * rb + (i & 3) + 8 * (i >> 2) + 4 * hh; float v = s[rb][i] * C1; if (key > t || key < t - 511) v = -INFINITY; s[rb][i] = v; }
                } else {
#pragma unroll
                    for (int rb = 0; rb < 2; ++rb)
#pragma unroll
                        for (int i = 0; i < 16; ++i) s[rb][i] *= C1;
                }
                softmax_update(s, m, l, O);
                pv_tile(lds + NS_V0 + bo, s, O, lane);
            }
            l += __shfl_xor(l, 32); NS_ROWPTRS(); const float sc = sigm(smr[64]) / l;
            bf16* orow = OBUF + row_ * DM + 2048 + head * HD;
#pragma unroll
            for (int db = 0; db < 4; ++db)
#pragma unroll
                for (int g4 = 0; g4 < 4; ++g4) { const v2u a = *(const v2u*)(oacc + 32 * db + 8 * g4 + 4 * hh);
                    v2u w; w.x = cvtpk(bflo(a.x) + O[db][4 * g4] * sc, bfhi(a.x) + O[db][4 * g4 + 1] * sc); w.y = cvtpk(bflo(a.y) + O[db][4 * g4 + 2] * sc, bfhi(a.y) + O[db][4 * g4 + 3] * sc);
                    *(v2u*)(orow + 32 * db + 8 * g4 + 4 * hh) = w; }
        }
    }
}
__device__ __forceinline__ int perm16(int k) { return ((k >> 2) & 1) * 8 + (k >> 3) * 4 + (k & 3); }
__device__ __forceinline__ int crow(int i, int hh) { return (i & 3) + 8 * (i >> 2) + 4 * hh; }
__device__ __forceinline__ bf16x8 pack8(const f32x16& x, int s) { v4u w; w.x = cvtpk(x[8 * s + 0], x[8 * s + 1]); w.y = cvtpk(x[8 * s + 2], x[8 * s + 3]); w.z = cvtpk(x[8 * s + 4], x[8 * s + 5]); w.w = cvtpk(x[8 * s + 6], x[8 * s + 7]); return __builtin_bit_cast(bf16x8, w); }
constexpr int CH_QT = 0, CH_KT = 16384, CH_VT = 32768, CH_KD = 49152, CH_PS = 65536, CH_OT = 0;
constexpr size_t SZ_QH = (size_t)64 * 128, SZ_DS = (size_t)128 * 128, SZ_SN = (size_t)128 * 128;
__device__ __forceinline__ void hgrn_chunk_prep(const bf16* proj, const float* lbl, bf16* QH, bf16* OI, bf16* DS, float* DEC, LAS unsigned char* lds, int tid, int lane, int wave) {
    const int d = tid & 127, pt = tid >> 7, r = lane & 31, hh = lane >> 5;
    unsigned short rf[16], rq[16], rv[16];
#define HG_LOAD_RAW(IDX) do { const int bh_ = (IDX) >> 5, n_ = (IDX) & 31; const bf16* pr_ = proj + ((size_t)(bh_ >> 4) * T + n_ * 64 + 16 * pt) * CD_LDP + (bh_ & 15) * HD + d; \
        _Pragma("unroll") for (int i_ = 0; i_ < 16; ++i_) { rf[i_] = pr_[(size_t)i_ * CD_LDP + C_HF]; rq[i_] = pr_[(size_t)i_ * CD_LDP + C_HQ]; rv[i_] = pr_[(size_t)i_ * CD_LDP + C_HI]; } } while (0)
    if ((int)blockIdx.x < 2048) HG_LOAD_RAW((int)blockIdx.x);
    for (int idx = blockIdx.x; idx < 2048; idx += gridDim.x) {
        const int bh = idx >> 5, n = idx & 31, b = bh >> 4, h = bh & 15; const size_t row0 = (size_t)b * T + n * 64;
        __syncthreads();
        const float lb = sigm(lbl[2048 + h * HD + d] - lbl[h * HD + d]);
        float cs[16], kk[16], qv[16]; unsigned short vb[16]; float run = 0.f;
#pragma unroll
        for (int i = 0; i < 16; ++i) {
            const float sg = sigm(bf2f(rf[i])), f = lb + (1.f - lb) * sg; run += __logf(f); cs[i] = run; kk[i] = (1.f - lb) * (1.f - sg); qv[i] = silu(bf2f(rq[i])); vb[i] = rv[i]; }
        LAS float* PS = (LAS float*)(lds + CH_PS);
        PS[pt * 128 + d] = run;
        __syncthreads();
        const float p0 = PS[d], p1 = PS[128 + d], p2 = PS[256 + d], p3 = PS[384 + d];
        const float pre = pt == 0 ? 0.f : (pt == 1 ? p0 : (pt == 2 ? p0 + p1 : p0 + p1 + p2)), bmid = p0 + p1, tot = (p0 + p1) + (p2 + p3);
        if (pt == 0) DEC[(size_t)idx * 128 + d] = __expf(tot);
        unsigned short kdb[16];
#pragma unroll
        for (int i = 0; i < 16; ++i) { const int rr = 16 * pt + i; const float bb = pre + cs[i];
            const float dmid = fminf(fmaxf(bb - bmid, -80.f), 80.f);
            const unsigned qt = f2bf(qv[i] * __expf(dmid)), kt = f2bf(kk[i] * __expf(-dmid)), qh = f2bf(qv[i] * __expf(bb));
            kdb[i] = (unsigned short)f2bf(kk[i] * __expf(tot - bb));
            const int sw = rr * 256 + (((d >> 3) ^ (rr & 15)) << 4) + (d & 7) * 2;
            *(LAS unsigned short*)(lds + CH_QT + sw) = (unsigned short)qt; *(LAS unsigned short*)(lds + CH_KT + sw) = (unsigned short)kt;
            QH[(size_t)idx * SZ_QH + rr * 128 + (d & ~15) + perm16(d & 15)] = (bf16)qh; }
#pragma unroll
        for (int h2 = 0; h2 < 2; ++h2) { v4u wk, wv; unsigned ek[8], ev[8];
#pragma unroll
            for (int j = 0; j < 8; ++j) { const int i = 8 * (j >> 2) + 4 * h2 + (j & 3); ek[j] = kdb[i]; ev[j] = vb[i]; }
            wk.x = ek[0] | (ek[1] << 16); wk.y = ek[2] | (ek[3] << 16); wk.z = ek[4] | (ek[5] << 16); wk.w = ek[6] | (ek[7] << 16);
            wv.x = ev[0] | (ev[1] << 16); wv.y = ev[2] | (ev[3] << 16); wv.z = ev[4] | (ev[5] << 16); wv.w = ev[6] | (ev[7] << 16);
            const int sw = d * 128 + (((2 * pt + h2) ^ ((d >> 1) & 7)) << 4);
            *(LAS v4u*)(lds + CH_KD + sw) = wk; *(LAS v4u*)(lds + CH_VT + sw) = wv; }
        __syncthreads();
        if (idx + (int)gridDim.x < 2048) HG_LOAD_RAW(idx + (int)gridDim.x);
        const int rbk = wave & 1, eb = wave >> 1;
        int yk = hh ^ (r & 15); asm volatile("" : "+v"(yk)); int yv = hh ^ ((r >> 1) & 7); asm volatile("" : "+v"(yv));
        f32x16 oi;
#pragma unroll
        for (int i = 0; i < 16; ++i) oi[i] = 0.f;
#pragma unroll
        for (int jb = 0; jb < 2; ++jb) {
            if (jb > rbk) continue;
            f32x16 s;
#pragma unroll
            for (int i = 0; i < 16; ++i) s[i] = 0.f;
#pragma unroll
            for (int ks = 0; ks < 8; ++ks) { const bf16x8 a = *(const LAS bf16x8*)(lds + CH_KT + (32 * jb + r) * 256 + (((2 * ks) ^ yk) << 4)), q = *(const LAS bf16x8*)(lds + CH_QT + (32 * rbk + r) * 256 + (((2 * ks) ^ yk) << 4));
                s = MFMA32(a, q, s); }
            if (jb == rbk) {
#pragma unroll
                for (int i = 0; i < 16; ++i) if (crow(i, hh) > r) s[i] = 0.f; }
#pragma unroll
            for (int st = 0; st < 2; ++st) { const bf16x8 a = *(const LAS bf16x8*)(lds + CH_VT + (32 * eb + r) * 128 + (((2 * (2 * jb + st)) ^ yv) << 4));
                oi = MFMA32(a, pack8(s, st), oi); }
        }
        { bf16* op = OI + ((size_t)idx * 64 + 32 * rbk + r) * 128 + 32 * eb + 4 * hh;
#pragma unroll
          for (int g4 = 0; g4 < 4; ++g4) { v2u w; w.x = cvtpk(oi[4 * g4], oi[4 * g4 + 1]); w.y = cvtpk(oi[4 * g4 + 2], oi[4 * g4 + 3]); *(v2u*)(op + 8 * g4) = w; } }
#pragma unroll
        for (int tt = 0; tt < 2; ++tt) { const int tile = 2 * wave + tt, db = tile >> 2, eb2 = tile & 3; f32x16 acc;
#pragma unroll
            for (int i = 0; i < 16; ++i) acc[i] = 0.f;
#pragma unroll
            for (int kq = 0; kq < 4; ++kq) { const bf16x8 a = *(const LAS bf16x8*)(lds + CH_KD + (32 * db + r) * 128 + (((2 * kq) ^ yv) << 4)), bq = *(const LAS bf16x8*)(lds + CH_VT + (32 * eb2 + r) * 128 + (((2 * kq) ^ yv) << 4));
                acc = MFMA32(a, bq, acc); }
            bf16* dp = DS + (size_t)idx * SZ_DS + ((size_t)tile * 4 * 64 + lane) * 4;
#pragma unroll
            for (int g4 = 0; g4 < 4; ++g4) { v2u w; w.x = cvtpk(acc[4 * g4], acc[4 * g4 + 1]); w.y = cvtpk(acc[4 * g4 + 2], acc[4 * g4 + 3]); *(v2u*)(dp + g4 * 256) = w; } }
    }
}
__device__ __forceinline__ void hgrn_state_scan(const bf16* DS, const float* DEC, bf16* SN, int item, int lane) {
    const int bh = item >> 2, eb = item & 3, hh = lane >> 5;
    f32x16 S[4];
#pragma unroll
    for (int rb = 0; rb < 4; ++rb)
#pragma unroll
        for (int i = 0; i < 16; ++i) S[rb][i] = 0.f;
    for (int n = 0; n < 32; ++n) {
        const size_t idx = (size_t)bh * 32 + n;
        f32x4 ds[4][4], dc[4][4];
#pragma unroll
        for (int rb = 0; rb < 4; ++rb)
#pragma unroll
            for (int g4 = 0; g4 < 4; ++g4) { const v2u w = *(const v2u*)(DS + idx * SZ_DS + ((size_t)((rb * 4 + eb) * 4 + g4) * 64 + lane) * 4); ds[rb][g4] = (f32x4){bflo(w.x), bfhi(w.x), bflo(w.y), bfhi(w.y)}; dc[rb][g4] = *(const f32x4*)(DEC + idx * 128 + 32 * rb + 8 * g4 + 4 * hh); }
        bf16* sp = SN + idx * SZ_SN + (size_t)eb * 8 * 512 + lane * 8;
#pragma unroll
        for (int rb = 0; rb < 4; ++rb)
#pragma unroll
            for (int st = 0; st < 2; ++st) *(bf16x8*)(sp + (rb * 2 + st) * 512) = pack8(S[rb], st);
#pragma unroll
        for (int rb = 0; rb < 4; ++rb)
#pragma unroll
            for (int i = 0; i < 16; ++i) S[rb][i] = S[rb][i] * dc[rb][i >> 2][i & 3] + ds[rb][i >> 2][i & 3];
    }
}
__device__ __forceinline__ void chunk_output(const bf16* QH, const bf16* SN, const bf16* OI, const float* nw, const bf16* gate, int ldg, bf16* OBUF, LAS unsigned char* lds, int tid, int lane, int wave) {
    const int r = lane & 31, hh = lane >> 5, rbk = wave & 1, eb = wave >> 1;
    LAS float* OT = (LAS float*)(lds + CH_OT);
    bf16x8 qf[8], sf[8]; unsigned short oi[16]; unsigned gw8[8];
#define CO_LOAD(IDX) do { const int bh_ = (IDX) >> 5, n_ = (IDX) & 31; const size_t row0_ = (size_t)(bh_ >> 4) * T + n_ * 64; \
        const bf16* qa_ = QH + (size_t)(IDX) * SZ_QH + (32 * rbk + r) * 128 + 8 * hh; const bf16* sb_ = SN + (size_t)(IDX) * SZ_SN + (size_t)eb * 8 * 512 + lane * 8; \
        _Pragma("unroll") for (int k8 = 0; k8 < 8; ++k8) { qf[k8] = *(const bf16x8*)(qa_ + 16 * k8); sf[k8] = *(const bf16x8*)(sb_ + k8 * 512); } \
        const bf16* op_ = OI + ((size_t)(IDX) * 64 + 32 * rbk) * 128 + 32 * eb + r; \
        _Pragma("unroll") for (int i = 0; i < 16; ++i) oi[i] = op_[crow(i, hh) * 128]; \
        _Pragma("unroll") for (int j = 0; j < 8; ++j) gw8[j] = *(const unsigned*)(gate + (row0_ + 8 * wave + j) * ldg + (bh_ & 15) * HD + 2 * lane); } while (0)
    if ((int)blockIdx.x < 2048) CO_LOAD((int)blockIdx.x);
    for (int idx = blockIdx.x; idx < 2048; idx += gridDim.x) {
        const int bh = idx >> 5, n = idx & 31, b = bh >> 4, h = bh & 15; const size_t row0 = (size_t)b * T + n * 64;
        f32x16 acc;
#pragma unroll
        for (int i = 0; i < 16; ++i) acc[i] = 0.f;
#pragma unroll
        for (int k8 = 0; k8 < 8; ++k8) acc = MFMA32(qf[k8], sf[k8], acc);
        float ov[16]; unsigned gcur[8];
#pragma unroll
        for (int i = 0; i < 16; ++i) ov[i] = acc[i] + bf2f(oi[i]);
#pragma unroll
        for (int j = 0; j < 8; ++j) gcur[j] = gw8[j];
        __syncthreads();
#pragma unroll
        for (int i = 0; i < 16; ++i) OT[(32 * rbk + crow(i, hh)) * 128 + 32 * eb + r] = ov[i];
        if (idx + (int)gridDim.x < 2048) CO_LOAD(idx + (int)gridDim.x);
        __syncthreads();
#pragma unroll
        for (int j = 0; j < 8; ++j) { const int rr = 8 * wave + j; const float o0 = OT[rr * 128 + 2 * lane], o1 = OT[rr * 128 + 2 * lane + 1];
            const float rstd = rsqrtf(wave_sum(o0 * o0 + o1 * o1) * (1.f / HD) + EPS);
            *(unsigned*)(OBUF + (row0 + rr) * DM + h * HD + 2 * lane) = pk2(o0 * rstd * nw[2 * lane] * silu(bflo(gcur[j])), o1 * rstd * nw[2 * lane + 1] * silu(bfhi(gcur[j]))); }
    }
#undef CO_LOAD
}
__device__ __forceinline__ int img256(int row, int c) { return row * 256 + ((c ^ (row & 15)) << 4); }
__device__ __forceinline__ int img128(int row, int c) { return row * 128 + ((c ^ ((row >> 1) & 7)) << 4); }
constexpr int G1_KT = 0, G1_SS = 16384, G1_GAM = 16384 + 1024, G1_BET = G1_GAM + 256;
constexpr int G3_KT = 0, G3_QT = 16384, G3_TT = 32768, G3_KBG = 40960, G3_VB = 57344, G3_KD = 73728, G3_QK = 90112, G3_GAM = 98304, G3_BET = G3_GAM + 256;
__device__ __forceinline__ void gdn_pass1(int idx, const bf16* proj, const float* small, const float* cw, const float* a_log, const float* dt_bias,
                                          bf16* QS, bf16* KS, bf16* VS, float* GB, float* AM, LAS unsigned char* lds, int tid, int lane, int wave) {
    asm volatile("" : "+v"(tid), "+v"(lane));
    const int d = tid & 127, pt = tid >> 7, r = lane & 31, hh = lane >> 5;
    const int bh = idx >> 5, n = idx & 31, b = bh >> 4, h = bh & 15; const size_t row0 = (size_t)b * T + n * 64;
    LAS float* SS = (LAS float*)(lds + G1_SS); LAS float* GAM = (LAS float*)(lds + G1_GAM); LAS float* BET = (LAS float*)(lds + G1_BET);
    __syncthreads();
    if (tid < 64) { float g = -__expf(a_log[h]) * softplus(small[(row0 + tid) * 256 + h] + dt_bias[h]);
#pragma unroll
        for (int o = 1; o < 64; o <<= 1) { const float v = __shfl_up(g, o); if (lane >= o) g += v; }
        const float be = sigm(small[(row0 + tid) * 256 + 16 + h]); GAM[tid] = g; BET[tid] = be; GB[(size_t)idx * 128 + tid] = g; GB[(size_t)idx * 128 + 64 + tid] = be; }
    { const int o = tid & 15;
#pragma unroll
      for (int s = 0; s < 3; ++s) { const int ch0 = s * 2048 + h * HD + 8 * o; float w[4][8];
#pragma unroll
          for (int j = 0; j < 4; ++j) { const f32x4 wa = *(const f32x4*)(cw + j * 6144 + ch0), wb = *(const f32x4*)(cw + j * 6144 + ch0 + 4);
              w[j][0] = wa.x; w[j][1] = wa.y; w[j][2] = wa.z; w[j][3] = wa.w; w[j][4] = wb.x; w[j][5] = wb.y; w[j][6] = wb.z; w[j][7] = wb.w; }
#pragma unroll
          for (int it = 0; it < 2; ++it) { const int rr = (tid >> 4) + 32 * it; float val[8];
#pragma unroll
              for (int e = 0; e < 8; ++e) val[e] = 0.f;
#pragma unroll
              for (int j = 0; j < 4; ++j) { const int rj = rr - 3 + j; v4u x = (v4u){0u, 0u, 0u, 0u};
                  if (n * 64 + rj >= 0) x = *(const v4u*)(proj + (row0 + rj) * AB_LDP + A_QKV + ch0);
                  val[0] += w[j][0] * bflo(x.x); val[1] += w[j][1] * bfhi(x.x); val[2] += w[j][2] * bflo(x.y); val[3] += w[j][3] * bfhi(x.y);
                  val[4] += w[j][4] * bflo(x.z); val[5] += w[j][5] * bfhi(x.z); val[6] += w[j][6] * bflo(x.w); val[7] += w[j][7] * bfhi(x.w); }
              float ssq = 0.f;
#pragma unroll
              for (int e = 0; e < 8; ++e) { val[e] = silu(val[e]); ssq += val[e] * val[e]; }
              if (s < 2) { ssq += __shfl_xor(ssq, 1); ssq += __shfl_xor(ssq, 2); ssq += __shfl_xor(ssq, 4); ssq += __shfl_xor(ssq, 8);
                  const float inv = rsqrtf(ssq + EPS) * (s == 0 ? QSCALE : 1.f);
#pragma unroll
                  for (int e = 0; e < 8; ++e) val[e] *= inv; }
              v4u pk; pk.x = pk2(val[0], val[1]); pk.y = pk2(val[2], val[3]); pk.z = pk2(val[4], val[5]); pk.w = pk2(val[6], val[7]);
              if (s == 1) *(LAS v4u*)(lds + G1_KT + img256(rr, o)) = pk;
              *(v4u*)((s == 0 ? QS : (s == 1 ? KS : VS)) + (size_t)idx * SZ_QH + rr * 128 + 8 * o) = pk; } } }
    __syncthreads();
    if (wave < 3) {
        const int jb = wave >> 1, rbk = (wave + 1) >> 1; int yk = hh ^ (r & 15); asm volatile("" : "+v"(yk));
        f32x16 acc;
#pragma unroll
        for (int i = 0; i < 16; ++i) acc[i] = 0.f;
#pragma unroll
        for (int ks = 0; ks < 8; ++ks) acc = MFMA32(*(const LAS bf16x8*)(lds + G1_KT + (32 * jb + r) * 256 + (((2 * ks) ^ yk) << 4)), *(const LAS bf16x8*)(lds + G1_KT + (32 * rbk + r) * 256 + (((2 * ks) ^ yk) << 4)), acc);
        const int rr = 32 * rbk + r; const float gr = GAM[rr], br = BET[rr];
#pragma unroll
        for (int g4 = 0; g4 < 4; ++g4) { const int j0 = 32 * jb + 8 * g4 + 4 * hh; const f32x4 gj = *(const LAS f32x4*)(GAM + j0); f32x4 o;
#pragma unroll
            for (int e = 0; e < 4; ++e) o[e] = (j0 + e < rr) ? br * __expf(gr - gj[e]) * acc[4 * g4 + e] : 0.f;
            *(f32x4*)(AM + (size_t)idx * 4096 + rr * 64 + j0) = o; }
    } else if (wave == 3) {
#pragma unroll
        for (int g4 = 0; g4 < 4; ++g4) *(f32x4*)(AM + (size_t)idx * 4096 + r * 64 + 32 + 8 * g4 + 4 * hh) = (f32x4){0.f, 0.f, 0.f, 0.f};
    }
}
__device__ __forceinline__ void gdn_pass2(int idx, const float* AM, bf16* TM, LAS unsigned char* wlds, int lane) {
    float Ar[64], Tr[64];
    { const f32x4* src = (const f32x4*)(AM + (size_t)idx * 4096 + lane * 64);
#pragma unroll
      for (int i = 0; i < 16; ++i) { const f32x4 v = src[i]; Ar[4 * i] = v[0]; Ar[4 * i + 1] = v[1]; Ar[4 * i + 2] = v[2]; Ar[4 * i + 3] = v[3]; } }
#pragma unroll
    for (int c = 0; c < 64; ++c) Tr[c] = (lane == c) ? 1.f : 0.f;
#pragma unroll
    for (int j = 0; j < 63; ++j) {
        const float na = -Ar[j];
#pragma unroll
        for (int c = 0; c <= j; ++c) { const float tj = __builtin_bit_cast(float, __builtin_amdgcn_readlane(__builtin_bit_cast(int, Tr[c]), j)); Tr[c] = fmaf(na, tj, Tr[c]); }
    }
    v4u* out = (v4u*)(TM + (size_t)idx * 4096 + lane * 64);
#pragma unroll
    for (int i = 0; i < 8; ++i) { v4u w; w.x = cvtpk(Tr[8 * i], Tr[8 * i + 1]); w.y = cvtpk(Tr[8 * i + 2], Tr[8 * i + 3]); w.z = cvtpk(Tr[8 * i + 4], Tr[8 * i + 5]); w.w = cvtpk(Tr[8 * i + 6], Tr[8 * i + 7]); out[i] = w; }
}
struct G3Pre { float g; v4u t[5]; unsigned short kc[16], vc[16]; };
__device__ __forceinline__ void g3_load(G3Pre& P, int idx, const bf16* QS, const bf16* KS, const bf16* VS, const float* GB, const bf16* TM, int tid) {
    const int d = tid & 127, pt = tid >> 7;
    P.g = tid < 128 ? GB[(size_t)idx * 128 + tid] : 0.f;
#pragma unroll
    for (int i = 0; i < 2; ++i) { const int id = tid + 512 * i, rw = id >> 4, c = id & 15; P.t[2 * i] = *(const v4u*)(KS + (size_t)idx * SZ_QH + rw * 128 + c * 8); P.t[2 * i + 1] = *(const v4u*)(QS + (size_t)idx * SZ_QH + rw * 128 + c * 8); }
    { const int rw = tid >> 3, c = tid & 7; P.t[4] = *(const v4u*)(TM + (size_t)idx * 4096 + rw * 64 + c * 8); }
#pragma unroll
    for (int i = 0; i < 16; ++i) { const size_t o = (size_t)idx * SZ_QH + (16 * pt + i) * 128 + d; P.kc[i] = KS[o]; P.vc[i] = VS[o]; }
}
__device__ __forceinline__ void gdn_pass3(int idx, int idx_next, G3Pre& P, const bf16* QS, const bf16* KS, const bf16* VS, const float* GB, const bf16* TM, bf16* QH, bf16* OI, bf16* AN, bf16* DS,
                                          LAS unsigned char* lds, int tid, int lane, int wave) {
    asm volatile("" : "+v"(tid), "+v"(lane));
    const int d = tid & 127, pt = tid >> 7, r = lane & 31, hh = lane >> 5;
    LAS float* GAM = (LAS float*)(lds + G3_GAM); LAS float* BET = (LAS float*)(lds + G3_BET);
    __syncthreads();
    if (tid < 128) GAM[tid] = P.g;
#pragma unroll
    for (int i = 0; i < 2; ++i) { const int id = tid + 512 * i, rw = id >> 4, c = id & 15;
        *(LAS v4u*)(lds + G3_KT + img256(rw, c)) = P.t[2 * i];
        *(LAS v4u*)(lds + G3_QT + img256(rw, c)) = P.t[2 * i + 1]; }
    { const int rw = tid >> 3, c = tid & 7; *(LAS v4u*)(lds + G3_TT + img128(rw, c)) = P.t[4]; }
    float kv[16], vv[16];
#pragma unroll
    for (int i = 0; i < 16; ++i) { kv[i] = bf2f(P.kc[i]); vv[i] = bf2f(P.vc[i]); }
    if (idx_next < 2048) g3_load(P, idx_next, QS, KS, VS, GB, TM, tid);
    __syncthreads();
    { const float glast = GAM[63]; unsigned kbg[16], vb[16], kd[16];
#pragma unroll
      for (int i = 0; i < 16; ++i) { const float gm = GAM[16 * pt + i], bm = BET[16 * pt + i]; kbg[i] = f2bf(kv[i] * bm * __expf(gm)); vb[i] = f2bf(vv[i] * bm); kd[i] = f2bf(kv[i] * __expf(glast - gm)); }
#pragma unroll
      for (int h2 = 0; h2 < 2; ++h2) { v4u a, bq, c;
          a.x = kbg[8 * h2] | (kbg[8 * h2 + 1] << 16); a.y = kbg[8 * h2 + 2] | (kbg[8 * h2 + 3] << 16); a.z = kbg[8 * h2 + 4] | (kbg[8 * h2 + 5] << 16); a.w = kbg[8 * h2 + 6] | (kbg[8 * h2 + 7] << 16);
          bq.x = vb[8 * h2] | (vb[8 * h2 + 1] << 16); bq.y = vb[8 * h2 + 2] | (vb[8 * h2 + 3] << 16); bq.z = vb[8 * h2 + 4] | (vb[8 * h2 + 5] << 16); bq.w = vb[8 * h2 + 6] | (vb[8 * h2 + 7] << 16);
          unsigned e[8];
#pragma unroll
          for (int j = 0; j < 8; ++j) e[j] = kd[8 * (j >> 2) + 4 * h2 + (j & 3)];
          c.x = e[0] | (e[1] << 16); c.y = e[2] | (e[3] << 16); c.z = e[4] | (e[5] << 16); c.w = e[6] | (e[7] << 16);
          const int sw = img128(d, 2 * pt + h2);
          *(LAS v4u*)(lds + G3_KBG + sw) = a; *(LAS v4u*)(lds + G3_VB + sw) = bq; *(LAS v4u*)(lds + G3_KD + sw) = c; } }
    int yk = hh ^ (r & 15); asm volatile("" : "+v"(yk)); int yv = hh ^ ((r >> 1) & 7); asm volatile("" : "+v"(yv));
    if (wave < 3) {
        const int jb = wave >> 1, rbk = (wave + 1) >> 1; f32x16 acc;
#pragma unroll
        for (int i = 0; i < 16; ++i) acc[i] = 0.f;
#pragma unroll
        for (int ks = 0; ks < 8; ++ks) acc = MFMA32(*(const LAS bf16x8*)(lds + G3_KT + (32 * jb + r) * 256 + (((2 * ks) ^ yk) << 4)), *(const LAS bf16x8*)(lds + G3_QT + (32 * rbk + r) * 256 + (((2 * ks) ^ yk) << 4)), acc);
        const int rr = 32 * rbk + r; const float gr = GAM[rr];
#pragma unroll
        for (int g4 = 0; g4 < 4; ++g4) { const int j0 = 32 * jb + 8 * g4 + 4 * hh; const f32x4 gj = *(const LAS f32x4*)(GAM + j0); float o[4];
#pragma unroll
            for (int e = 0; e < 4; ++e) o[e] = (j0 + e <= rr) ? __expf(gr - gj[e]) * acc[4 * g4 + e] : 0.f;
            v2u w; w.x = cvtpk(o[0], o[1]); w.y = cvtpk(o[2], o[3]);
            *(LAS v2u*)(lds + G3_QK + img128(rr, 2 * (j0 >> 4) + hh) + 8 * (g4 & 1)) = w; }
    } else if (wave == 3) {
        const v2u z = (v2u){0u, 0u};
#pragma unroll
        for (int g4 = 0; g4 < 4; ++g4) { const int j0 = 32 + 8 * g4 + 4 * hh; *(LAS v2u*)(lds + G3_QK + img128(r, 2 * (j0 >> 4) + hh) + 8 * (g4 & 1)) = z; }
    }
    __syncthreads();
    const int cb = wave & 3; const bool isw = wave < 4; const int boff = isw ? G3_KBG : G3_VB;
    f32x16 X[2];
#pragma unroll
    for (int jb = 0; jb < 2; ++jb) {
#pragma unroll
        for (int i = 0; i < 16; ++i) X[jb][i] = 0.f;
#pragma unroll
        for (int ms = 0; ms < 4; ++ms) X[jb] = MFMA32(*(const LAS bf16x8*)(lds + G3_TT + (32 * jb + r) * 128 + (((2 * ms) ^ yv) << 4)), *(const LAS bf16x8*)(lds + boff + (32 * cb + r) * 128 + (((2 * ms) ^ yv) << 4)), X[jb]); }
    bf16x8 xf[4];
#pragma unroll
    for (int kq = 0; kq < 4; ++kq) xf[kq] = pack8(X[kq >> 1], kq & 1);
    __syncthreads();
#pragma unroll 1
    for (int rbk = 0; rbk < 2; ++rbk) { f32x16 acc;
#pragma unroll
        for (int i = 0; i < 16; ++i) acc[i] = 0.f;
#pragma unroll
        for (int kq = 0; kq < 4; ++kq) acc = MFMA32(*(const LAS bf16x8*)(lds + G3_QK + (32 * rbk + r) * 128 + (((2 * kq) ^ yv) << 4)), xf[kq], acc);
        const int col = 32 * cb + r;
        if (isw) {
#pragma unroll
            for (int i = 0; i < 16; ++i) { const int rr = 32 * rbk + crow(i, hh); const float qv = bf2f(*(const LAS unsigned short*)(lds + G3_QT + img256(rr, col >> 3) + (col & 7) * 2));
                *(LAS unsigned short*)(lds + G3_KT + rr * 256 + ((col & ~15) + perm16(col & 15)) * 2) = (unsigned short)f2bf(qv * __expf(GAM[rr]) - acc[i]); }
        } else {
#pragma unroll
            for (int i = 0; i < 16; ++i) { const int rr = 32 * rbk + crow(i, hh); OI[((size_t)idx * 64 + rr) * 128 + col] = (bf16)f2bf(acc[i]); }
        } }
    const float gl = __expf(GAM[63]);
#pragma unroll 1
    for (int rb = 0; rb < 4; ++rb) { f32x16 acc;
#pragma unroll
        for (int i = 0; i < 16; ++i) acc[i] = 0.f;
#pragma unroll
        for (int kq = 0; kq < 4; ++kq) acc = MFMA32(*(const LAS bf16x8*)(lds + G3_KD + (32 * rb + r) * 128 + (((2 * kq) ^ yv) << 4)), xf[kq], acc);
        const int col = 32 * cb + r;
        if (isw) {
#pragma unroll
            for (int i = 0; i < 16; ++i) { const int dr = 32 * rb + crow(i, hh); *(LAS unsigned short*)(lds + G3_TT + dr * 256 + ((col & ~15) + perm16(col & 15)) * 2) = (unsigned short)f2bf((dr == col ? gl : 0.f) - acc[i]); }
        } else {
            bf16* dp = DS + (size_t)idx * SZ_DS + ((size_t)(rb * 4 + cb) * 4 * 64 + lane) * 4;
#pragma unroll
            for (int g4 = 0; g4 < 4; ++g4) { v2u w; w.x = cvtpk(acc[4 * g4], acc[4 * g4 + 1]); w.y = cvtpk(acc[4 * g4 + 2], acc[4 * g4 + 3]); *(v2u*)(dp + g4 * 256) = w; }
        } }
    __syncthreads();
#pragma unroll
    for (int i = 0; i < 2; ++i) { const int id = tid + 512 * i; *(v4u*)(QH + (size_t)idx * SZ_QH + id * 8) = *(const LAS v4u*)(lds + G3_KT + id * 16); }
#pragma unroll
    for (int i = 0; i < 4; ++i) { const int id = tid + 512 * i; *(v4u*)(AN + (size_t)idx * SZ_DS + id * 8) = *(const LAS v4u*)(lds + G3_TT + id * 16); }
}
__device__ __forceinline__ void gdn_prep_a(const bf16* proj, const float* small, const float* cw, const float* a_log, const float* dt_bias, bf16* QS, bf16* KS, bf16* VS, float* GB, float* AM, LAS unsigned char* lds, int tid, int lane, int wave) {
#pragma unroll 1
    for (int k = 0; k < 8; ++k) { const int idx = blockIdx.x + k * gridDim.x; if (idx < 2048) gdn_pass1(idx, proj, small, cw, a_log, dt_bias, QS, KS, VS, GB, AM, lds, tid, lane, wave); }
    asm volatile("s_waitcnt vmcnt(0)" ::: "memory"); __syncthreads();
}
__device__ __forceinline__ void gdn_prep_b(const float* AM, bf16* TM, LAS unsigned char* lds, int lane, int wave) {
    { const int idx = blockIdx.x + wave * gridDim.x; if (idx < 2048) gdn_pass2(idx, AM, TM, lds + wave * 16384, lane); }
    asm volatile("s_waitcnt vmcnt(0)" ::: "memory"); __syncthreads();
}
__device__ __forceinline__ void gdn_prep_c(const bf16* QS, const bf16* KS, const bf16* VS, const float* GB, const bf16* TM, bf16* QH, bf16* OI, bf16* AN, bf16* DS, LAS unsigned char* lds, int tid, int lane, int wave) {
    G3Pre P; if ((int)blockIdx.x < 2048) g3_load(P, (int)blockIdx.x, QS, KS, VS, GB, TM, tid);
#pragma unroll 1
    for (int k = 0; k < 8; ++k) { const int idx = blockIdx.x + k * gridDim.x; if (idx < 2048) gdn_pass3(idx, k < 7 ? idx + (int)gridDim.x : 2048, P, QS, KS, VS, GB, TM, QH, OI, AN, DS, lds, tid, lane, wave); }
}
__device__ __forceinline__ void gdn_state_scan(const bf16* AN, const bf16* DS, bf16* SN, int item, int lane) {
    const int bh = item >> 2, eb = item & 3, r = lane & 31, hh = lane >> 5;
    f32x16 S[4];
#pragma unroll
    for (int rb = 0; rb < 4; ++rb)
#pragma unroll
        for (int i = 0; i < 16; ++i) S[rb][i] = 0.f;
    for (int n = 0; n < 32; ++n) {
        const size_t idx = (size_t)bh * 32 + n;
        bf16x8 sf[8];
#pragma unroll
        for (int k8 = 0; k8 < 8; ++k8) sf[k8] = pack8(S[k8 >> 1], k8 & 1);
        bf16* sp = SN + idx * SZ_SN + (size_t)eb * 8 * 512 + lane * 8;
#pragma unroll
        for (int k8 = 0; k8 < 8; ++k8) *(bf16x8*)(sp + k8 * 512) = sf[k8];
#pragma unroll
        for (int rb = 0; rb < 4; ++rb) {
#pragma unroll
            for (int g4 = 0; g4 < 4; ++g4) { const v2u w = *(const v2u*)(DS + idx * SZ_DS + ((size_t)((rb * 4 + eb) * 4 + g4) * 64 + lane) * 4); S[rb][4 * g4] = bflo(w.x); S[rb][4 * g4 + 1] = bfhi(w.x); S[rb][4 * g4 + 2] = bflo(w.y); S[rb][4 * g4 + 3] = bfhi(w.y); }
            const bf16* ap = AN + idx * SZ_DS + (32 * rb + r) * 128 + 8 * hh;
#pragma unroll
            for (int k8 = 0; k8 < 8; ++k8) S[rb] = MFMA32(*(const bf16x8*)(ap + 16 * k8), sf[k8], S[rb]);
        }
    }
}

constexpr size_t MS_BIAS = 5 * MiB, MS_W2T = 5 * MiB + 65536, MS_WFF = 5 * MiB + 131072, MS_W1T = 6 * MiB;
constexpr int CP_PART = 0, CP_HID = 16384;
__device__ __forceinline__ void nsa_compress_mfma(const bf16* proj, const bf16* W1T, const bf16* W2T, const float* BIAS, bf16* KC, bf16* VCT, LAS unsigned char* lds, int tid, int lane, int wave) {
    const int r = lane & 31, hh = lane >> 5, jb = wave & 3, kh = wave >> 2;
    for (int item = (int)blockIdx.x - ((int)gridDim.x - 128); item < 128; item += gridDim.x) {
        if (item < 0) break;
        const int nb = item & 3, kv = (item >> 2) & 1, bg = item >> 3, b = bg >> 2, g = bg & 3;
        const int n = 32 * nb + r, ne = n < NCMP ? n : NCMP - 1;
        const bf16* ap = proj + (size_t)(b * T + 16 * ne) * AB_LDP + A_NKV + kv * 512 + g * HD + 8 * hh;
        const bf16* bp = W1T + ((size_t)kv * 128 + 32 * jb + r) * 4096 + 8 * hh;
        f32x16 acc;
#pragma unroll
        for (int i = 0; i < 16; ++i) acc[i] = 0.f;
#pragma unroll 4
        for (int l = 16 * kh; l < 16 * kh + 16; ++l) {
#pragma unroll
            for (int q = 0; q < 8; ++q) acc = MFMA32(*(const bf16x8*)(ap + (size_t)l * AB_LDP + 16 * q), *(const bf16x8*)(bp + l * 128 + 16 * q), acc); }
        __syncthreads();
        LAS float* PART = (LAS float*)(lds + CP_PART);
        if (kh == 1) {
#pragma unroll
            for (int i = 0; i < 16; ++i) PART[crow(i, hh) * 128 + 32 * jb + r] = acc[i]; }
        __syncthreads();
        if (kh == 0) { const float bs = BIAS[kv * 128 + 32 * jb + r]; const int col = 32 * jb + r;
#pragma unroll
            for (int i = 0; i < 16; ++i) { const int rr = crow(i, hh); const float hv = silu(acc[i] + PART[rr * 128 + col] + bs);
                *(LAS unsigned short*)(lds + CP_HID + img256(rr, col >> 3) + (col & 7) * 2) = (unsigned short)f2bf(hv); } }
        __syncthreads();
        if (wave < 4) { int yk = hh ^ (r & 15); asm volatile("" : "+v"(yk));
            const bf16* wp = W2T + ((size_t)kv * 128 + 32 * wave + r) * 128 + 8 * hh; f32x16 o;
#pragma unroll
            for (int i = 0; i < 16; ++i) o[i] = 0.f;
#pragma unroll
            for (int ks = 0; ks < 8; ++ks) o = MFMA32(*(const LAS bf16x8*)(lds + CP_HID + r * 256 + (((2 * ks) ^ yk) << 4)), *(const bf16x8*)(wp + 16 * ks), o);
            const int j = 32 * wave + r;
#pragma unroll
            for (int i = 0; i < 16; ++i) { const int nn = 32 * nb + crow(i, hh); const bf16 v = nn < NCMP ? (bf16)f2bf(o[i]) : (bf16)0;
                if (kv) VCT[((size_t)bg * 128 + j) * 128 + (nn & ~15) + perm16(nn & 15)] = v; else KC[((size_t)bg * 128 + nn) * HD + j] = v; } }
    }
}
#ifndef MK_SINGLE
#define MK_SINGLE 1
#endif
constexpr int NPHASE = 28;
struct Args { const float* in[33]; float* out; unsigned char* ws; int ph_lo, ph_hi; };
enum { I_X = 0, I_P, I_AB_NPRE, I_AB_NPOST, I_AB_WIN, I_GDN_CW, I_GDN_ALOG, I_GDN_DTB, I_GDN_NORM, I_PE_K, I_PE_V, I_K1, I_K2, I_V1, I_V2, I_AB_WOUT, I_CD_NPRE, I_CD_NPOST, I_CD_WIN,
       I_LB, I_HGRN_NORM, I_FOX_B, I_CD_WOUT, I_FFN_NPRE, I_FFN_NPOST, I_FFN_WUP, I_FFN_CW, I_FFN_CB, I_FFN_WDOWN, I_PLE_WPROJ, I_PLE_GNORM, I_PLE_WGATE, I_PLE_NPOST };

__global__ void __launch_bounds__(NTHR, 2) fwd(Args args) {
    extern __shared__ __attribute__((aligned(16))) unsigned char lds_raw[];
    LAS unsigned char* lds = (LAS unsigned char*)lds_raw;
    volatile LAS unsigned* MISC = (volatile LAS unsigned*)(lds + MISC_OFF);
    const int tid = threadIdx.x, lane = tid & 63, wave = __builtin_amdgcn_readfirstlane(tid >> 6);
    const int G = gridDim.x, gw = blockIdx.x * NWAVES + wave, ngw = G * NWAVES, gw2 = wave * G + blockIdx.x;
    unsigned char* ws = args.ws;
    unsigned* ctl = (unsigned*)(ws + WS_CTL);
    for (int u = tid; u < (LDS_BYTES - LDSCTL_OFF) / 4; u += NTHR) ((LAS unsigned*)(lds + LDSCTL_OFF))[u] = 0u;
    __syncthreads();
    const int lo = args.ph_lo, hi = args.ph_hi;
    XcdBarrier bar; bar.bar = ctl + CW_BAR; bar.x = 0; bar.st = nullptr;
    if (hi - lo > 1) bar = xcd_barrier_post(ctl + CW_BAR, MISC + 8);
#ifndef PH_MASK
#define PH_MASK 0xFFFFFFFFu
#endif
#define IN(k) (((PH_MASK >> (k)) & 1u) && lo <= (k) && (k) < hi)
#define SEAM(k) do { if (IN(k) && IN((k) + 1)) xcd_barrier(bar); } while (0)
    bf16* WABIN = (bf16*)(ws + WS_WABIN); bf16* WABOUT = (bf16*)(ws + WS_WABOUT); bf16* WCDIN = (bf16*)(ws + WS_WCDIN); bf16* WCDOUT = (bf16*)(ws + WS_WCDOUT);
    bf16* WUP = (bf16*)(ws + WS_WUP); bf16* WDOWN = (bf16*)(ws + WS_WDOWN); bf16* WGATE = (bf16*)(ws + WS_WGATE); bf16* WPROJ = (bf16*)(ws + WS_WPROJ);
    float* XRES = (float*)(ws + WS_XRES); bf16* H = (bf16*)(ws + WS_H); bf16* PROJ = (bf16*)(ws + WS_PROJ); float* SMALL = (float*)(ws + WS_SMALL); float* Y = (float*)(ws + WS_Y);
    bf16* OBUF = (bf16*)(ws + WS_OBUF); bf16* Z = (bf16*)(ws + WS_Z); bf16* ACT = (bf16*)(ws + WS_ACT); bf16* PP = (bf16*)(ws + WS_PP); bf16* PBF = (bf16*)(ws + WS_PBF);
    float* QN = (float*)(ws + WS_QN); float* KN = (float*)(ws + WS_KN); float* VV = (float*)(ws + WS_VV); float* ORAW = (float*)(ws + WS_ORAW); float* OCMP = (float*)(ws + WS_OCMP);
    unsigned char* ms = ws + WS_MISC;
    bf16* KC = (bf16*)(ms + MS_KC); bf16* VC = (bf16*)(ms + MS_VC); float* GG = (float*)(ms + MS_GG); float* BB = (float*)(ms + MS_BB); unsigned* SEL = (unsigned*)(ms + MS_SEL); float* CUM = (float*)(ms + MS_CUM);
    bf16* QH = (bf16*)(ws + WS_Z); bf16* OI = (bf16*)(ws + WS_Z + 32 * MiB); bf16* SN = (bf16*)(ws + WS_Z + 96 * MiB); bf16* AN = (bf16*)(ws + WS_Z + 160 * MiB); float* DEC = (float*)(ws + WS_Z + 224 * MiB); bf16* DS = (bf16*)(ws + WS_ACT + 32 * MiB);
    bf16* QS = (bf16*)(ws + WS_Z + 225 * MiB); bf16* KS = (bf16*)(ws + WS_Z + 257 * MiB); bf16* VS = (bf16*)(ws + WS_Z + 289 * MiB); float* AMX = (float*)(ws + WS_PP); float* GB = (float*)(ws + WS_PP + 32 * MiB); bf16* TM = (bf16*)(ws + WS_ACT + 16 * MiB);
    float* RS = (float*)(ws + WS_MISC + 4 * MiB + 768 * 1024); bf16* YB = (bf16*)(ws + WS_Y);
    LAS float* wl = (LAS float*)(lds + wave * 1024);
    constexpr size_t SZ_UP = (size_t)2 * DFF * DM, SZ_DOWN = (size_t)DFF * DM, SZ_SQ = (size_t)DM * DM, SZ_PJ = (size_t)DPLE * DM;

    if (IN(0)) {
        LAS float* scr = (LAS float*)(lds + wave * 16384);
        transpose_seg(args.in[I_AB_WIN], DM, AB_IN, 0, 6144, 6144, WABIN, 0, scr, gw, ngw, lane, args.in[I_AB_NPRE]);
        transpose_seg(args.in[I_AB_WIN], DM, AB_IN, 6176, 7168, 7168, WABIN, 6144, scr, gw, ngw, lane, args.in[I_AB_NPRE]);
        transpose_seg(args.in[I_AB_WIN], DM, AB_IN, 6144, 32, 32, WABIN, 13312, scr, gw, ngw, lane, args.in[I_AB_NPRE]);
        transpose_seg(args.in[I_AB_WIN], DM, AB_IN, 13344, 48, 64, WABIN, 13344, scr, gw, ngw, lane, args.in[I_AB_NPRE]);
        transpose_seg(args.in[I_AB_WIN], DM, AB_IN, 0, 0, 160, WABIN, 13408, scr, gw, ngw, lane);
        transpose_seg(args.in[I_AB_WOUT], DM, DM, 0, DM, DM, WABOUT, 0, scr, gw, ngw, lane);
        transpose_seg(args.in[I_CD_WIN], DM, CD_IN, 0, 14336, 14336, WCDIN, 0, scr, gw, ngw, lane, args.in[I_CD_NPRE]);
        for (int i = blockIdx.x * NTHR + tid; i < DM * 16; i += G * NTHR) { const int cc = i & 15, k = i >> 4;
            ((bf16*)(ms + MS_WFF))[(size_t)cc * DM + k] = (bf16)f2bf(args.in[I_CD_WIN][(size_t)k * CD_IN + 14336 + cc] * args.in[I_CD_NPRE][k]); }
        for (int l = 0; l < 2; ++l) {
            transpose_seg(args.in[I_FFN_WUP] + l * SZ_UP, DM, 2 * DFF, 0, 2 * DFF, 2 * DFF, WUP + l * SZ_UP, 0, scr, gw, ngw, lane, args.in[I_FFN_NPRE] + l * DM);
            if (l == 0) transpose_seg(args.in[I_FFN_WDOWN] + l * SZ_DOWN, DFF, DM, 0, DM, DM, WDOWN + l * SZ_DOWN, 0, scr, gw, ngw, lane);
            if (l == 0) transpose_seg(args.in[I_PLE_WGATE] + l * SZ_SQ, DM, DM, 0, DM, DM, WGATE + l * SZ_SQ, 0, scr, gw, ngw, lane, args.in[I_PLE_GNORM] + l * DM);
            transpose_seg(args.in[I_PLE_WPROJ] + l * SZ_PJ, DPLE, DM, 0, DM, DM, WPROJ + l * SZ_PJ, 0, scr, gw, ngw, lane);
        }
        for (int m = gw; m < M; m += ngw) prep_row(args.in[I_X] + (size_t)m * DM, H + (size_t)m * DM, RS + m, lane);
        transpose_seg(args.in[I_K1], 4096, 128, 0, 128, 128, (bf16*)(ms + MS_W1T), 0, scr, gw, ngw, lane);
        transpose_seg(args.in[I_V1], 4096, 128, 0, 128, 128, (bf16*)(ms + MS_W1T) + (size_t)128 * 4096, 0, scr, gw, ngw, lane);
        transpose_seg(args.in[I_K2], 128, 128, 0, 128, 128, (bf16*)(ms + MS_W2T), 0, scr, gw, ngw, lane);
        transpose_seg(args.in[I_V2], 128, 128, 0, 128, 128, (bf16*)(ms + MS_W2T) + 128 * 128, 0, scr, gw, ngw, lane);
        if (gw < 256) { const int kv = gw >> 7, j = gw & 127; const float* pe = args.in[kv ? I_PE_V : I_PE_K]; const float* w1 = args.in[kv ? I_V1 : I_K1]; float sacc = 0.f;
            for (int i = lane; i < 4096; i += 64) sacc += pe[i] * w1[(size_t)i * 128 + j];
            sacc = wave_sum(sacc); if (lane == 0) ((float*)(ms + MS_BIAS))[gw] = sacc; }
        { const float* p = args.in[I_P]; for (size_t i = (size_t)blockIdx.x * NTHR + tid; i < (size_t)2 * M * DPLE / 4; i += (size_t)G * NTHR) { const f32x4 v = ((const f32x4*)p)[i]; v2u o; o.x = pk2(v.x, v.y); o.y = pk2(v.z, v.w); ((v2u*)PBF)[i] = o; } }
        for (int i = blockIdx.x * NTHR + tid; i < 16 * HD; i += G * NTHR) { const int bg = i >> 7, d = i & 127; KC[((size_t)bg * 128 + 127) * HD + d] = 0; VC[((size_t)bg * 128 + d) * 128 + 127] = 0; }
    }
    SEAM(0);
    if (IN(1)) { pg8::Gemm g{H, WABIN, M, AB_NPAD, DM, DM}; pg8::StaticOrder S; S.init(M, AB_NPAD, G, (int)blockIdx.x); pg8::EpiProj E{PROJ, AB_LDP, SMALL, AB_LDP / 256, RS};
        pg8::gemm_phase<pg8::EpiProj, pg8::StaticOrder, true, true>(lds, g, S, E); }
    SEAM(1);
    if (IN(2)) gdn_prep_a(PROJ, SMALL, args.in[I_GDN_CW], args.in[I_GDN_ALOG], args.in[I_GDN_DTB], QS, KS, VS, GB, AMX, lds, tid, lane, wave);
    if (IN(2)) gdn_prep_b(AMX, TM, lds, lane, wave);
    if (IN(2)) { gdn_prep_c(QS, KS, VS, GB, TM, QH, OI, AN, DS, lds, tid, lane, wave); __syncthreads(); }
    if (IN(2)) {
        nsa_compress_mfma(PROJ, (const bf16*)(ms + MS_W1T), (const bf16*)(ms + MS_W2T), (const float*)(ms + MS_BIAS), KC, VC, lds, tid, lane, wave);
        if (G == 256) { if (blockIdx.x < 128) { vt_transpose(PROJ, AB_LDP, A_NKV + 3 * 512, 4, (bf16*)(ws + WS_ACT), blockIdx.x * NTHR + tid, 128 * NTHR);
                vt_transpose(PROJ, AB_LDP, A_NKV + 5 * 512, 4, (bf16*)(ws + WS_ACT + 8 * MiB), blockIdx.x * NTHR + tid, 128 * NTHR); } }
        else { vt_transpose(PROJ, AB_LDP, A_NKV + 3 * 512, 4, (bf16*)(ws + WS_ACT), blockIdx.x * NTHR + tid, G * NTHR);
            vt_transpose(PROJ, AB_LDP, A_NKV + 5 * 512, 4, (bf16*)(ws + WS_ACT + 8 * MiB), blockIdx.x * NTHR + tid, G * NTHR); }
    }
    SEAM(2);
    if (IN(3)) { if (wave == 0) { if (gw2 < 256) gdn_state_scan(AN, DS, SN, gw2, lane); }
        else transpose_seg(args.in[I_FFN_WDOWN] + SZ_DOWN, DFF, DM, 0, DM, DM, WDOWN + SZ_DOWN, 0, (LAS float*)(lds + wave * 16384), (int)blockIdx.x * 7 + wave - 1, G * 7, lane); }
    SEAM(3);
    if (IN(4)) { nsa_attn_mfma(PROJ, SMALL, KC, VC, (const bf16*)(ws + WS_ACT), (const bf16*)(ws + WS_ACT + 8 * MiB), (bf16*)Y, OBUF, lds, tid, lane, wave); __syncthreads(); }
    if (IN(5)) {
        chunk_output(QH, SN, OI, args.in[I_GDN_NORM], PROJ + A_GATE, AB_LDP, OBUF, lds, tid, lane, wave);
    }
    SEAM(5);
    if (IN(6)) { pg8::Gemm g{OBUF, WABOUT, M, DM, DM, DM}; pg8::StaticOrder S; S.init(M, DM, G, (int)blockIdx.x); pg8::EpiB16 E{YB, DM, nullptr};
        pg8::gemm_phase<pg8::EpiB16, pg8::StaticOrder, true, true>(lds, g, S, E); }
    SEAM(6);
    if (IN(7)) for (int m = gw; m < M; m += ngw) post_row<false>(YB + (size_t)m * DM, H + (size_t)m * DM, nullptr, args.in[I_AB_NPOST], RS + m, lane);
    SEAM(7);
#define FFN_PLE(P0, L, FINALP) \
    if (IN(P0)) { pg8::Gemm g{H, WUP + (L) * SZ_UP, M, 2 * DFF, DM, DM}; pg8::StaticOrder S; S.init(M, 2 * DFF, G, (int)blockIdx.x); pg8::EpiB16 E{Z, 2 * DFF, RS}; \
        pg8::gemm_phase<pg8::EpiB16, pg8::StaticOrder, true, true>(lds, g, S, E); } \
    SEAM(P0); \
    if (IN(P0 + 1)) convact_phase(Z, args.in[I_FFN_CW] + (size_t)(L) * 3 * 2 * DFF, args.in[I_FFN_CB] + (size_t)(L) * 2 * DFF, ACT, blockIdx.x * NTHR + tid, G * NTHR); \
    SEAM(P0 + 1); \
    if (IN(P0 + 2)) { pg8::Gemm g{ACT, WDOWN + (L) * SZ_DOWN, M, DM, DFF, DFF}; pg8::StaticOrder S; S.init(M, DM, G, (int)blockIdx.x); pg8::EpiB16 E{YB, DM, nullptr}; \
        pg8::gemm_phase<pg8::EpiB16, pg8::StaticOrder, true, true>(lds, g, S, E); } \
    SEAM(P0 + 2); \
    if (IN(P0 + 3)) for (int m = gw; m < M; m += ngw) post_row<false>(YB + (size_t)m * DM, H + (size_t)m * DM, nullptr, args.in[I_FFN_NPOST] + (L) * DM, RS + m, lane); \
    SEAM(P0 + 3); \
    if (IN(P0 + 4)) { pg8::Gemm g{PBF + (size_t)(L) * M * DPLE, WPROJ + (L) * SZ_PJ, M, DM, DPLE, DPLE}; pg8::StaticOrder S; S.init(M, DM, G, (int)blockIdx.x); pg8::EpiB16 E{PP, DM, nullptr}; \
        pg8::gemm_phase<pg8::EpiB16, pg8::StaticOrder, true, true>(lds, g, S, E); } \
    SEAM(P0 + 4); \
    if (IN(P0 + 5)) { pg8::Gemm g{H, WGATE + (L) * SZ_SQ, M, DM, DM, DM}; pg8::StaticOrder S; S.init(M, DM, G, (int)blockIdx.x); pg8::EpiGate E{YB, PP, DM, RS}; \
        pg8::gemm_phase<pg8::EpiGate, pg8::StaticOrder, true, true>(lds, g, S, E); } \
    SEAM(P0 + 5); \
    if (IN(P0 + 6)) { \
        for (int m = gw; m < M; m += ngw) post_row<FINALP>(YB + (size_t)m * DM, H + (size_t)m * DM, FINALP ? args.out + (size_t)m * DM : (float*)nullptr, args.in[I_PLE_NPOST] + (L) * DM, RS + m, lane); \
        if (!(FINALP) && G == 256) { asm volatile("s_waitcnt vmcnt(0)" ::: "memory"); __syncthreads(); ff_rows_mfma(H, (const bf16*)(ms + MS_WFF), RS, SMALL, lds, tid, lane, wave); } }

    FFN_PLE(8, 0, false)
    SEAM(14);
    if (IN(15)) { pg8::Gemm g{H, WCDIN, M, CD_LDP, DM, DM}; pg8::StaticOrder S; S.init(M, CD_LDP, G, (int)blockIdx.x); pg8::EpiProj E{PROJ, CD_LDP, SMALL, CD_LDP / 256, RS};
        pg8::gemm_phase<pg8::EpiProj, pg8::StaticOrder, true, true>(lds, g, S, E); }
    SEAM(15);
    if (IN(16)) {
        hgrn_chunk_prep(PROJ, args.in[I_LB], QH, OI, DS, DEC, lds, tid, lane, wave);
        if (gw2 < 64) fox_cum(SMALL, args.in[I_FOX_B], CUM, gw2, lane);
        vt_transpose(PROJ, CD_LDP, C_FV, NH, (bf16*)(ws + WS_ACT), blockIdx.x * NTHR + tid, G * NTHR);
    }
    SEAM(16);
    if (IN(17)) { if (wave == 0) { if (gw2 < 256) hgrn_state_scan(DS, DEC, SN, gw2, lane); }
        else { LAS float* scr7 = (LAS float*)(lds + wave * 16384);
            transpose_seg(args.in[I_CD_WOUT], DM, DM, 0, DM, DM, WCDOUT, 0, scr7, (int)blockIdx.x * 7 + wave - 1, G * 7, lane);
            transpose_seg(args.in[I_PLE_WGATE] + SZ_SQ, DM, DM, 0, DM, DM, WGATE + SZ_SQ, 0, scr7, (int)blockIdx.x * 7 + wave - 1, G * 7, lane, args.in[I_PLE_GNORM] + DM); } }
    SEAM(17);
    if (IN(18)) {
        fox_attn_mfma(PROJ, (const bf16*)(ws + WS_ACT), CUM, OBUF, lds, tid, lane, wave);
        __syncthreads();
        chunk_output(QH, SN, OI, args.in[I_HGRN_NORM], PROJ + C_HG, CD_LDP, OBUF, lds, tid, lane, wave);
    }
    SEAM(18);
    if (IN(19)) { pg8::Gemm g{OBUF, WCDOUT, M, DM, DM, DM}; pg8::StaticOrder S; S.init(M, DM, G, (int)blockIdx.x); pg8::EpiB16 E{YB, DM, nullptr};
        pg8::gemm_phase<pg8::EpiB16, pg8::StaticOrder, true, true>(lds, g, S, E); }
    SEAM(19);
    if (IN(20)) for (int m = gw; m < M; m += ngw) post_row<false>(YB + (size_t)m * DM, H + (size_t)m * DM, nullptr, args.in[I_CD_NPOST], RS + m, lane);
    SEAM(20);
    FFN_PLE(21, 1, true)
#undef IN
#undef SEAM
}

extern "C" void kernel_launch(void* const* d_in, const int* in_sizes, int n_in, void* d_out, int out_size, void* d_ws, size_t ws_size, hipStream_t stream) {
    static int grid = 0;
    if (grid == 0) {
        if (n_in != 33 || out_size != M * DM || ws_size < WS_END) { fprintf(stderr, "kernel_launch: unexpected problem (n_in %d, out %d, ws %zu < %zu)\n", n_in, out_size, ws_size, (size_t)WS_END); grid = -1; return; }
        int dev = 0, cus = 0, per_cu = 0;
        if (hipGetDevice(&dev) != hipSuccess || hipDeviceGetAttribute(&cus, hipDeviceAttributeMultiprocessorCount, dev) != hipSuccess) { grid = -1; return; }
        if (hipFuncSetAttribute((const void*)fwd, hipFuncAttributeMaxDynamicSharedMemorySize, LDS_BYTES) != hipSuccess) { fprintf(stderr, "kernel_launch: hipFuncSetAttribute failed\n"); grid = -1; return; }
        if (hipOccupancyMaxActiveBlocksPerMultiprocessor(&per_cu, (const void*)fwd, NTHR, LDS_BYTES) != hipSuccess || per_cu < 1) fprintf(stderr, "kernel_launch: occupancy query says %d\n", per_cu);
        (void)hipGetLastError();
        if (cus * 8 < 2048) { fprintf(stderr, "kernel_launch: needs >= 256 CUs (GDN chunk prep owns 8 chunks per workgroup)\n"); grid = -1; return; }
        grid = 256;
    }
    if (grid < 0) return;
    (void)hipMemsetAsync((char*)d_ws + WS_CTL, 0, CTL_BYTES, stream);
    Args a{};
    for (int i = 0; i < 33; ++i) a.in[i] = (const float*)d_in[i];
    a.out = (float*)d_out; a.ws = (unsigned char*)d_ws;
#if MK_SINGLE
    a.ph_lo = 0; a.ph_hi = NPHASE;
    hipLaunchKernelGGL(fwd, dim3(grid), dim3(NTHR), LDS_BYTES, stream, a);
#else
    for (int ph = 0; ph < NPHASE; ++ph) { a.ph_lo = ph; a.ph_hi = ph + 1; hipLaunchKernelGGL(fwd, dim3(grid), dim3(NTHR), LDS_BYTES, stream, a); }
#endif
}
```

```cpp
#include <hip/hip_runtime.h>
#include <cstdio>
#include <cstdint>
namespace pg8 {
#define PG8_LAS __attribute__((address_space(3)))
typedef unsigned short bf16_t;
typedef short bf16x8 __attribute__((ext_vector_type(8)));
typedef float f32x4 __attribute__((ext_vector_type(4)));
typedef unsigned u32x4 __attribute__((ext_vector_type(4)));
constexpr int BM = 256, BK = 64, HALF = 128, HTB = HALF * BK * 2  , STAGE_BYTES = 8 * HTB, NXCD = 8, WGM = 8;

__host__ __device__ __forceinline__ int lds_byte(int r, int c) { const int st = (r >> 4) * 2 + (c >> 5), rr = r & 15, cc = c & 31, ob = rr * 64 + cc * 2; return st * 1024 + (ob ^ (((ob >> 9) & 1) << 5)); }
__host__ __device__ __forceinline__ void stage_rc(int b, int& R, int& C) { const int st = b / 1024, sb = b % 1024, swz = sb ^ (((sb >> 9) & 1) << 5); R = (st >> 1) * 16 + swz / 64; C = (st & 1) * 32 + (swz % 64) / 2; }
__host__ __device__ __forceinline__ int perm32(int rho) { const int n = rho >> 4, i = rho & 15; return 8 * (i >> 2) + 4 * n + (i & 3); }

struct Unit { int pm, pn; };
struct Gemm { const bf16_t* A; const bf16_t* Bt; int M, N, K, lda; };

struct StaticOrder {
    int nM, nN, nwg, G, c;
    __host__ __device__ void init(int M, int N, int G_, int c_) { nM = M / BM; nN = N / BM; nwg = nM * nN; G = G_; c = c_; }
    __host__ __device__ bool next(int i, Unit& u) const {
        const long L = (long)i * G + c; if (L >= nwg) return false;
        int wgid = (int)L; { const int q = nwg / NXCD, r = nwg % NXCD, xcd = wgid % NXCD, off = wgid / NXCD; wgid = (xcd < r ? xcd * (q + 1) : r * (q + 1) + (xcd - r) * q) + off; }
        const int nig = WGM * nN, gid = wgid / nig, fm = gid * WGM, gsz = (nM - fm) < WGM ? (nM - fm) : WGM;
        u.pm = fm + ((wgid % nig) % gsz); u.pn = (wgid % nig) / gsz; return true;
    }
    __device__ __forceinline__ void a_ready(const Unit&) const {}
    __device__ __forceinline__ void done(const Unit&) const {}
};

__device__ __forceinline__ unsigned cvt_pk_bf16(float lo, float hi) { unsigned r; asm volatile("v_cvt_pk_bf16_f32 %0, %1, %2" : "=v"(r) : "v"(lo), "v"(hi)); return r; }
typedef float f32x2 __attribute__((ext_vector_type(2)));
struct EpiB16 {
    static constexpr bool PERM = true, AFTER_DRAIN = false;
    bf16_t* O; int ldc; const float* rs;
    __device__ __forceinline__ void operator()(const f32x4 (&acc)[2][2][4][2], const Unit& u, int wr, int wc, int fr, int fq) const {
        const int row0 = u.pm * BM + wr * 64 + fr, col0 = u.pn * BM + wc * 32 + 8 * fq;
#pragma unroll
        for (int ai = 0; ai < 2; ++ai)
#pragma unroll
            for (int m = 0; m < 4; ++m) { const int row = row0 + ai * HALF + m * 16; const float sc = rs ? rs[row] : 1.f; bf16_t* rowp = O + (size_t)row * ldc + col0;
#pragma unroll
                for (int bj = 0; bj < 2; ++bj) { const f32x4 v0 = acc[ai][bj][m][0] * sc, v1 = acc[ai][bj][m][1] * sc;
                    u32x4 w; w.x = cvt_pk_bf16(v0[0], v0[1]); w.y = cvt_pk_bf16(v0[2], v0[3]); w.z = cvt_pk_bf16(v1[0], v1[1]); w.w = cvt_pk_bf16(v1[2], v1[3]);
                    *(u32x4*)(rowp + bj * HALF) = w; } }
    }
};
struct EpiProj {
    static constexpr bool PERM = true, AFTER_DRAIN = false;
    bf16_t* O; int ldc; float* S; int nb16; const float* rs;
    __device__ __forceinline__ void operator()(const f32x4 (&acc)[2][2][4][2], const Unit& u, int wr, int wc, int fr, int fq) const {
        const int row0 = u.pm * BM + wr * 64 + fr;
        if (u.pn < nb16) {
            const int col0 = u.pn * BM + wc * 32 + 8 * fq;
#pragma unroll
            for (int ai = 0; ai < 2; ++ai)
#pragma unroll
                for (int m = 0; m < 4; ++m) { const int row = row0 + ai * HALF + m * 16; const float sc = rs[row]; bf16_t* rowp = O + (size_t)row * ldc + col0;
#pragma unroll
                    for (int bj = 0; bj < 2; ++bj) { const f32x4 v0 = acc[ai][bj][m][0] * sc, v1 = acc[ai][bj][m][1] * sc;
                        u32x4 w; w.x = cvt_pk_bf16(v0[0], v0[1]); w.y = cvt_pk_bf16(v0[2], v0[3]); w.z = cvt_pk_bf16(v1[0], v1[1]); w.w = cvt_pk_bf16(v1[2], v1[3]);
                        *(u32x4*)(rowp + bj * HALF) = w; } }
        } else {
            const int col0 = wc * 32 + 8 * fq;
#pragma unroll
            for (int ai = 0; ai < 2; ++ai)
#pragma unroll
                for (int m = 0; m < 4; ++m) { const int row = row0 + ai * HALF + m * 16; const float sc = rs[row]; float* rowp = S + (size_t)row * 256 + col0;
#pragma unroll
                    for (int bj = 0; bj < 2; ++bj) { *(f32x4*)(rowp + bj * HALF) = acc[ai][bj][m][0] * sc; *(f32x4*)(rowp + bj * HALF + 4) = acc[ai][bj][m][1] * sc; } }
        }
    }
};
struct EpiGate {
    static constexpr bool PERM = true, AFTER_DRAIN = false;
    bf16_t* C; const bf16_t* PP; int ldc; const float* rs;
    __device__ __forceinline__ void operator()(const f32x4 (&acc)[2][2][4][2], const Unit& u, int wr, int wc, int fr, int fq) const {
        const int row0 = u.pm * BM + wr * 64 + fr, col0 = u.pn * BM + wc * 32 + 8 * fq;
#pragma unroll
        for (int ai = 0; ai < 2; ++ai)
#pragma unroll
            for (int m = 0; m < 4; ++m) { const int row = row0 + ai * HALF + m * 16; const float sc = rs[row]; const size_t off = (size_t)row * ldc + col0;
#pragma unroll
                for (int bj = 0; bj < 2; ++bj) { const u32x4 pw = *(const u32x4*)(PP + off + bj * HALF); const f32x4 a = acc[ai][bj][m][0] * sc, b = acc[ai][bj][m][1] * sc; u32x4 w;
                    w.x = cvt_pk_bf16(__uint_as_float(pw.x << 16) * __builtin_amdgcn_rcpf(1.f + __expf(-a[0])), __uint_as_float(pw.x & 0xffff0000u) * __builtin_amdgcn_rcpf(1.f + __expf(-a[1])));
                    w.y = cvt_pk_bf16(__uint_as_float(pw.y << 16) * __builtin_amdgcn_rcpf(1.f + __expf(-a[2])), __uint_as_float(pw.y & 0xffff0000u) * __builtin_amdgcn_rcpf(1.f + __expf(-a[3])));
                    w.z = cvt_pk_bf16(__uint_as_float(pw.z << 16) * __builtin_amdgcn_rcpf(1.f + __expf(-b[0])), __uint_as_float(pw.z & 0xffff0000u) * __builtin_amdgcn_rcpf(1.f + __expf(-b[1])));
                    w.w = cvt_pk_bf16(__uint_as_float(pw.w << 16) * __builtin_amdgcn_rcpf(1.f + __expf(-b[2])), __uint_as_float(pw.w & 0xffff0000u) * __builtin_amdgcn_rcpf(1.f + __expf(-b[3])));
                    *(u32x4*)(C + off + bj * HALF) = w; } }
    }
};
template <class Epi, class Sched, bool ALIGN_EPI = false, bool SP2 = false>
__device__ __forceinline__ void gemm_phase(PG8_LAS unsigned char* lds, const Gemm g, const Sched& S, const Epi& E) {
    const int tid = threadIdx.x, wid = __builtin_amdgcn_readfirstlane(tid >> 6), lane = tid & 63, wr = wid >> 2, wc = wid & 3, fr = lane & 15, fq = lane >> 4;
    const int K = g.K, nt = K / BK;
    unsigned voffA[2], voffB[2];
#pragma unroll
    for (int i = 0; i < 2; ++i) { int R, C; stage_rc(tid * 16 + i * 8192, R, C); const int Rb = Epi::PERM ? ((R & ~31) + perm32(R & 31)) : R;
        voffA[i] = (unsigned)(R * g.lda + C) * 2u; voffB[i] = (unsigned)(Rb * K + C) * 2u; }
    const size_t kstep = (size_t)(BK * 2);
    const size_t hstepA = (size_t)HALF * g.lda * 2, hstepB = (size_t)HALF * K * 2;
    const size_t tstepA = 2 * hstepA, tstepB = 2 * hstepB;
    const unsigned ldsw = (unsigned)wid * 1024u;
    const int aoff = lds_byte(wr * 64 + fr, fq * 8), boff = lds_byte(wc * 32 + fr, fq * 8);
#define PG8_SA(b, h) (((b) * 2 + (h)) * HTB)
#define PG8_SB(b, h) ((4 + (b) * 2 + (h)) * HTB)
#define PG8_STAGE(bufoff, gbase, voff) do { _Pragma("unroll") for (int _i = 0; _i < 2; ++_i) \
        __builtin_amdgcn_global_load_lds((const unsigned*)((const char*)(gbase) + (voff)[_i]), (PG8_LAS unsigned*)(lds + (bufoff) + ldsw + _i * 8192), 16, 0, 0); } while (0)
#define PG8_LDA(dst, b, h) do { _Pragma("unroll") for (int m = 0; m < 4; ++m) _Pragma("unroll") for (int k = 0; k < 2; ++k) dst[m][k] = *(const PG8_LAS bf16x8*)(lds + PG8_SA(b, h) + aoff + m * 2048 + k * 1024); } while (0)
#define PG8_LDB(dst, b, h) do { _Pragma("unroll") for (int n = 0; n < 2; ++n) _Pragma("unroll") for (int k = 0; k < 2; ++k) dst[n][k] = *(const PG8_LAS bf16x8*)(lds + PG8_SB(b, h) + boff + n * 2048 + k * 1024); } while (0)
#define PG8_MMA(ai, bj, At, Bt) do { __builtin_amdgcn_s_setprio(1); _Pragma("unroll") for (int m = 0; m < 4; ++m) _Pragma("unroll") for (int n = 0; n < 2; ++n) _Pragma("unroll") for (int k = 0; k < 2; ++k) \
        acc[ai][bj][m][n] = __builtin_amdgcn_mfma_f32_16x16x32_bf16(Bt[n][k], At[m][k], acc[ai][bj][m][n], 0, 0, 0); __builtin_amdgcn_s_setprio(0); } while (0)
#define PG8_WAIT_V(n) asm volatile("s_waitcnt vmcnt(" #n ")" ::: "memory")
#define PG8_WAIT_L(n) asm volatile("s_waitcnt lgkmcnt(" #n ")" ::: "memory")
#define PG8_BAR __builtin_amdgcn_s_barrier()
#define PG8_SCHED __builtin_amdgcn_sched_barrier(0)
    Unit cur, nxt; int ui = 0;
    if (!S.next(0, cur)) return;
    f32x4 acc[2][2][4][2];
#pragma unroll
    for (int a = 0; a < 2; ++a)
#pragma unroll
        for (int b = 0; b < 2; ++b)
#pragma unroll
            for (int m = 0; m < 4; ++m)
#pragma unroll
                for (int n = 0; n < 2; ++n) acc[a][b][m][n] = (f32x4){0.f, 0.f, 0.f, 0.f};
    bf16x8 At[4][2], B0[2][2], B1[2][2];
    const char* cA = (const char*)g.A + (size_t)cur.pm * tstepA; const char* cB = (const char*)g.Bt + (size_t)cur.pn * tstepB;
    S.a_ready(cur);
    if constexpr (SP2) {
        PG8_STAGE(PG8_SB(0, 0), cB, voffB); PG8_STAGE(PG8_SB(0, 1), cB + hstepB, voffB); PG8_STAGE(PG8_SA(0, 0), cA, voffA); PG8_STAGE(PG8_SA(0, 1), cA + hstepA, voffA);
        if (wr == 1) PG8_BAR;
        PG8_WAIT_V(2); PG8_BAR;
        PG8_STAGE(PG8_SB(1, 0), cB + kstep, voffB); PG8_STAGE(PG8_SA(1, 0), cA + kstep, voffA); PG8_STAGE(PG8_SB(1, 1), cB + hstepB + kstep, voffB);
        PG8_WAIT_V(6); PG8_BAR;
    } else {
        PG8_STAGE(PG8_SB(0, 0), cB, voffB); PG8_STAGE(PG8_SA(0, 0), cA, voffA); PG8_STAGE(PG8_SB(0, 1), cB + hstepB, voffB); PG8_STAGE(PG8_SA(0, 1), cA + hstepA, voffA);
        if (wr == 1) PG8_BAR;
        PG8_WAIT_V(4); PG8_BAR;
        PG8_STAGE(PG8_SB(1, 0), cB + kstep, voffB); PG8_STAGE(PG8_SA(1, 0), cA + kstep, voffA); PG8_STAGE(PG8_SB(1, 1), cB + hstepB + kstep, voffB);
        PG8_WAIT_V(6); PG8_BAR;
    }
    for (;;) {
        const bool has_next = S.next(ui + 1, nxt);
        const char* nA = has_next ? (const char*)g.A + (size_t)nxt.pm * tstepA : cA; const char* nB = has_next ? (const char*)g.Bt + (size_t)nxt.pn * tstepB : cB;
        for (int t = 0; t < nt; t += 2) {
            const bool last = (t == nt - 2);
            const char* a1 = cA + (size_t)(t + 1) * kstep;
            const char* a2 = last ? nA : cA + (size_t)(t + 2) * kstep; const char* b2 = last ? nB : cB + (size_t)(t + 2) * kstep;
            const char* a3 = a2 + kstep; const char* b3 = b2 + kstep;
            if (last && has_next) S.a_ready(nxt);
            if constexpr (SP2) {
            PG8_LDB(B0, 0, 0); PG8_LDB(B1, 0, 1); PG8_SCHED; PG8_LDA(At, 0, 0); PG8_STAGE(PG8_SA(1, 1), a1 + hstepA, voffA);
            PG8_WAIT_V(8); PG8_WAIT_L(0); PG8_BAR; PG8_MMA(0, 0, At, B0); PG8_MMA(0, 1, At, B1); PG8_BAR; PG8_SCHED;
            PG8_LDA(At, 0, 1); PG8_STAGE(PG8_SB(0, 0), b2, voffB); PG8_STAGE(PG8_SB(0, 1), b2 + hstepB, voffB); PG8_STAGE(PG8_SA(0, 0), a2, voffA);
            PG8_WAIT_V(8); PG8_WAIT_L(0); PG8_BAR; PG8_MMA(1, 0, At, B0); PG8_MMA(1, 1, At, B1); PG8_BAR; PG8_SCHED;
            PG8_LDB(B0, 1, 0); PG8_LDB(B1, 1, 1); PG8_SCHED; PG8_LDA(At, 1, 0); PG8_STAGE(PG8_SA(0, 1), a2 + hstepA, voffA);
            PG8_WAIT_V(8); PG8_WAIT_L(0); PG8_BAR; PG8_MMA(0, 0, At, B0); PG8_MMA(0, 1, At, B1); PG8_BAR; PG8_SCHED;
            PG8_LDA(At, 1, 1); PG8_STAGE(PG8_SB(1, 0), b3, voffB); PG8_STAGE(PG8_SB(1, 1), b3 + hstepB, voffB); PG8_STAGE(PG8_SA(1, 0), a3, voffA);
            PG8_WAIT_V(8); PG8_WAIT_L(0); PG8_BAR; PG8_MMA(1, 0, At, B0); PG8_MMA(1, 1, At, B1); PG8_BAR; PG8_SCHED;
            } else {
            PG8_LDB(B0, 0, 0); PG8_SCHED; PG8_LDA(At, 0, 0); PG8_STAGE(PG8_SA(1, 1), a1 + hstepA, voffA);
            PG8_WAIT_L(8); PG8_BAR; PG8_WAIT_L(0); PG8_MMA(0, 0, At, B0); PG8_BAR; PG8_SCHED;
            PG8_LDB(B1, 0, 1); PG8_STAGE(PG8_SB(0, 0), b2, voffB);
            PG8_BAR; PG8_WAIT_L(0); PG8_MMA(0, 1, At, B1); PG8_BAR;
            PG8_LDA(At, 0, 1); PG8_STAGE(PG8_SA(0, 0), a2, voffA);
            PG8_BAR; PG8_WAIT_L(0); PG8_MMA(1, 0, At, B0); PG8_BAR; PG8_SCHED;
            PG8_STAGE(PG8_SB(0, 1), b2 + hstepB, voffB);
            PG8_WAIT_V(6); PG8_BAR; PG8_MMA(1, 1, At, B1); PG8_BAR;
            PG8_LDB(B0, 1, 0); PG8_SCHED; PG8_LDA(At, 1, 0); PG8_STAGE(PG8_SA(0, 1), a2 + hstepA, voffA);
            PG8_WAIT_L(8); PG8_BAR; PG8_WAIT_L(0); PG8_MMA(0, 0, At, B0); PG8_BAR; PG8_SCHED;
            PG8_LDB(B1, 1, 1); PG8_STAGE(PG8_SB(1, 0), b3, voffB);
            PG8_BAR; PG8_WAIT_L(0); PG8_MMA(0, 1, At, B1); PG8_BAR;
            PG8_LDA(At, 1, 1); PG8_STAGE(PG8_SA(1, 0), a3, voffA);
            PG8_BAR; PG8_WAIT_L(0); PG8_MMA(1, 0, At, B0); PG8_BAR; PG8_SCHED;
            PG8_STAGE(PG8_SB(1, 1), b3 + hstepB, voffB);
            PG8_WAIT_V(6); PG8_BAR; PG8_MMA(1, 1, At, B1); PG8_BAR;
            }
        }
        if constexpr (ALIGN_EPI) { if (wr == 0) PG8_BAR; }
        if constexpr (!Epi::AFTER_DRAIN) { E(acc, cur, wr, wc, fr, fq); S.done(cur); }
        if (!has_next) break;
#pragma unroll
        for (int a = 0; a < 2; ++a)
#pragma unroll
            for (int b = 0; b < 2; ++b)
#pragma unroll
                for (int m = 0; m < 4; ++m)
#pragma unroll
                    for (int n = 0; n < 2; ++n) acc[a][b][m][n] = (f32x4){0.f, 0.f, 0.f, 0.f};
        cur = nxt; cA = nA; cB = nB; ++ui;
        if constexpr (ALIGN_EPI) { if (wr == 1) PG8_BAR; }
    }
    PG8_WAIT_V(0);
    if constexpr (!ALIGN_EPI) { if (wr == 0) PG8_BAR; }
    PG8_BAR;
    if constexpr (Epi::AFTER_DRAIN) { E.fused(acc, cur, wr, wc, fr, fq, lds, wid, lane); S.done(cur); }
#undef PG8_SA
#undef PG8_SB
#undef PG8_STAGE
#undef PG8_LDA
#undef PG8_LDB
#undef PG8_MMA
#undef PG8_WAIT_V
#undef PG8_WAIT_L
#undef PG8_BAR
#undef PG8_SCHED
}
}
constexpr int NB = 4, T = 2048, DM = 4096, M = NB * T, HD = 128, NH = 16, DFF = 11008, DPLE = 256;
constexpr int AB_IN = 13392, CD_IN = 14352;
constexpr int AB_LDP = 13312, AB_NPAD = 13568;
constexpr int CD_LDP = 14336, CD_NPAD = 14592;
constexpr int A_QKV = 0, A_GATE = 6144, A_NQ = 8192, A_NKV = 10240;
constexpr int C_HQ = 0, C_HF = 2048, C_HI = 4096, C_HG = 6144, C_FQ = 8192, C_FK = 10240, C_FV = 12288;
constexpr int NCMP = 127;
constexpr float EPS = 1e-6f, QSCALE = 0.08838834764831845f;
constexpr size_t MiB = 1u << 20;
constexpr size_t WS_CTL = 0, CTL_BYTES = 65536;
constexpr size_t WS_WABIN = 1 * MiB;
constexpr size_t WS_WABOUT = WS_WABIN + 106 * MiB;
constexpr size_t WS_WCDIN = WS_WABOUT + 32 * MiB;
constexpr size_t WS_WCDOUT = WS_WCDIN + 114 * MiB;
constexpr size_t WS_WUP = WS_WCDOUT + 32 * MiB;
constexpr size_t WS_WDOWN = WS_WUP + 2 * 172 * MiB;
constexpr size_t WS_WGATE = WS_WDOWN + 2 * 86 * MiB;
constexpr size_t WS_WPROJ = WS_WGATE + 2 * 32 * MiB;
constexpr size_t WS_XRES = WS_WPROJ + 2 * 2 * MiB;
constexpr size_t WS_H = WS_XRES + 128 * MiB;
constexpr size_t WS_PROJ = WS_H + 64 * MiB;
constexpr size_t WS_SMALL = WS_PROJ + 224 * MiB;
constexpr size_t WS_Y = WS_SMALL + 8 * MiB;
constexpr size_t WS_OBUF = WS_Y + 128 * MiB;
constexpr size_t WS_Z = WS_OBUF + 64 * MiB;
constexpr size_t WS_ACT = WS_Z + 344 * MiB;
constexpr size_t WS_PP = WS_ACT + 172 * MiB;
constexpr size_t WS_PBF = WS_PP + 64 * MiB;
constexpr size_t WS_MISC = WS_PBF + 8 * MiB;
constexpr size_t WS_END = WS_MISC + 8 * MiB;
constexpr size_t WS_QN = WS_Z, WS_KN = WS_Z + 64 * MiB, WS_VV = WS_Z + 128 * MiB, WS_ORAW = WS_Z + 192 * MiB, WS_OCMP = WS_Z + 256 * MiB;
constexpr size_t MS_KC = 0, MS_VC = 1 * MiB  , MS_GG = 2 * MiB, MS_BB = 2 * MiB + 512 * 1024, MS_SEL = 3 * MiB, MS_CUM = 4 * MiB, MS_PEB = 5 * MiB;
constexpr int CW_BAR = 4096;

constexpr int NWAVES = 8, NTHR = 512;
constexpr int RING_BYTES = 131072, LDSCTL_OFF = RING_BYTES, MISC_OFF = LDSCTL_OFF + 320, LDS_BYTES = 147456;

#define GAS __attribute__((address_space(1)))
#define LAS __attribute__((address_space(3)))
typedef unsigned short bf16;
typedef unsigned v4u __attribute__((ext_vector_type(4)));
typedef unsigned v2u __attribute__((ext_vector_type(2)));
typedef float f32x4 __attribute__((ext_vector_type(4)));
#define LDS_WAIT() asm volatile("s_waitcnt lgkmcnt(0)" ::: "memory")
typedef __bf16 bf16x2_t __attribute__((ext_vector_type(2)));
typedef float f32x2_t __attribute__((ext_vector_type(2)));
__device__ __forceinline__ unsigned cvtpk(float lo, float hi) { f32x2_t v = {lo, hi}; return __builtin_bit_cast(unsigned, __builtin_convertvector(v, bf16x2_t)); }
__device__ __forceinline__ unsigned f2bf(float f) { return cvtpk(f, 0.f); }
__device__ __forceinline__ unsigned pk2(float lo, float hi) { return cvtpk(lo, hi); }
__device__ __forceinline__ float bflo(unsigned w) { return __uint_as_float(w << 16); }
__device__ __forceinline__ float bfhi(unsigned w) { return __uint_as_float(w & 0xffff0000u); }
__device__ __forceinline__ float bf2f(bf16 b) { return __uint_as_float(((unsigned)b) << 16); }
__device__ __forceinline__ float wave_sum(float v) {
#pragma unroll
    for (int o = 1; o < 64; o <<= 1) v += __shfl_xor(v, o);
    return v; }
__device__ __forceinline__ float wave_max(float v) {
#pragma unroll
    for (int o = 1; o < 64; o <<= 1) v = fmaxf(v, __shfl_xor(v, o));
    return v; }
__device__ __forceinline__ float sigm(float x) { return __builtin_amdgcn_rcpf(1.f + __expf(-x)); }
__device__ __forceinline__ float silu(float x) { return x * __builtin_amdgcn_rcpf(1.f + __expf(-x)); }
__device__ __forceinline__ float softplus(float x) { return x > 20.f ? x : log1pf(__expf(x)); }
__device__ __forceinline__ float logsigm(float x) { return fminf(x, 0.f) - log1pf(__expf(-fabsf(x))); }

#define XB_TMO      128
#define XB_XCNT(j)  (256  + 64 * (j))
#define XB_XSUB(j)  (1280 + 64 * (j))
#define XB_XGEN(j)  (2304 + 64 * (j))
#define XB_TOP      3328
#define XB_TOPGEN   3392
#define XCD_BAR_WORDS 3456
#define XB_SPIN_CAP (1u << 18)
__device__ __forceinline__ unsigned xb_ld(unsigned* p)              { return __hip_atomic_load(p, __ATOMIC_RELAXED, __HIP_MEMORY_SCOPE_AGENT); }
__device__ __forceinline__ unsigned xb_add(unsigned* p, unsigned v) { return __hip_atomic_fetch_add(p, v, __ATOMIC_RELAXED, __HIP_MEMORY_SCOPE_AGENT); }
__device__ __forceinline__ unsigned xb_xcc_id() { return (unsigned)__builtin_amdgcn_s_getreg((3 << 11) | 20) & 0xFu; }
#define XB_SPIN(cond, bar) do { unsigned _sp = 0; while (cond) { __builtin_amdgcn_s_sleep(1); \
    if ((++_sp & 255u) == 0u) { if (xb_ld(&(bar)[XB_TMO])) break; if (_sp > XB_SPIN_CAP) { atomicAdd(&(bar)[XB_TMO], 1u); break; } } } } while (0)
struct XcdBarrier { unsigned* bar; unsigned x; volatile LAS unsigned* st; };
__device__ __forceinline__ XcdBarrier xcd_barrier_post(unsigned* bar, volatile LAS unsigned* st) {
    XcdBarrier b; b.bar = bar; b.x = xb_xcc_id(); b.st = st;
    if (threadIdx.x == 0) (void)xb_add(&bar[XB_XCNT(b.x)], 1u);
    return b;
}
__device__ __forceinline__ void xcd_barrier_complete(unsigned* bar, unsigned x, unsigned& nloc, unsigned& nx) {
    const unsigned G = gridDim.x * gridDim.y * gridDim.z;
    unsigned sum, cnt, mine, sp = 0u;
    for (;;) {
        sum = 0u; cnt = 0u; mine = 0u;
#pragma unroll
        for (unsigned j = 0; j < 16; ++j) { const unsigned c = xb_ld(&bar[XB_XCNT(j)]); sum += c; cnt += (c > 0u) ? 1u : 0u; mine = (j == x) ? c : mine; }
        if (sum == G) break;
        __builtin_amdgcn_s_sleep(1);
        if ((++sp & 255u) == 0u) { if (xb_ld(&bar[XB_TMO])) break; if (sp > XB_SPIN_CAP) { atomicAdd(&bar[XB_TMO], 1u); break; } }
    }
    nloc = mine > 0u ? mine : 1u; nx = cnt > 0u ? cnt : 1u;
}
__device__ __forceinline__ void xcd_barrier(const XcdBarrier& b) {
    asm volatile("s_waitcnt vmcnt(0)" ::: "memory");
    __syncthreads();
    if (threadIdx.x == 0) {
        unsigned* bar = b.bar;
        __builtin_amdgcn_s_waitcnt(0);
        unsigned nloc = b.st[0], nx = b.st[1];
        if (nloc == 0u) { xcd_barrier_complete(bar, b.x, nloc, nx); b.st[0] = nloc; b.st[1] = nx; }
        const unsigned old = xb_add(&bar[XB_XSUB(b.x)], 1u);
        const unsigned gen = old / nloc;
        if (old + 1u == (gen + 1u) * nloc) {
            __builtin_amdgcn_fence(__ATOMIC_RELEASE, "agent");
            asm volatile("s_waitcnt vmcnt(0)" ::: "memory");
            const unsigned og = xb_add(&bar[XB_TOP], 1u);
            const unsigned tg = og / nx;
            if (og + 1u == (tg + 1u) * nx) xb_add(&bar[XB_TOPGEN], 1u);
            else XB_SPIN(xb_ld(&bar[XB_TOPGEN]) == tg, bar);
            __builtin_amdgcn_fence(__ATOMIC_ACQUIRE, "agent");
            xb_add(&bar[XB_XGEN(b.x)], 1u);
            asm volatile("s_waitcnt vmcnt(0)" ::: "memory");
        } else {
            XB_SPIN(xb_ld(&bar[XB_XGEN(b.x)]) == gen, bar);
            __builtin_amdgcn_fence(__ATOMIC_ACQUIRE, "agent");
            asm volatile("s_waitcnt vmcnt(0)" ::: "memory");
        }
    }
    __syncthreads();
}

__device__ __forceinline__ void transpose_seg(const float* W, int K, int ldw, int c0, int nvalid, int npad, bf16* Wt, int r0, LAS float* scr, int gw, int ngw, int lane, const float* kscale = nullptr) {
    const int nblk = npad / 32, nitems = (K / 64) * nblk;
    const int nkb = K / 64, GK = (nkb % 8 == 0) ? 8 : ((nkb % 4 == 0) ? 4 : 1), GN = 64 / GK; const bool blocked = (GK > 1) && (nblk % GN == 0);
    for (int item = gw; item < nitems; item += ngw) {
        int kb, nb;
        if (blocked) { const int grp = item >> 6, w = item & 63, gpr = nblk / GN; kb = GK * (grp / gpr) + w / GN; nb = GN * (grp % gpr) + w % GN; }
        else { kb = item / nblk; nb = item % nblk; }
        const int k0 = 64 * kb, n0 = 32 * nb;
        const int nn = n0 + (lane & 31); const bool ok = nn < nvalid;
        const float* src = W + (size_t)k0 * ldw + c0 + (ok ? nn : 0);
        float tv[32];
#pragma unroll
        for (int i = 0; i < 32; ++i) tv[i] = src[(size_t)(2 * i + (lane >> 5)) * ldw];
#pragma unroll
        for (int i = 0; i < 32; ++i) { const int kk = 2 * i + (lane >> 5); scr[kk * 33 + (lane & 31)] = ok ? tv[i] : 0.f; }
        LDS_WAIT(); asm volatile("" ::: "memory");
        const int c = lane & 7;
        f32x4 ka = (f32x4){1.f, 1.f, 1.f, 1.f}, kb2 = ka;
        if (kscale) { ka = *(const f32x4*)(kscale + k0 + 8 * c); kb2 = *(const f32x4*)(kscale + k0 + 8 * c + 4); }
#pragma unroll
        for (int j = 0; j < 4; ++j) { const int n = (lane >> 3) + 8 * j; const LAS float* s = scr + (8 * c) * 33 + n;
            v4u o; o.x = pk2(s[0 * 33] * ka.x, s[1 * 33] * ka.y); o.y = pk2(s[2 * 33] * ka.z, s[3 * 33] * ka.w); o.z = pk2(s[4 * 33] * kb2.x, s[5 * 33] * kb2.y); o.w = pk2(s[6 * 33] * kb2.z, s[7 * 33] * kb2.w);
            *(v4u*)(Wt + (size_t)(r0 + n0 + n) * K + k0 + 8 * c) = o; }
        LDS_WAIT(); asm volatile("" ::: "memory");
    }
}
__device__ __forceinline__ void prep_row(const float* xrow, bf16* orow, float* rs, int lane) {
    asm volatile("" : "+v"(lane));
    const f32x4* xr = (const f32x4*)xrow; v4u* o = (v4u*)orow; float s = 0.f;
#pragma unroll
    for (int j = 0; j < 8; ++j) { const int c = lane + 64 * j; const f32x4 a = xr[2 * c], b = xr[2 * c + 1];
        s += (a.x * a.x + a.y * a.y) + (a.z * a.z + a.w * a.w) + (b.x * b.x + b.y * b.y) + (b.z * b.z + b.w * b.w);
        v4u w; w.x = pk2(a.x, a.y); w.y = pk2(a.z, a.w); w.z = pk2(b.x, b.y); w.w = pk2(b.z, b.w); o[c] = w; }
    s = wave_sum(s); if (lane == 0) *rs = rsqrtf(s * (1.f / DM) + EPS);
}
template <bool FINAL>
__device__ __forceinline__ void post_row(const bf16* yrow, bf16* xrow, float* fout, const float* wpost, float* rs, int lane) {
    asm volatile("" : "+v"(lane));
    const v4u* yr = (const v4u*)yrow; v4u* xr = (v4u*)xrow; const f32x4* wp = (const f32x4*)wpost; v4u yv[8]; float s = 0.f;
#pragma unroll
    for (int j = 0; j < 8; ++j) { yv[j] = yr[lane + 64 * j]; const v4u w = yv[j];
        s += (bflo(w.x) * bflo(w.x) + bfhi(w.x) * bfhi(w.x)) + (bflo(w.y) * bflo(w.y) + bfhi(w.y) * bfhi(w.y)) + (bflo(w.z) * bflo(w.z) + bfhi(w.z) * bfhi(w.z)) + (bflo(w.w) * bflo(w.w) + bfhi(w.w) * bfhi(w.w)); }
    const float rstd = rsqrtf(wave_sum(s) * (1.f / DM) + EPS); float s2 = 0.f;
#pragma unroll
    for (int j = 0; j < 8; ++j) { const int c = lane + 64 * j; const v4u xw = xr[c], yw = yv[j]; const f32x4 wa = wp[2 * c], wb = wp[2 * c + 1];
        f32x4 a, b;
        a.x = bflo(xw.x) + bflo(yw.x) * rstd * wa.x; a.y = bfhi(xw.x) + bfhi(yw.x) * rstd * wa.y; a.z = bflo(xw.y) + bflo(yw.y) * rstd * wa.z; a.w = bfhi(xw.y) + bfhi(yw.y) * rstd * wa.w;
        b.x = bflo(xw.z) + bflo(yw.z) * rstd * wb.x; b.y = bfhi(xw.z) + bfhi(yw.z) * rstd * wb.y; b.z = bflo(xw.w) + bflo(yw.w) * rstd * wb.z; b.w = bfhi(xw.w) + bfhi(yw.w) * rstd * wb.w;
        if (FINAL) { ((f32x4*)fout)[2 * c] = a; ((f32x4*)fout)[2 * c + 1] = b; }
        else { s2 += (a.x * a.x + a.y * a.y) + (a.z * a.z + a.w * a.w) + (b.x * b.x + b.y * b.y) + (b.z * b.z + b.w * b.w);
            v4u w; w.x = pk2(a.x, a.y); w.y = pk2(a.z, a.w); w.z = pk2(b.x, b.y); w.w = pk2(b.z, b.w); xr[c] = w; } }
    if (!FINAL) { s2 = wave_sum(s2); if (lane == 0) *rs = rsqrtf(s2 * (1.f / DM) + EPS); }
}
__device__ __forceinline__ void ff_rows_mfma(const bf16* X, const bf16* WT, const float* RS, float* SMALLp, LAS unsigned char* lds, int tid, int lane, int wave) {
    typedef short bf16x8_ __attribute__((ext_vector_type(8))); typedef float f32x16_ __attribute__((ext_vector_type(16)));
    const int r = lane & 31, hh = lane >> 5; const int m = 8 * (int)blockIdx.x + (r & 7) + 2048 * (r >> 3);
    const bf16* xa = X + (size_t)m * DM + 512 * wave + 8 * hh; const bf16* wb = WT + (size_t)(r & 15) * DM + 512 * wave + 8 * hh;
    f32x16_ acc;
#pragma unroll
    for (int i = 0; i < 16; ++i) acc[i] = 0.f;
#pragma unroll 8
    for (int ks = 0; ks < 32; ++ks) { const bf16x8_ a = *(const bf16x8_*)(xa + 16 * ks); bf16x8_ b = *(const bf16x8_*)(wb + 16 * ks); if (r >= 16) b = (bf16x8_){0, 0, 0, 0, 0, 0, 0, 0};
        acc = __builtin_amdgcn_mfma_f32_32x32x16_bf16(a, b, acc, 0, 0, 0); }
    LAS float* P = (LAS float*)lds;
    if (r < 16) {
#pragma unroll
        for (int i = 0; i < 16; ++i) { const int rr = (i & 3) + 8 * (i >> 2) + 4 * hh; P[(wave * 32 + rr) * 16 + r] = acc[i]; } }
    __syncthreads();
    { const int rr = tid >> 4, c = tid & 15; float sacc = 0.f;
#pragma unroll
      for (int w = 0; w < 8; ++w) sacc += P[(w * 32 + rr) * 16 + c];
      const int mm = 8 * (int)blockIdx.x + (rr & 7) + 2048 * (rr >> 3);
      SMALLp[(size_t)mm * 256 + c] = sacc * RS[mm]; }
    __syncthreads();
}
__device__ __forceinline__ void convact_phase(const bf16* Z, const float* cw, const float* cb, bf16* ACT, int gtid, int ngt) {
    constexpr int CG = DFF / 8, RG = M / 8;
    for (int item = gtid; item < CG * RG; item += ngt) {
        const int cg = item % CG, rg = item / CG, c = cg * 8, r0 = rg * 8, t0 = r0 & (T - 1);
        float w[2][3][8], bb[2][8];
#pragma unroll
        for (int s = 0; s < 2; ++s) {
#pragma unroll
            for (int j = 0; j < 3; ++j) { const f32x4 a = *(const f32x4*)(cw + (size_t)j * 2 * DFF + s * DFF + c), b = *(const f32x4*)(cw + (size_t)j * 2 * DFF + s * DFF + c + 4);
                w[s][j][0] = a.x; w[s][j][1] = a.y; w[s][j][2] = a.z; w[s][j][3] = a.w; w[s][j][4] = b.x; w[s][j][5] = b.y; w[s][j][6] = b.z; w[s][j][7] = b.w; }
            const f32x4 a = *(const f32x4*)(cb + s * DFF + c), b = *(const f32x4*)(cb + s * DFF + c + 4);
            bb[s][0] = a.x; bb[s][1] = a.y; bb[s][2] = a.z; bb[s][3] = a.w; bb[s][4] = b.x; bb[s][5] = b.y; bb[s][6] = b.z; bb[s][7] = b.w; }
        float zm2[2][8], zm1[2][8];
#pragma unroll
        for (int s = 0; s < 2; ++s) {
            v4u a = (v4u){0u, 0u, 0u, 0u}, b = (v4u){0u, 0u, 0u, 0u};
            if (t0 >= 2) a = *(const v4u*)(Z + (size_t)(r0 - 2) * (2 * DFF) + s * DFF + c);
            if (t0 >= 1) b = *(const v4u*)(Z + (size_t)(r0 - 1) * (2 * DFF) + s * DFF + c);
            zm2[s][0] = bflo(a.x); zm2[s][1] = bfhi(a.x); zm2[s][2] = bflo(a.y); zm2[s][3] = bfhi(a.y); zm2[s][4] = bflo(a.z); zm2[s][5] = bfhi(a.z); zm2[s][6] = bflo(a.w); zm2[s][7] = bfhi(a.w);
            zm1[s][0] = bflo(b.x); zm1[s][1] = bfhi(b.x); zm1[s][2] = bflo(b.y); zm1[s][3] = bfhi(b.y); zm1[s][4] = bflo(b.z); zm1[s][5] = bfhi(b.z); zm1[s][6] = bflo(b.w); zm1[s][7] = bfhi(b.w); }
#pragma unroll
        for (int i = 0; i < 8; ++i) {
            float z0[2][8], u[2][8];
#pragma unroll
            for (int s = 0; s < 2; ++s) { const v4u a = *(const v4u*)(Z + (size_t)(r0 + i) * (2 * DFF) + s * DFF + c);
                z0[s][0] = bflo(a.x); z0[s][1] = bfhi(a.x); z0[s][2] = bflo(a.y); z0[s][3] = bfhi(a.y); z0[s][4] = bflo(a.z); z0[s][5] = bfhi(a.z); z0[s][6] = bflo(a.w); z0[s][7] = bfhi(a.w);
#pragma unroll
                for (int e = 0; e < 8; ++e) { u[s][e] = bb[s][e] + w[s][0][e] * zm2[s][e] + w[s][1][e] * zm1[s][e] + w[s][2][e] * z0[s][e]; zm2[s][e] = zm1[s][e]; zm1[s][e] = z0[s][e]; } }
            v4u o; o.x = pk2(silu(u[0][0]) * u[1][0], silu(u[0][1]) * u[1][1]); o.y = pk2(silu(u[0][2]) * u[1][2], silu(u[0][3]) * u[1][3]);
            o.z = pk2(silu(u[0][4]) * u[1][4], silu(u[0][5]) * u[1][5]); o.w = pk2(silu(u[0][6]) * u[1][6], silu(u[0][7]) * u[1][7]);
            *(v4u*)(ACT + (size_t)(r0 + i) * DFF + c) = o;
        }
    }
}
__device__ __forceinline__ void gdn_prep_naive(const bf16* proj, const float* small, const float* cw, const float* a_log, const float* dt_bias,
                                               float* QN, float* KN, float* VV, float* GG, float* BB, int gw, int ngw, int lane) {
    for (int item = gw; item < M * NH; item += ngw) {
        const int row = item >> 4, h = item & 15, t = row & (T - 1), b = row >> 11;
        float val[3][2];
#pragma unroll
        for (int s = 0; s < 3; ++s)
#pragma unroll
            for (int dd = 0; dd < 2; ++dd) { const int ch = s * 2048 + h * HD + lane + 64 * dd; float acc = 0.f;
#pragma unroll
                for (int j = 0; j < 4; ++j) { const int tt = t - 3 + j; if (tt >= 0) acc += cw[j * 6144 + ch] * bf2f(proj[(size_t)(row - 3 + j) * AB_LDP + A_QKV + ch]); }
                val[s][dd] = silu(acc); }
        const float qi = rsqrtf(wave_sum(val[0][0] * val[0][0] + val[0][1] * val[0][1]) + EPS) * QSCALE;
        const float ki = rsqrtf(wave_sum(val[1][0] * val[1][0] + val[1][1] * val[1][1]) + EPS);
        const size_t o = ((size_t)(b * NH + h) * T + t) * HD + lane;
        QN[o] = val[0][0] * qi; QN[o + 64] = val[0][1] * qi; KN[o] = val[1][0] * ki; KN[o + 64] = val[1][1] * ki; VV[o] = val[2][0]; VV[o + 64] = val[2][1];
        if (lane == 0) { const float a = small[(size_t)row * 256 + h]; GG[(b * NH + h) * T + t] = -__expf(a_log[h]) * softplus(a + dt_bias[h]); BB[(b * NH + h) * T + t] = sigm(small[(size_t)row * 256 + 16 + h]); }
    }
}
__device__ __forceinline__ void gdn_scan_naive(const float* QN, const float* KN, const float* VV, const float* GG, const float* BB, float* ORAW, int item, int lane) {
    const int bh = item >> 2, e = (item & 3) * 32 + (lane & 31), dh = (lane >> 5) * 64, b = bh >> 4, h = bh & 15;
    float S[64];
#pragma unroll
    for (int d = 0; d < 64; ++d) S[d] = 0.f;
    const float* qp = QN + (size_t)bh * T * HD + dh; const float* kp = KN + (size_t)bh * T * HD + dh; const float* vp = VV + (size_t)bh * T * HD;
    for (int t = 0; t < T; ++t) {
        const float eg = __expf(GG[bh * T + t]), beta = BB[bh * T + t], ve = vp[(size_t)t * HD + e];
        float k[64]; float dot = 0.f;
#pragma unroll
        for (int d4 = 0; d4 < 16; ++d4) { const f32x4 k4 = *(const f32x4*)(kp + (size_t)t * HD + 4 * d4);
#pragma unroll
            for (int i = 0; i < 4; ++i) { k[4 * d4 + i] = k4[i]; S[4 * d4 + i] *= eg; dot += S[4 * d4 + i] * k4[i]; } }
        dot += __shfl_xor(dot, 32);
        const float u = beta * (ve - dot); float o = 0.f;
#pragma unroll
        for (int d4 = 0; d4 < 16; ++d4) { const f32x4 q4 = *(const f32x4*)(qp + (size_t)t * HD + 4 * d4);
#pragma unroll
            for (int i = 0; i < 4; ++i) { S[4 * d4 + i] += k[4 * d4 + i] * u; o += S[4 * d4 + i] * q4[i]; } }
        o += __shfl_xor(o, 32);
        if (lane < 32) ORAW[(size_t)(b * T + t) * 2048 + h * HD + e] = o;
    }
}
__device__ __forceinline__ void headnorm_gate(const float* ORAW, const float* nw, const bf16* gate, int ldg, bf16* OBUF, int gw, int ngw, int lane) {
    for (int item = gw; item < M * NH; item += ngw) {
        const int row = item >> 4, h = item & 15;
        const float o0 = ORAW[(size_t)row * 2048 + h * HD + 2 * lane], o1 = ORAW[(size_t)row * 2048 + h * HD + 2 * lane + 1];
        const float rstd = rsqrtf(wave_sum(o0 * o0 + o1 * o1) * (1.f / HD) + EPS);
        const unsigned gwd = *(const unsigned*)(gate + (size_t)row * ldg + h * HD + 2 * lane);
        *(unsigned*)(OBUF + (size_t)row * DM + h * HD + 2 * lane) = pk2(o0 * rstd * nw[2 * lane] * silu(bflo(gwd)), o1 * rstd * nw[2 * lane + 1] * silu(bfhi(gwd)));
    }
}
__device__ __forceinline__ void hgrn_prep_naive(const bf16* proj, const float* lbl, float* FB, float* QB, int gw, int ngw, int lane) {
    for (int item = gw; item < M * NH; item += ngw) {
        const int row = item >> 4, h = item & 15, t = row & (T - 1), b = row >> 11;
#pragma unroll
        for (int dd = 0; dd < 2; ++dd) { const int c = h * HD + lane + 64 * dd; const float lb = sigm(lbl[2048 + c] - lbl[c]);
            const float fx = bf2f(proj[(size_t)row * CD_LDP + C_HF + c]), qx = bf2f(proj[(size_t)row * CD_LDP + C_HQ + c]);
            const size_t o = ((size_t)(b * NH + h) * T + t) * HD + lane + 64 * dd; FB[o] = lb + (1.f - lb) * sigm(fx); QB[o] = silu(qx); }
    }
}
__device__ __forceinline__ void hgrn_scan_naive(const float* FB, const float* QB, const bf16* proj, float* ORAW, int item, int lane) {
    const int bh = item >> 1, e = (item & 1) * 64 + lane, b = bh >> 4, h = bh & 15;
    float S[HD];
#pragma unroll
    for (int d = 0; d < HD; ++d) S[d] = 0.f;
    const float* fp = FB + (size_t)bh * T * HD; const float* qp = QB + (size_t)bh * T * HD;
    for (int t = 0; t < T; ++t) {
        const float ve = bf2f(proj[(size_t)(b * T + t) * CD_LDP + C_HI + h * HD + e]); float o = 0.f;
#pragma unroll
        for (int d4 = 0; d4 < HD / 4; ++d4) { const f32x4 f4 = *(const f32x4*)(fp + (size_t)t * HD + 4 * d4), q4 = *(const f32x4*)(qp + (size_t)t * HD + 4 * d4);
#pragma unroll
            for (int i = 0; i < 4; ++i) { S[4 * d4 + i] = f4[i] * S[4 * d4 + i] + (1.f - f4[i]) * ve; o += S[4 * d4 + i] * q4[i]; } }
        ORAW[(size_t)(b * T + t) * 2048 + h * HD + e] = o;
    }
}
__device__ __forceinline__ void fox_cum(const float* small, const float* fbias, float* CUM, int item, int lane) {
    const int b = item >> 4, h = item & 15; float loc[32]; float run = 0.f;
#pragma unroll
    for (int i = 0; i < 32; ++i) { run += logsigm(small[(size_t)(b * T + 32 * lane + i) * 256 + h] + fbias[h]); loc[i] = run; }
    float incl = run;
#pragma unroll
    for (int o = 1; o < 64; o <<= 1) { const float v = __shfl_up(incl, o); if (lane >= o) incl += v; }
    const float excl = incl - run;
#pragma unroll
    for (int i = 0; i < 32; ++i) CUM[(size_t)item * T + 32 * lane + i] = excl + loc[i];
}
struct RowAcc { float m, l, a0, a1; };
__device__ __forceinline__ float dot128(const LAS float* qs, const bf16* krow) {
    const v4u* kr = (const v4u*)krow; float dot = 0.f;
#pragma unroll
    for (int c = 0; c < 16; ++c) { const v4u w = kr[c]; const f32x4 qa = *(const LAS f32x4*)(qs + 8 * c), qb = *(const LAS f32x4*)(qs + 8 * c + 4);
        dot += bflo(w.x) * qa[0] + bfhi(w.x) * qa[1] + bflo(w.y) * qa[2] + bfhi(w.y) * qa[3] + bflo(w.z) * qb[0] + bfhi(w.z) * qb[1] + bflo(w.w) * qb[2] + bfhi(w.w) * qb[3]; }
    return dot;
}
__device__ __forceinline__ void attend_chunk(RowAcc& st, const LAS float* qs, const bf16* Kb, const bf16* Vb, size_t ld, int kb, int kmax, bool valid, float bias, LAS float* pbuf, int lane) {
    int key = kb + lane; key = key < 0 ? 0 : (key > kmax ? kmax : key);
    const float dot = dot128(qs, Kb + (size_t)key * ld);
    const float s = valid ? dot + bias : -INFINITY;
    const float cm = wave_max(s);
    if (cm == -INFINITY) return;
    const float mn = fmaxf(st.m, cm), corr = __expf(st.m - mn), p = valid ? __expf(s - mn) : 0.f;
    st.l = st.l * corr + wave_sum(p); st.m = mn; st.a0 *= corr; st.a1 *= corr;
    asm volatile("s_waitcnt lgkmcnt(0)" ::: "memory"); pbuf[lane] = p; asm volatile("s_waitcnt lgkmcnt(0)" ::: "memory");
    for (int j = 0; j < 64; ++j) { const float pj = pbuf[j]; int kj = kb + j; kj = kj < 0 ? 0 : (kj > kmax ? kmax : kj);
        const unsigned w = *(const unsigned*)(Vb + (size_t)kj * ld + 2 * lane); st.a0 += pj * bflo(w); st.a1 += pj * bfhi(w); }
    asm volatile("s_waitcnt lgkmcnt(0)" ::: "memory");
}
__device__ __forceinline__ void fox_attn_naive(const bf16* proj, const float* CUM, bf16* OBUF, LAS float* wl, int gw, int ngw, int lane) {
    LAS float* qs = wl; LAS float* pbuf = wl + 128;
    for (int item = gw; item < M * NH; item += ngw) {
        const int row = item >> 4, h = item & 15, t = row & (T - 1), b = row >> 11;
        const unsigned qw = *(const unsigned*)(proj + (size_t)row * CD_LDP + C_FQ + h * HD + 2 * lane);
        asm volatile("s_waitcnt lgkmcnt(0)" ::: "memory"); qs[2 * lane] = bflo(qw) * QSCALE; qs[2 * lane + 1] = bfhi(qw) * QSCALE; asm volatile("s_waitcnt lgkmcnt(0)" ::: "memory");
        const bf16* Kb = proj + (size_t)b * T * CD_LDP + C_FK + h * HD; const bf16* Vb = proj + (size_t)b * T * CD_LDP + C_FV + h * HD;
        const float* cum = CUM + (size_t)(b * NH + h) * T; const float cq = cum[t];
        RowAcc st{-INFINITY, 0.f, 0.f, 0.f};
        for (int kb = 0; kb <= t; kb += 64) { const int key = kb + lane; const bool valid = key <= t; attend_chunk(st, qs, Kb, Vb, CD_LDP, kb, T - 1, valid, cq - cum[key > T - 1 ? T - 1 : key], pbuf, lane); }
        const float il = 1.f / st.l;
        *(unsigned*)(OBUF + (size_t)row * DM + 2048 + h * HD + 2 * lane) = pk2(st.a0 * il, st.a1 * il);
    }
}
__device__ __forceinline__ void nsa_compress_naive(const bf16* proj, const float* pe_k, const float* pe_v, const float* wk1, const float* wk2, const float* wv1, const float* wv2,
                                                   bf16* KC, bf16* VC, LAS float* lf, int tid) {
    for (int item = blockIdx.x; item < 16 * NCMP * 2; item += gridDim.x) {
        const int kv = item & 1, r = item >> 1, n = r % NCMP, bg = r / NCMP, b = bg >> 2, g = bg & 3;
        const float* pe = kv ? pe_v : pe_k; const float* w1 = kv ? wv1 : wk1; const float* w2 = kv ? wv2 : wk2;
        const int j = tid & 127, part = tid >> 7; float acc = 0.f;
        for (int i = part * 1024; i < part * 1024 + 1024; ++i) { const int l = i >> 7, d = i & 127;
            const float z = bf2f(proj[(size_t)(b * T + 16 * n + l) * AB_LDP + A_NKV + kv * 512 + g * HD + d]) + pe[i];
            acc += z * w1[(size_t)i * HD + j]; }
        lf[part * 128 + j] = acc;
        __syncthreads();
        if (tid < 128) { const float hsum = lf[j] + lf[128 + j] + lf[256 + j] + lf[384 + j]; lf[512 + j] = silu(hsum); }
        __syncthreads();
        if (tid < 128) { float o = 0.f; for (int i = 0; i < 128; ++i) o += lf[512 + i] * w2[i * HD + j]; if (kv) VC[((size_t)bg * 128 + j) * 128 + (n & ~15) + ((n >> 2) & 1) * 8 + ((n & 15) >> 3) * 4 + (n & 3)] = (bf16)f2bf(o); else KC[((size_t)bg * 128 + n) * HD + j] = (bf16)f2bf(o); }
        __syncthreads();
    }
}
__device__ __forceinline__ void nsa_cmp_naive(const bf16* proj, const bf16* KC, const bf16* VC, float* OCMP, unsigned* SEL, LAS float* wl, int gw, int ngw, int lane) {
    LAS float* qs = wl; LAS float* pbuf = wl + 128;
    for (int item = gw; item < M * 4; item += ngw) {
        const int row = item >> 2, g = item & 3, t = row & (T - 1), b = row >> 11, bg = b * 4 + g;
        const bf16* Kb = KC + (size_t)bg * 128 * HD; const bf16* Vb = VC + (size_t)bg * 128 * HD;
        const int n0 = lane, n1 = lane + 64; const bool v0 = 16 * n0 + 31 <= t, v1 = (n1 < NCMP) && (16 * n1 + 31 <= t);
        float ps0 = 0.f, ps1 = 0.f;
        for (int p = 0; p < 4; ++p) {
            const int head = g * 4 + p;
            const unsigned qw = *(const unsigned*)(proj + (size_t)row * AB_LDP + A_NQ + head * HD + 2 * lane);
            asm volatile("s_waitcnt lgkmcnt(0)" ::: "memory"); qs[2 * lane] = bflo(qw) * QSCALE; qs[2 * lane + 1] = bfhi(qw) * QSCALE; asm volatile("s_waitcnt lgkmcnt(0)" ::: "memory");
            const float s0 = v0 ? dot128(qs, Kb + (size_t)n0 * HD) : -INFINITY, s1 = v1 ? dot128(qs, Kb + (size_t)(n1 < 128 ? n1 : 127) * HD) : -INFINITY;
            const float mx = wave_max(fmaxf(s0, s1)); float p0 = 0.f, p1 = 0.f;
            if (mx != -INFINITY) { const float e0 = v0 ? __expf(s0 - mx) : 0.f, e1 = v1 ? __expf(s1 - mx) : 0.f; const float il = 1.f / wave_sum(e0 + e1); p0 = e0 * il; p1 = e1 * il; }
            ps0 += p0; ps1 += p1;
            pbuf[lane] = p0; pbuf[64 + lane] = p1; asm volatile("s_waitcnt lgkmcnt(0)" ::: "memory");
            float a0 = 0.f, a1 = 0.f;
            for (int n = 0; n < NCMP; ++n) { const float pj = pbuf[n]; const unsigned w = *(const unsigned*)(Vb + (size_t)n * HD + 2 * lane); a0 += pj * bflo(w); a1 += pj * bfhi(w); }
            *(float2*)(OCMP + (size_t)row * 2048 + head * HD + 2 * lane) = make_float2(a0, a1);
            asm volatile("s_waitcnt lgkmcnt(0)" ::: "memory");
        }
        pbuf[lane] = ps0; pbuf[64 + lane] = ps1; asm volatile("s_waitcnt lgkmcnt(0)" ::: "memory");
        const int cur = t >> 6, m = lane; float sc = -INFINITY;
        if (m < 32 && m <= cur) {
            if (m == 0 || m == cur || m == cur - 1) sc = 1e4f;
            else { float im = 0.f; for (int n = 4 * m - 1; n <= 4 * m + 3; ++n) if (n >= 0 && n < NCMP) im += pbuf[n]; sc = im; }
        }
        unsigned mask = 0u;
        for (int r = 0; r < 8; ++r) { const float mx = wave_max(sc); if (mx == -INFINITY) break;
            const unsigned long long ball = __ballot(sc == mx); const int idx = __ffsll((long long)ball) - 1; mask |= 1u << idx; if (lane == idx) sc = -INFINITY; }
        if (lane == 0) SEL[(size_t)bg * T + t] = mask;
        asm volatile("s_waitcnt lgkmcnt(0)" ::: "memory");
    }
}
__device__ __forceinline__ void nsa_slcwin_naive(const bf16* proj, const float* small, const float* OCMP, const unsigned* SEL, bf16* OBUF, LAS float* wl, int gw, int ngw, int lane) {
    LAS float* qs = wl; LAS float* pbuf = wl + 128;
    for (int item = gw; item < M * NH; item += ngw) {
        const int row = item >> 4, head = item & 15, g = head >> 2, t = row & (T - 1), b = row >> 11;
        const unsigned qw = *(const unsigned*)(proj + (size_t)row * AB_LDP + A_NQ + head * HD + 2 * lane);
        asm volatile("s_waitcnt lgkmcnt(0)" ::: "memory"); qs[2 * lane] = bflo(qw) * QSCALE; qs[2 * lane + 1] = bfhi(qw) * QSCALE; asm volatile("s_waitcnt lgkmcnt(0)" ::: "memory");
        const bf16* base = proj + (size_t)b * T * AB_LDP + A_NKV + g * HD;
        const unsigned sel = SEL[(size_t)(b * 4 + g) * T + t]; const int cur = t >> 6;
        RowAcc ss{-INFINITY, 0.f, 0.f, 0.f};
        for (int m = 0; m <= cur; ++m) if ((sel >> m) & 1u) { const int key = 64 * m + lane; attend_chunk(ss, qs, base + 2 * 512, base + 3 * 512, AB_LDP, 64 * m, T - 1, key <= t, 0.f, pbuf, lane); }
        RowAcc sw{-INFINITY, 0.f, 0.f, 0.f};
        const int first = t - 511 > 0 ? t - 511 : 0;
        for (int kb = first & ~63; kb <= t; kb += 64) { const int key = kb + lane; attend_chunk(sw, qs, base + 4 * 512, base + 5 * 512, AB_LDP, kb, T - 1, key >= first && key <= t, 0.f, pbuf, lane); }
        const float gc = sigm(small[(size_t)row * 256 + 32 + head]), gs = sigm(small[(size_t)row * 256 + 48 + head]), gwn = sigm(small[(size_t)row * 256 + 64 + head]);
        const float2 oc = *(const float2*)(OCMP + (size_t)row * 2048 + head * HD + 2 * lane);
        const float is = gs / ss.l, iw = gwn / sw.l;
        *(unsigned*)(OBUF + (size_t)row * DM + 2048 + head * HD + 2 * lane) = pk2(gc * oc.x + is * ss.a0 + iw * sw.a0, gc * oc.y + is * ss.a1 + iw * sw.a1);
    }
}
typedef short bf16x8 __attribute__((ext_vector_type(8)));
typedef float f32x16 __attribute__((ext_vector_type(16)));
#define MFMA32(a, b, c) __builtin_amdgcn_mfma_f32_32x32x16_bf16((a), (b), (c), 0, 0, 0)
constexpr float LOG2E = 1.4426950408889634f, C1 = QSCALE * LOG2E;
constexpr int AT_K = 0, AT_V = 16384, AT_CK = 32768;
__device__ __forceinline__ void vt_transpose(const bf16* src, int ld, int col0, int nh, bf16* VT, int gtid, int ngt) {
    const int total = NB * nh * 128 * (T / 8);
    for (int idx = gtid; idx < total; idx += ngt) {
        const int d = idx & 127, tc = (idx >> 7) & 255, bh = idx >> 15, b = bh / nh, hh = bh % nh;
        unsigned short e[8];
#pragma unroll
        for (int j = 0; j < 8; ++j) { const int p = 8 * tc + j, pp = p & 15, h2 = pp >> 3, jj = pp & 7, t = (p & ~15) + 8 * (jj >> 2) + 4 * h2 + (jj & 3);
            e[j] = src[(size_t)(b * T + t) * ld + col0 + hh * 128 + d]; }
        v4u o; o.x = e[0] | ((unsigned)e[1] << 16); o.y = e[2] | ((unsigned)e[3] << 16); o.z = e[4] | ((unsigned)e[5] << 16); o.w = e[6] | ((unsigned)e[7] << 16);
        *(v4u*)(VT + ((size_t)bh * 128 + d) * T + 8 * tc) = o;
    }
}
__device__ __forceinline__ void qk_tile(const LAS unsigned char* ldk, const bf16x8 (&qf)[8], f32x16 (&s)[2], int lane) {
    const int r = lane & 31; int y = (lane >> 5) ^ (r & 15); asm volatile("" : "+v"(y));
    const LAS unsigned char* base = ldk + r * 256;
#pragma unroll
    for (int i = 0; i < 16; ++i) { s[0][i] = 0.f; s[1][i] = 0.f; }
#pragma unroll
    for (int ks = 0; ks < 8; ++ks)
#pragma unroll
        for (int rb = 0; rb < 2; ++rb) {
            const bf16x8 a = *(const LAS bf16x8*)(base + rb * 8192 + (((2 * ks) ^ y) << 4));
            s[rb] = MFMA32(a, qf[ks], s[rb]); }
}
__device__ __forceinline__ void qk_tile_lq(const LAS unsigned char* ldk, const LAS unsigned char* ldq, f32x16 (&s)[2], int lane) {
    const int r = lane & 31; int y = (lane >> 5) ^ (r & 15); asm volatile("" : "+v"(y));
    const LAS unsigned char* base = ldk + r * 256; const LAS unsigned char* qb = ldq + r * 256;
#pragma unroll
    for (int i = 0; i < 16; ++i) { s[0][i] = 0.f; s[1][i] = 0.f; }
#pragma unroll
    for (int ks = 0; ks < 8; ++ks) { const bf16x8 q = *(const LAS bf16x8*)(qb + (((2 * ks) ^ y) << 4));
#pragma unroll
        for (int rb = 0; rb < 2; ++rb) {
            const bf16x8 a = *(const LAS bf16x8*)(base + rb * 8192 + (((2 * ks) ^ y) << 4));
            s[rb] = MFMA32(a, q, s[rb]); }
        if ((ks & 3) == 3) __builtin_amdgcn_sched_barrier(0); }
}
__device__ __forceinline__ void pv_tile(const LAS unsigned char* ldv, const f32x16 (&p)[2], f32x16 (&O)[4], int lane) {
    const int r = lane & 31; int y = (lane >> 5) ^ ((r >> 1) & 7); asm volatile("" : "+v"(y));
    const LAS unsigned char* base = ldv + r * 128;
    bf16x8 pf[2][2];
#pragma unroll
    for (int rb = 0; rb < 2; ++rb)
#pragma unroll
        for (int st = 0; st < 2; ++st) { v4u w; w.x = cvtpk(p[rb][8 * st + 0], p[rb][8 * st + 1]); w.y = cvtpk(p[rb][8 * st + 2], p[rb][8 * st + 3]); w.z = cvtpk(p[rb][8 * st + 4], p[rb][8 * st + 5]); w.w = cvtpk(p[rb][8 * st + 6], p[rb][8 * st + 7]);
            pf[rb][st] = __builtin_bit_cast(bf16x8, w); }
#pragma unroll
    for (int db = 0; db < 4; ++db) {
#pragma unroll
        for (int kk = 0; kk < 4; ++kk) { const bf16x8 a = *(const LAS bf16x8*)(base + db * 4096 + (((2 * kk) ^ y) << 4));
            O[db] = MFMA32(a, pf[kk >> 1][kk & 1], O[db]); } }
}
struct TileRegs { v4u k[2], v[2]; float ck; };
__device__ __forceinline__ void tile_fetch(TileRegs& R, const bf16* Kg  , size_t ldk, const bf16* Vg  , size_t ldv, const float* ckg, int tid) {
#pragma unroll
    for (int i = 0; i < 2; ++i) { const int id = tid + 512 * i; R.k[i] = *(const v4u*)(Kg + (size_t)(id >> 4) * ldk + (id & 15) * 8); R.v[i] = *(const v4u*)(Vg + (size_t)(id >> 3) * ldv + (id & 7) * 8); }
    R.ck = (ckg && tid < 64) ? ckg[tid] * LOG2E : 0.f;
}
__device__ __forceinline__ void tile_commit(const TileRegs& R, LAS unsigned char* ldk, LAS unsigned char* ldv, LAS unsigned char* ldc, int tid) {
#pragma unroll
    for (int i = 0; i < 2; ++i) { const int id = tid + 512 * i; const int key = id >> 4, c = id & 15, d = id >> 3, c2 = id & 7;
        *(LAS v4u*)(ldk + key * 256 + ((c ^ (key & 15)) * 16)) = R.k[i];
        *(LAS v4u*)(ldv + d * 128 + ((c2 ^ ((d >> 1) & 7)) * 16)) = R.v[i]; }
    if (ldc && tid < 64) *(LAS float*)(ldc + tid * 4) = R.ck;
}
__device__ __forceinline__ void tile_dma(const bf16* Kg, size_t ldk, const bf16* Vg, size_t ldv, LAS unsigned char* dk, LAS unsigned char* dv, int wave, int lane) {
#pragma unroll
    for (int i = 0; i < 2; ++i) { const int piece = wave * 2 + i;
        const int krow = 4 * piece + (lane >> 4), kc = (lane & 15) ^ (krow & 15);
        __builtin_amdgcn_global_load_lds((const unsigned*)(Kg + (size_t)krow * ldk + kc * 8), (LAS unsigned*)(dk + piece * 1024), 16, 0, 0);
        const int d = 8 * piece + (lane >> 3), vc = (lane & 7) ^ ((d >> 1) & 7);
        __builtin_amdgcn_global_load_lds((const unsigned*)(Vg + (size_t)d * ldv + vc * 8), (LAS unsigned*)(dv + piece * 1024), 16, 0, 0); }
}
constexpr int AT3_CK = 3 * 32768;
constexpr int AT_B1 = 32768, AT_CK0 = 65536, AT_CK1 = 65536 + 256;
__device__ __forceinline__ void fox_attn_mfma(const bf16* proj, const bf16* VTG, const float* CUM, bf16* OBUF, LAS unsigned char* lds, int tid, int lane, int wave) {
    const int r = lane & 31, hh = lane >> 5;
    for (int idx = blockIdx.x; idx < 512; idx += gridDim.x) {
        const int bh = idx & 63, qq = idx >> 6, qt = qq < 4 ? qq : 11 - qq, b = bh >> 4, h = bh & 15, q0 = qt * 256, wq0 = q0 + 32 * wave, qi = wq0 + r;
        bf16x8 qf[8];
#pragma unroll
        for (int ks = 0; ks < 8; ++ks) qf[ks] = *(const bf16x8*)(proj + (size_t)(b * T + qi) * CD_LDP + C_FQ + h * HD + 16 * ks + 8 * hh);
        const float cq2 = CUM[(size_t)bh * T + qi] * LOG2E;
        float m = -INFINITY, l = 0.f; f32x16 O[4];
#pragma unroll
        for (int db = 0; db < 4; ++db)
#pragma unroll
            for (int i = 0; i < 16; ++i) O[db][i] = 0.f;
        const bf16* Kg = proj + (size_t)b * T * CD_LDP + C_FK + h * HD; const bf16* Vg = VTG + (size_t)bh * 128 * T; const float* ckg = CUM + (size_t)bh * T;
        const int ntiles = 4 * qt + 4;
        __syncthreads();
        tile_dma(Kg, CD_LDP, Vg, T, lds + AT_K, lds + AT_V, wave, lane);
        if (wave == 0) __builtin_amdgcn_global_load_lds((const unsigned*)(ckg + lane), (LAS unsigned*)(lds + AT3_CK), 4, 0, 0);
        tile_dma(Kg + (size_t)64 * CD_LDP, CD_LDP, Vg + 64, T, lds + AT_K + AT_B1, lds + AT_V + AT_B1, wave, lane);
        if (wave == 0) __builtin_amdgcn_global_load_lds((const unsigned*)(ckg + 64 + lane), (LAS unsigned*)(lds + AT3_CK + 256), 4, 0, 0);
        for (int kt = 0, buf = 0; kt < ntiles; ++kt, buf = buf == 2 ? 0 : buf + 1) {
            const int bo = buf * AT_B1, cko = AT3_CK + buf * 256;
            if (kt + 1 < ntiles) { if (wave == 0) asm volatile("s_waitcnt vmcnt(5)" ::: "memory"); else asm volatile("s_waitcnt vmcnt(4)" ::: "memory"); }
            else asm volatile("s_waitcnt vmcnt(0)" ::: "memory");
            __syncthreads();
            if (kt + 2 < ntiles) { const int b2 = buf == 0 ? 2 : buf - 1;
                tile_dma(Kg + (size_t)(kt + 2) * 64 * CD_LDP, CD_LDP, Vg + (kt + 2) * 64, T, lds + AT_K + b2 * AT_B1, lds + AT_V + b2 * AT_B1, wave, lane);
                if (wave == 0) __builtin_amdgcn_global_load_lds((const unsigned*)(ckg + (kt + 2) * 64 + lane), (LAS unsigned*)(lds + AT3_CK + b2 * 256), 4, 0, 0); }
            if (kt * 64 <= wq0 + 31) {
                f32x16 s[2]; qk_tile(lds + AT_K + bo, qf, s, lane);
                const bool full = kt * 64 + 63 <= wq0; float mx = -INFINITY;
#pragma unroll
                for (int rb = 0; rb < 2; ++rb)
#pragma unroll
                    for (int g4 = 0; g4 < 4; ++g4) { const f32x4 ck4 = *(const LAS f32x4*)(lds + cko + (32 * rb + 8 * g4 + 4 * hh) * 4);
#pragma unroll
                        for (int e = 0; e < 4; ++e) { const int i = 4 * g4 + e, key = kt * 64 + 32 * rb + 8 * g4 + 4 * hh + e;
                            float v = s[rb][i] * C1 + (cq2 - ck4[e] * LOG2E); if (!full && key > qi) v = -INFINITY; s[rb][i] = v; mx = fmaxf(mx, v); } }
                mx = fmaxf(mx, __shfl_xor(mx, 32));
                if (!__all(mx - m <= 8.f)) {
                    const float mn = fmaxf(m, mx), corr = __builtin_amdgcn_exp2f(m - mn); m = mn; l *= corr;
#pragma unroll
                    for (int db = 0; db < 4; ++db)
#pragma unroll
                        for (int i = 0; i < 16; ++i) O[db][i] *= corr;
                }
                float ls = 0.f;
#pragma unroll
                for (int rb = 0; rb < 2; ++rb)
#pragma unroll
                    for (int i = 0; i < 16; ++i) { const float p = __builtin_amdgcn_exp2f(s[rb][i] - m); s[rb][i] = p; ls += p; }
                l += ls;
                pv_tile(lds + AT_V + bo, s, O, lane);
            }
        }
        l += __shfl_xor(l, 32); const float il = 1.f / l;
        bf16* orow = OBUF + (size_t)(b * T + qi) * DM + 2048 + h * HD;
#pragma unroll
        for (int db = 0; db < 4; ++db)
#pragma unroll
            for (int g4 = 0; g4 < 4; ++g4) { v2u w; w.x = cvtpk(O[db][4 * g4] * il, O[db][4 * g4 + 1] * il); w.y = cvtpk(O[db][4 * g4 + 2] * il, O[db][4 * g4 + 3] * il);
                *(v2u*)(orow + 32 * db + 8 * g4 + 4 * hh) = w; }
    }
}

__device__ __forceinline__ void softmax_update(f32x16 (&s)[2], float& m, float& l, f32x16 (&O)[4]) {
    float mx = -INFINITY;
#pragma unroll
    for (int rb = 0; rb < 2; ++rb)
#pragma unroll
        for (int i = 0; i < 16; ++i) mx = fmaxf(mx, s[rb][i]);
    mx = fmaxf(mx, __shfl_xor(mx, 32));
    if (!__all(mx - m <= 8.f)) {
        const float mn = fmaxf(m, mx), ms = (mn == -INFINITY) ? 0.f : mn, corr = __builtin_amdgcn_exp2f(m - ms); m = mn; l *= corr;
#pragma unroll
        for (int db = 0; db < 4; ++db)
#pragma unroll
            for (int i = 0; i < 16; ++i) O[db][i] *= corr;
    }
    const float ms = (m == -INFINITY) ? 0.f : m; float ls = 0.f;
#pragma unroll
    for (int rb = 0; rb < 2; ++rb)
#pragma unroll
        for (int i = 0; i < 16; ++i) { const float p = __builtin_amdgcn_exp2f(s[rb][i] - ms); s[rb][i] = p; ls += p; }
    l += ls;
}
#define NS_ROWPTRS() int rr_ = lane & 31; asm volatile("" : "+v"(rr_)); const size_t row_ = (size_t)(b * T + 64 * c + 32 * th + rr_); bf16* oacc = OACC + row_ * 2048 + head * HD; const float* smr = small + row_ * 256 + head
constexpr int NS_K0 = 0, NS_V0 = 16384, NS_K1 = 32768, NS_V1 = 49152, NS_Q = 65536, NS_IMP = 131072 + 512, NS_SEL = NS_IMP + 64 * 33 * 4, NS_UNI = NS_SEL + 256;
static_assert(NS_UNI + 4 <= LDS_BYTES, "NSA LDS map");
__device__ __forceinline__ void nsa_attn_mfma(const bf16* proj, const float* small, const bf16* KC, const bf16* VCT, const bf16* VTS, const bf16* VTW, bf16* OACC, bf16* OBUF, LAS unsigned char* lds, int tid, int lane, int wave) {
    const int p = wave >> 1, th = wave & 1;
    LAS float* IMP = (LAS float*)(lds + NS_IMP); LAS unsigned* SELM = (LAS unsigned*)(lds + NS_SEL); LAS unsigned* UNI = (LAS unsigned*)(lds + NS_UNI);
    for (int idx = blockIdx.x; idx < 512; idx += gridDim.x) {
        asm volatile("" : "+v"(lane), "+v"(tid));
        const int r = lane & 31, hh = lane >> 5;
        const int bg = idx & 15, cc = idx >> 4, c = cc < 16 ? cc : 47 - cc, b = bg >> 2, g = bg & 3, head = 4 * g + p, tok = 32 * th + r, t = 64 * c + tok;
        __syncthreads();
        bf16x8 qf[8];
#pragma unroll
        for (int ks = 0; ks < 8; ++ks) qf[ks] = *(const bf16x8*)(proj + (size_t)(b * T + t) * AB_LDP + A_NQ + head * HD + 16 * ks + 8 * hh);
        for (int i = tid; i < 64 * 33; i += NTHR) IMP[i] = 0.f;
        if (tid == 0) UNI[0] = 0u;
        const int ncmp_t = c >= 16 ? 2 : 1;
        { TileRegs R;
          tile_fetch(R, KC + (size_t)bg * 128 * HD, HD, VCT + (size_t)bg * 128 * 128, 128, nullptr, tid); tile_commit(R, lds + NS_K0, lds + NS_V0, nullptr, tid);
          if (ncmp_t == 2) { tile_fetch(R, KC + (size_t)bg * 128 * HD + 64 * HD, HD, VCT + (size_t)bg * 128 * 128 + 64, 128, nullptr, tid); tile_commit(R, lds + NS_K1, lds + NS_V1, nullptr, tid); } }
        __syncthreads();
        float mC = -INFINITY, lC = 0.f;
        for (int tl = 0; tl < ncmp_t; ++tl) {
            f32x16 s[2]; qk_tile(lds + (tl ? NS_K1 : NS_K0), qf, s, lane); float mx = -INFINITY;
#pragma unroll
            for (int rb = 0; rb < 2; ++rb)
#pragma unroll
                for (int i = 0; i < 16; ++i) { const int n = 64 * tl + 32 * rb + (i & 3) + 8 * (i >> 2) + 4 * hh; float v = s[rb][i] * C1; if (16 * n + 31 > t) v = -INFINITY; s[rb][i] = v; mx = fmaxf(mx, v); }
            mx = fmaxf(mx, __shfl_xor(mx, 32));
            const float mn = fmaxf(mC, mx), ms = (mn == -INFINITY) ? 0.f : mn; float ls = 0.f;
#pragma unroll
            for (int rb = 0; rb < 2; ++rb)
#pragma unroll
                for (int i = 0; i < 16; ++i) ls += __builtin_amdgcn_exp2f(s[rb][i] - ms);
            ls += __shfl_xor(ls, 32);
            lC = lC * __builtin_amdgcn_exp2f(mC - ms) + ls; mC = mn;
        }
        { const float ms = (mC == -INFINITY) ? 0.f : mC, il = lC > 0.f ? 1.f / lC : 0.f; float gc; { NS_ROWPTRS(); gc = sigm(smr[32]); }
          f32x16 OC[4];
#pragma unroll
          for (int db = 0; db < 4; ++db)
#pragma unroll
              for (int i = 0; i < 16; ++i) OC[db][i] = 0.f;
          for (int tl = 0; tl < ncmp_t; ++tl) {
            f32x16 s[2]; qk_tile(lds + (tl ? NS_K1 : NS_K0), qf, s, lane);
#pragma unroll
            for (int rb = 0; rb < 2; ++rb)
#pragma unroll
                for (int g4 = 0; g4 < 4; ++g4) { float grp = 0.f, last = 0.f;
#pragma unroll
                    for (int e = 0; e < 4; ++e) { const int i = 4 * g4 + e, n = 64 * tl + 32 * rb + 8 * g4 + 4 * hh + e; float v = s[rb][i] * C1; if (16 * n + 31 > t) v = -INFINITY;
                        const float pr = __builtin_amdgcn_exp2f(v - ms) * il; s[rb][i] = pr * gc; grp += pr; last = pr; }
                    const int mb = 16 * tl + 8 * rb + 2 * g4 + hh;
                    __hip_atomic_fetch_add(&IMP[tok * 33 + mb], grp, __ATOMIC_RELAXED, __HIP_MEMORY_SCOPE_WORKGROUP); if (mb + 1 < 32) __hip_atomic_fetch_add(&IMP[tok * 33 + mb + 1], last, __ATOMIC_RELAXED, __HIP_MEMORY_SCOPE_WORKGROUP); }
            pv_tile(lds + (tl ? NS_V1 : NS_V0), s, OC, lane);
          }
          NS_ROWPTRS();
#pragma unroll
          for (int db = 0; db < 4; ++db)
#pragma unroll
              for (int g4 = 0; g4 < 4; ++g4) { v2u w; w.x = cvtpk(OC[db][4 * g4], OC[db][4 * g4 + 1]); w.y = cvtpk(OC[db][4 * g4 + 2], OC[db][4 * g4 + 3]); *(v2u*)(oacc + 32 * db + 8 * g4 + 4 * hh) = w; }
        }
        __syncthreads();
        if (tid < 64) {
            unsigned sel = 1u | (1u << c) | (c >= 1 ? (1u << (c - 1)) : 0u); const int need = 8 - __popc(sel);
            for (int rr = 0; rr < need; ++rr) { int best = -1; float bv = -1.f;
                for (int mm = 1; mm <= c - 2; ++mm) if (!((sel >> mm) & 1u)) { const float v = IMP[tid * 33 + mm]; if (v > bv) { bv = v; best = mm; } }
                if (best < 0) break; sel |= 1u << best; }
            SELM[tid] = sel; __hip_atomic_fetch_or(UNI, sel, __ATOMIC_RELAXED, __HIP_MEMORY_SCOPE_WORKGROUP);
        }
        __syncthreads();
        const unsigned uni = UNI[0], mysel = SELM[tok];
        const bf16* kvb = proj + (size_t)b * T * AB_LDP + A_NKV + g * HD;
        {
            float m = -INFINITY, l = 0.f; f32x16 O[4];
#pragma unroll
            for (int db = 0; db < 4; ++db)
#pragma unroll
                for (int i = 0; i < 16; ++i) O[db][i] = 0.f;
            const bf16* Vg = VTS + (size_t)bg * 128 * T;
            tile_dma(kvb + 2 * 512, AB_LDP, Vg, T, lds + NS_K0, lds + NS_V0, wave, lane);
            for (int mt = 0, bo = 0; mt >= 0; bo ^= AT_B1) {
                const unsigned rest = (mt >= 31) ? 0u : ((uni >> (mt + 1)) << (mt + 1)); const int nx = rest ? (int)__builtin_ctz(rest) : -1;
                asm volatile("s_waitcnt vmcnt(0)" ::: "memory"); __syncthreads();
                if (nx >= 0) tile_dma(kvb + 2 * 512 + (size_t)nx * 64 * AB_LDP, AB_LDP, Vg + nx * 64, T, lds + NS_K0 + (bo ^ AT_B1), lds + NS_V0 + (bo ^ AT_B1), wave, lane);
                const bool mine = (mysel >> mt) & 1u;
                if (__ballot(mine) != 0ull) {
                    f32x16 s[2]; qk_tile(lds + NS_K0 + bo, qf, s, lane);
                    const float mbias = mine ? 0.f : -INFINITY;
                    if (mt == c) {
#pragma unroll
                        for (int rb = 0; rb < 2; ++rb)
#pragma unroll
                            for (int i = 0; i < 16; ++i) { const int key = 64 * mt + 32 * rb + (i & 3) + 8 * (i >> 2) + 4 * hh; float v = fmaf(s[rb][i], C1, mbias); if (key > t) v = -INFINITY; s[rb][i] = v; }
                    } else {
#pragma unroll
                        for (int rb = 0; rb < 2; ++rb)
#pragma unroll
                            for (int i = 0; i < 16; ++i) s[rb][i] = fmaf(s[rb][i], C1, mbias);
                    }
                    softmax_update(s, m, l, O);
                    pv_tile(lds + NS_V0 + bo, s, O, lane);
                }
                mt = nx;
            }
            l += __shfl_xor(l, 32); NS_ROWPTRS(); const float sc = sigm(smr[48]) / l;
#pragma unroll
            for (int db = 0; db < 4; ++db)
#pragma unroll
                for (int g4 = 0; g4 < 4; ++g4) { v2u* pa = (v2u*)(oacc + 32 * db + 8 * g4 + 4 * hh); const v2u a = *pa; v2u w;
                    w.x = cvtpk(bflo(a.x) + O[db][4 * g4] * sc, bfhi(a.x) + O[db][4 * g4 + 1] * sc); w.y = cvtpk(bflo(a.y) + O[db][4 * g4 + 2] * sc, bfhi(a.y) + O[db][4 * g4 + 3] * sc); *pa = w; }
        }
        {
            float m = -INFINITY, l = 0.f; f32x16 O[4];
#pragma unroll
            for (int db = 0; db < 4; ++db)
#pragma unroll
                for (int i = 0; i < 16; ++i) O[db][i] = 0.f;
            const bf16* Vg = VTW + (size_t)bg * 128 * T;
            const int kt0 = c >= 8 ? c - 8 : 0;
            __syncthreads();
            tile_dma(kvb + 4 * 512 + (size_t)kt0 * 64 * AB_LDP, AB_LDP, Vg + kt0 * 64, T, lds + NS_K0, lds + NS_V0, wave, lane);
            for (int kt = kt0, bo = 0; kt <= c; ++kt, bo ^= AT_B1) {
                asm volatile("s_waitcnt vmcnt(0)" ::: "memory"); __syncthreads();
                if (kt < c) tile_dma(kvb + 4 * 512 + (size_t)(kt + 1) * 64 * AB_LDP, AB_LDP, Vg + (kt + 1) * 64, T, lds + NS_K0 + (bo ^ AT_B1), lds + NS_V0 + (bo ^ AT_B1), wave, lane);
                f32x16 s[2]; qk_tile(lds + NS_K0 + bo, qf, s, lane);
                const bool edge = (kt == c) || (kt == c - 8);
                if (edge) {
#pragma unroll
                    for (int rb = 0; rb < 2; ++rb)
#pragma unroll
                        for (int i = 0; i < 16; ++i) { const int key = 64 * kt + 32 * rb + (i & 3) + 8 * (i >> 2) + 4 * hh; float v = s[rb][i] * C1; if (key > t || key < t - 511) v = -INFINITY; s[rb][i] = v; }
                } else {
#pragma unroll
                    for (int rb = 0; rb < 2; ++rb)
#pragma unroll
                        for (int i = 0; i < 16; ++i) s[rb][i] *= C1;
                }
                softmax_update(s, m, l, O);
                pv_tile(lds + NS_V0 + bo, s, O, lane);
            }
            l += __shfl_xor(l, 32); NS_ROWPTRS(); const float sc = sigm(smr[64]) / l;
            bf16* orow = OBUF + row_ * DM + 2048 + head * HD;
#pragma unroll
            for (int db = 0; db < 4; ++db)
#pragma unroll
                for (int g4 = 0; g4 < 4; ++g4) { const v2u a = *(const v2u*)(oacc + 32 * db + 8 * g4 + 4 * hh);
                    v2u w; w.x = cvtpk(bflo(a.x) + O[db][4 * g4] * sc, bfhi(a.x) + O[db][4 * g4 + 1] * sc); w.y = cvtpk(bflo(a.y) + O[db][4 * g4 + 2] * sc, bfhi(a.y) + O[db][4 * g4 + 3] * sc);
                    *(v2u*)(orow + 32 * db + 8 * g4 + 4 * hh) = w; }
        }
    }
}
__device__ __forceinline__ int perm16(int k) { return ((k >> 2) & 1) * 8 + (k >> 3) * 4 + (k & 3); }
__device__ __forceinline__ int crow(int i, int hh) { return (i & 3) + 8 * (i >> 2) + 4 * hh; }
__device__ __forceinline__ bf16x8 pack8(const f32x16& x, int s) { v4u w; w.x = cvtpk(x[8 * s + 0], x[8 * s + 1]); w.y = cvtpk(x[8 * s + 2], x[8 * s + 3]); w.z = cvtpk(x[8 * s + 4], x[8 * s + 5]); w.w = cvtpk(x[8 * s + 6], x[8 * s + 7]); return __builtin_bit_cast(bf16x8, w); }
constexpr int CH_QT = 0, CH_KT = 16384, CH_VT = 32768, CH_KD = 49152, CH_PS = 65536, CH_OT = 0;
constexpr size_t SZ_QH = (size_t)64 * 128, SZ_DS = (size_t)128 * 128, SZ_SN = (size_t)128 * 128;
__device__ __forceinline__ void hgrn_chunk_prep(const bf16* proj, const float* lbl, bf16* QH, bf16* OI, bf16* DS, float* DEC, LAS unsigned char* lds, int tid, int lane, int wave) {
    const int d = tid & 127, pt = tid >> 7, r = lane & 31, hh = lane >> 5;
    unsigned short rf[16], rq[16], rv[16];
#define HG_LOAD_RAW(IDX) do { const int bh_ = (IDX) >> 5, n_ = (IDX) & 31; const bf16* pr_ = proj + ((size_t)(bh_ >> 4) * T + n_ * 64 + 16 * pt) * CD_LDP + (bh_ & 15) * HD + d; \
        _Pragma("unroll") for (int i_ = 0; i_ < 16; ++i_) { rf[i_] = pr_[(size_t)i_ * CD_LDP + C_HF]; rq[i_] = pr_[(size_t)i_ * CD_LDP + C_HQ]; rv[i_] = pr_[(size_t)i_ * CD_LDP + C_HI]; } } while (0)
    if ((int)blockIdx.x < 2048) HG_LOAD_RAW((int)blockIdx.x);
    for (int idx = blockIdx.x; idx < 2048; idx += gridDim.x) {
        const int bh = idx >> 5, n = idx & 31, b = bh >> 4, h = bh & 15; const size_t row0 = (size_t)b * T + n * 64;
        __syncthreads();
        const float lb = sigm(lbl[2048 + h * HD + d] - lbl[h * HD + d]);
        float cs[16], kk[16], qv[16]; unsigned short vb[16]; float run = 0.f;
#pragma unroll
        for (int i = 0; i < 16; ++i) {
            const float sg = sigm(bf2f(rf[i])), f = lb + (1.f - lb) * sg; run += __logf(f); cs[i] = run; kk[i] = (1.f - lb) * (1.f - sg); qv[i] = silu(bf2f(rq[i])); vb[i] = rv[i]; }
        LAS float* PS = (LAS float*)(lds + CH_PS);
        PS[pt * 128 + d] = run;
        __syncthreads();
        const float p0 = PS[d], p1 = PS[128 + d], p2 = PS[256 + d], p3 = PS[384 + d];
        const float pre = pt == 0 ? 0.f : (pt == 1 ? p0 : (pt == 2 ? p0 + p1 : p0 + p1 + p2)), bmid = p0 + p1, tot = (p0 + p1) + (p2 + p3);
        if (pt == 0) DEC[(size_t)idx * 128 + d] = __expf(tot);
        unsigned short kdb[16];
#pragma unroll
        for (int i = 0; i < 16; ++i) { const int rr = 16 * pt + i; const float bb = pre + cs[i];
            const float dmid = fminf(fmaxf(bb - bmid, -80.f), 80.f);
            const unsigned qt = f2bf(qv[i] * __expf(dmid)), kt = f2bf(kk[i] * __expf(-dmid)), qh = f2bf(qv[i] * __expf(bb));
            kdb[i] = (unsigned short)f2bf(kk[i] * __expf(tot - bb));
            const int sw = rr * 256 + (((d >> 3) ^ (rr & 15)) << 4) + (d & 7) * 2;
            *(LAS unsigned short*)(lds + CH_QT + sw) = (unsigned short)qt; *(LAS unsigned short*)(lds + CH_KT + sw) = (unsigned short)kt;
            QH[(size_t)idx * SZ_QH + rr * 128 + (d & ~15) + perm16(d & 15)] = (bf16)qh; }
#pragma unroll
        for (int h2 = 0; h2 < 2; ++h2) { v4u wk, wv; unsigned ek[8], ev[8];
#pragma unroll
            for (int j = 0; j < 8; ++j) { const int i = 8 * (j >> 2) + 4 * h2 + (j & 3); ek[j] = kdb[i]; ev[j] = vb[i]; }
            wk.x = ek[0] | (ek[1] << 16); wk.y = ek[2] | (ek[3] << 16); wk.z = ek[4] | (ek[5] << 16); wk.w = ek[6] | (ek[7] << 16);
            wv.x = ev[0] | (ev[1] << 16); wv.y = ev[2] | (ev[3] << 16); wv.z = ev[4] | (ev[5] << 16); wv.w = ev[6] | (ev[7] << 16);
            const int sw = d * 128 + (((2 * pt + h2) ^ ((d >> 1) & 7)) << 4);
            *(LAS v4u*)(lds + CH_KD + sw) = wk; *(LAS v4u*)(lds + CH_VT + sw) = wv; }
        __syncthreads();
        if (idx + (int)gridDim.x < 2048) HG_LOAD_RAW(idx + (int)gridDim.x);
        const int rbk = wave & 1, eb = wave >> 1;
        int yk = hh ^ (r & 15); asm volatile("" : "+v"(yk)); int yv = hh ^ ((r >> 1) & 7); asm volatile("" : "+v"(yv));
        f32x16 oi;
#pragma unroll
        for (int i = 0; i < 16; ++i) oi[i] = 0.f;
#pragma unroll
        for (int jb = 0; jb < 2; ++jb) {
            if (jb > rbk) continue;
            f32x16 s;
#pragma unroll
            for (int i = 0; i < 16; ++i) s[i] = 0.f;
#pragma unroll
            for (int ks = 0; ks < 8; ++ks) { const bf16x8 a = *(const LAS bf16x8*)(lds + CH_KT + (32 * jb + r) * 256 + (((2 * ks) ^ yk) << 4)), q = *(const LAS bf16x8*)(lds + CH_QT + (32 * rbk + r) * 256 + (((2 * ks) ^ yk) << 4));
                s = MFMA32(a, q, s); }
            if (jb == rbk) {
#pragma unroll
                for (int i = 0; i < 16; ++i) if (crow(i, hh) > r) s[i] = 0.f; }
#pragma unroll
            for (int st = 0; st < 2; ++st) { const bf16x8 a = *(const LAS bf16x8*)(lds + CH_VT + (32 * eb + r) * 128 + (((2 * (2 * jb + st)) ^ yv) << 4));
                oi = MFMA32(a, pack8(s, st), oi); }
        }
        { bf16* op = OI + ((size_t)idx * 64 + 32 * rbk + r) * 128 + 32 * eb + 4 * hh;
#pragma unroll
          for (int g4 = 0; g4 < 4; ++g4) { v2u w; w.x = cvtpk(oi[4 * g4], oi[4 * g4 + 1]); w.y = cvtpk(oi[4 * g4 + 2], oi[4 * g4 + 3]); *(v2u*)(op + 8 * g4) = w; } }
#pragma unroll
        for (int tt = 0; tt < 2; ++tt) { const int tile = 2 * wave + tt, db = tile >> 2, eb2 = tile & 3; f32x16 acc;
#pragma unroll
            for (int i = 0; i < 16; ++i) acc[i] = 0.f;
#pragma unroll
            for (int kq = 0; kq < 4; ++kq) { const bf16x8 a = *(const LAS bf16x8*)(lds + CH_KD + (32 * db + r) * 128 + (((2 * kq) ^ yv) << 4)), bq = *(const LAS bf16x8*)(lds + CH_VT + (32 * eb2 + r) * 128 + (((2 * kq) ^ yv) << 4));
                acc = MFMA32(a, bq, acc); }
            bf16* dp = DS + (size_t)idx * SZ_DS + ((size_t)tile * 4 * 64 + lane) * 4;
#pragma unroll
            for (int g4 = 0; g4 < 4; ++g4) { v2u w; w.x = cvtpk(acc[4 * g4], acc[4 * g4 + 1]); w.y = cvtpk(acc[4 * g4 + 2], acc[4 * g4 + 3]); *(v2u*)(dp + g4 * 256) = w; } }
    }
}
__device__ __forceinline__ void hgrn_state_scan(const bf16* DS, const float* DEC, bf16* SN, int item, int lane) {
    const int bh = item >> 2, eb = item & 3, hh = lane >> 5;
    f32x16 S[4];
#pragma unroll
    for (int rb = 0; rb < 4; ++rb)
#pragma unroll
        for (int i = 0; i < 16; ++i) S[rb][i] = 0.f;
    for (int n = 0; n < 32; ++n) {
        const size_t idx = (size_t)bh * 32 + n;
        f32x4 ds[4][4], dc[4][4];
#pragma unroll
        for (int rb = 0; rb < 4; ++rb)
#pragma unroll
            for (int g4 = 0; g4 < 4; ++g4) { const v2u w = *(const v2u*)(DS + idx * SZ_DS + ((size_t)((rb * 4 + eb) * 4 + g4) * 64 + lane) * 4); ds[rb][g4] = (f32x4){bflo(w.x), bfhi(w.x), bflo(w.y), bfhi(w.y)}; dc[rb][g4] = *(const f32x4*)(DEC + idx * 128 + 32 * rb + 8 * g4 + 4 * hh); }
        bf16* sp = SN + idx * SZ_SN + (size_t)eb * 8 * 512 + lane * 8;
#pragma unroll
        for (int rb = 0; rb < 4; ++rb)
#pragma unroll
            for (int st = 0; st < 2; ++st) *(bf16x8*)(sp + (rb * 2 + st) * 512) = pack8(S[rb], st);
#pragma unroll
        for (int rb = 0; rb < 4; ++rb)
#pragma unroll
            for (int i = 0; i < 16; ++i) S[rb][i] = S[rb][i] * dc[rb][i >> 2][i & 3] + ds[rb][i >> 2][i & 3];
    }
}
__device__ __forceinline__ void chunk_output(const bf16* QH, const bf16* SN, const bf16* OI, const float* nw, const bf16* gate, int ldg, bf16* OBUF, LAS unsigned char* lds, int tid, int lane, int wave) {
    const int r = lane & 31, hh = lane >> 5, rbk = wave & 1, eb = wave >> 1;
    LAS float* OT = (LAS float*)(lds + CH_OT);
    bf16x8 qf[8], sf[8]; unsigned short oi[16]; unsigned gw8[8];
#define CO_LOAD(IDX) do { const int bh_ = (IDX) >> 5, n_ = (IDX) & 31; const size_t row0_ = (size_t)(bh_ >> 4) * T + n_ * 64; \
        const bf16* qa_ = QH + (size_t)(IDX) * SZ_QH + (32 * rbk + r) * 128 + 8 * hh; const bf16* sb_ = SN + (size_t)(IDX) * SZ_SN + (size_t)eb * 8 * 512 + lane * 8; \
        _Pragma("unroll") for (int k8 = 0; k8 < 8; ++k8) { qf[k8] = *(const bf16x8*)(qa_ + 16 * k8); sf[k8] = *(const bf16x8*)(sb_ + k8 * 512); } \
        const bf16* op_ = OI + ((size_t)(IDX) * 64 + 32 * rbk) * 128 + 32 * eb + r; \
        _Pragma("unroll") for (int i = 0; i < 16; ++i) oi[i] = op_[crow(i, hh) * 128]; \
        _Pragma("unroll") for (int j = 0; j < 8; ++j) gw8[j] = *(const unsigned*)(gate + (row0_ + 8 * wave + j) * ldg + (bh_ & 15) * HD + 2 * lane); } while (0)
    if ((int)blockIdx.x < 2048) CO_LOAD((int)blockIdx.x);
    for (int idx = blockIdx.x; idx < 2048; idx += gridDim.x) {
        const int bh = idx >> 5, n = idx & 31, b = bh >> 4, h = bh & 15; const size_t row0 = (size_t)b * T + n * 64;
        f32x16 acc;
#pragma unroll
        for (int i = 0; i < 16; ++i) acc[i] = 0.f;
#pragma unroll
        for (int k8 = 0; k8 < 8; ++k8) acc = MFMA32(qf[k8], sf[k8], acc);
        float ov[16]; unsigned gcur[8];
#pragma unroll
        for (int i = 0; i < 16; ++i) ov[i] = acc[i] + bf2f(oi[i]);
#pragma unroll
        for (int j = 0; j < 8; ++j) gcur[j] = gw8[j];
        __syncthreads();
#pragma unroll
        for (int i = 0; i < 16; ++i) OT[(32 * rbk + crow(i, hh)) * 128 + 32 * eb + r] = ov[i];
        if (idx + (int)gridDim.x < 2048) CO_LOAD(idx + (int)gridDim.x);
        __syncthreads();
#pragma unroll
        for (int j = 0; j < 8; ++j) { const int rr = 8 * wave + j; const float o0 = OT[rr * 128 + 2 * lane], o1 = OT[rr * 128 + 2 * lane + 1];
            const float rstd = rsqrtf(wave_sum(o0 * o0 + o1 * o1) * (1.f / HD) + EPS);
            *(unsigned*)(OBUF + (row0 + rr) * DM + h * HD + 2 * lane) = pk2(o0 * rstd * nw[2 * lane] * silu(bflo(gcur[j])), o1 * rstd * nw[2 * lane + 1] * silu(bfhi(gcur[j]))); }
    }
#undef CO_LOAD
}
__device__ __forceinline__ int img256(int row, int c) { return row * 256 + ((c ^ (row & 15)) << 4); }
__device__ __forceinline__ int img128(int row, int c) { return row * 128 + ((c ^ ((row >> 1) & 7)) << 4); }
constexpr int G1_KT = 0, G1_SS = 16384, G1_GAM = 16384 + 1024, G1_BET = G1_GAM + 256;
constexpr int G3_KT = 0, G3_QT = 16384, G3_TT = 32768, G3_KBG = 40960, G3_VB = 57344, G3_KD = 73728, G3_QK = 90112, G3_GAM = 98304, G3_BET = G3_GAM + 256;
__device__ __forceinline__ void gdn_pass1(int idx, const bf16* proj, const float* small, const float* cw, const float* a_log, const float* dt_bias,
                                          bf16* QS, bf16* KS, bf16* VS, float* GB, float* AM, LAS unsigned char* lds, int tid, int lane, int wave) {
    asm volatile("" : "+v"(tid), "+v"(lane));
    const int d = tid & 127, pt = tid >> 7, r = lane & 31, hh = lane >> 5;
    const int bh = idx >> 5, n = idx & 31, b = bh >> 4, h = bh & 15; const size_t row0 = (size_t)b * T + n * 64;
    LAS float* SS = (LAS float*)(lds + G1_SS); LAS float* GAM = (LAS float*)(lds + G1_GAM); LAS float* BET = (LAS float*)(lds + G1_BET);
    __syncthreads();
    if (tid < 64) { float g = -__expf(a_log[h]) * softplus(small[(row0 + tid) * 256 + h] + dt_bias[h]);
#pragma unroll
        for (int o = 1; o < 64; o <<= 1) { const float v = __shfl_up(g, o); if (lane >= o) g += v; }
        const float be = sigm(small[(row0 + tid) * 256 + 16 + h]); GAM[tid] = g; BET[tid] = be; GB[(size_t)idx * 128 + tid] = g; GB[(size_t)idx * 128 + 64 + tid] = be; }
    { const int o = tid & 15;
#pragma unroll
      for (int s = 0; s < 3; ++s) { const int ch0 = s * 2048 + h * HD + 8 * o; float w[4][8];
#pragma unroll
          for (int j = 0; j < 4; ++j) { const f32x4 wa = *(const f32x4*)(cw + j * 6144 + ch0), wb = *(const f32x4*)(cw + j * 6144 + ch0 + 4);
              w[j][0] = wa.x; w[j][1] = wa.y; w[j][2] = wa.z; w[j][3] = wa.w; w[j][4] = wb.x; w[j][5] = wb.y; w[j][6] = wb.z; w[j][7] = wb.w; }
#pragma unroll
          for (int it = 0; it < 2; ++it) { const int rr = (tid >> 4) + 32 * it; float val[8];
#pragma unroll
              for (int e = 0; e < 8; ++e) val[e] = 0.f;
#pragma unroll
              for (int j = 0; j < 4; ++j) { const int rj = rr - 3 + j; v4u x = (v4u){0u, 0u, 0u, 0u};
                  if (n * 64 + rj >= 0) x = *(const v4u*)(proj + (row0 + rj) * AB_LDP + A_QKV + ch0);
                  val[0] += w[j][0] * bflo(x.x); val[1] += w[j][1] * bfhi(x.x); val[2] += w[j][2] * bflo(x.y); val[3] += w[j][3] * bfhi(x.y);
                  val[4] += w[j][4] * bflo(x.z); val[5] += w[j][5] * bfhi(x.z); val[6] += w[j][6] * bflo(x.w); val[7] += w[j][7] * bfhi(x.w); }
              float ssq = 0.f;
#pragma unroll
              for (int e = 0; e < 8; ++e) { val[e] = silu(val[e]); ssq += val[e] * val[e]; }
              if (s < 2) { ssq += __shfl_xor(ssq, 1); ssq += __shfl_xor(ssq, 2); ssq += __shfl_xor(ssq, 4); ssq += __shfl_xor(ssq, 8);
                  const float inv = rsqrtf(ssq + EPS) * (s == 0 ? QSCALE : 1.f);
#pragma unroll
                  for (int e = 0; e < 8; ++e) val[e] *= inv; }
              v4u pk; pk.x = pk2(val[0], val[1]); pk.y = pk2(val[2], val[3]); pk.z = pk2(val[4], val[5]); pk.w = pk2(val[6], val[7]);
              if (s == 1) *(LAS v4u*)(lds + G1_KT + img256(rr, o)) = pk;
              *(v4u*)((s == 0 ? QS : (s == 1 ? KS : VS)) + (size_t)idx * SZ_QH + rr * 128 + 8 * o) = pk; } } }
    __syncthreads();
    if (wave < 3) {
        const int jb = wave >> 1, rbk = (wave + 1) >> 1; int yk = hh ^ (r & 15); asm volatile("" : "+v"(yk));
        f32x16 acc;
#pragma unroll
        for (int i = 0; i < 16; ++i) acc[i] = 0.f;
#pragma unroll
        for (int ks = 0; ks < 8; ++ks) acc = MFMA32(*(const LAS bf16x8*)(lds + G1_KT + (32 * jb + r) * 256 + (((2 * ks) ^ yk) << 4)), *(const LAS bf16x8*)(lds + G1_KT + (32 * rbk + r) * 256 + (((2 * ks) ^ yk) << 4)), acc);
        const int rr = 32 * rbk + r; const float gr = GAM[rr], br = BET[rr];
#pragma unroll
        for (int g4 = 0; g4 < 4; ++g4) { const int j0 = 32 * jb + 8 * g4 + 4 * hh; const f32x4 gj = *(const LAS f32x4*)(GAM + j0); f32x4 o;
#pragma unroll
            for (int e = 0; e < 4; ++e) o[e] = (j0 + e < rr) ? br * __expf(gr - gj[e]) * acc[4 * g4 + e] : 0.f;
            *(f32x4*)(AM + (size_t)idx * 4096 + rr * 64 + j0) = o; }
    } else if (wave == 3) {
#pragma unroll
        for (int g4 = 0; g4 < 4; ++g4) *(f32x4*)(AM + (size_t)idx * 4096 + r * 64 + 32 + 8 * g4 + 4 * hh) = (f32x4){0.f, 0.f, 0.f, 0.f};
    }
}
__device__ __forceinline__ void gdn_pass2(int idx, const float* AM, bf16* TM, LAS unsigned char* wlds, int lane) {
    float Ar[64], Tr[64];
    { const f32x4* src = (const f32x4*)(AM + (size_t)idx * 4096 + lane * 64);
#pragma unroll
      for (int i = 0; i < 16; ++i) { const f32x4 v = src[i]; Ar[4 * i] = v[0]; Ar[4 * i + 1] = v[1]; Ar[4 * i + 2] = v[2]; Ar[4 * i + 3] = v[3]; } }
#pragma unroll
    for (int c = 0; c < 64; ++c) Tr[c] = (lane == c) ? 1.f : 0.f;
#pragma unroll
    for (int j = 0; j < 63; ++j) {
        const float na = -Ar[j];
#pragma unroll
        for (int c = 0; c <= j; ++c) { const float tj = __builtin_bit_cast(float, __builtin_amdgcn_readlane(__builtin_bit_cast(int, Tr[c]), j)); Tr[c] = fmaf(na, tj, Tr[c]); }
    }
    v4u* out = (v4u*)(TM + (size_t)idx * 4096 + lane * 64);
#pragma unroll
    for (int i = 0; i < 8; ++i) { v4u w; w.x = cvtpk(Tr[8 * i], Tr[8 * i + 1]); w.y = cvtpk(Tr[8 * i + 2], Tr[8 * i + 3]); w.z = cvtpk(Tr[8 * i + 4], Tr[8 * i + 5]); w.w = cvtpk(Tr[8 * i + 6], Tr[8 * i + 7]); out[i] = w; }
}
struct G3Pre { float g; v4u t[5]; unsigned short kc[16], vc[16]; };
__device__ __forceinline__ void g3_load(G3Pre& P, int idx, const bf16* QS, const bf16* KS, const bf16* VS, const float* GB, const bf16* TM, int tid) {
    const int d = tid & 127, pt = tid >> 7;
    P.g = tid < 128 ? GB[(size_t)idx * 128 + tid] : 0.f;
#pragma unroll
    for (int i = 0; i < 2; ++i) { const int id = tid + 512 * i, rw = id >> 4, c = id & 15; P.t[2 * i] = *(const v4u*)(KS + (size_t)idx * SZ_QH + rw * 128 + c * 8); P.t[2 * i + 1] = *(const v4u*)(QS + (size_t)idx * SZ_QH + rw * 128 + c * 8); }
    { const int rw = tid >> 3, c = tid & 7; P.t[4] = *(const v4u*)(TM + (size_t)idx * 4096 + rw * 64 + c * 8); }
#pragma unroll
    for (int i = 0; i < 16; ++i) { const size_t o = (size_t)idx * SZ_QH + (16 * pt + i) * 128 + d; P.kc[i] = KS[o]; P.vc[i] = VS[o]; }
}
__device__ __forceinline__ void gdn_pass3(int idx, int idx_next, G3Pre& P, const bf16* QS, const bf16* KS, const bf16* VS, const float* GB, const bf16* TM, bf16* QH, bf16* OI, bf16* AN, bf16* DS,
                                          LAS unsigned char* lds, int tid, int lane, int wave) {
    asm volatile("" : "+v"(tid), "+v"(lane));
    const int d = tid & 127, pt = tid >> 7, r = lane & 31, hh = lane >> 5;
    LAS float* GAM = (LAS float*)(lds + G3_GAM); LAS float* BET = (LAS float*)(lds + G3_BET);
    __syncthreads();
    if (tid < 128) GAM[tid] = P.g;
#pragma unroll
    for (int i = 0; i < 2; ++i) { const int id = tid + 512 * i, rw = id >> 4, c = id & 15;
        *(LAS v4u*)(lds + G3_KT + img256(rw, c)) = P.t[2 * i];
        *(LAS v4u*)(lds + G3_QT + img256(rw, c)) = P.t[2 * i + 1]; }
    { const int rw = tid >> 3, c = tid & 7; *(LAS v4u*)(lds + G3_TT + img128(rw, c)) = P.t[4]; }
    float kv[16], vv[16];
#pragma unroll
    for (int i = 0; i < 16; ++i) { kv[i] = bf2f(P.kc[i]); vv[i] = bf2f(P.vc[i]); }
    if (idx_next < 2048) g3_load(P, idx_next, QS, KS, VS, GB, TM, tid);
    __syncthreads();
    { const float glast = GAM[63]; unsigned kbg[16], vb[16], kd[16];
#pragma unroll
      for (int i = 0; i < 16; ++i) { const float gm = GAM[16 * pt + i], bm = BET[16 * pt + i]; kbg[i] = f2bf(kv[i] * bm * __expf(gm)); vb[i] = f2bf(vv[i] * bm); kd[i] = f2bf(kv[i] * __expf(glast - gm)); }
#pragma unroll
      for (int h2 = 0; h2 < 2; ++h2) { v4u a, bq, c;
          a.x = kbg[8 * h2] | (kbg[8 * h2 + 1] << 16); a.y = kbg[8 * h2 + 2] | (kbg[8 * h2 + 3] << 16); a.z = kbg[8 * h2 + 4] | (kbg[8 * h2 + 5] << 16); a.w = kbg[8 * h2 + 6] | (kbg[8 * h2 + 7] << 16);
          bq.x = vb[8 * h2] | (vb[8 * h2 + 1] << 16); bq.y = vb[8 * h2 + 2] | (vb[8 * h2 + 3] << 16); bq.z = vb[8 * h2 + 4] | (vb[8 * h2 + 5] << 16); bq.w = vb[8 * h2 + 6] | (vb[8 * h2 + 7] << 16);
          unsigned e[8];
#pragma unroll
          for (int j = 0; j < 8; ++j) e[j] = kd[8 * (j >> 2) + 4 * h2 + (j & 3)];
          c.x = e[0] | (e[1] << 16); c.y = e[2] | (e[3] << 16); c.z = e[4] | (e[5] << 16); c.w = e[6] | (e[7] << 16);
          const int sw = img128(d, 2 * pt + h2);
          *(LAS v4u*)(lds + G3_KBG + sw) = a; *(LAS v4u*)(lds + G3_VB + sw) = bq; *(LAS v4u*)(lds + G3_KD + sw) = c; } }
    int yk = hh ^ (r & 15); asm volatile("" : "+v"(yk)); int yv = hh ^ ((r >> 1) & 7); asm volatile("" : "+v"(yv));
    if (wave < 3) {
        const int jb = wave >> 1, rbk = (wave + 1) >> 1; f32x16 acc;
#pragma unroll
        for (int i = 0; i < 16; ++i) acc[i] = 0.f;
#pragma unroll
        for (int ks = 0; ks < 8; ++ks) acc = MFMA32(*(const LAS bf16x8*)(lds + G3_KT + (32 * jb + r) * 256 + (((2 * ks) ^ yk) << 4)), *(const LAS bf16x8*)(lds + G3_QT + (32 * rbk + r) * 256 + (((2 * ks) ^ yk) << 4)), acc);
        const int rr = 32 * rbk + r; const float gr = GAM[rr];
#pragma unroll
        for (int g4 = 0; g4 < 4; ++g4) { const int j0 = 32 * jb + 8 * g4 + 4 * hh; const f32x4 gj = *(const LAS f32x4*)(GAM + j0); float o[4];
#pragma unroll
            for (int e = 0; e < 4; ++e) o[e] = (j0 + e <= rr) ? __expf(gr - gj[e]) * acc[4 * g4 + e] : 0.f;
            v2u w; w.x = cvtpk(o[0], o[1]); w.y = cvtpk(o[2], o[3]);
            *(LAS v2u*)(lds + G3_QK + img128(rr, 2 * (j0 >> 4) + hh) + 8 * (g4 & 1)) = w; }
    } else if (wave == 3) {
        const v2u z = (v2u){0u, 0u};
#pragma unroll
        for (int g4 = 0; g4 < 4; ++g4) { const int j0 = 32 + 8 * g4 + 4 * hh; *(LAS v2u*)(lds + G3_QK + img128(r, 2 * (j0 >> 4) + hh) + 8 * (g4 & 1)) = z; }
    }
    __syncthreads();
    const int cb = wave & 3; const bool isw = wave < 4; const int boff = isw ? G3_KBG : G3_VB;
    f32x16 X[2];
#pragma unroll
    for (int jb = 0; jb < 2; ++jb) {
#pragma unroll
        for (int i = 0; i < 16; ++i) X[jb][i] = 0.f;
#pragma unroll
        for (int ms = 0; ms < 4; ++ms) X[jb] = MFMA32(*(const LAS bf16x8*)(lds + G3_TT + (32 * jb + r) * 128 + (((2 * ms) ^ yv) << 4)), *(const LAS bf16x8*)(lds + boff + (32 * cb + r) * 128 + (((2 * ms) ^ yv) << 4)), X[jb]); }
    bf16x8 xf[4];
#pragma unroll
    for (int kq = 0; kq < 4; ++kq) xf[kq] = pack8(X[kq >> 1], kq & 1);
    __syncthreads();
#pragma unroll 1
    for (int rbk = 0; rbk < 2; ++rbk) { f32x16 acc;
#pragma unroll
        for (int i = 0; i < 16; ++i) acc[i] = 0.f;
#pragma unroll
        for (int kq = 0; kq < 4; ++kq) acc = MFMA32(*(const LAS bf16x8*)(lds + G3_QK + (32 * rbk + r) * 128 + (((2 * kq) ^ yv) << 4)), xf[kq], acc);
        const int col = 32 * cb + r;
        if (isw) {
#pragma unroll
            for (int i = 0; i < 16; ++i) { const int rr = 32 * rbk + crow(i, hh); const float qv = bf2f(*(const LAS unsigned short*)(lds + G3_QT + img256(rr, col >> 3) + (col & 7) * 2));
                *(LAS unsigned short*)(lds + G3_KT + rr * 256 + ((col & ~15) + perm16(col & 15)) * 2) = (unsigned short)f2bf(qv * __expf(GAM[rr]) - acc[i]); }
        } else {
#pragma unroll
            for (int i = 0; i < 16; ++i) { const int rr = 32 * rbk + crow(i, hh); OI[((size_t)idx * 64 + rr) * 128 + col] = (bf16)f2bf(acc[i]); }
        } }
    const float gl = __expf(GAM[63]);
#pragma unroll 1
    for (int rb = 0; rb < 4; ++rb) { f32x16 acc;
#pragma unroll
        for (int i = 0; i < 16; ++i) acc[i] = 0.f;
#pragma unroll
        for (int kq = 0; kq < 4; ++kq) acc = MFMA32(*(const LAS bf16x8*)(lds + G3_KD + (32 * rb + r) * 128 + (((2 * kq) ^ yv) << 4)), xf[kq], acc);
        const int col = 32 * cb + r;
        if (isw) {
#pragma unroll
            for (int i = 0; i < 16; ++i) { const int dr = 32 * rb + crow(i, hh); *(LAS unsigned short*)(lds + G3_TT + dr * 256 + ((col & ~15) + perm16(col & 15)) * 2) = (unsigned short)f2bf((dr == col ? gl : 0.f) - acc[i]); }
        } else {
            bf16* dp = DS + (size_t)idx * SZ_DS + ((size_t)(rb * 4 + cb) * 4 * 64 + lane) * 4;
#pragma unroll
            for (int g4 = 0; g4 < 4; ++g4) { v2u w; w.x = cvtpk(acc[4 * g4], acc[4 * g4 + 1]); w.y = cvtpk(acc[4 * g4 + 2], acc[4 * g4 + 3]); *(v2u*)(dp + g4 * 256) = w; }
        } }
    __syncthreads();
#pragma unroll
    for (int i = 0; i < 2; ++i) { const int id = tid + 512 * i; *(v4u*)(QH + (size_t)idx * SZ_QH + id * 8) = *(const LAS v4u*)(lds + G3_KT + id * 16); }
#pragma unroll
    for (int i = 0; i < 4; ++i) { const int id = tid + 512 * i; *(v4u*)(AN + (size_t)idx * SZ_DS + id * 8) = *(const LAS v4u*)(lds + G3_TT + id * 16); }
}
__device__ __forceinline__ void gdn_prep_a(const bf16* proj, const float* small, const float* cw, const float* a_log, const float* dt_bias, bf16* QS, bf16* KS, bf16* VS, float* GB, float* AM, LAS unsigned char* lds, int tid, int lane, int wave) {
#pragma unroll 1
    for (int k = 0; k < 8; ++k) { const int idx = blockIdx.x + k * gridDim.x; if (idx < 2048) gdn_pass1(idx, proj, small, cw, a_log, dt_bias, QS, KS, VS, GB, AM, lds, tid, lane, wave); }
    asm volatile("s_waitcnt vmcnt(0)" ::: "memory"); __syncthreads();
}
__device__ __forceinline__ void gdn_prep_b(const float* AM, bf16* TM, LAS unsigned char* lds, int lane, int wave) {
    { const int idx = blockIdx.x + wave * gridDim.x; if (idx < 2048) gdn_pass2(idx, AM, TM, lds + wave * 16384, lane); }
    asm volatile("s_waitcnt vmcnt(0)" ::: "memory"); __syncthreads();
}
__device__ __forceinline__ void gdn_prep_c(const bf16* QS, const bf16* KS, const bf16* VS, const float* GB, const bf16* TM, bf16* QH, bf16* OI, bf16* AN, bf16* DS, LAS unsigned char* lds, int tid, int lane, int wave) {
    G3Pre P; if ((int)blockIdx.x < 2048) g3_load(P, (int)blockIdx.x, QS, KS, VS, GB, TM, tid);
#pragma unroll 1
    for (int k = 0; k < 8; ++k) { const int idx = blockIdx.x + k * gridDim.x; if (idx < 2048) gdn_pass3(idx, k < 7 ? idx + (int)gridDim.x : 2048, P, QS, KS, VS, GB, TM, QH, OI, AN, DS, lds, tid, lane, wave); }
}
__device__ __forceinline__ void gdn_state_scan(const bf16* AN, const bf16* DS, bf16* SN, int item, int lane) {
    const int bh = item >> 2, eb = item & 3, r = lane & 31, hh = lane >> 5;
    f32x16 S[4];
#pragma unroll
    for (int rb = 0; rb < 4; ++rb)
#pragma unroll
        for (int i = 0; i < 16; ++i) S[rb][i] = 0.f;
    for (int n = 0; n < 32; ++n) {
        const size_t idx = (size_t)bh * 32 + n;
        bf16x8 sf[8];
#pragma unroll
        for (int k8 = 0; k8 < 8; ++k8) sf[k8] = pack8(S[k8 >> 1], k8 & 1);
        bf16* sp = SN + idx * SZ_SN + (size_t)eb * 8 * 512 + lane * 8;
#pragma unroll
        for (int k8 = 0; k8 < 8; ++k8) *(bf16x8*)(sp + k8 * 512) = sf[k8];
#pragma unroll
        for (int rb = 0; rb < 4; ++rb) {
#pragma unroll
            for (int g4 = 0; g4 < 4; ++g4) { const v2u w = *(const v2u*)(DS + idx * SZ_DS + ((size_t)((rb * 4 + eb) * 4 + g4) * 64 + lane) * 4); S[rb][4 * g4] = bflo(w.x); S[rb][4 * g4 + 1] = bfhi(w.x); S[rb][4 * g4 + 2] = bflo(w.y); S[rb][4 * g4 + 3] = bfhi(w.y); }
            const bf16* ap = AN + idx * SZ_DS + (32 * rb + r) * 128 + 8 * hh;
#pragma unroll
            for (int k8 = 0; k8 < 8; ++k8) S[rb] = MFMA32(*(const bf16x8*)(ap + 16 * k8), sf[k8], S[rb]);
        }
    }
}

constexpr size_t MS_BIAS = 5 * MiB, MS_W2T = 5 * MiB + 65536, MS_WFF = 5 * MiB + 131072, MS_W1T = 6 * MiB;
constexpr int CP_PART = 0, CP_HID = 16384;
__device__ __forceinline__ void nsa_compress_mfma(const bf16* proj, const bf16* W1T, const bf16* W2T, const float* BIAS, bf16* KC, bf16* VCT, LAS unsigned char* lds, int tid, int lane, int wave) {
    const int r = lane & 31, hh = lane >> 5, jb = wave & 3, kh = wave >> 2;
    for (int item = (int)blockIdx.x - ((int)gridDim.x - 128); item < 128; item += gridDim.x) {
        if (item < 0) break;
        const int nb = item & 3, kv = (item >> 2) & 1, bg = item >> 3, b = bg >> 2, g = bg & 3;
        const int n = 32 * nb + r, ne = n < NCMP ? n : NCMP - 1;
        const bf16* ap = proj + (size_t)(b * T + 16 * ne) * AB_LDP + A_NKV + kv * 512 + g * HD + 8 * hh;
        const bf16* bp = W1T + ((size_t)kv * 128 + 32 * jb + r) * 4096 + 8 * hh;
        f32x16 acc;
#pragma unroll
        for (int i = 0; i < 16; ++i) acc[i] = 0.f;
#pragma unroll 4
        for (int l = 16 * kh; l < 16 * kh + 16; ++l) {
#pragma unroll
            for (int q = 0; q < 8; ++q) acc = MFMA32(*(const bf16x8*)(ap + (size_t)l * AB_LDP + 16 * q), *(const bf16x8*)(bp + l * 128 + 16 * q), acc); }
        __syncthreads();
        LAS float* PART = (LAS float*)(lds + CP_PART);
        if (kh == 1) {
#pragma unroll
            for (int i = 0; i < 16; ++i) PART[crow(i, hh) * 128 + 32 * jb + r] = acc[i]; }
        __syncthreads();
        if (kh == 0) { const float bs = BIAS[kv * 128 + 32 * jb + r]; const int col = 32 * jb + r;
#pragma unroll
            for (int i = 0; i < 16; ++i) { const int rr = crow(i, hh); const float hv = silu(acc[i] + PART[rr * 128 + col] + bs);
                *(LAS unsigned short*)(lds + CP_HID + img256(rr, col >> 3) + (col & 7) * 2) = (unsigned short)f2bf(hv); } }
        __syncthreads();
        if (wave < 4) { int yk = hh ^ (r & 15); asm volatile("" : "+v"(yk));
            const bf16* wp = W2T + ((size_t)kv * 128 + 32 * wave + r) * 128 + 8 * hh; f32x16 o;
#pragma unroll
            for (int i = 0; i < 16; ++i) o[i] = 0.f;
#pragma unroll
            for (int ks = 0; ks < 8; ++ks) o = MFMA32(*(const LAS bf16x8*)(lds + CP_HID + r * 256 + (((2 * ks) ^ yk) << 4)), *(const bf16x8*)(wp + 16 * ks), o);
            const int j = 32 * wave + r;
#pragma unroll
            for (int i = 0; i < 16; ++i) { const int nn = 32 * nb + crow(i, hh); const bf16 v = nn < NCMP ? (bf16)f2bf(o[i]) : (bf16)0;
                if (kv) VCT[((size_t)bg * 128 + j) * 128 + (nn & ~15) + perm16(nn & 15)] = v; else KC[((size_t)bg * 128 + nn) * HD + j] = v; } }
    }
}
#ifndef MK_SINGLE
#define MK_SINGLE 1
#endif
constexpr int NPHASE = 28;
struct Args { const float* in[33]; float* out; unsigned char* ws; int ph_lo, ph_hi; };
enum { I_X = 0, I_P, I_AB_NPRE, I_AB_NPOST, I_AB_WIN, I_GDN_CW, I_GDN_ALOG, I_GDN_DTB, I_GDN_NORM, I_PE_K, I_PE_V, I_K1, I_K2, I_V1, I_V2, I_AB_WOUT, I_CD_NPRE, I_CD_NPOST, I_CD_WIN,
       I_LB, I_HGRN_NORM, I_FOX_B, I_CD_WOUT, I_FFN_NPRE, I_FFN_NPOST, I_FFN_WUP, I_FFN_CW, I_FFN_CB, I_FFN_WDOWN, I_PLE_WPROJ, I_PLE_GNORM, I_PLE_WGATE, I_PLE_NPOST };

__global__ void __launch_bounds__(NTHR, 2) fwd(Args args) {
    extern __shared__ __attribute__((aligned(16))) unsigned char lds_raw[];
    LAS unsigned char* lds = (LAS unsigned char*)lds_raw;
    volatile LAS unsigned* MISC = (volatile LAS unsigned*)(lds + MISC_OFF);
    const int tid = threadIdx.x, lane = tid & 63, wave = __builtin_amdgcn_readfirstlane(tid >> 6);
    const int G = gridDim.x, gw = blockIdx.x * NWAVES + wave, ngw = G * NWAVES, gw2 = wave * G + blockIdx.x;
    unsigned char* ws = args.ws;
    unsigned* ctl = (unsigned*)(ws + WS_CTL);
    for (int u = tid; u < (LDS_BYTES - LDSCTL_OFF) / 4; u += NTHR) ((LAS unsigned*)(lds + LDSCTL_OFF))[u] = 0u;
    __syncthreads();
    const int lo = args.ph_lo, hi = args.ph_hi;
    XcdBarrier bar; bar.bar = ctl + CW_BAR; bar.x = 0; bar.st = nullptr;
    if (hi - lo > 1) bar = xcd_barrier_post(ctl + CW_BAR, MISC + 8);
#ifndef PH_MASK
#define PH_MASK 0xFFFFFFFFu
#endif
#define IN(k) (((PH_MASK >> (k)) & 1u) && lo <= (k) && (k) < hi)
#define SEAM(k) do { if (IN(k) && IN((k) + 1)) xcd_barrier(bar); } while (0)
    bf16* WABIN = (bf16*)(ws + WS_WABIN); bf16* WABOUT = (bf16*)(ws + WS_WABOUT); bf16* WCDIN = (bf16*)(ws + WS_WCDIN); bf16* WCDOUT = (bf16*)(ws + WS_WCDOUT);
    bf16* WUP = (bf16*)(ws + WS_WUP); bf16* WDOWN = (bf16*)(ws + WS_WDOWN); bf16* WGATE = (bf16*)(ws + WS_WGATE); bf16* WPROJ = (bf16*)(ws + WS_WPROJ);
    float* XRES = (float*)(ws + WS_XRES); bf16* H = (bf16*)(ws + WS_H); bf16* PROJ = (bf16*)(ws + WS_PROJ); float* SMALL = (float*)(ws + WS_SMALL); float* Y = (float*)(ws + WS_Y);
    bf16* OBUF = (bf16*)(ws + WS_OBUF); bf16* Z = (bf16*)(ws + WS_Z); bf16* ACT = (bf16*)(ws + WS_ACT); bf16* PP = (bf16*)(ws + WS_PP); bf16* PPL = (bf16*)(ws + WS_XRES);     bf16* PBF = (bf16*)(ws + WS_PBF);
    float* QN = (float*)(ws + WS_QN); float* KN = (float*)(ws + WS_KN); float* VV = (float*)(ws + WS_VV); float* ORAW = (float*)(ws + WS_ORAW); float* OCMP = (float*)(ws + WS_OCMP);
    unsigned char* ms = ws + WS_MISC;
    bf16* KC = (bf16*)(ms + MS_KC); bf16* VC = (bf16*)(ms + MS_VC); float* GG = (float*)(ms + MS_GG); float* BB = (float*)(ms + MS_BB); unsigned* SEL = (unsigned*)(ms + MS_SEL); float* CUM = (float*)(ms + MS_CUM);
    bf16* QH = (bf16*)(ws + WS_Z); bf16* OI = (bf16*)(ws + WS_Z + 32 * MiB); bf16* SN = (bf16*)(ws + WS_Z + 96 * MiB); bf16* AN = (bf16*)(ws + WS_Z + 160 * MiB); float* DEC = (float*)(ws + WS_Z + 224 * MiB); bf16* DS = (bf16*)(ws + WS_ACT + 32 * MiB);
    bf16* QS = (bf16*)(ws + WS_Z + 225 * MiB); bf16* KS = (bf16*)(ws + WS_Z + 257 * MiB); bf16* VS = (bf16*)(ws + WS_Z + 289 * MiB); float* AMX = (float*)(ws + WS_PP); float* GB = (float*)(ws + WS_PP + 32 * MiB); bf16* TM = (bf16*)(ws + WS_ACT + 16 * MiB);
    float* RS = (float*)(ws + WS_MISC + 4 * MiB + 768 * 1024); bf16* YB = (bf16*)(ws + WS_Y);
    LAS float* wl = (LAS float*)(lds + wave * 1024);
    constexpr size_t SZ_UP = (size_t)2 * DFF * DM, SZ_DOWN = (size_t)DFF * DM, SZ_SQ = (size_t)DM * DM, SZ_PJ = (size_t)DPLE * DM;

    if (IN(0)) {
        LAS float* scr = (LAS float*)(lds + wave * 16384);
        transpose_seg(args.in[I_AB_WIN], DM, AB_IN, 0, 6144, 6144, WABIN, 0, scr, gw, ngw, lane, args.in[I_AB_NPRE]);
        transpose_seg(args.in[I_AB_WIN], DM, AB_IN, 6176, 7168, 7168, WABIN, 6144, scr, gw, ngw, lane, args.in[I_AB_NPRE]);
        transpose_seg(args.in[I_AB_WIN], DM, AB_IN, 6144, 32, 32, WABIN, 13312, scr, gw, ngw, lane, args.in[I_AB_NPRE]);
        transpose_seg(args.in[I_AB_WIN], DM, AB_IN, 13344, 48, 64, WABIN, 13344, scr, gw, ngw, lane, args.in[I_AB_NPRE]);
        transpose_seg(args.in[I_AB_WIN], DM, AB_IN, 0, 0, 160, WABIN, 13408, scr, gw, ngw, lane);
        transpose_seg(args.in[I_AB_WOUT], DM, DM, 0, DM, DM, WABOUT, 0, scr, gw, ngw, lane);
        transpose_seg(args.in[I_CD_WIN], DM, CD_IN, 0, 14336, 14336, WCDIN, 0, scr, gw, ngw, lane, args.in[I_CD_NPRE]);
        for (int i = blockIdx.x * NTHR + tid; i < DM * 16; i += G * NTHR) { const int cc = i & 15, k = i >> 4;
            ((bf16*)(ms + MS_WFF))[(size_t)cc * DM + k] = (bf16)f2bf(args.in[I_CD_WIN][(size_t)k * CD_IN + 14336 + cc] * args.in[I_CD_NPRE][k]); }
        for (int l = 0; l < 2; ++l) {
            transpose_seg(args.in[I_FFN_WUP] + l * SZ_UP, DM, 2 * DFF, 0, 2 * DFF, 2 * DFF, WUP + l * SZ_UP, 0, scr, gw, ngw, lane, args.in[I_FFN_NPRE] + l * DM);
            if (l == 0) transpose_seg(args.in[I_FFN_WDOWN] + l * SZ_DOWN, DFF, DM, 0, DM, DM, WDOWN + l * SZ_DOWN, 0, scr, gw, ngw, lane);
            if (l == 0) transpose_seg(args.in[I_PLE_WGATE] + l * SZ_SQ, DM, DM, 0, DM, DM, WGATE + l * SZ_SQ, 0, scr, gw, ngw, lane, args.in[I_PLE_GNORM] + l * DM);
            transpose_seg(args.in[I_PLE_WPROJ] + l * SZ_PJ, DPLE, DM, 0, DM, DM, WPROJ + l * SZ_PJ, 0, scr, gw, ngw, lane);
        }
        for (int m = gw; m < M; m += ngw) prep_row(args.in[I_X] + (size_t)m * DM, H + (size_t)m * DM, RS + m, lane);
        transpose_seg(args.in[I_K1], 4096, 128, 0, 128, 128, (bf16*)(ms + MS_W1T), 0, scr, gw, ngw, lane);
        transpose_seg(args.in[I_V1], 4096, 128, 0, 128, 128, (bf16*)(ms + MS_W1T) + (size_t)128 * 4096, 0, scr, gw, ngw, lane);
        transpose_seg(args.in[I_K2], 128, 128, 0, 128, 128, (bf16*)(ms + MS_W2T), 0, scr, gw, ngw, lane);
        transpose_seg(args.in[I_V2], 128, 128, 0, 128, 128, (bf16*)(ms + MS_W2T) + 128 * 128, 0, scr, gw, ngw, lane);
        if (gw < 256) { const int kv = gw >> 7, j = gw & 127; const float* pe = args.in[kv ? I_PE_V : I_PE_K]; const float* w1 = args.in[kv ? I_V1 : I_K1]; float sacc = 0.f;
            for (int i = lane; i < 4096; i += 64) sacc += pe[i] * w1[(size_t)i * 128 + j];
            sacc = wave_sum(sacc); if (lane == 0) ((float*)(ms + MS_BIAS))[gw] = sacc; }
        { const float* p = args.in[I_P]; for (size_t i = (size_t)blockIdx.x * NTHR + tid; i < (size_t)2 * M * DPLE / 4; i += (size_t)G * NTHR) { const f32x4 v = ((const f32x4*)p)[i]; v2u o; o.x = pk2(v.x, v.y); o.y = pk2(v.z, v.w); ((v2u*)PBF)[i] = o; } }
        for (int i = blockIdx.x * NTHR + tid; i < 16 * HD; i += G * NTHR) { const int bg = i >> 7, d = i & 127; KC[((size_t)bg * 128 + 127) * HD + d] = 0; VC[((size_t)bg * 128 + d) * 128 + 127] = 0; }
    }
    SEAM(0);
    if (IN(1)) { pg8::Gemm g{H, WABIN, M, AB_NPAD, DM, DM}; pg8::StaticOrder S; S.init(M, AB_NPAD, G, (int)blockIdx.x); pg8::EpiProj E{PROJ, AB_LDP, SMALL, AB_LDP / 256, RS};
        pg8::gemm_phase<pg8::EpiProj, pg8::StaticOrder, true, true>(lds, g, S, E); }
    SEAM(1);
    if (IN(2)) gdn_prep_a(PROJ, SMALL, args.in[I_GDN_CW], args.in[I_GDN_ALOG], args.in[I_GDN_DTB], QS, KS, VS, GB, AMX, lds, tid, lane, wave);
    if (IN(2)) gdn_prep_b(AMX, TM, lds, lane, wave);
    if (IN(2)) { gdn_prep_c(QS, KS, VS, GB, TM, QH, OI, AN, DS, lds, tid, lane, wave); __syncthreads(); }
    if (IN(2)) {
        nsa_compress_mfma(PROJ, (const bf16*)(ms + MS_W1T), (const bf16*)(ms + MS_W2T), (const float*)(ms + MS_BIAS), KC, VC, lds, tid, lane, wave);
        if (G == 256) { if (blockIdx.x < 128) { vt_transpose(PROJ, AB_LDP, A_NKV + 3 * 512, 4, (bf16*)(ws + WS_ACT), blockIdx.x * NTHR + tid, 128 * NTHR);
                vt_transpose(PROJ, AB_LDP, A_NKV + 5 * 512, 4, (bf16*)(ws + WS_ACT + 8 * MiB), blockIdx.x * NTHR + tid, 128 * NTHR); } }
        else { vt_transpose(PROJ, AB_LDP, A_NKV + 3 * 512, 4, (bf16*)(ws + WS_ACT), blockIdx.x * NTHR + tid, G * NTHR);
            vt_transpose(PROJ, AB_LDP, A_NKV + 5 * 512, 4, (bf16*)(ws + WS_ACT + 8 * MiB), blockIdx.x * NTHR + tid, G * NTHR); }
    }
    SEAM(2);
    if (IN(3)) { if (wave == 0) { if (gw2 < 256) gdn_state_scan(AN, DS, SN, gw2, lane); }
        else transpose_seg(args.in[I_FFN_WDOWN] + SZ_DOWN, DFF, DM, 0, DM, DM, WDOWN + SZ_DOWN, 0, (LAS float*)(lds + wave * 16384), (int)blockIdx.x * 7 + wave - 1, G * 7, lane); }
    SEAM(3);
    if (IN(4)) { nsa_attn_mfma(PROJ, SMALL, KC, VC, (const bf16*)(ws + WS_ACT), (const bf16*)(ws + WS_ACT + 8 * MiB), (bf16*)Y, OBUF, lds, tid, lane, wave); __syncthreads(); }
    if (IN(5)) {
        chunk_output(QH, SN, OI, args.in[I_GDN_NORM], PROJ + A_GATE, AB_LDP, OBUF, lds, tid, lane, wave);
    }
    SEAM(5);
    if (IN(6)) { pg8::Gemm g{OBUF, WABOUT, M, DM, DM, DM}; pg8::StaticOrder S; S.init(M, DM, G, (int)blockIdx.x); pg8::EpiB16 E{YB, DM, nullptr};
        pg8::gemm_phase<pg8::EpiB16, pg8::StaticOrder, true, true>(lds, g, S, E); }
    SEAM(6);
    if (IN(7)) for (int m = gw; m < M; m += ngw) post_row<false>(YB + (size_t)m * DM, H + (size_t)m * DM, nullptr, args.in[I_AB_NPOST], RS + m, lane);
    SEAM(7);
#define FFN_PLE(P0, L, FINALP) \
    if (IN(P0)) { pg8::Gemm g{H, WUP + (L) * SZ_UP, M, 2 * DFF, DM, DM}; pg8::StaticOrder S; S.init(M, 2 * DFF, G, (int)blockIdx.x); pg8::EpiB16 E{Z, 2 * DFF, RS}; \
        pg8::gemm_phase<pg8::EpiB16, pg8::StaticOrder, true, true>(lds, g, S, E); } \
    SEAM(P0); \
    if (IN(P0 + 1)) convact_phase(Z, args.in[I_FFN_CW] + (size_t)(L) * 3 * 2 * DFF, args.in[I_FFN_CB] + (size_t)(L) * 2 * DFF, ACT, blockIdx.x * NTHR + tid, G * NTHR); \
    SEAM(P0 + 1); \
    if (IN(P0 + 2)) { pg8::Gemm g{ACT, WDOWN + (L) * SZ_DOWN, M, DM, DFF, DFF}; pg8::StaticOrder S; S.init(M, DM, G, (int)blockIdx.x); pg8::EpiB16 E{YB, DM, nullptr}; \
        pg8::gemm_phase<pg8::EpiB16, pg8::StaticOrder, true, true>(lds, g, S, E); } \
    SEAM(P0 + 2); \
    if (IN(P0 + 3)) { for (int m = gw; m < M; m += ngw) post_row<false>(YB + (size_t)m * DM, H + (size_t)m * DM, nullptr, args.in[I_FFN_NPOST] + (L) * DM, RS + m, lane); \
        if ((L) == 0) { asm volatile("s_waitcnt vmcnt(0)" ::: "memory"); __syncthreads(); \
            _Pragma("unroll 1") for (int l2 = 0; l2 < 2; ++l2) {                \
                pg8::Gemm g{PBF + (size_t)l2 * M * DPLE, WPROJ + l2 * SZ_PJ, M, DM, DPLE, DPLE}; pg8::StaticOrder S; S.init(M, DM, G, (int)blockIdx.x); pg8::EpiB16 E{PPL + (size_t)l2 * M * DM, DM, nullptr}; \
                pg8::gemm_phase<pg8::EpiB16, pg8::StaticOrder, true, true>(lds, g, S, E); } } } \
    SEAM(P0 + 3); \
    if (IN(P0 + 5)) { pg8::Gemm g{H, WGATE + (L) * SZ_SQ, M, DM, DM, DM}; pg8::StaticOrder S; S.init(M, DM, G, (int)blockIdx.x); pg8::EpiGate E{YB, PPL + (size_t)(L) * M * DM, DM, RS}; \
        pg8::gemm_phase<pg8::EpiGate, pg8::StaticOrder, true, true>(lds, g, S, E); } \
    SEAM(P0 + 5); \
    if (IN(P0 + 6)) { \
        for (int m = gw; m < M; m += ngw) post_row<FINALP>(YB + (size_t)m * DM, H + (size_t)m * DM, FINALP ? args.out + (size_t)m * DM : (float*)nullptr, args.in[I_PLE_NPOST] + (L) * DM, RS + m, lane); \
        if (!(FINALP) && G == 256) { asm volatile("s_waitcnt vmcnt(0)" ::: "memory"); __syncthreads(); ff_rows_mfma(H, (const bf16*)(ms + MS_WFF), RS, SMALL, lds, tid, lane, wave); } }

    FFN_PLE(8, 0, false)
    SEAM(14);
    if (IN(15)) { pg8::Gemm g{H, WCDIN, M, CD_LDP, DM, DM}; pg8::StaticOrder S; S.init(M, CD_LDP, G, (int)blockIdx.x); pg8::EpiProj E{PROJ, CD_LDP, SMALL, CD_LDP / 256, RS};
        pg8::gemm_phase<pg8::EpiProj, pg8::StaticOrder, true, true>(lds, g, S, E); }
    SEAM(15);
    if (IN(16)) {
        hgrn_chunk_prep(PROJ, args.in[I_LB], QH, OI, DS, DEC, lds, tid, lane, wave);
        if (gw2 < 64) fox_cum(SMALL, args.in[I_FOX_B], CUM, gw2, lane);
        vt_transpose(PROJ, CD_LDP, C_FV, NH, (bf16*)(ws + WS_ACT), blockIdx.x * NTHR + tid, G * NTHR);
    }
    SEAM(16);
    if (IN(17)) { if (wave == 0) { if (gw2 < 256) hgrn_state_scan(DS, DEC, SN, gw2, lane); }
        else { LAS float* scr7 = (LAS float*)(lds + wave * 16384);
            transpose_seg(args.in[I_CD_WOUT], DM, DM, 0, DM, DM, WCDOUT, 0, scr7, (int)blockIdx.x * 7 + wave - 1, G * 7, lane);
            transpose_seg(args.in[I_PLE_WGATE] + SZ_SQ, DM, DM, 0, DM, DM, WGATE + SZ_SQ, 0, scr7, (int)blockIdx.x * 7 + wave - 1, G * 7, lane, args.in[I_PLE_GNORM] + DM); } }
    SEAM(17);
    if (IN(18)) {
        fox_attn_mfma(PROJ, (const bf16*)(ws + WS_ACT), CUM, OBUF, lds, tid, lane, wave);
        __syncthreads();
        chunk_output(QH, SN, OI, args.in[I_HGRN_NORM], PROJ + C_HG, CD_LDP, OBUF, lds, tid, lane, wave);
    }
    SEAM(18);
    if (IN(19)) { pg8::Gemm g{OBUF, WCDOUT, M, DM, DM, DM}; pg8::StaticOrder S; S.init(M, DM, G, (int)blockIdx.x); pg8::EpiB16 E{YB, DM, nullptr};
        pg8::gemm_phase<pg8::EpiB16, pg8::StaticOrder, true, true>(lds, g, S, E); }
    SEAM(19);
    if (IN(20)) for (int m = gw; m < M; m += ngw) post_row<false>(YB + (size_t)m * DM, H + (size_t)m * DM, nullptr, args.in[I_CD_NPOST], RS + m, lane);
    SEAM(20);
    FFN_PLE(21, 1, true)
#undef IN
#undef SEAM
}

extern "C" void kernel_launch(void* const* d_in, const int* in_sizes, int n_in, void* d_out, int out_size, void* d_ws, size_t ws_size, hipStream_t stream) {
    static int grid = 0;
    if (grid == 0) {
        if (n_in != 33 || out_size != M * DM || ws_size < WS_END) { fprintf(stderr, "kernel_launch: unexpected problem (n_in %d, out %d, ws %zu < %zu)\n", n_in, out_size, ws_size, (size_t)WS_END); grid = -1; return; }
        int dev = 0, cus = 0, per_cu = 0;
        if (hipGetDevice(&dev) != hipSuccess || hipDeviceGetAttribute(&cus, hipDeviceAttributeMultiprocessorCount, dev) != hipSuccess) { grid = -1; return; }
        if (hipFuncSetAttribute((const void*)fwd, hipFuncAttributeMaxDynamicSharedMemorySize, LDS_BYTES) != hipSuccess) { fprintf(stderr, "kernel_launch: hipFuncSetAttribute failed\n"); grid = -1; return; }
        if (hipOccupancyMaxActiveBlocksPerMultiprocessor(&per_cu, (const void*)fwd, NTHR, LDS_BYTES) != hipSuccess || per_cu < 1) fprintf(stderr, "kernel_launch: occupancy query says %d\n", per_cu);
        (void)hipGetLastError();
        if (cus * 8 < 2048) { fprintf(stderr, "kernel_launch: needs >= 256 CUs (GDN chunk prep owns 8 chunks per workgroup)\n"); grid = -1; return; }
        grid = 256;
    }
    if (grid < 0) return;
    (void)hipMemsetAsync((char*)d_ws + WS_CTL, 0, CTL_BYTES, stream);
    Args a{};
    for (int i = 0; i < 33; ++i) a.in[i] = (const float*)d_in[i];
    a.out = (float*)d_out; a.ws = (unsigned char*)d_ws;
#if MK_SINGLE
    a.ph_lo = 0; a.ph_hi = NPHASE;
    hipLaunchKernelGGL(fwd, dim3(grid), dim3(NTHR), LDS_BYTES, stream, a);
#else
    for (int ph = 0; ph < NPHASE; ++ph) { a.ph_lo = ph; a.ph_hi = ph + 1; hipLaunchKernelGGL(fwd, dim3(grid), dim3(NTHR), LDS_BYTES, stream, a); }
#endif
}
```
